# Optimizing an MI355X kernel written in HIP

```python
import jax
import jax.numpy as jnp
from jax import lax
import numpy as np

D_MODEL = 2048
BATCH = 8
SEQ = 4096
DEPTH = 1

PLE_DIM = 256
HEAD_DIM = 128
CONV_WIDTH = D_MODEL // 2
CONV_GROUPS = CONV_WIDTH // HEAD_DIM
CONV_KERNEL = 3
SB_HEADS = (D_MODEL // 2) // HEAD_DIM
SB_WIDTH = SB_HEADS * HEAD_DIM
MIX_WIDTH = CONV_WIDTH + SB_WIDTH
IN_PROJ_WIDTH = 3 * CONV_WIDTH + 3 * SB_WIDTH
SPLIT_POINTS = (CONV_WIDTH, 2 * CONV_WIDTH, 3 * CONV_WIDTH,
                3 * CONV_WIDTH + SB_WIDTH, 3 * CONV_WIDTH + 2 * SB_WIDTH)
Q_BLOCK = 128
ATTN_SCALE = HEAD_DIM ** -0.5
N_EXPERTS = 64
N_GROUPS = 8
EXPERTS_PER_GROUP = N_EXPERTS // N_GROUPS
TOPK_GROUPS = 4
TOP_K = 8
EXPERT_DIM = D_MODEL // 4
SHARED_DIM = D_MODEL // 4
ROUTED_SCALE = 2.5
NORM_EPS = 1e-6

kernel_name = 'hybrid_conv_stickbreaking_moe_ple'


def rms_norm(x, g):
    xf = x.astype(jnp.float32)
    y = xf * lax.rsqrt(jnp.mean(xf * xf, axis=-1, keepdims=True) + NORM_EPS)
    return (y * g.astype(jnp.float32)).astype(x.dtype)


def short_conv_mixer(h, b_gate, c_gate, conv_w):
    seq = h.shape[1]
    u = c_gate * h
    u_pad = jnp.pad(u, ((0, 0), (CONV_KERNEL - 1, 0), (0, 0)))
    y = conv_w[0] * u_pad[:, 0:seq]
    for j in range(1, CONV_KERNEL):
        y = y + conv_w[j] * u_pad[:, j:j + seq]
    return b_gate * y


def stick_breaking_attention(q, k, v):
    seq = q.shape[2]
    outs = []
    for i in range(seq // Q_BLOCK):
        q0 = i * Q_BLOCK
        kv_len = q0 + Q_BLOCK
        qb = q[:, :, q0:kv_len].astype(jnp.float32)
        kb = k[:, :, :kv_len].astype(jnp.float32)
        vb = v[:, :, :kv_len].astype(jnp.float32)
        z = jnp.einsum('bhqd,bhkd->bhqk', qb, kb) * ATTN_SCALE
        t_pos = q0 + jnp.arange(Q_BLOCK)[:, None]
        s_pos = jnp.arange(kv_len)[None, :]
        causal = s_pos < t_pos
        log_keep = jnp.where(causal, jax.nn.log_sigmoid(-z), 0.0)
        log_between = lax.cumsum(log_keep, axis=3, reverse=True) - log_keep
        a = jnp.where(causal, jnp.exp(jax.nn.log_sigmoid(z) + log_between), 0.0)
        outs.append(jnp.einsum('bhqk,bhkd->bhqd', a, vb))
    return jnp.concatenate(outs, axis=2).astype(q.dtype)


def hybrid_mixer(h, norm_g, w_in, conv_w, gnorm_conv_g, gnorm_sb_g, w_out):
    bsz, seq, _ = h.shape
    hn = rms_norm(h, norm_g)
    proj = jnp.einsum('bsd,de->bse', hn, w_in)
    c_h, c_b, c_c, q, k, v = jnp.split(proj, SPLIT_POINTS, axis=-1)
    conv_out = short_conv_mixer(c_h, c_b, c_c, conv_w)

    def heads(t):
        return t.reshape(bsz, seq, SB_HEADS, HEAD_DIM).transpose(0, 2, 1, 3)

    sb = stick_breaking_attention(heads(q), heads(k), heads(v))
    sb = sb.transpose(0, 2, 1, 3).reshape(bsz, seq, SB_WIDTH)
    y = jnp.concatenate([rms_norm(conv_out, gnorm_conv_g), rms_norm(sb, gnorm_sb_g)], axis=-1)
    return jnp.einsum('bse,ed->bsd', y, w_out)


def swiglu(x, w_gate, w_up, w_down):
    return (jax.nn.silu(x @ w_gate) * (x @ w_up)) @ w_down


def moe_ffn(h, norm_g, w_router, router_bias, w_exp_gate, w_exp_up, w_exp_down,
            w_sh_gate, w_sh_up, w_sh_down):
    bsz, seq, d = h.shape
    xt = rms_norm(h, norm_g).reshape(bsz * seq, d)
    scores = jax.nn.sigmoid((xt @ w_router).astype(jnp.float32))
    biased = scores + router_bias.astype(jnp.float32)
    grouped = biased.reshape(-1, N_GROUPS, EXPERTS_PER_GROUP)
    group_score = jnp.sum(lax.top_k(grouped, 2)[0], axis=-1)
    _, top_groups = lax.top_k(group_score, TOPK_GROUPS)
    group_ok = jnp.any(top_groups[..., None] == jnp.arange(N_GROUPS), axis=1)
    expert_ok = jnp.repeat(group_ok, EXPERTS_PER_GROUP, axis=1)
    _, top_idx = lax.top_k(jnp.where(expert_ok, biased, -jnp.inf), TOP_K)
    w = jnp.take_along_axis(scores, top_idx, axis=1)
    w = w / jnp.sum(w, axis=-1, keepdims=True) * ROUTED_SCALE
    gates = jnp.sum(jnp.where(top_idx[..., None] == jnp.arange(N_EXPERTS), w[..., None], 0.0),
                    axis=1).astype(xt.dtype)

    def expert_step(acc, ew):
        wg, wu, wd, g = ew
        return acc + g[:, None] * swiglu(xt, wg, wu, wd), None

    routed, _ = lax.scan(expert_step, jnp.zeros_like(xt), (w_exp_gate, w_exp_up, w_exp_down, gates.T))
    out = routed + swiglu(xt, w_sh_gate, w_sh_up, w_sh_down)
    return out.reshape(bsz, seq, d)


def per_layer_embedding(h, p_i, norm_g, w_gate, w_proj):
    gate = jax.nn.sigmoid(rms_norm(h, norm_g) @ w_gate)
    return gate * (p_i @ w_proj)


def setup_inputs(seed: int = 0) -> dict:
    key = jax.random.key(seed)
    ks = jax.random.split(key, 21)

    def normal(k, shape, scale):
        return jax.random.normal(k, shape, jnp.float32) * scale

    def gain(k, shape):
        return 1.0 + 0.1 * jax.random.normal(k, shape, jnp.float32)

    return {
        'x': normal(ks[0], (BATCH, SEQ, D_MODEL), 1.0),
        'p': normal(ks[1], (DEPTH, BATCH, SEQ, PLE_DIM), 1.0),
        'norm_mix_g': gain(ks[2], (DEPTH, D_MODEL)),
        'w_in': normal(ks[3], (DEPTH, D_MODEL, IN_PROJ_WIDTH), D_MODEL ** -0.5),
        'conv_w': normal(ks[4], (DEPTH, CONV_KERNEL, CONV_WIDTH), CONV_KERNEL ** -0.5),
        'gnorm_conv_g': gain(ks[5], (DEPTH, CONV_WIDTH)),
        'gnorm_sb_g': gain(ks[6], (DEPTH, SB_WIDTH)),
        'w_out': normal(ks[7], (DEPTH, MIX_WIDTH, D_MODEL), MIX_WIDTH ** -0.5),
        'norm_ffn_g': gain(ks[8], (DEPTH, D_MODEL)),
        'w_router': normal(ks[9], (DEPTH, D_MODEL, N_EXPERTS), D_MODEL ** -0.5),
        'router_bias': normal(ks[10], (DEPTH, N_EXPERTS), 0.01),
        'w_exp_gate': normal(ks[11], (DEPTH, N_EXPERTS, D_MODEL, EXPERT_DIM), D_MODEL ** -0.5),
        'w_exp_up': normal(ks[12], (DEPTH, N_EXPERTS, D_MODEL, EXPERT_DIM), D_MODEL ** -0.5),
        'w_exp_down': normal(ks[13], (DEPTH, N_EXPERTS, EXPERT_DIM, D_MODEL), EXPERT_DIM ** -0.5),
        'w_sh_gate': normal(ks[14], (DEPTH, D_MODEL, SHARED_DIM), D_MODEL ** -0.5),
        'w_sh_up': normal(ks[15], (DEPTH, D_MODEL, SHARED_DIM), D_MODEL ** -0.5),
        'w_sh_down': normal(ks[16], (DEPTH, SHARED_DIM, D_MODEL), SHARED_DIM ** -0.5),
        'norm_ple_g': gain(ks[17], (DEPTH, D_MODEL)),
        'w_ple_gate': normal(ks[18], (DEPTH, D_MODEL, D_MODEL), D_MODEL ** -0.5),
        'w_ple_proj': normal(ks[19], (DEPTH, PLE_DIM, D_MODEL), PLE_DIM ** -0.5),
        'norm_final_g': gain(ks[20], (D_MODEL,)),
    }


def reference(x, p, norm_mix_g, w_in, conv_w, gnorm_conv_g, gnorm_sb_g, w_out,
              norm_ffn_g, w_router, router_bias, w_exp_gate, w_exp_up, w_exp_down,
              w_sh_gate, w_sh_up, w_sh_down, norm_ple_g, w_ple_gate, w_ple_proj,
              norm_final_g):
    h = x
    for i in range(DEPTH):
        h = h + hybrid_mixer(h, norm_mix_g[i], w_in[i], conv_w[i], gnorm_conv_g[i],
                             gnorm_sb_g[i], w_out[i])
        h = h + moe_ffn(h, norm_ffn_g[i], w_router[i], router_bias[i], w_exp_gate[i],
                        w_exp_up[i], w_exp_down[i], w_sh_gate[i], w_sh_up[i], w_sh_down[i])
        h = h + per_layer_embedding(h, p[i], norm_ple_g[i], w_ple_gate[i], w_ple_proj[i])
    return rms_norm(h, norm_final_g)
```

```cpp
#include <hip/hip_runtime.h>
#include <cstdio>
#ifndef PROBE_K
#define PROBE_K -1
#endif
#ifndef PH_HI
#define PH_HI 100
#endif
#ifndef FIN_MODE
#define FIN_MODE 0
#endif

#define GAS __attribute__((address_space(1)))
#define LAS __attribute__((address_space(3)))
typedef unsigned short bf16;
typedef unsigned v4u __attribute__((ext_vector_type(4)));
typedef unsigned v2u __attribute__((ext_vector_type(2)));
typedef float f32x4 __attribute__((ext_vector_type(4)));
typedef float f32x2 __attribute__((ext_vector_type(2)));
typedef float f32x16 __attribute__((ext_vector_type(16)));
typedef short bf16x8 __attribute__((ext_vector_type(8)));
typedef short s16x4 __attribute__((ext_vector_type(4)));
typedef GAS unsigned gu32;
#define RLX_AGENT __ATOMIC_RELAXED, __HIP_MEMORY_SCOPE_AGENT
#define LDS_WAIT() asm volatile("s_waitcnt lgkmcnt(0)" ::: "memory")
#define VM_WAIT() asm volatile("s_waitcnt vmcnt(0)" ::: "memory")

constexpr int NB = 8, SEQ = 4096, T = NB * SEQ, D = 2048, NPROJ = 6144, CW = 1024, HD = 128, NH = 8;
constexpr int PLE = 256, NE = 64, ED = 512, TOPK = 8, NSLOT = 9;
constexpr float EPS = 1e-6f;
constexpr int NWAVES = 8, NTHR = 512;
constexpr int MAXTILES = 1216;
constexpr int MAXROWS = MAXTILES * 256;
constexpr int NSLICE = 4, SLW = D / NSLICE;

constexpr size_t MiB = 1u << 20;
constexpr size_t WS_CTL = 0, CTL_ZERO_BYTES = 1 * MiB;
constexpr size_t WS_RMIX = 1 * MiB;
constexpr size_t WS_RFFN = WS_RMIX + 128 * 1024;
constexpr size_t WS_SSQ2 = WS_RFFN + 128 * 1024;
constexpr size_t WS_SSQ3 = WS_SSQ2 + 512 * 1024;
constexpr size_t WS_TOPE = WS_SSQ3 + 4 * MiB;
constexpr size_t WS_TOPW = WS_TOPE + 1 * MiB;
constexpr size_t WS_CNT  = WS_TOPW + 1 * MiB;
constexpr size_t WS_RTOK = WS_CNT + 64 * 1024;
constexpr size_t WS_RW   = WS_RTOK + 1280 * 1024;
constexpr size_t WS_RDST = WS_RW + 1280 * 1024;
constexpr size_t WS_RR   = WS_RDST + 1280 * 1024;
constexpr size_t WS_TILEE = WS_RR + 1280 * 1024;
constexpr size_t WS_WR   = 16 * MiB;
constexpr size_t WS_WIN  = 17 * MiB;
constexpr size_t WS_WOUT = WS_WIN + 24 * MiB;
constexpr size_t WS_WGU  = WS_WOUT + 8 * MiB;
constexpr size_t WS_WDN  = WS_WGU + 260 * MiB;
constexpr size_t WS_WPG  = WS_WDN + 130 * MiB;
constexpr size_t WS_WPP  = WS_WPG + 8 * MiB;
constexpr size_t WS_PB   = WS_WPP + 1 * MiB;
constexpr size_t WS_H1B  = WS_PB + 16 * MiB;
constexpr size_t WS_OVL  = WS_H1B + 128 * MiB;
constexpr size_t WS_PROJ = WS_OVL;
constexpr size_t WS_HPERM = WS_OVL;
constexpr size_t WS_SLOT8 = WS_OVL + 304 * MiB;
constexpr size_t WS_PP   = WS_OVL;
constexpr size_t WS_H3   = WS_OVL + 128 * MiB;
constexpr size_t WS_END  = WS_OVL + 384 * MiB;
constexpr int CW_BAR = 4096;

constexpr int RING_OFF = 0, RING_BYTES = 131072;
constexpr int RT_OFF = 131072, RT_UNITS = 20, RT_BYTES = RT_UNITS * 1024;
constexpr int TE_OFF = RT_OFF + RT_BYTES, TE_BYTES = 4864 + 128;
constexpr int MISC_OFF = TE_OFF + TE_BYTES;
constexpr int LDS_BYTES = MISC_OFF + 128;
static_assert(LDS_BYTES <= 163840, "LDS");

__device__ __forceinline__ unsigned f2bf(float f) { unsigned u = __builtin_bit_cast(unsigned, f); return (u + 0x7fffu + ((u >> 16) & 1u)) >> 16; }
__device__ __forceinline__ unsigned pk2(float lo, float hi) { return f2bf(lo) | (f2bf(hi) << 16); }
__device__ __forceinline__ float bflo(unsigned w) { return __builtin_bit_cast(float, w << 16); }
__device__ __forceinline__ float bfhi(unsigned w) { return __builtin_bit_cast(float, w & 0xffff0000u); }
__device__ __forceinline__ float wave_sum(float v) {
#pragma unroll
    for (int o = 1; o < 64; o <<= 1) v += __shfl_xor(v, o);
    return v;
}
__device__ __forceinline__ float fsigmoid(float v) { return __builtin_amdgcn_rcpf(1.f + __builtin_amdgcn_exp2f(-1.4426950409f * v)); }

#define XB_TMO      128
#define XB_XCNT(j)  (256  + 64 * (j))
#define XB_XSUB(j)  (1280 + 64 * (j))
#define XB_XGEN(j)  (2304 + 64 * (j))
#define XB_TOP      3328
#define XB_TOPGEN   3392
#define XCD_BAR_WORDS 3456
#define XB_SPIN_CAP (1u << 18)
__device__ __forceinline__ unsigned xb_ld(unsigned* p)              { return __hip_atomic_load(p, __ATOMIC_RELAXED, __HIP_MEMORY_SCOPE_AGENT); }
__device__ __forceinline__ unsigned xb_add(unsigned* p, unsigned v) { return __hip_atomic_fetch_add(p, v, __ATOMIC_RELAXED, __HIP_MEMORY_SCOPE_AGENT); }
__device__ __forceinline__ unsigned xb_xcc_id() { return (unsigned)__builtin_amdgcn_s_getreg((3 << 11) | 20) & 0xFu; }
#define XB_SPIN(cond, bar) do { unsigned _sp = 0; while (cond) { __builtin_amdgcn_s_sleep(1); \
    if ((++_sp & 255u) == 0u) { if (xb_ld(&(bar)[XB_TMO])) break; if (_sp > XB_SPIN_CAP) { atomicAdd(&(bar)[XB_TMO], 1u); break; } } } } while (0)
struct XcdBarrier { unsigned* bar; unsigned x; volatile LAS unsigned* st; };
__device__ __forceinline__ XcdBarrier xcd_barrier_post(unsigned* bar, volatile LAS unsigned* st) {
    XcdBarrier b; b.bar = bar; b.x = xb_xcc_id(); b.st = st;
    if (threadIdx.x == 0) (void)xb_add(&bar[XB_XCNT(b.x)], 1u);
    return b;
}
__device__ __forceinline__ void xcd_barrier_complete(unsigned* bar, unsigned x, unsigned& nloc, unsigned& nx) {
    const unsigned G = gridDim.x * gridDim.y * gridDim.z;
    unsigned sum, cnt, mine, sp = 0u;
    for (;;) {
        sum = 0u; cnt = 0u; mine = 0u;
#pragma unroll
        for (unsigned j = 0; j < 16; ++j) { const unsigned c = xb_ld(&bar[XB_XCNT(j)]); sum += c; cnt += (c > 0u) ? 1u : 0u; mine = (j == x) ? c : mine; }
        if (sum == G) break;
        __builtin_amdgcn_s_sleep(1);
        if ((++sp & 255u) == 0u) { if (xb_ld(&bar[XB_TMO])) break; if (sp > XB_SPIN_CAP) { atomicAdd(&bar[XB_TMO], 1u); break; } }
    }
    nloc = mine > 0u ? mine : 1u; nx = cnt > 0u ? cnt : 1u;
}
__device__ __forceinline__ void xcd_barrier(const XcdBarrier& b) {
    asm volatile("s_waitcnt vmcnt(0)" ::: "memory");
    __syncthreads();
    if (threadIdx.x == 0) {
        unsigned* bar = b.bar;
        __builtin_amdgcn_s_waitcnt(0);
        unsigned nloc = b.st[0], nx = b.st[1];
        if (nloc == 0u) { xcd_barrier_complete(bar, b.x, nloc, nx); b.st[0] = nloc; b.st[1] = nx; }
        const unsigned old = xb_add(&bar[XB_XSUB(b.x)], 1u);
        const unsigned gen = old / nloc;
        if (old + 1u == (gen + 1u) * nloc) {
            __builtin_amdgcn_fence(__ATOMIC_RELEASE, "agent");
            asm volatile("s_waitcnt vmcnt(0)" ::: "memory");
            const unsigned og = xb_add(&bar[XB_TOP], 1u);
            const unsigned tg = og / nx;
            if (og + 1u == (tg + 1u) * nx) xb_add(&bar[XB_TOPGEN], 1u);
            else XB_SPIN(xb_ld(&bar[XB_TOPGEN]) == tg, bar);
            __builtin_amdgcn_fence(__ATOMIC_ACQUIRE, "agent");
            xb_add(&bar[XB_XGEN(b.x)], 1u);
            asm volatile("s_waitcnt vmcnt(0)" ::: "memory");
        } else {
            XB_SPIN(xb_ld(&bar[XB_XGEN(b.x)]) == gen, bar);
            __builtin_amdgcn_fence(__ATOMIC_ACQUIRE, "agent");
            asm volatile("s_waitcnt vmcnt(0)" ::: "memory");
        }
    }
    __syncthreads();
}

namespace pg8 {
constexpr int BM = 256, BK = 64, HALF = 128, HTB = HALF * BK * 2, STAGE_BYTES = 8 * HTB, NXCD = 8, WGM = 8;
__device__ __forceinline__ int lds_byte(int r, int c) { const int st = (r >> 4) * 2 + (c >> 5), rr = r & 15, cc = c & 31, ob = rr * 64 + cc * 2; return st * 1024 + (ob ^ (((ob >> 9) & 1) << 5)); }
__device__ __forceinline__ void stage_rc(int b, int& R, int& C) { const int st = b / 1024, sb = b % 1024, swz = sb ^ (((sb >> 9) & 1) << 5); R = (st >> 1) * 16 + swz / 64; C = (st & 1) * 32 + (swz % 64) / 2; }
__device__ __forceinline__ int perm32(int rho) { const int n = rho >> 4, i = rho & 15; return 8 * (i >> 2) + 4 * n + (i & 3); }

struct Unit { int pm, pn, e; };

__device__ __forceinline__ bool order_next(int i, int G, int c, int nM, int nN, int& pm, int& pn) {
    const int nwg = nM * nN; const long L = (long)i * G + c; if (L >= nwg) return false;
    int wgid = (int)L; { const int q = nwg / NXCD, r = nwg % NXCD, xcd = wgid % NXCD, off = wgid / NXCD; wgid = (xcd < r ? xcd * (q + 1) : r * (q + 1) + (xcd - r) * q) + off; }
    const int nig = WGM * nN, gid = wgid / nig, fm = gid * WGM, gsz = (nM - fm) < WGM ? (nM - fm) : WGM;
    pm = fm + ((wgid % nig) % gsz); pn = (wgid % nig) / gsz; return true;
}

struct DenseSched {
    int nM, nN, G, c, K; const char* Bt;
    __device__ __forceinline__ bool next(int i, Unit& u) const { u.e = 0; return order_next(i, G, c, nM, nN, u.pm, u.pn); }
    __device__ __forceinline__ const char* bbase(const Unit& u) const { return Bt + (size_t)u.pn * (BM * 2) * K; }
    __device__ __forceinline__ void aoffs(int ui, const Unit& u, const int (&R)[2], const int (&C)[2], unsigned (&ao)[2][2]) const {
#pragma unroll
        for (int h = 0; h < 2; ++h)
#pragma unroll
            for (int i = 0; i < 2; ++i) ao[h][i] = (unsigned)((u.pm * BM + h * HALF + R[i]) * K + C[i]) * 2u;
    }
};
template <bool GATHER> struct GroupSched {
    int nM, nN, G, c, K, pn0; const char* Bt; size_t estride; const LAS int* te; const LAS unsigned* rt;
    __device__ __forceinline__ bool next(int i, Unit& u) const { if (!order_next(i, G, c, nM, nN, u.pm, u.pn)) return false; u.e = __builtin_amdgcn_readfirstlane(te[u.pm]); return true; }
    __device__ __forceinline__ const char* bbase(const Unit& u) const { return Bt + (size_t)u.e * estride + (size_t)(pn0 + u.pn) * (BM * 2) * K; }
    __device__ __forceinline__ void aoffs(int ui, const Unit& u, const int (&R)[2], const int (&C)[2], unsigned (&ao)[2][2]) const {
#pragma unroll
        for (int h = 0; h < 2; ++h)
#pragma unroll
            for (int i = 0; i < 2; ++i) {
                if (GATHER) ao[h][i] = rt[ui * 256 + h * HALF + R[i]] + (unsigned)C[i] * 2u;
                else ao[h][i] = (unsigned)((u.pm * BM + h * HALF + R[i]) * K + C[i]) * 2u;
            }
    }
};

__device__ __forceinline__ unsigned cvt_pk_bf16(float lo, float hi) { unsigned r; asm volatile("v_cvt_pk_bf16_f32 %0, %1, %2" : "=v"(r) : "v"(lo), "v"(hi)); return r; }

template <class Epi, class Sched>
__device__ __forceinline__ void gemm_phase(LAS unsigned char* lds, const char* Abase, const int K, const Sched& S, const Epi& E) {
    const int tid = threadIdx.x, wid = __builtin_amdgcn_readfirstlane(tid >> 6), lane = tid & 63, wr = wid >> 2, wc = wid & 3, fr = lane & 15, fq = lane >> 4;
    const int nt = K / BK;
    int sR[2], sC[2]; unsigned voffB[2];
#pragma unroll
    for (int i = 0; i < 2; ++i) { int R, C; stage_rc(tid * 16 + i * 8192, R, C); sR[i] = R; sC[i] = C; const int Rb = (R & ~31) + perm32(R & 31); voffB[i] = (unsigned)(Rb * K + C) * 2u; }
    const size_t kstep = (size_t)(BK * 2);
    const size_t hstep = (size_t)HALF * K * 2;
    const unsigned ldsw = (unsigned)wid * 1024u;
    const int aoff = lds_byte(wr * 64 + fr, fq * 8), boff = lds_byte(wc * 32 + fr, fq * 8);
#define PG8_SA(b, h) (((b) * 2 + (h)) * HTB)
#define PG8_SB(b, h) ((4 + (b) * 2 + (h)) * HTB)
#define PG8_STAGE(bufoff, gbase, voff) do { _Pragma("unroll") for (int _i = 0; _i < 2; ++_i) \
        __builtin_amdgcn_global_load_lds((const unsigned*)((const char*)(gbase) + (voff)[_i]), (LAS unsigned*)(lds + (bufoff) + ldsw + _i * 8192), 16, 0, 0); } while (0)
#define PG8_LDA(dst, b, h) do { _Pragma("unroll") for (int m = 0; m < 4; ++m) _Pragma("unroll") for (int k = 0; k < 2; ++k) dst[m][k] = *(const LAS bf16x8*)(lds + PG8_SA(b, h) + aoff + m * 2048 + k * 1024); } while (0)
#define PG8_LDB(dst, b, h) do { _Pragma("unroll") for (int n = 0; n < 2; ++n) _Pragma("unroll") for (int k = 0; k < 2; ++k) dst[n][k] = *(const LAS bf16x8*)(lds + PG8_SB(b, h) + boff + n * 2048 + k * 1024); } while (0)
#define PG8_MMA(ai, bj, At, Bt) do { __builtin_amdgcn_s_setprio(1); _Pragma("unroll") for (int m = 0; m < 4; ++m) _Pragma("unroll") for (int n = 0; n < 2; ++n) _Pragma("unroll") for (int k = 0; k < 2; ++k) \
        acc[ai][bj][m][n] = __builtin_amdgcn_mfma_f32_16x16x32_bf16(Bt[n][k], At[m][k], acc[ai][bj][m][n], 0, 0, 0); __builtin_amdgcn_s_setprio(0); } while (0)
#define PG8_WAIT_V(n) asm volatile("s_waitcnt vmcnt(" #n ")" ::: "memory")
#define PG8_WAIT_L(n) asm volatile("s_waitcnt lgkmcnt(" #n ")" ::: "memory")
#define PG8_BAR __builtin_amdgcn_s_barrier()
#define PG8_SCHED __builtin_amdgcn_sched_barrier(0)
    Unit cur, nxt; int ui = 0;
    if (!S.next(0, cur)) return;
    f32x4 acc[2][2][4][2];
#pragma unroll
    for (int a = 0; a < 2; ++a)
#pragma unroll
        for (int b = 0; b < 2; ++b)
#pragma unroll
            for (int m = 0; m < 4; ++m)
#pragma unroll
                for (int n = 0; n < 2; ++n) acc[a][b][m][n] = (f32x4){0.f, 0.f, 0.f, 0.f};
    bf16x8 At[4][2], B0[2][2], B1[2][2];
    unsigned ca[2][2], na[2][2];
    S.aoffs(0, cur, sR, sC, ca);
    const char* cB = S.bbase(cur);
    PG8_STAGE(PG8_SB(0, 0), cB, voffB); PG8_STAGE(PG8_SA(0, 0), Abase, ca[0]); PG8_STAGE(PG8_SB(0, 1), cB + hstep, voffB); PG8_STAGE(PG8_SA(0, 1), Abase, ca[1]);
    if (wr == 1) PG8_BAR;
    PG8_WAIT_V(4); PG8_BAR;
    PG8_STAGE(PG8_SB(1, 0), cB + kstep, voffB); PG8_STAGE(PG8_SA(1, 0), Abase + kstep, ca[0]); PG8_STAGE(PG8_SB(1, 1), cB + hstep + kstep, voffB);
    PG8_WAIT_V(6); PG8_BAR;
    for (;;) {
        const bool has_next = S.next(ui + 1, nxt);
        const char* nB = has_next ? S.bbase(nxt) : cB;
        if (has_next) S.aoffs(ui + 1, nxt, sR, sC, na);
        else {
#pragma unroll
            for (int h = 0; h < 2; ++h)
#pragma unroll
                for (int i = 0; i < 2; ++i) na[h][i] = ca[h][i];
        }
        for (int t = 0; t < nt; t += 2) {
            const bool last = (t == nt - 2);
            const char* a1 = Abase + (size_t)(t + 1) * kstep;
            const char* a2 = last ? Abase : Abase + (size_t)(t + 2) * kstep; const char* b2 = last ? nB : cB + (size_t)(t + 2) * kstep;
            const char* a3 = a2 + kstep; const char* b3 = b2 + kstep;
            PG8_LDB(B0, 0, 0); PG8_SCHED; PG8_LDA(At, 0, 0); PG8_STAGE(PG8_SA(1, 1), a1, ca[1]);
            PG8_WAIT_L(8); PG8_BAR; PG8_WAIT_L(0); PG8_MMA(0, 0, At, B0); PG8_BAR; PG8_SCHED;
            if (last) {
#pragma unroll
                for (int h = 0; h < 2; ++h)
#pragma unroll
                    for (int i = 0; i < 2; ++i) ca[h][i] = na[h][i];
            }
            PG8_LDB(B1, 0, 1); PG8_STAGE(PG8_SB(0, 0), b2, voffB);
            PG8_BAR; PG8_WAIT_L(0); PG8_MMA(0, 1, At, B1); PG8_BAR;
            PG8_LDA(At, 0, 1); PG8_STAGE(PG8_SA(0, 0), a2, ca[0]);
            PG8_BAR; PG8_WAIT_L(0); PG8_MMA(1, 0, At, B0); PG8_BAR; PG8_SCHED;
            PG8_STAGE(PG8_SB(0, 1), b2 + hstep, voffB);
            PG8_WAIT_V(6); PG8_BAR; PG8_MMA(1, 1, At, B1); PG8_BAR;
            PG8_LDB(B0, 1, 0); PG8_SCHED; PG8_LDA(At, 1, 0); PG8_STAGE(PG8_SA(0, 1), a2, ca[1]);
            PG8_WAIT_L(8); PG8_BAR; PG8_WAIT_L(0); PG8_MMA(0, 0, At, B0); PG8_BAR; PG8_SCHED;
            PG8_LDB(B1, 1, 1); PG8_STAGE(PG8_SB(1, 0), b3, voffB);
            PG8_BAR; PG8_WAIT_L(0); PG8_MMA(0, 1, At, B1); PG8_BAR;
            PG8_LDA(At, 1, 1); PG8_STAGE(PG8_SA(1, 0), a3, ca[0]);
            PG8_BAR; PG8_WAIT_L(0); PG8_MMA(1, 0, At, B0); PG8_BAR; PG8_SCHED;
            PG8_STAGE(PG8_SB(1, 1), b3 + hstep, voffB);
            PG8_WAIT_V(6); PG8_BAR; PG8_MMA(1, 1, At, B1); PG8_BAR;
        }
        E(acc, cur, wr, wc, fr, fq);
        if (!has_next) break;
#pragma unroll
        for (int a = 0; a < 2; ++a)
#pragma unroll
            for (int b = 0; b < 2; ++b)
#pragma unroll
                for (int m = 0; m < 4; ++m)
#pragma unroll
                    for (int n = 0; n < 2; ++n) acc[a][b][m][n] = (f32x4){0.f, 0.f, 0.f, 0.f};
        cur = nxt; cB = nB; ++ui;
    }
    PG8_WAIT_V(0);
    if (wr == 0) PG8_BAR;
    PG8_BAR;
#undef PG8_SA
#undef PG8_SB
#undef PG8_STAGE
#undef PG8_LDA
#undef PG8_LDB
#undef PG8_MMA
#undef PG8_WAIT_V
#undef PG8_WAIT_L
#undef PG8_BAR
#undef PG8_SCHED
}

struct EpiBf16Scale {
    bf16* O; int ldc; const float* rs;
    __device__ __forceinline__ void operator()(const f32x4 (&acc)[2][2][4][2], const Unit& u, int wr, int wc, int fr, int fq) const {
        const int row0 = u.pm * BM + wr * 64 + fr, col0 = u.pn * BM + wc * 32 + 8 * fq;
#pragma unroll
        for (int ai = 0; ai < 2; ++ai)
#pragma unroll
            for (int m = 0; m < 4; ++m) { const int row = row0 + ai * HALF + m * 16; const float s = rs ? rs[row] : 1.f; bf16* rowp = O + (size_t)row * ldc + col0;
#pragma unroll
                for (int bj = 0; bj < 2; ++bj) { const f32x4 v0 = acc[ai][bj][m][0] * s, v1 = acc[ai][bj][m][1] * s;
                    v4u w; w.x = cvt_pk_bf16(v0[0], v0[1]); w.y = cvt_pk_bf16(v0[2], v0[3]); w.z = cvt_pk_bf16(v1[0], v1[1]); w.w = cvt_pk_bf16(v1[2], v1[3]);
                    *(v4u*)(rowp + bj * HALF) = w; } }
    }
};
struct EpiResF32 {
    bf16* O; const float* X; int ldc;
    __device__ __forceinline__ void operator()(const f32x4 (&acc)[2][2][4][2], const Unit& u, int wr, int wc, int fr, int fq) const {
        const int row0 = u.pm * BM + wr * 64 + fr, col0 = u.pn * BM + wc * 32 + 8 * fq;
#pragma unroll
        for (int ai = 0; ai < 2; ++ai)
#pragma unroll
            for (int m = 0; m < 4; ++m) { const size_t ro = (size_t)(row0 + ai * HALF + m * 16) * ldc + col0;
#pragma unroll
                for (int bj = 0; bj < 2; ++bj) { const f32x4 x0 = *(const f32x4*)(X + ro + bj * HALF), x1 = *(const f32x4*)(X + ro + bj * HALF + 4);
                    const f32x4 v0 = acc[ai][bj][m][0] + x0, v1 = acc[ai][bj][m][1] + x1;
                    v4u w; w.x = cvt_pk_bf16(v0[0], v0[1]); w.y = cvt_pk_bf16(v0[2], v0[3]); w.z = cvt_pk_bf16(v1[0], v1[1]); w.w = cvt_pk_bf16(v1[2], v1[3]);
                    *(v4u*)(O + ro + bj * HALF) = w; } }
    }
};
struct EpiGateUp {
    bf16* Hp; const float* rr;
    __device__ __forceinline__ void operator()(const f32x4 (&acc)[2][2][4][2], const Unit& u, int wr, int wc, int fr, int fq) const {
        const int row0 = u.pm * BM + wr * 64 + fr, col0 = u.pn * HALF + wc * 32 + 8 * fq;
#pragma unroll
        for (int ai = 0; ai < 2; ++ai)
#pragma unroll
            for (int m = 0; m < 4; ++m) { const int row = row0 + ai * HALF + m * 16; const float s = rr[row];
                float h[8];
#pragma unroll
                for (int n = 0; n < 2; ++n)
#pragma unroll
                    for (int j = 0; j < 4; ++j) { const float g = acc[ai][0][m][n][j] * s, up = acc[ai][1][m][n][j] * s; h[n * 4 + j] = g * fsigmoid(g) * up; }
                v4u w; w.x = cvt_pk_bf16(h[0], h[1]); w.y = cvt_pk_bf16(h[2], h[3]); w.z = cvt_pk_bf16(h[4], h[5]); w.w = cvt_pk_bf16(h[6], h[7]);
                *(v4u*)(Hp + (size_t)row * ED + col0) = w; }
    }
};
struct EpiDown {
    bf16* S0; bf16* S8; const float* rw; const int* rdst;
    __device__ __forceinline__ void operator()(const f32x4 (&acc)[2][2][4][2], const Unit& u, int wr, int wc, int fr, int fq) const {
        const int row0 = u.pm * BM + wr * 64 + fr, col0 = u.pn * BM + wc * 32 + 8 * fq;
#pragma unroll
        for (int ai = 0; ai < 2; ++ai)
#pragma unroll
            for (int m = 0; m < 4; ++m) { const int row = row0 + ai * HALF + m * 16; const float s = rw[row]; const int dst = rdst[row];
                if (dst >= 0) { bf16* rowp = (dst < 8 * T ? S0 + (size_t)dst * SLW : S8 + (size_t)(dst - 8 * T) * SLW) + col0;
#pragma unroll
                    for (int bj = 0; bj < 2; ++bj) { const f32x4 v0 = acc[ai][bj][m][0] * s, v1 = acc[ai][bj][m][1] * s;
                        v4u w; w.x = cvt_pk_bf16(v0[0], v0[1]); w.y = cvt_pk_bf16(v0[2], v0[3]); w.z = cvt_pk_bf16(v1[0], v1[1]); w.w = cvt_pk_bf16(v1[2], v1[3]);
                        *(v4u*)(rowp + bj * HALF) = w; } } }
    }
};
struct EpiPle {
    bf16* H3; const bf16* H2; const bf16* PP; const float* ssq2; float* ssq3;
    __device__ __forceinline__ void operator()(const f32x4 (&acc)[2][2][4][2], const Unit& u, int wr, int wc, int fr, int fq) const {
        const int row0 = u.pm * BM + wr * 64 + fr, col0 = u.pn * BM + wc * 32 + 8 * fq;
#pragma unroll
        for (int ai = 0; ai < 2; ++ai)
#pragma unroll
            for (int m = 0; m < 4; ++m) { const int row = row0 + ai * HALF + m * 16;
                const float r = __builtin_amdgcn_rsqf((ssq2[row] + ssq2[T + row] + ssq2[2 * T + row] + ssq2[3 * T + row]) * (1.f / D) + EPS);
                const size_t ro = (size_t)row * D + col0; float ss = 0.f;
#pragma unroll
                for (int bj = 0; bj < 2; ++bj) { const v4u h2 = *(const v4u*)(H2 + ro + bj * HALF), pp = *(const v4u*)(PP + ro + bj * HALF);
                    float o[8];
#pragma unroll
                    for (int q = 0; q < 4; ++q) { const int n = q >> 1, j = (q & 1) * 2;
                        const float g0 = fsigmoid(acc[ai][bj][m][n][j] * r), g1 = fsigmoid(acc[ai][bj][m][n][j + 1] * r);
                        o[2 * q] = bflo(h2[q]) + g0 * bflo(pp[q]); o[2 * q + 1] = bfhi(h2[q]) + g1 * bfhi(pp[q]);
                        ss += o[2 * q] * o[2 * q] + o[2 * q + 1] * o[2 * q + 1]; }
                    v4u w; w.x = cvt_pk_bf16(o[0], o[1]); w.y = cvt_pk_bf16(o[2], o[3]); w.z = cvt_pk_bf16(o[4], o[5]); w.w = cvt_pk_bf16(o[6], o[7]);
                    *(v4u*)(H3 + ro + bj * HALF) = w; }
                ss += __shfl_xor(ss, 16); ss += __shfl_xor(ss, 32);
                if (fq == 0) ssq3[(size_t)(u.pn * 4 + wc) * T + row] = ss; }
    }
};
}

struct Frame {
    LAS unsigned char* lds;
    int tid, lane, wave, G, bx;
    unsigned char* ws;
    const float* in[21];
    float* out;
};
enum { I_X = 0, I_P, I_NMIX, I_WIN, I_CONVW, I_GCONV, I_GSB, I_WOUT, I_NFFN, I_WR, I_RB, I_WEG, I_WEU, I_WED, I_WSG, I_WSU, I_WSD, I_NPLE, I_WPG, I_WPP, I_NFIN };

__device__ __forceinline__ void p0_transpose_item(const float* W, int N, bf16* WT, int ldk, int k0, int n0, int row_off, const float* g64, LAS float* scr, int lane) {
#pragma unroll 8
    for (int i = 0; i < 32; ++i) { const int kk = 2 * i + (lane >> 5); float v = W[(size_t)(k0 + kk) * N + n0 + (lane & 31)]; if (g64) v *= g64[kk]; scr[kk * 33 + (lane & 31)] = v; }
    LDS_WAIT(); asm volatile("" ::: "memory");
    const int c = lane & 7;
#pragma unroll
    for (int j = 0; j < 4; ++j) { const int n = (lane >> 3) + 8 * j; const LAS float* s = scr + (8 * c) * 33 + n;
        v4u o; o.x = pk2(s[0 * 33], s[1 * 33]); o.y = pk2(s[2 * 33], s[3 * 33]); o.z = pk2(s[4 * 33], s[5 * 33]); o.w = pk2(s[6 * 33], s[7 * 33]);
        *(GAS v4u*)(WT + (size_t)(row_off + n) * ldk + k0 + 8 * c) = o; }
    LDS_WAIT(); asm volatile("" ::: "memory");
}
constexpr int P0_I_WIN = (D / 64) * (NPROJ / 32), P0_I_WOUT = (D / 64) * (D / 32), P0_I_WR = (D / 64) * (NE / 32), P0_I_WPG = (D / 64) * (D / 32), P0_I_WPP = (PLE / 64) * (D / 32);
constexpr int P0_I_EXP = 1536, P0_NITEMS = P0_I_WIN + P0_I_WOUT + P0_I_WR + P0_I_WPG + P0_I_WPP + 65 * P0_I_EXP;
__device__ __forceinline__ void p0_item(Frame& F, int it, LAS float* scr) {
    unsigned char* ws = F.ws; const int lane = F.lane;
    if (it < P0_I_WIN) { const int kb = it / (NPROJ / 32), nb = it % (NPROJ / 32); p0_transpose_item(F.in[I_WIN], NPROJ, (bf16*)(ws + WS_WIN), D, 64 * kb, 32 * nb, 32 * nb, F.in[I_NMIX] + 64 * kb, scr, lane); return; } it -= P0_I_WIN;
    if (it < P0_I_WOUT) { const int kb = it / (D / 32), nb = it % (D / 32), k0 = 64 * kb; const float* g = k0 < CW ? F.in[I_GCONV] + k0 : F.in[I_GSB] + (k0 - CW);
        p0_transpose_item(F.in[I_WOUT], D, (bf16*)(ws + WS_WOUT), D, k0, 32 * nb, 32 * nb, g, scr, lane); return; } it -= P0_I_WOUT;
    if (it < P0_I_WR) { const int kb = it / (NE / 32), nb = it % (NE / 32); p0_transpose_item(F.in[I_WR], NE, (bf16*)(ws + WS_WR), D, 64 * kb, 32 * nb, 32 * nb, F.in[I_NFFN] + 64 * kb, scr, lane); return; } it -= P0_I_WR;
    if (it < P0_I_WPG) { const int kb = it / (D / 32), nb = it % (D / 32); p0_transpose_item(F.in[I_WPG], D, (bf16*)(ws + WS_WPG), D, 64 * kb, 32 * nb, 32 * nb, F.in[I_NPLE] + 64 * kb, scr, lane); return; } it -= P0_I_WPG;
    if (it < P0_I_WPP) { const int kb = it / (D / 32), nb = it % (D / 32); p0_transpose_item(F.in[I_WPP], D, (bf16*)(ws + WS_WPP), PLE, 64 * kb, 32 * nb, 32 * nb, nullptr, scr, lane); return; } it -= P0_I_WPP;
    const int e = it / P0_I_EXP, r = it % P0_I_EXP, sub = r / 512, q = r % 512;
    if (sub < 2) {
        const float* src = e < NE ? (sub == 0 ? F.in[I_WEG] : F.in[I_WEU]) + (size_t)e * D * ED : (sub == 0 ? F.in[I_WSG] : F.in[I_WSU]);
        const int kb = q / (ED / 32), nb = q % (ED / 32), n0 = 32 * nb, ro = 256 * (n0 / 128) + (n0 % 128) + (sub == 1 ? 128 : 0);
        p0_transpose_item(src, ED, (bf16*)(ws + WS_WGU) + (size_t)e * 1024 * D, D, 64 * kb, n0, ro, F.in[I_NFFN] + 64 * kb, scr, lane);
    } else {
        const float* src = e < NE ? F.in[I_WED] + (size_t)e * ED * D : F.in[I_WSD];
        const int kb = q / (D / 32), nb = q % (D / 32);
        p0_transpose_item(src, D, (bf16*)(ws + WS_WDN) + (size_t)e * D * ED, ED, 64 * kb, 32 * nb, 32 * nb, nullptr, scr, lane);
    }
}
__device__ __forceinline__ void p0_prologue(Frame& F) {
    LAS float* scr = (LAS float*)(F.lds + RING_OFF + F.wave * 16384);
    const int gw = F.bx * NWAVES + F.wave, NGW = F.G * NWAVES;
    {
        bf16* XB = (bf16*)F.out; float* rmix = (float*)(F.ws + WS_RMIX); const float* x = F.in[I_X];
        for (int m = gw; m < T; m += NGW) {
            const GAS f32x4* xr = (const GAS f32x4*)(x + (size_t)m * D) + F.lane;
            f32x4 v[8]; float s = 0.f;
#pragma unroll
            for (int j = 0; j < 8; ++j) { v[j] = xr[64 * j]; s += (v[j].x * v[j].x + v[j].y * v[j].y) + (v[j].z * v[j].z + v[j].w * v[j].w); }
            s = wave_sum(s);
            if (F.lane == 0) rmix[m] = __builtin_amdgcn_rsqf(s * (1.f / D) + EPS);
            GAS v2u* o8 = (GAS v2u*)(XB + (size_t)m * D) + F.lane;
#pragma unroll
            for (int j = 0; j < 8; ++j) { v2u w; w.x = pk2(v[j].x, v[j].y); w.y = pk2(v[j].z, v[j].w); o8[64 * j] = w; }
        }
    }
    {
        const float* p = F.in[I_P]; bf16* PB = (bf16*)(F.ws + WS_PB);
        const int nchunk = T * PLE / 8, gt = F.bx * NTHR + F.tid, NGT = F.G * NTHR;
        for (int c = gt; c < nchunk; c += NGT) { const f32x4 a = *(const GAS f32x4*)(p + (size_t)c * 8), b = *(const GAS f32x4*)(p + (size_t)c * 8 + 4);
            v4u w; w.x = pk2(a.x, a.y); w.y = pk2(a.z, a.w); w.z = pk2(b.x, b.y); w.w = pk2(b.z, b.w); *(GAS v4u*)(PB + (size_t)c * 8) = w; }
    }
    for (int it = gw; it < P0_NITEMS; it += NGW) p0_item(F, it, scr);
}

__device__ __forceinline__ unsigned off_b(unsigned row, unsigned ch) { return 256u * row + 16u * (ch ^ (((row & 3) << 2) | ((row >> 2) & 3))); }
#define MFMA32(a, b, c) __builtin_amdgcn_mfma_f32_32x32x16_bf16((a), (b), (c), 0, 0, 0)

__device__ __forceinline__ void conv_item(Frame& F, int it) {
    const bf16* proj = (const bf16*)(F.ws + WS_PROJ); bf16* ymix = (bf16*)F.out + (size_t)T * D;
    const float* cw = F.in[I_CONVW]; const int lane = F.lane;
    float w0[16], w1[16], w2[16], u1[16], u2[16];
#pragma unroll
    for (int j = 0; j < 2; ++j)
#pragma unroll
        for (int i = 0; i < 8; ++i) { const int c = 512 * j + 8 * lane + i; w0[8 * j + i] = cw[c]; w1[8 * j + i] = cw[CW + c]; w2[8 * j + i] = cw[2 * CW + c]; u1[8 * j + i] = 0.f; u2[8 * j + i] = 0.f; }
    const int t0 = 16 * it; const bool seq_start = (t0 & (SEQ - 1)) == 0;
    for (int tt = -2; tt < 16; ++tt) {
        if (tt < 0 && seq_start) continue;
        const size_t t = (size_t)(t0 + tt);
        const bf16* pr = proj + t * NPROJ + 8 * lane;
        float u[16], cb[16];
#pragma unroll
        for (int j = 0; j < 2; ++j) { const v4u h = *(const GAS v4u*)(pr + 512 * j), c = *(const GAS v4u*)(pr + 2 * CW + 512 * j);
#pragma unroll
            for (int q = 0; q < 4; ++q) { u[8 * j + 2 * q] = bflo(h[q]) * bflo(c[q]); u[8 * j + 2 * q + 1] = bfhi(h[q]) * bfhi(c[q]); } }
        if (tt >= 0) {
#pragma unroll
            for (int j = 0; j < 2; ++j) { const v4u b = *(const GAS v4u*)(pr + CW + 512 * j);
#pragma unroll
                for (int q = 0; q < 4; ++q) { cb[8 * j + 2 * q] = bflo(b[q]); cb[8 * j + 2 * q + 1] = bfhi(b[q]); } }
            float y[16], ss = 0.f;
#pragma unroll
            for (int i = 0; i < 16; ++i) { y[i] = cb[i] * (w0[i] * u2[i] + w1[i] * u1[i] + w2[i] * u[i]); ss += y[i] * y[i]; }
            const float r = __builtin_amdgcn_rsqf(wave_sum(ss) * (1.f / CW) + EPS);
            bf16* yo = ymix + t * D + 8 * lane;
#pragma unroll
            for (int j = 0; j < 2; ++j) { v4u w; w.x = pk2(y[8 * j] * r, y[8 * j + 1] * r); w.y = pk2(y[8 * j + 2] * r, y[8 * j + 3] * r); w.z = pk2(y[8 * j + 4] * r, y[8 * j + 5] * r); w.w = pk2(y[8 * j + 6] * r, y[8 * j + 7] * r);
                *(GAS v4u*)(yo + 512 * j) = w; }
        }
#pragma unroll
        for (int i = 0; i < 16; ++i) { u2[i] = u1[i]; u1[i] = u[i]; }
    }
}

__device__ __forceinline__ bf16x8 pack8(float a0, float a1, float a2, float a3, float a4, float a5, float a6, float a7) {
    v4u p; p.x = pk2(a0, a1); p.y = pk2(a2, a3); p.z = pk2(a4, a5); p.w = pk2(a6, a7); return __builtin_bit_cast(bf16x8, p);
}
__device__ __forceinline__ void tr_read4(unsigned a_t0, unsigned a_t1, s16x4& r00, s16x4& r01, s16x4& r10, s16x4& r11) {
    asm volatile("ds_read_b64_tr_b16 %0, %4\n\tds_read_b64_tr_b16 %1, %5\n\tds_read_b64_tr_b16 %2, %4 offset:4096\n\tds_read_b64_tr_b16 %3, %5 offset:4096\n\ts_waitcnt lgkmcnt(0)"
                 : "=&v"(r00), "=&v"(r01), "=&v"(r10), "=&v"(r11) : "v"(a_t0), "v"(a_t1) : "memory");
}
constexpr float ATT_C = 0.08838834764831845f * 1.4426950408889634f;
constexpr float ATT_EXIT = -152.f;

__device__ __forceinline__ void attn_unit(Frame& F, int b, int qblk, int parity) {
    const int lane = F.lane, h = F.wave, r = lane & 31, hh = lane >> 5;
    const bf16* proj = (const bf16*)(F.ws + WS_PROJ); bf16* ymix = (bf16*)F.out + (size_t)T * D;
    const size_t rowbase = (size_t)b * SEQ; const int t0 = qblk * 32;
    LAS unsigned char* kt = F.lds + h * 16384; LAS unsigned char* vt = kt + 8192;
    LAS float* XS = (LAS float*)(F.lds + RT_OFF) + parity * 256;
    bf16x8 qf[8];
    { const bf16* qp = proj + (rowbase + t0 + r) * NPROJ + 3 * CW + h * HD + 8 * hh;
#pragma unroll
      for (int kk = 0; kk < 8; ++kk) qf[kk] = *(const GAS bf16x8*)(qp + 16 * kk); }
    f32x16 oacc[4];
#pragma unroll
    for (int c = 0; c < 4; ++c)
#pragma unroll
        for (int i = 0; i < 16; ++i) oacc[c][i] = 0.f;
    float L = 0.f;
    const unsigned pr = (unsigned)((r & 19) | ((r & 4) << 1) | ((r & 8) >> 1));
    const unsigned ktb = (unsigned)(size_t)kt, vtb = (unsigned)(size_t)vt;
    unsigned va[2][4];
    { const unsigned blk = (lane >> 4) & 1, q = (lane & 15) >> 2, p = lane & 3;
#pragma unroll
      for (int t = 0; t < 2; ++t)
#pragma unroll
          for (int c = 0; c < 4; ++c) va[t][c] = vtb + off_b(8 * hh + 4 * t + q, 4 * c + 2 * blk + (p >> 1)) + 8 * (p & 1); }
    for (int kti = qblk; kti >= 0; --kti) {
        const int s0 = kti * 32;
        {
            v4u kreg[8], vreg[8];
            const bf16* kp = proj + (rowbase + s0 + (lane >> 4)) * NPROJ + 4 * CW + h * HD + (lane & 15) * 8;
#pragma unroll
            for (int i = 0; i < 8; ++i) { kreg[i] = *(const GAS v4u*)(kp + (size_t)(4 * i) * NPROJ); vreg[i] = *(const GAS v4u*)(kp + (size_t)(4 * i) * NPROJ + CW); }
#pragma unroll
            for (int i = 0; i < 8; ++i) { const unsigned o = off_b(4 * i + (lane >> 4), lane & 15); *(LAS v4u*)(kt + o) = kreg[i]; *(LAS v4u*)(vt + o) = vreg[i]; }
        }
        LDS_WAIT();
        f32x16 x;
#pragma unroll
        for (int i = 0; i < 16; ++i) x[i] = 0.f;
#pragma unroll
        for (int kk = 0; kk < 8; ++kk) { const bf16x8 kf = *(const LAS bf16x8*)(kt + off_b(pr, 2 * kk + hh)); x = MFMA32(kf, qf[kk], x); }
        const bool diag = (kti == qblk);
        float zz[16], suf[16];
#pragma unroll
        for (int i = 0; i < 16; ++i) {
            zz[i] = x[i] * ATT_C;
            const float e = __builtin_amdgcn_exp2f(fminf(zz[i], 126.f));
            float l = -__builtin_amdgcn_logf(1.f + e);
            const int kap = 16 * (i >> 3) + 8 * hh + (i & 7);
            if (diag && !(kap < r)) l = 0.f;
            suf[i] = l;
        }
#pragma unroll
        for (int j = 6; j >= 0; --j) { suf[j] += suf[j + 1]; suf[8 + j] += suf[8 + j + 1]; }
        const float T0 = suf[0], T1 = suf[8];
        const float T0p = __shfl_xor(T0, 32), T1p = __shfl_xor(T1, 32);
        const float base0 = L + T1 + T1p + (hh == 0 ? T0p : 0.f), base1 = L + (hh == 0 ? T1p : 0.f);
        float a[16];
#pragma unroll
        for (int i = 0; i < 16; ++i) {
            float v = __builtin_amdgcn_exp2f(zz[i] + (i < 8 ? base0 : base1) + suf[i]);
            const int kap = 16 * (i >> 3) + 8 * hh + (i & 7);
            if (diag && !(kap < r)) v = 0.f;
            a[i] = v;
        }
        L += (T0 + T1) + (T0p + T1p);
        const bf16x8 pf0 = pack8(a[0], a[1], a[2], a[3], a[4], a[5], a[6], a[7]);
        const bf16x8 pf1 = pack8(a[8], a[9], a[10], a[11], a[12], a[13], a[14], a[15]);
#pragma unroll
        for (int c = 0; c < 4; ++c) {
            s16x4 r00, r01, r10, r11; tr_read4(va[0][c], va[1][c], r00, r01, r10, r11);
            const bf16x8 vf0 = __builtin_shufflevector(r00, r01, 0, 1, 2, 3, 4, 5, 6, 7), vf1 = __builtin_shufflevector(r10, r11, 0, 1, 2, 3, 4, 5, 6, 7);
            oacc[c] = MFMA32(vf0, pf0, oacc[c]); oacc[c] = MFMA32(vf1, pf1, oacc[c]);
        }
        if (__all(L < ATT_EXIT)) break;
    }
    float ss = 0.f;
#pragma unroll
    for (int c = 0; c < 4; ++c)
#pragma unroll
        for (int i = 0; i < 16; ++i) ss += oacc[c][i] * oacc[c][i];
    ss += __shfl_xor(ss, 32);
    if (hh == 0) XS[h * 32 + r] = ss;
    __syncthreads();
    float tot = 0.f;
#pragma unroll
    for (int w = 0; w < 8; ++w) tot += XS[w * 32 + r];
    const float rs = __builtin_amdgcn_rsqf(tot * (1.f / CW) + EPS);
    bf16* yo = ymix + (rowbase + t0 + r) * D + CW + h * HD + 4 * hh;
#pragma unroll
    for (int c = 0; c < 4; ++c)
#pragma unroll
        for (int g = 0; g < 4; ++g) { v2u w; w.x = pk2(oacc[c][4 * g] * rs, oacc[c][4 * g + 1] * rs); w.y = pk2(oacc[c][4 * g + 2] * rs, oacc[c][4 * g + 3] * rs);
            *(GAS v2u*)(yo + 32 * c + 8 * g) = w; }
}
__device__ __forceinline__ void p2_mixer(Frame& F) {
    int par = 0;
    for (int u = F.bx; u < NB * (SEQ / 32); u += F.G) { attn_unit(F, u / (SEQ / 32), u % (SEQ / 32), par); par ^= 1; }
    const int gw = F.bx * NWAVES + F.wave, NGW = F.G * NWAVES;
    for (int it = gw; it < T / 16; it += NGW) conv_item(F, it);
}

__device__ __forceinline__ void router_unit(Frame& F, int unit, LAS int* hist) {
    const int lane = F.lane, r16 = lane & 15, g = lane >> 4;
    const bf16* H = (const bf16*)(F.ws + WS_H1B); const bf16* WR = (const bf16*)(F.ws + WS_WR);
    const int t0 = unit * 16;
    LAS float* LG = (LAS float*)(F.lds + F.wave * 16384); LAS float* BI = LG + 16 * 65 + 16;
    f32x4 acc[4];
#pragma unroll
    for (int nb = 0; nb < 4; ++nb) acc[nb] = (f32x4){0.f, 0.f, 0.f, 0.f};
    float ss = 0.f;
    const bf16* ap = H + (size_t)(t0 + r16) * D + 8 * g; const bf16* bp = WR + (size_t)r16 * D + 8 * g;
#pragma unroll 4
    for (int ks = 0; ks < D / 32; ++ks) {
        const v4u aw = *(const GAS v4u*)(ap + 32 * ks);
#pragma unroll
        for (int q = 0; q < 4; ++q) { const float lo = bflo(aw[q]), hi = bfhi(aw[q]); ss += lo * lo + hi * hi; }
        const bf16x8 af = __builtin_bit_cast(bf16x8, aw);
#pragma unroll
        for (int nb = 0; nb < 4; ++nb) { const bf16x8 bf = *(const GAS bf16x8*)(bp + (size_t)(16 * nb) * D + 32 * ks); acc[nb] = __builtin_amdgcn_mfma_f32_16x16x32_bf16(af, bf, acc[nb], 0, 0, 0); }
    }
    ss += __shfl_xor(ss, 16); ss += __shfl_xor(ss, 32);
#pragma unroll
    for (int nb = 0; nb < 4; ++nb)
#pragma unroll
        for (int j = 0; j < 4; ++j) LG[(4 * g + j) * 65 + 16 * nb + r16] = acc[nb][j];
    LDS_WAIT();
    if (lane < 16) {
        const int t = t0 + lane; const float rs = __builtin_amdgcn_rsqf(ss * (1.f / D) + EPS);
        ((float*)(F.ws + WS_RFFN))[t] = rs;
        LAS float* lg = LG + lane * 65; LAS float* bi = BI + lane * 65; const float* rb = F.in[I_RB];
        for (int e = 0; e < NE; ++e) { const float s = fsigmoid(lg[e] * rs); lg[e] = s; bi[e] = s + rb[e]; }
        float gs[8];
#pragma unroll
        for (int gg = 0; gg < 8; ++gg) { float m1 = -__builtin_inff(), m2 = -__builtin_inff();
#pragma unroll
            for (int j = 0; j < 8; ++j) { const float v = bi[8 * gg + j]; if (v > m1) { m2 = m1; m1 = v; } else if (v > m2) m2 = v; }
            gs[gg] = m1 + m2; }
        unsigned gmask = 0u;
#pragma unroll
        for (int gg = 0; gg < 8; ++gg) { int cnt = 0;
#pragma unroll
            for (int g2 = 0; g2 < 8; ++g2) cnt += (gs[g2] > gs[gg] || (gs[g2] == gs[gg] && g2 < gg)) ? 1 : 0;
            if (cnt < 4) gmask |= 1u << gg; }
        int se[8]; float sv[8]; float wsum = 0.f;
#pragma unroll
        for (int k = 0; k < 8; ++k) { float best = -__builtin_inff(); int be = 0;
            for (int e = 0; e < NE; ++e) { const float v = bi[e]; if (((gmask >> (e >> 3)) & 1u) && v > best) { best = v; be = e; } }
            bi[be] = -__builtin_inff(); se[k] = be; sv[k] = lg[be]; wsum += sv[k]; }
        const float inv = 2.5f / wsum;
        int* te = (int*)(F.ws + WS_TOPE) + (size_t)t * 8; float* tw = (float*)(F.ws + WS_TOPW) + (size_t)t * 8;
#pragma unroll
        for (int k = 0; k < 8; ++k) { te[k] = se[k]; tw[k] = sv[k] * inv; (void)__hip_atomic_fetch_add(hist + se[k], 1, __ATOMIC_RELAXED, __HIP_MEMORY_SCOPE_WORKGROUP); }
    }
}
__device__ __forceinline__ void p4_router(Frame& F) {
    LAS int* hist = (LAS int*)(F.lds + RT_OFF);
    for (int v = F.bx; v < 256; v += F.G) {
        if (F.tid < 64) hist[F.tid] = 0;
        __syncthreads();
        router_unit(F, v * 8 + F.wave, hist);
        __syncthreads();
        if (F.tid < 64) ((int*)(F.ws + WS_CNT))[v * 64 + F.tid] = hist[F.tid];
        __syncthreads();
    }
}

__device__ __forceinline__ void p4b_tables(Frame& F) {
    LAS int* L = (LAS int*)(F.lds + RING_OFF);
    LAS int* part_t = L;
    LAS int* part_b = L + 512;
    LAS int* totals = L + 1024;
    LAS int* below = L + 1088;
    LAS int* segst = L + 1152;
    LAS int* wcount = L + 1280;
    LAS int* pe = L + 2048;
    LAS int* rank = L + 3072;
    const int* CNT = (const int*)(F.ws + WS_CNT); const int* TOPE = (const int*)(F.ws + WS_TOPE); const float* TOPW = (const float*)(F.ws + WS_TOPW);
    const float* RFFN = (const float*)(F.ws + WS_RFFN);
    int* RTOK = (int*)(F.ws + WS_RTOK); float* RW = (float*)(F.ws + WS_RW); int* RDST = (int*)(F.ws + WS_RDST); float* RR = (float*)(F.ws + WS_RR); int* TILEE = (int*)(F.ws + WS_TILEE);
    const int tid = F.tid, lane = F.lane, wave = F.wave;
    for (int v = F.bx; v < 256; v += F.G) {
        { const int e = tid & 63, part = tid >> 6; int tot = 0, bel = 0;
          for (int vv = 32 * part; vv < 32 * part + 32; ++vv) { const int c = CNT[vv * 64 + e]; tot += c; bel += (vv < v) ? c : 0; }
          part_t[part * 64 + e] = tot; part_b[part * 64 + e] = bel; }
        for (int i = tid; i < 1024; i += NTHR) pe[i] = TOPE[(size_t)v * 1024 + i];
        __syncthreads();
        if (wave == 0) {
            int tot = 0, bel = 0;
#pragma unroll
            for (int p = 0; p < 8; ++p) { tot += part_t[p * 64 + lane]; bel += part_b[p * 64 + lane]; }
            totals[lane] = tot; below[lane] = bel;
            const int ru = (tot + 255) & ~255; int sc = ru;
#pragma unroll
            for (int o = 1; o < 64; o <<= 1) { const int n = __shfl_up(sc, o); if (lane >= o) sc += n; }
            segst[lane] = sc - ru; if (lane == 63) segst[64] = sc;
        }
        { int cnt = 0;
          for (int j = 0; j < 128; ++j) { const int p = 128 * wave + j; if (pe[p] == lane) { rank[p] = cnt; ++cnt; } }
          wcount[wave * 64 + lane] = cnt; }
        __syncthreads();
        const int SS = segst[64];
        for (int p = tid; p < 1024; p += NTHR) { const int e = pe[p], w = p >> 7; int off = 0;
            for (int w2 = 0; w2 < w; ++w2) off += wcount[w2 * 64 + e];
            const int row = segst[e] + below[e] + off + rank[p]; const int t = 128 * v + (p >> 3), k = p & 7;
            RTOK[row] = t; RW[row] = TOPW[(size_t)t * 8 + k]; RDST[row] = k * T + t; RR[row] = RFFN[t]; }
        if (tid < 128) { const int t = 128 * v + tid, row = SS + t; RTOK[row] = t; RW[row] = 1.f; RDST[row] = 8 * T + t; RR[row] = RFFN[t]; }
        if (v < NE) { const int e = v, tot = totals[e], ru = (tot + 255) & ~255, st = segst[e];
            if (tid < ru - tot) { const int row = st + tot + tid; RTOK[row] = 0; RW[row] = 0.f; RDST[row] = -1; RR[row] = 0.f; }
            if (tid < ru / 256) TILEE[st / 256 + tid] = e; }
        if (v == NE) { if (tid < T / 256) TILEE[SS / 256 + tid] = NE; if (tid == 0) TILEE[MAXTILES] = SS / 256 + T / 256; }
        __syncthreads();
    }
}

template <bool GATHER> __device__ __forceinline__ int group_setup(Frame& F, int nN) {
    const int* TILEE = (const int*)(F.ws + WS_TILEE);
    const int NT = __builtin_amdgcn_readfirstlane((int)__hip_atomic_load((unsigned*)TILEE + MAXTILES, RLX_AGENT));
    LAS int* te = (LAS int*)(F.lds + TE_OFF); LAS unsigned* rt = (LAS unsigned*)(F.lds + RT_OFF);
    for (int i = F.tid; i < NT && i < MAXTILES; i += NTHR) te[i] = TILEE[i];
    if (GATHER) {
        const int* RTOK = (const int*)(F.ws + WS_RTOK);
        for (int ui = F.tid >> 8; ui < RT_UNITS; ui += 2) { int pm, pn; if (!pg8::order_next(ui, F.G, F.bx, NT, nN, pm, pn)) break;
            rt[ui * 256 + (F.tid & 255)] = (unsigned)RTOK[pm * 256 + (F.tid & 255)] * (unsigned)(D * 2); }
    }
    __syncthreads();
    return NT;
}

__device__ __forceinline__ void p7_combine(Frame& F, int n) {
    const int gw = F.bx * NWAVES + F.wave, NGW = F.G * NWAVES, lane = F.lane;
    bf16* H = (bf16*)(F.ws + WS_H1B); const bf16* S0 = (const bf16*)F.out; const bf16* S8 = (const bf16*)(F.ws + WS_SLOT8); float* ssq2 = (float*)(F.ws + WS_SSQ2) + (size_t)n * T;
    for (int t = gw; t < T; t += NGW) {
        bf16* hp = H + (size_t)t * D + n * SLW + 8 * lane;
        v4u w[10]; w[0] = *(const GAS v4u*)hp;
#pragma unroll
        for (int k = 0; k < 8; ++k) w[1 + k] = *(const GAS v4u*)(S0 + ((size_t)k * T + t) * SLW + 8 * lane);
        w[9] = *(const GAS v4u*)(S8 + (size_t)t * SLW + 8 * lane);
        float o[8];
#pragma unroll
        for (int i = 0; i < 8; ++i) o[i] = 0.f;
#pragma unroll
        for (int k = 0; k < 10; ++k)
#pragma unroll
            for (int q = 0; q < 4; ++q) { o[2 * q] += bflo(w[k][q]); o[2 * q + 1] += bfhi(w[k][q]); }
        float ss = 0.f;
#pragma unroll
        for (int i = 0; i < 8; ++i) ss += o[i] * o[i];
        ss = wave_sum(ss);
        if (lane == 0) ssq2[t] = ss;
        v4u r; r.x = pk2(o[0], o[1]); r.y = pk2(o[2], o[3]); r.z = pk2(o[4], o[5]); r.w = pk2(o[6], o[7]);
        *(GAS v4u*)hp = r;
    }
}

__device__ __forceinline__ void p9_final(Frame& F, const bf16* H, const float* ssq, int nparts) {
    const int gw = F.bx * NWAVES + F.wave, NGW = F.G * NWAVES, lane = F.lane; const float* g = F.in[I_NFIN];
    for (int t = gw; t < T; t += NGW) {
        v4u w[4];
#pragma unroll
        for (int j = 0; j < 4; ++j) w[j] = *(const GAS v4u*)(H + (size_t)t * D + 512 * j + 8 * lane);
        float ss = 0.f;
        if (nparts > 0) { if (lane < nparts) ss = ssq[(size_t)lane * T + t]; }
        else {
#pragma unroll
            for (int j = 0; j < 4; ++j)
#pragma unroll
                for (int q = 0; q < 4; ++q) { const float lo = bflo(w[j][q]), hi = bfhi(w[j][q]); ss += lo * lo + hi * hi; }
        }
        const float r = __builtin_amdgcn_rsqf(wave_sum(ss) * (1.f / D) + EPS);
        float* o = F.out + (size_t)t * D;
#pragma unroll
        for (int j = 0; j < 4; ++j) { const int c = 512 * j + 8 * lane; const f32x4 g0 = *(const GAS f32x4*)(g + c), g1 = *(const GAS f32x4*)(g + c + 4);
            f32x4 a, b; a.x = bflo(w[j][0]) * r * g0.x; a.y = bfhi(w[j][0]) * r * g0.y; a.z = bflo(w[j][1]) * r * g0.z; a.w = bfhi(w[j][1]) * r * g0.w;
            b.x = bflo(w[j][2]) * r * g1.x; b.y = bfhi(w[j][2]) * r * g1.y; b.z = bflo(w[j][3]) * r * g1.z; b.w = bfhi(w[j][3]) * r * g1.w;
            *(GAS f32x4*)(o + c) = a; *(GAS f32x4*)(o + c + 4) = b; }
    }
}

struct Args { const float* in[21]; float* out; unsigned char* ws; int ph_lo, ph_hi, fin_mode, li; };
__global__ void __launch_bounds__(NTHR, 2) mk_fwd(Args args) {
    extern __shared__ __attribute__((aligned(16))) unsigned char lds[];
    Frame F;
    F.lds = (LAS unsigned char*)lds;
    F.tid = threadIdx.x; F.lane = F.tid & 63; F.wave = __builtin_amdgcn_readfirstlane(F.tid >> 6);
    F.G = gridDim.x; F.bx = blockIdx.x; F.ws = args.ws; F.out = args.out;
#pragma unroll
    for (int i = 0; i < 21; ++i) F.in[i] = args.in[i];
    volatile LAS unsigned* MISC = (volatile LAS unsigned*)(F.lds + MISC_OFF);
    if (F.tid < 32) MISC[F.tid] = 0u;
    __syncthreads();
    XcdBarrier bar = xcd_barrier_post((unsigned*)(F.ws + WS_CTL) + CW_BAR + args.li * XCD_BAR_WORDS, MISC + 8);
    unsigned char* ws = F.ws;
    const int lo = args.ph_lo, hi = args.ph_hi;
    LAS unsigned char* ring = F.lds + RING_OFF;
#define PHASE(k) if (lo <= (k) && (k) < hi)
#define GRID_BAR() xcd_barrier(bar)

    PHASE(0) { p0_prologue(F); GRID_BAR(); }
    PHASE(1) {
        pg8::DenseSched S{T / 256, NPROJ / 256, F.G, F.bx, D, (const char*)(ws + WS_WIN)};
        pg8::EpiBf16Scale E{(bf16*)(ws + WS_PROJ), NPROJ, (const float*)(ws + WS_RMIX)};
        pg8::gemm_phase(ring, (const char*)F.out, D, S, E);
        GRID_BAR();
    }
    PHASE(2) { p2_mixer(F); GRID_BAR(); }
    PHASE(3) {
        pg8::DenseSched S{T / 256, D / 256, F.G, F.bx, D, (const char*)(ws + WS_WOUT)};
        pg8::EpiResF32 E{(bf16*)(ws + WS_H1B), F.in[I_X], D};
        pg8::gemm_phase(ring, (const char*)((bf16*)F.out + (size_t)T * D), D, S, E);
        GRID_BAR();
    }
    PHASE(4) { p4_router(F); GRID_BAR(); }
    PHASE(5) { p4b_tables(F); GRID_BAR(); }
    PHASE(6) {
        const int NT = group_setup<true>(F, 4);
        pg8::GroupSched<true> S{NT, 4, F.G, F.bx, D, 0, (const char*)(ws + WS_WGU), (size_t)1024 * D * 2, (const LAS int*)(F.lds + TE_OFF), (const LAS unsigned*)(F.lds + RT_OFF)};
        pg8::EpiGateUp E{(bf16*)(ws + WS_HPERM), (const float*)(ws + WS_RR)};
        pg8::gemm_phase(ring, (const char*)(ws + WS_H1B), D, S, E);
        GRID_BAR();
    }
    {
        for (int n = 0; n < NSLICE; ++n) {
            PHASE(7 + 2 * n) {
            const int NT = group_setup<false>(F, 2);
            pg8::GroupSched<false> S{NT, 2, F.G, F.bx, ED, 2 * n, (const char*)(ws + WS_WDN), (size_t)D * ED * 2, (const LAS int*)(F.lds + TE_OFF), (const LAS unsigned*)(F.lds + RT_OFF)};
            pg8::EpiDown E{(bf16*)F.out, (bf16*)(ws + WS_SLOT8), (const float*)(ws + WS_RW), (const int*)(ws + WS_RDST)};
            pg8::gemm_phase(ring, (const char*)(ws + WS_HPERM), ED, S, E);
            GRID_BAR();
            }
            PHASE(8 + 2 * n) {
            p7_combine(F, n);
            GRID_BAR();
            }
        }
    }
    PHASE(15) {
        pg8::DenseSched S{T / 256, D / 256, F.G, F.bx, PLE, (const char*)(ws + WS_WPP)};
        pg8::EpiBf16Scale E{(bf16*)(ws + WS_PP), D, nullptr};
        pg8::gemm_phase(ring, (const char*)(ws + WS_PB), PLE, S, E);
        GRID_BAR();
    }
    PHASE(16) {
        pg8::DenseSched S{T / 256, D / 256, F.G, F.bx, D, (const char*)(ws + WS_WPG)};
        pg8::EpiPle E{(bf16*)(ws + WS_H3), (const bf16*)(ws + WS_H1B), (const bf16*)(ws + WS_PP), (const float*)(ws + WS_SSQ2), (float*)(ws + WS_SSQ3)};
        pg8::gemm_phase(ring, (const char*)(ws + WS_H1B), D, S, E);
        GRID_BAR();
    }
    PHASE(17) {
    if (args.fin_mode == 0) p9_final(F, (const bf16*)(ws + WS_H3), (const float*)(ws + WS_SSQ3), 32);
    else p9_final(F, (const bf16*)(ws + WS_H1B), nullptr, 0);
    }
}

extern "C" void kernel_launch(void* const* d_in, const int* in_sizes, int n_in, void* d_out, int out_size, void* d_ws, size_t ws_size, hipStream_t stream) {
    static int grid = 0;
    if (grid == 0) {
        int dev = 0, cus = 0;
        if (n_in != 21 || ws_size < WS_END) { fprintf(stderr, "kernel_launch: n_in %d ws %zu (need %zu)\n", n_in, ws_size, (size_t)WS_END); grid = -1; return; }
        if (hipGetDevice(&dev) != hipSuccess || hipDeviceGetAttribute(&cus, hipDeviceAttributeMultiprocessorCount, dev) != hipSuccess) { grid = -1; return; }
        if (hipFuncSetAttribute((const void*)mk_fwd, hipFuncAttributeMaxDynamicSharedMemorySize, LDS_BYTES) != hipSuccess) { fprintf(stderr, "hipFuncSetAttribute failed\n"); grid = -1; return; }
        int per_cu = 0;
        (void)hipOccupancyMaxActiveBlocksPerMultiprocessor(&per_cu, (const void*)mk_fwd, NTHR, LDS_BYTES);
        (void)hipGetLastError();
        grid = cus > 256 ? 256 : cus;
    }
    if (grid < 0) return;
    (void)hipMemsetAsync((char*)d_ws + WS_CTL, 0, CTL_ZERO_BYTES, stream);
    Args a{};
    for (int i = 0; i < 21; ++i) a.in[i] = (const float*)d_in[i];
    a.out = (float*)d_out; a.ws = (unsigned char*)d_ws; a.fin_mode = FIN_MODE;
#if PROBE_K >= 0
    a.ph_lo = 0; a.ph_hi = PROBE_K + 1; a.li = 0;
    hipLaunchKernelGGL(mk_fwd, dim3(grid), dim3(NTHR), LDS_BYTES, stream, a);
    a.ph_lo = PROBE_K; a.ph_hi = PH_HI; a.li = 1;
    hipLaunchKernelGGL(mk_fwd, dim3(grid), dim3(NTHR), LDS_BYTES, stream, a);
#else
    a.ph_lo = 0; a.ph_hi = PH_HI; a.li = 0;
    hipLaunchKernelGGL(mk_fwd, dim3(grid), dim3(NTHR), LDS_BYTES, stream, a);
#endif
}
```

```cpp
#include <hip/hip_runtime.h>
#include <cstdio>
#ifndef PROBE_K
#define PROBE_K -1
#endif
#ifndef PH_HI
#define PH_HI 100
#endif
#ifndef FIN_MODE
#define FIN_MODE 0
#endif

#define GAS __attribute__((address_space(1)))
#define LAS __attribute__((address_space(3)))
typedef unsigned short bf16;
typedef unsigned v4u __attribute__((ext_vector_type(4)));
typedef unsigned v2u __attribute__((ext_vector_type(2)));
typedef float f32x4 __attribute__((ext_vector_type(4)));
typedef float f32x2 __attribute__((ext_vector_type(2)));
typedef float f32x16 __attribute__((ext_vector_type(16)));
typedef short bf16x8 __attribute__((ext_vector_type(8)));
typedef short s16x4 __attribute__((ext_vector_type(4)));
typedef GAS unsigned gu32;
#define RLX_AGENT __ATOMIC_RELAXED, __HIP_MEMORY_SCOPE_AGENT
#define LDS_WAIT() asm volatile("s_waitcnt lgkmcnt(0)" ::: "memory")
#define VM_WAIT() asm volatile("s_waitcnt vmcnt(0)" ::: "memory")

constexpr int NB = 8, SEQ = 4096, T = NB * SEQ, D = 2048, NPROJ = 6144, CW = 1024, HD = 128, NH = 8;
constexpr int PLE = 256, NE = 64, ED = 512, TOPK = 8, NSLOT = 9;
constexpr float EPS = 1e-6f;
constexpr int NWAVES = 8, NTHR = 512;
constexpr int MAXTILES = 1216;
constexpr int MAXROWS = MAXTILES * 256;
constexpr int NSLICE = 4, SLW = D / NSLICE;

constexpr size_t MiB = 1u << 20;
constexpr size_t WS_CTL = 0, CTL_ZERO_BYTES = 1 * MiB;
constexpr size_t WS_RMIX = 1 * MiB;
constexpr size_t WS_RFFN = WS_RMIX + 128 * 1024;
constexpr size_t WS_SSQ2 = WS_RFFN + 128 * 1024;
constexpr size_t WS_SSQ3 = WS_SSQ2 + 512 * 1024;
constexpr size_t WS_TOPE = WS_SSQ3 + 4 * MiB;
constexpr size_t WS_TOPW = WS_TOPE + 1 * MiB;
constexpr size_t WS_CNT  = WS_TOPW + 1 * MiB;
constexpr size_t WS_RTOK = WS_CNT + 64 * 1024;
constexpr size_t WS_RW   = WS_RTOK + 1280 * 1024;
constexpr size_t WS_RDST = WS_RW + 1280 * 1024;
constexpr size_t WS_RR   = WS_RDST + 1280 * 1024;
constexpr size_t WS_TILEE = WS_RR + 1280 * 1024;
constexpr size_t WS_WR   = 16 * MiB;
constexpr size_t WS_WIN  = 17 * MiB;
constexpr size_t WS_WOUT = WS_WIN + 24 * MiB;
constexpr size_t WS_WGU  = WS_WOUT + 8 * MiB;
constexpr size_t WS_WDN  = WS_WGU + 260 * MiB;
constexpr size_t WS_WPG  = WS_WDN + 130 * MiB;
constexpr size_t WS_WPP  = WS_WPG + 8 * MiB;
constexpr size_t WS_PB   = WS_WPP + 1 * MiB;
constexpr size_t WS_H1B  = WS_PB + 16 * MiB;
constexpr size_t WS_OVL  = WS_H1B + 128 * MiB;
constexpr size_t WS_PROJ = WS_OVL;
constexpr size_t WS_HPERM = WS_OVL;
constexpr size_t WS_SLOT8 = WS_OVL + 304 * MiB;
constexpr size_t WS_PP   = WS_OVL;
constexpr size_t WS_H3   = WS_OVL + 128 * MiB;
constexpr size_t WS_END  = WS_OVL + 384 * MiB;
constexpr int CW_BAR = 4096;

constexpr int RING_OFF = 0, RING_BYTES = 131072;
constexpr int RT_OFF = 131072, RT_UNITS = 20, RT_BYTES = RT_UNITS * 1024;
constexpr int TE_OFF = RT_OFF + RT_BYTES, TE_BYTES = 4864 + 128;
constexpr int MISC_OFF = TE_OFF + TE_BYTES;
constexpr int LDS_BYTES = MISC_OFF + 128;
static_assert(LDS_BYTES <= 163840, "LDS");

__device__ __forceinline__ unsigned f2bf(float f) { unsigned u = __builtin_bit_cast(unsigned, f); return (u + 0x7fffu + ((u >> 16) & 1u)) >> 16; }
__device__ __forceinline__ unsigned pk2(float lo, float hi) { return f2bf(lo) | (f2bf(hi) << 16); }
__device__ __forceinline__ float bflo(unsigned w) { return __builtin_bit_cast(float, w << 16); }
__device__ __forceinline__ float bfhi(unsigned w) { return __builtin_bit_cast(float, w & 0xffff0000u); }
__device__ __forceinline__ float wave_sum(float v) {
#pragma unroll
    for (int o = 1; o < 64; o <<= 1) v += __shfl_xor(v, o);
    return v;
}
__device__ __forceinline__ float fsigmoid(float v) { return __builtin_amdgcn_rcpf(1.f + __builtin_amdgcn_exp2f(-1.4426950409f * v)); }

#define XB_TMO      128
#define XB_XCNT(j)  (256  + 64 * (j))
#define XB_XSUB(j)  (1280 + 64 * (j))
#define XB_XGEN(j)  (2304 + 64 * (j))
#define XB_TOP      3328
#define XB_TOPGEN   3392
#define XCD_BAR_WORDS 3456
#define XB_SPIN_CAP (1u << 18)
__device__ __forceinline__ unsigned xb_ld(unsigned* p)              { return __hip_atomic_load(p, __ATOMIC_RELAXED, __HIP_MEMORY_SCOPE_AGENT); }
__device__ __forceinline__ unsigned xb_add(unsigned* p, unsigned v) { return __hip_atomic_fetch_add(p, v, __ATOMIC_RELAXED, __HIP_MEMORY_SCOPE_AGENT); }
__device__ __forceinline__ unsigned xb_xcc_id() { return (unsigned)__builtin_amdgcn_s_getreg((3 << 11) | 20) & 0xFu; }
#define XB_SPIN(cond, bar) do { unsigned _sp = 0; while (cond) { __builtin_amdgcn_s_sleep(1); \
    if ((++_sp & 255u) == 0u) { if (xb_ld(&(bar)[XB_TMO])) break; if (_sp > XB_SPIN_CAP) { atomicAdd(&(bar)[XB_TMO], 1u); break; } } } } while (0)
struct XcdBarrier { unsigned* bar; unsigned x; volatile LAS unsigned* st; };
__device__ __forceinline__ XcdBarrier xcd_barrier_post(unsigned* bar, volatile LAS unsigned* st) {
    XcdBarrier b; b.bar = bar; b.x = xb_xcc_id(); b.st = st;
    if (threadIdx.x == 0) (void)xb_add(&bar[XB_XCNT(b.x)], 1u);
    return b;
}
__device__ __forceinline__ void xcd_barrier_complete(unsigned* bar, unsigned x, unsigned& nloc, unsigned& nx) {
    const unsigned G = gridDim.x * gridDim.y * gridDim.z;
    unsigned sum, cnt, mine, sp = 0u;
    for (;;) {
        sum = 0u; cnt = 0u; mine = 0u;
#pragma unroll
        for (unsigned j = 0; j < 16; ++j) { const unsigned c = xb_ld(&bar[XB_XCNT(j)]); sum += c; cnt += (c > 0u) ? 1u : 0u; mine = (j == x) ? c : mine; }
        if (sum == G) break;
        __builtin_amdgcn_s_sleep(1);
        if ((++sp & 255u) == 0u) { if (xb_ld(&bar[XB_TMO])) break; if (sp > XB_SPIN_CAP) { atomicAdd(&bar[XB_TMO], 1u); break; } }
    }
    nloc = mine > 0u ? mine : 1u; nx = cnt > 0u ? cnt : 1u;
}
__device__ __forceinline__ void xcd_barrier(const XcdBarrier& b) {
    asm volatile("s_waitcnt vmcnt(0)" ::: "memory");
    __syncthreads();
    if (threadIdx.x == 0) {
        unsigned* bar = b.bar;
        __builtin_amdgcn_s_waitcnt(0);
        unsigned nloc = b.st[0], nx = b.st[1];
        if (nloc == 0u) { xcd_barrier_complete(bar, b.x, nloc, nx); b.st[0] = nloc; b.st[1] = nx; }
        const unsigned old = xb_add(&bar[XB_XSUB(b.x)], 1u);
        const unsigned gen = old / nloc;
        if (old + 1u == (gen + 1u) * nloc) {
            __builtin_amdgcn_fence(__ATOMIC_RELEASE, "agent");
            asm volatile("s_waitcnt vmcnt(0)" ::: "memory");
            const unsigned og = xb_add(&bar[XB_TOP], 1u);
            const unsigned tg = og / nx;
            if (og + 1u == (tg + 1u) * nx) xb_add(&bar[XB_TOPGEN], 1u);
            else XB_SPIN(xb_ld(&bar[XB_TOPGEN]) == tg, bar);
            __builtin_amdgcn_fence(__ATOMIC_ACQUIRE, "agent");
            xb_add(&bar[XB_XGEN(b.x)], 1u);
            asm volatile("s_waitcnt vmcnt(0)" ::: "memory");
        } else {
            XB_SPIN(xb_ld(&bar[XB_XGEN(b.x)]) == gen, bar);
            __builtin_amdgcn_fence(__ATOMIC_ACQUIRE, "agent");
            asm volatile("s_waitcnt vmcnt(0)" ::: "memory");
        }
    }
    __syncthreads();
}

namespace pg8 {
constexpr int BM = 256, BK = 64, HALF = 128, HTB = HALF * BK * 2, STAGE_BYTES = 8 * HTB, NXCD = 8, WGM = 8;
__device__ __forceinline__ int lds_byte(int r, int c) { const int st = (r >> 4) * 2 + (c >> 5), rr = r & 15, cc = c & 31, ob = rr * 64 + cc * 2; return st * 1024 + (ob ^ (((ob >> 9) & 1) << 5)); }
__device__ __forceinline__ void stage_rc(int b, int& R, int& C) { const int st = b / 1024, sb = b % 1024, swz = sb ^ (((sb >> 9) & 1) << 5); R = (st >> 1) * 16 + swz / 64; C = (st & 1) * 32 + (swz % 64) / 2; }
__device__ __forceinline__ int perm32(int rho) { const int n = rho >> 4, i = rho & 15; return 8 * (i >> 2) + 4 * n + (i & 3); }

struct Unit { int pm, pn, e; };

__device__ __forceinline__ bool order_next(int i, int G, int c, int nM, int nN, int& pm, int& pn) {
    const int nwg = nM * nN; const long L = (long)i * G + c; if (L >= nwg) return false;
    int wgid = (int)L; { const int q = nwg / NXCD, r = nwg % NXCD, xcd = wgid % NXCD, off = wgid / NXCD; wgid = (xcd < r ? xcd * (q + 1) : r * (q + 1) + (xcd - r) * q) + off; }
    const int nig = WGM * nN, gid = wgid / nig, fm = gid * WGM, gsz = (nM - fm) < WGM ? (nM - fm) : WGM;
    pm = fm + ((wgid % nig) % gsz); pn = (wgid % nig) / gsz; return true;
}

struct DenseSched {
    int nM, nN, G, c, K; const char* Bt;
    __device__ __forceinline__ bool next(int i, Unit& u) const { u.e = 0; return order_next(i, G, c, nM, nN, u.pm, u.pn); }
    __device__ __forceinline__ const char* bbase(const Unit& u) const { return Bt + (size_t)u.pn * (BM * 2) * K; }
    __device__ __forceinline__ void aoffs(int ui, const Unit& u, const int (&R)[2], const int (&C)[2], unsigned (&ao)[2][2]) const {
#pragma unroll
        for (int h = 0; h < 2; ++h)
#pragma unroll
            for (int i = 0; i < 2; ++i) ao[h][i] = (unsigned)((u.pm * BM + h * HALF + R[i]) * K + C[i]) * 2u;
    }
};
template <bool GATHER> struct GroupSched {
    int nM, nN, G, c, K, pn0; const char* Bt; size_t estride; const LAS int* te; const LAS unsigned* rt;
    __device__ __forceinline__ bool next(int i, Unit& u) const { if (!order_next(i, G, c, nM, nN, u.pm, u.pn)) return false; u.e = __builtin_amdgcn_readfirstlane(te[u.pm]); return true; }
    __device__ __forceinline__ const char* bbase(const Unit& u) const { return Bt + (size_t)u.e * estride + (size_t)(pn0 + u.pn) * (BM * 2) * K; }
    __device__ __forceinline__ void aoffs(int ui, const Unit& u, const int (&R)[2], const int (&C)[2], unsigned (&ao)[2][2]) const {
#pragma unroll
        for (int h = 0; h < 2; ++h)
#pragma unroll
            for (int i = 0; i < 2; ++i) {
                if (GATHER) ao[h][i] = rt[ui * 256 + h * HALF + R[i]] + (unsigned)C[i] * 2u;
                else ao[h][i] = (unsigned)((u.pm * BM + h * HALF + R[i]) * K + C[i]) * 2u;
            }
    }
};

__device__ __forceinline__ unsigned cvt_pk_bf16(float lo, float hi) { unsigned r; asm volatile("v_cvt_pk_bf16_f32 %0, %1, %2" : "=v"(r) : "v"(lo), "v"(hi)); return r; }

template <class Epi, class Sched>
__device__ __forceinline__ void gemm_phase(LAS unsigned char* lds, const char* Abase, const int K, const Sched& S, const Epi& E) {
    const int tid = threadIdx.x, wid = __builtin_amdgcn_readfirstlane(tid >> 6), lane = tid & 63, wr = wid >> 2, wc = wid & 3, fr = lane & 15, fq = lane >> 4;
    const int nt = K / BK;
    int sR[2], sC[2]; unsigned voffB[2];
#pragma unroll
    for (int i = 0; i < 2; ++i) { int R, C; stage_rc(tid * 16 + i * 8192, R, C); sR[i] = R; sC[i] = C; const int Rb = (R & ~31) + perm32(R & 31); voffB[i] = (unsigned)(Rb * K + C) * 2u; }
    const size_t kstep = (size_t)(BK * 2);
    const size_t hstep = (size_t)HALF * K * 2;
    const unsigned ldsw = (unsigned)wid * 1024u;
    const int aoff = lds_byte(wr * 64 + fr, fq * 8), boff = lds_byte(wc * 32 + fr, fq * 8);
#define PG8_SA(b, h) (((b) * 2 + (h)) * HTB)
#define PG8_SB(b, h) ((4 + (b) * 2 + (h)) * HTB)
#define PG8_STAGE(bufoff, gbase, voff) do { _Pragma("unroll") for (int _i = 0; _i < 2; ++_i) \
        __builtin_amdgcn_global_load_lds((const unsigned*)((const char*)(gbase) + (voff)[_i]), (LAS unsigned*)(lds + (bufoff) + ldsw + _i * 8192), 16, 0, 0); } while (0)
#define PG8_LDA(dst, b, h) do { _Pragma("unroll") for (int m = 0; m < 4; ++m) _Pragma("unroll") for (int k = 0; k < 2; ++k) dst[m][k] = *(const LAS bf16x8*)(lds + PG8_SA(b, h) + aoff + m * 2048 + k * 1024); } while (0)
#define PG8_LDB(dst, b, h) do { _Pragma("unroll") for (int n = 0; n < 2; ++n) _Pragma("unroll") for (int k = 0; k < 2; ++k) dst[n][k] = *(const LAS bf16x8*)(lds + PG8_SB(b, h) + boff + n * 2048 + k * 1024); } while (0)
#define PG8_MMA(ai, bj, At, Bt) do { __builtin_amdgcn_s_setprio(1); _Pragma("unroll") for (int m = 0; m < 4; ++m) _Pragma("unroll") for (int n = 0; n < 2; ++n) _Pragma("unroll") for (int k = 0; k < 2; ++k) \
        acc[ai][bj][m][n] = __builtin_amdgcn_mfma_f32_16x16x32_bf16(Bt[n][k], At[m][k], acc[ai][bj][m][n], 0, 0, 0); __builtin_amdgcn_s_setprio(0); } while (0)
#define PG8_WAIT_V(n) asm volatile("s_waitcnt vmcnt(" #n ")" ::: "memory")
#define PG8_WAIT_L(n) asm volatile("s_waitcnt lgkmcnt(" #n ")" ::: "memory")
#define PG8_BAR __builtin_amdgcn_s_barrier()
#define PG8_SCHED __builtin_amdgcn_sched_barrier(0)
    Unit cur, nxt; int ui = 0;
    if (!S.next(0, cur)) return;
    f32x4 acc[2][2][4][2];
#pragma unroll
    for (int a = 0; a < 2; ++a)
#pragma unroll
        for (int b = 0; b < 2; ++b)
#pragma unroll
            for (int m = 0; m < 4; ++m)
#pragma unroll
                for (int n = 0; n < 2; ++n) acc[a][b][m][n] = (f32x4){0.f, 0.f, 0.f, 0.f};
    bf16x8 At[4][2], B0[2][2], B1[2][2];
    unsigned ca[2][2], na[2][2];
    S.aoffs(0, cur, sR, sC, ca);
    const char* cB = S.bbase(cur);
    PG8_STAGE(PG8_SB(0, 0), cB, voffB); PG8_STAGE(PG8_SA(0, 0), Abase, ca[0]); PG8_STAGE(PG8_SB(0, 1), cB + hstep, voffB); PG8_STAGE(PG8_SA(0, 1), Abase, ca[1]);
    if (wr == 1) PG8_BAR;
    PG8_WAIT_V(4); PG8_BAR;
    PG8_STAGE(PG8_SB(1, 0), cB + kstep, voffB); PG8_STAGE(PG8_SA(1, 0), Abase + kstep, ca[0]); PG8_STAGE(PG8_SB(1, 1), cB + hstep + kstep, voffB);
    PG8_WAIT_V(6); PG8_BAR;
    for (;;) {
        const bool has_next = S.next(ui + 1, nxt);
        const char* nB = has_next ? S.bbase(nxt) : cB;
        if (has_next) S.aoffs(ui + 1, nxt, sR, sC, na);
        else {
#pragma unroll
            for (int h = 0; h < 2; ++h)
#pragma unroll
                for (int i = 0; i < 2; ++i) na[h][i] = ca[h][i];
        }
        for (int t = 0; t < nt; t += 2) {
            const bool last = (t == nt - 2);
            const char* a1 = Abase + (size_t)(t + 1) * kstep;
            const char* a2 = last ? Abase : Abase + (size_t)(t + 2) * kstep; const char* b2 = last ? nB : cB + (size_t)(t + 2) * kstep;
            const char* a3 = a2 + kstep; const char* b3 = b2 + kstep;
            PG8_LDB(B0, 0, 0); PG8_SCHED; PG8_LDA(At, 0, 0); PG8_STAGE(PG8_SA(1, 1), a1, ca[1]);
            PG8_WAIT_L(8); PG8_BAR; PG8_WAIT_L(0); PG8_MMA(0, 0, At, B0); PG8_BAR; PG8_SCHED;
            if (last) {
#pragma unroll
                for (int h = 0; h < 2; ++h)
#pragma unroll
                    for (int i = 0; i < 2; ++i) ca[h][i] = na[h][i];
            }
            PG8_LDB(B1, 0, 1); PG8_STAGE(PG8_SB(0, 0), b2, voffB);
            PG8_BAR; PG8_WAIT_L(0); PG8_MMA(0, 1, At, B1); PG8_BAR;
            PG8_LDA(At, 0, 1); PG8_STAGE(PG8_SA(0, 0), a2, ca[0]);
            PG8_BAR; PG8_WAIT_L(0); PG8_MMA(1, 0, At, B0); PG8_BAR; PG8_SCHED;
            PG8_STAGE(PG8_SB(0, 1), b2 + hstep, voffB);
            PG8_WAIT_V(6); PG8_BAR; PG8_MMA(1, 1, At, B1); PG8_BAR;
            PG8_LDB(B0, 1, 0); PG8_SCHED; PG8_LDA(At, 1, 0); PG8_STAGE(PG8_SA(0, 1), a2, ca[1]);
            PG8_WAIT_L(8); PG8_BAR; PG8_WAIT_L(0); PG8_MMA(0, 0, At, B0); PG8_BAR; PG8_SCHED;
            PG8_LDB(B1, 1, 1); PG8_STAGE(PG8_SB(1, 0), b3, voffB);
            PG8_BAR; PG8_WAIT_L(0); PG8_MMA(0, 1, At, B1); PG8_BAR;
            PG8_LDA(At, 1, 1); PG8_STAGE(PG8_SA(1, 0), a3, ca[0]);
            PG8_BAR; PG8_WAIT_L(0); PG8_MMA(1, 0, At, B0); PG8_BAR; PG8_SCHED;
            PG8_STAGE(PG8_SB(1, 1), b3 + hstep, voffB);
            PG8_WAIT_V(6); PG8_BAR; PG8_MMA(1, 1, At, B1); PG8_BAR;
        }
        E(acc, cur, wr, wc, fr, fq);
        if (!has_next) break;
#pragma unroll
        for (int a = 0; a < 2; ++a)
#pragma unroll
            for (int b = 0; b < 2; ++b)
#pragma unroll
                for (int m = 0; m < 4; ++m)
#pragma unroll
                    for (int n = 0; n < 2; ++n) acc[a][b][m][n] = (f32x4){0.f, 0.f, 0.f, 0.f};
        cur = nxt; cB = nB; ++ui;
    }
    PG8_WAIT_V(0);
    if (wr == 0) PG8_BAR;
    PG8_BAR;
#undef PG8_SA
#undef PG8_SB
#undef PG8_STAGE
#undef PG8_LDA
#undef PG8_LDB
#undef PG8_MMA
#undef PG8_WAIT_V
#undef PG8_WAIT_L
#undef PG8_BAR
#undef PG8_SCHED
}

struct EpiBf16Scale {
    bf16* O; int ldc; const float* rs;
    __device__ __forceinline__ void operator()(const f32x4 (&acc)[2][2][4][2], const Unit& u, int wr, int wc, int fr, int fq) const {
        const int row0 = u.pm * BM + wr * 64 + fr, col0 = u.pn * BM + wc * 32 + 8 * fq;
#pragma unroll
        for (int ai = 0; ai < 2; ++ai)
#pragma unroll
            for (int m = 0; m < 4; ++m) { const int row = row0 + ai * HALF + m * 16; const float s = rs ? rs[row] : 1.f; bf16* rowp = O + (size_t)row * ldc + col0;
#pragma unroll
                for (int bj = 0; bj < 2; ++bj) { const f32x4 v0 = acc[ai][bj][m][0] * s, v1 = acc[ai][bj][m][1] * s;
                    v4u w; w.x = cvt_pk_bf16(v0[0], v0[1]); w.y = cvt_pk_bf16(v0[2], v0[3]); w.z = cvt_pk_bf16(v1[0], v1[1]); w.w = cvt_pk_bf16(v1[2], v1[3]);
                    *(v4u*)(rowp + bj * HALF) = w; } }
    }
};
struct EpiResF32 {
    bf16* O; const bf16* X; int ldc;
    __device__ __forceinline__ void operator()(const f32x4 (&acc)[2][2][4][2], const Unit& u, int wr, int wc, int fr, int fq) const {
        const int row0 = u.pm * BM + wr * 64 + fr, col0 = u.pn * BM + wc * 32 + 8 * fq;
#pragma unroll
        for (int ai = 0; ai < 2; ++ai)
#pragma unroll
            for (int m = 0; m < 4; ++m) { const size_t ro = (size_t)(row0 + ai * HALF + m * 16) * ldc + col0;
#pragma unroll
                for (int bj = 0; bj < 2; ++bj) { const v4u xw = *(const v4u*)(X + ro + bj * HALF);
                    const f32x4 x0 = (f32x4){bflo(xw[0]), bfhi(xw[0]), bflo(xw[1]), bfhi(xw[1])}, x1 = (f32x4){bflo(xw[2]), bfhi(xw[2]), bflo(xw[3]), bfhi(xw[3])};
                    const f32x4 v0 = acc[ai][bj][m][0] + x0, v1 = acc[ai][bj][m][1] + x1;
                    v4u w; w.x = cvt_pk_bf16(v0[0], v0[1]); w.y = cvt_pk_bf16(v0[2], v0[3]); w.z = cvt_pk_bf16(v1[0], v1[1]); w.w = cvt_pk_bf16(v1[2], v1[3]);
                    *(v4u*)(O + ro + bj * HALF) = w; } }
    }
};
struct EpiGateUp {
    bf16* Hp; const float* rr;
    __device__ __forceinline__ void operator()(const f32x4 (&acc)[2][2][4][2], const Unit& u, int wr, int wc, int fr, int fq) const {
        const int row0 = u.pm * BM + wr * 64 + fr, col0 = u.pn * HALF + wc * 32 + 8 * fq;
#pragma unroll
        for (int ai = 0; ai < 2; ++ai)
#pragma unroll
            for (int m = 0; m < 4; ++m) { const int row = row0 + ai * HALF + m * 16; const float s = rr[row];
                float h[8];
#pragma unroll
                for (int n = 0; n < 2; ++n)
#pragma unroll
                    for (int j = 0; j < 4; ++j) { const float g = acc[ai][0][m][n][j] * s, up = acc[ai][1][m][n][j] * s; h[n * 4 + j] = g * fsigmoid(g) * up; }
                v4u w; w.x = cvt_pk_bf16(h[0], h[1]); w.y = cvt_pk_bf16(h[2], h[3]); w.z = cvt_pk_bf16(h[4], h[5]); w.w = cvt_pk_bf16(h[6], h[7]);
                *(v4u*)(Hp + (size_t)row * ED + col0) = w; }
    }
};
struct EpiDown {
    bf16* S0; bf16* S8; const float* rw; const int* rdst;
    __device__ __forceinline__ void operator()(const f32x4 (&acc)[2][2][4][2], const Unit& u, int wr, int wc, int fr, int fq) const {
        const int row0 = u.pm * BM + wr * 64 + fr, col0 = u.pn * BM + wc * 32 + 8 * fq;
#pragma unroll
        for (int ai = 0; ai < 2; ++ai)
#pragma unroll
            for (int m = 0; m < 4; ++m) { const int row = row0 + ai * HALF + m * 16; const float s = rw[row]; const int dst = rdst[row];
                if (dst >= 0) { bf16* rowp = (dst < 8 * T ? S0 + (size_t)dst * SLW : S8 + (size_t)(dst - 8 * T) * SLW) + col0;
#pragma unroll
                    for (int bj = 0; bj < 2; ++bj) { const f32x4 v0 = acc[ai][bj][m][0] * s, v1 = acc[ai][bj][m][1] * s;
                        v4u w; w.x = cvt_pk_bf16(v0[0], v0[1]); w.y = cvt_pk_bf16(v0[2], v0[3]); w.z = cvt_pk_bf16(v1[0], v1[1]); w.w = cvt_pk_bf16(v1[2], v1[3]);
                        *(v4u*)(rowp + bj * HALF) = w; } } }
    }
};
struct EpiPle {
    bf16* H3; const bf16* H2; const bf16* PP; const float* ssq2; float* ssq3;
    __device__ __forceinline__ void operator()(const f32x4 (&acc)[2][2][4][2], const Unit& u, int wr, int wc, int fr, int fq) const {
        const int row0 = u.pm * BM + wr * 64 + fr, col0 = u.pn * BM + wc * 32 + 8 * fq;
#pragma unroll
        for (int ai = 0; ai < 2; ++ai)
#pragma unroll
            for (int m = 0; m < 4; ++m) { const int row = row0 + ai * HALF + m * 16;
                const float r = __builtin_amdgcn_rsqf((ssq2[row] + ssq2[T + row] + ssq2[2 * T + row] + ssq2[3 * T + row]) * (1.f / D) + EPS);
                const size_t ro = (size_t)row * D + col0; float ss = 0.f;
#pragma unroll
                for (int bj = 0; bj < 2; ++bj) { const v4u h2 = *(const v4u*)(H2 + ro + bj * HALF), pp = *(const v4u*)(PP + ro + bj * HALF);
                    float o[8];
#pragma unroll
                    for (int q = 0; q < 4; ++q) { const int n = q >> 1, j = (q & 1) * 2;
                        const float g0 = fsigmoid(acc[ai][bj][m][n][j] * r), g1 = fsigmoid(acc[ai][bj][m][n][j + 1] * r);
                        o[2 * q] = bflo(h2[q]) + g0 * bflo(pp[q]); o[2 * q + 1] = bfhi(h2[q]) + g1 * bfhi(pp[q]);
                        ss += o[2 * q] * o[2 * q] + o[2 * q + 1] * o[2 * q + 1]; }
                    v4u w; w.x = cvt_pk_bf16(o[0], o[1]); w.y = cvt_pk_bf16(o[2], o[3]); w.z = cvt_pk_bf16(o[4], o[5]); w.w = cvt_pk_bf16(o[6], o[7]);
                    *(v4u*)(H3 + ro + bj * HALF) = w; }
                ss += __shfl_xor(ss, 16); ss += __shfl_xor(ss, 32);
                if (fq == 0) ssq3[(size_t)(u.pn * 4 + wc) * T + row] = ss; }
    }
};
}

struct Frame {
    LAS unsigned char* lds;
    int tid, lane, wave, G, bx;
    unsigned char* ws;
    const float* in[21];
    float* out;
};
enum { I_X = 0, I_P, I_NMIX, I_WIN, I_CONVW, I_GCONV, I_GSB, I_WOUT, I_NFFN, I_WR, I_RB, I_WEG, I_WEU, I_WED, I_WSG, I_WSU, I_WSD, I_NPLE, I_WPG, I_WPP, I_NFIN };

__device__ __forceinline__ void p0_transpose_item(const float* W, int N, bf16* WT, int ldk, int k0, int n0, int row_off, const float* g64, LAS float* scr, int lane) {
    const int n4 = lane & 15, kr = lane >> 4;
    f32x4 v[16];
    const float* src = W + (size_t)(k0 + kr) * N + n0 + 4 * n4;
#pragma unroll
    for (int i = 0; i < 16; ++i) v[i] = *(const GAS f32x4*)(src + (size_t)(4 * i) * N);
    const int c = lane >> 3, nn = lane & 7;
    f32x4 ga = (f32x4){1.f, 1.f, 1.f, 1.f}, gb = ga;
    if (g64) { ga = *(const GAS f32x4*)(g64 + 8 * c); gb = *(const GAS f32x4*)(g64 + 8 * c + 4); }
#pragma unroll
    for (int i = 0; i < 16; ++i) { LAS float* d = scr + (4 * i + kr) * 65 + 4 * n4; d[0] = v[i].x; d[1] = v[i].y; d[2] = v[i].z; d[3] = v[i].w; }
    LDS_WAIT(); asm volatile("" ::: "memory");
#pragma unroll
    for (int j = 0; j < 8; ++j) { const int n = nn + 8 * j; const LAS float* s = scr + (8 * c) * 65 + n;
        v4u o; o.x = pg8::cvt_pk_bf16(s[0] * ga.x, s[65] * ga.y); o.y = pg8::cvt_pk_bf16(s[130] * ga.z, s[195] * ga.w); o.z = pg8::cvt_pk_bf16(s[260] * gb.x, s[325] * gb.y); o.w = pg8::cvt_pk_bf16(s[390] * gb.z, s[455] * gb.w);
        *(GAS v4u*)(WT + (size_t)(row_off + n) * ldk + k0 + 8 * c) = o; }
    LDS_WAIT(); asm volatile("" ::: "memory");
}
constexpr int P0_I_WIN = (D / 64) * (NPROJ / 64), P0_I_WOUT = (D / 64) * (D / 64), P0_I_WR = (D / 64) * (NE / 64), P0_I_WPG = (D / 64) * (D / 64), P0_I_WPP = (PLE / 64) * (D / 64);
constexpr int P0_I_EXP = 768, P0_NITEMS = P0_I_WIN + P0_I_WOUT + P0_I_WR + P0_I_WPG + P0_I_WPP + 65 * P0_I_EXP;
__device__ __forceinline__ void p0_item(Frame& F, int it, LAS float* scr) {
    unsigned char* ws = F.ws; const int lane = F.lane;
    if (it < P0_I_WIN) { const int kb = it / (NPROJ / 64), nb = it % (NPROJ / 64); p0_transpose_item(F.in[I_WIN], NPROJ, (bf16*)(ws + WS_WIN), D, 64 * kb, 64 * nb, 64 * nb, F.in[I_NMIX] + 64 * kb, scr, lane); return; } it -= P0_I_WIN;
    if (it < P0_I_WOUT) { const int kb = it / (D / 64), nb = it % (D / 64), k0 = 64 * kb; const float* g = k0 < CW ? F.in[I_GCONV] + k0 : F.in[I_GSB] + (k0 - CW);
        p0_transpose_item(F.in[I_WOUT], D, (bf16*)(ws + WS_WOUT), D, k0, 64 * nb, 64 * nb, g, scr, lane); return; } it -= P0_I_WOUT;
    if (it < P0_I_WR) { const int kb = it; p0_transpose_item(F.in[I_WR], NE, (bf16*)(ws + WS_WR), D, 64 * kb, 0, 0, F.in[I_NFFN] + 64 * kb, scr, lane); return; } it -= P0_I_WR;
    if (it < P0_I_WPG) { const int kb = it / (D / 64), nb = it % (D / 64); p0_transpose_item(F.in[I_WPG], D, (bf16*)(ws + WS_WPG), D, 64 * kb, 64 * nb, 64 * nb, F.in[I_NPLE] + 64 * kb, scr, lane); return; } it -= P0_I_WPG;
    if (it < P0_I_WPP) { const int kb = it / (D / 64), nb = it % (D / 64); p0_transpose_item(F.in[I_WPP], D, (bf16*)(ws + WS_WPP), PLE, 64 * kb, 64 * nb, 64 * nb, nullptr, scr, lane); return; } it -= P0_I_WPP;
    const int e = it / P0_I_EXP, r = it % P0_I_EXP, sub = r / 256, q = r % 256;
    if (sub < 2) {
        const float* src = e < NE ? (sub == 0 ? F.in[I_WEG] : F.in[I_WEU]) + (size_t)e * D * ED : (sub == 0 ? F.in[I_WSG] : F.in[I_WSU]);
        const int kb = q / (ED / 64), nb = q % (ED / 64), n0 = 64 * nb, ro = 256 * (n0 / 128) + (n0 % 128) + (sub == 1 ? 128 : 0);
        p0_transpose_item(src, ED, (bf16*)(ws + WS_WGU) + (size_t)e * 1024 * D, D, 64 * kb, n0, ro, F.in[I_NFFN] + 64 * kb, scr, lane);
    } else {
        const float* src = e < NE ? F.in[I_WED] + (size_t)e * ED * D : F.in[I_WSD];
        const int kb = q / (D / 64), nb = q % (D / 64);
        p0_transpose_item(src, D, (bf16*)(ws + WS_WDN) + (size_t)e * D * ED, ED, 64 * kb, 64 * nb, 64 * nb, nullptr, scr, lane);
    }
}
__device__ __forceinline__ void p0_prologue(Frame& F) {
    LAS float* scr = (LAS float*)(F.lds + RING_OFF + F.wave * 16896);
    const int gw = F.bx * NWAVES + F.wave, NGW = F.G * NWAVES;
    {
        bf16* XB = (bf16*)F.out; float* rmix = (float*)(F.ws + WS_RMIX); const float* x = F.in[I_X];
        for (int m = gw; m < T; m += NGW) {
            const GAS f32x4* xr = (const GAS f32x4*)(x + (size_t)m * D) + F.lane;
            f32x4 v[8]; float s = 0.f;
#pragma unroll
            for (int j = 0; j < 8; ++j) { v[j] = xr[64 * j]; s += (v[j].x * v[j].x + v[j].y * v[j].y) + (v[j].z * v[j].z + v[j].w * v[j].w); }
            s = wave_sum(s);
            if (F.lane == 0) rmix[m] = __builtin_amdgcn_rsqf(s * (1.f / D) + EPS);
            GAS v2u* o8 = (GAS v2u*)(XB + (size_t)m * D) + F.lane;
#pragma unroll
            for (int j = 0; j < 8; ++j) { v2u w; w.x = pk2(v[j].x, v[j].y); w.y = pk2(v[j].z, v[j].w); o8[64 * j] = w; }
        }
    }
    {
        const float* p = F.in[I_P]; bf16* PB = (bf16*)(F.ws + WS_PB);
        const int nchunk = T * PLE / 8, gt = F.bx * NTHR + F.tid, NGT = F.G * NTHR;
        for (int c = gt; c < nchunk; c += NGT) { const f32x4 a = *(const GAS f32x4*)(p + (size_t)c * 8), b = *(const GAS f32x4*)(p + (size_t)c * 8 + 4);
            v4u w; w.x = pk2(a.x, a.y); w.y = pk2(a.z, a.w); w.z = pk2(b.x, b.y); w.w = pk2(b.z, b.w); *(GAS v4u*)(PB + (size_t)c * 8) = w; }
    }
    for (int it = gw; it < P0_NITEMS; it += NGW) p0_item(F, it, scr);
}

__device__ __forceinline__ unsigned off_b(unsigned row, unsigned ch) { return 256u * row + 16u * (ch ^ (((row & 3) << 2) | ((row >> 2) & 3))); }
#define MFMA32(a, b, c) __builtin_amdgcn_mfma_f32_32x32x16_bf16((a), (b), (c), 0, 0, 0)

__device__ __forceinline__ void conv_item(Frame& F, int it) {
    const bf16* proj = (const bf16*)(F.ws + WS_PROJ); bf16* ymix = (bf16*)F.out + (size_t)T * D;
    const float* cw = F.in[I_CONVW]; const int lane = F.lane;
    float w0[16], w1[16], w2[16], u1[16], u2[16];
#pragma unroll
    for (int j = 0; j < 2; ++j)
#pragma unroll
        for (int i = 0; i < 8; ++i) { const int c = 512 * j + 8 * lane + i; w0[8 * j + i] = cw[c]; w1[8 * j + i] = cw[CW + c]; w2[8 * j + i] = cw[2 * CW + c]; u1[8 * j + i] = 0.f; u2[8 * j + i] = 0.f; }
    const int t0 = 16 * it; const bool seq_start = (t0 & (SEQ - 1)) == 0;
    for (int tt = -2; tt < 16; ++tt) {
        if (tt < 0 && seq_start) continue;
        const size_t t = (size_t)(t0 + tt);
        const bf16* pr = proj + t * NPROJ + 8 * lane;
        float u[16], cb[16];
#pragma unroll
        for (int j = 0; j < 2; ++j) { const v4u h = *(const GAS v4u*)(pr + 512 * j), c = *(const GAS v4u*)(pr + 2 * CW + 512 * j);
#pragma unroll
            for (int q = 0; q < 4; ++q) { u[8 * j + 2 * q] = bflo(h[q]) * bflo(c[q]); u[8 * j + 2 * q + 1] = bfhi(h[q]) * bfhi(c[q]); } }
        if (tt >= 0) {
#pragma unroll
            for (int j = 0; j < 2; ++j) { const v4u b = *(const GAS v4u*)(pr + CW + 512 * j);
#pragma unroll
                for (int q = 0; q < 4; ++q) { cb[8 * j + 2 * q] = bflo(b[q]); cb[8 * j + 2 * q + 1] = bfhi(b[q]); } }
            float y[16], ss = 0.f;
#pragma unroll
            for (int i = 0; i < 16; ++i) { y[i] = cb[i] * (w0[i] * u2[i] + w1[i] * u1[i] + w2[i] * u[i]); ss += y[i] * y[i]; }
            const float r = __builtin_amdgcn_rsqf(wave_sum(ss) * (1.f / CW) + EPS);
            bf16* yo = ymix + t * D + 8 * lane;
#pragma unroll
            for (int j = 0; j < 2; ++j) { v4u w; w.x = pk2(y[8 * j] * r, y[8 * j + 1] * r); w.y = pk2(y[8 * j + 2] * r, y[8 * j + 3] * r); w.z = pk2(y[8 * j + 4] * r, y[8 * j + 5] * r); w.w = pk2(y[8 * j + 6] * r, y[8 * j + 7] * r);
                *(GAS v4u*)(yo + 512 * j) = w; }
        }
#pragma unroll
        for (int i = 0; i < 16; ++i) { u2[i] = u1[i]; u1[i] = u[i]; }
    }
}

__device__ __forceinline__ bf16x8 pack8(float a0, float a1, float a2, float a3, float a4, float a5, float a6, float a7) {
    v4u p; p.x = pk2(a0, a1); p.y = pk2(a2, a3); p.z = pk2(a4, a5); p.w = pk2(a6, a7); return __builtin_bit_cast(bf16x8, p);
}
__device__ __forceinline__ void tr_read4(unsigned a_t0, unsigned a_t1, s16x4& r00, s16x4& r01, s16x4& r10, s16x4& r11) {
    asm volatile("ds_read_b64_tr_b16 %0, %4\n\tds_read_b64_tr_b16 %1, %5\n\tds_read_b64_tr_b16 %2, %4 offset:4096\n\tds_read_b64_tr_b16 %3, %5 offset:4096\n\ts_waitcnt lgkmcnt(0)"
                 : "=&v"(r00), "=&v"(r01), "=&v"(r10), "=&v"(r11) : "v"(a_t0), "v"(a_t1) : "memory");
}
constexpr float ATT_C = 0.08838834764831845f * 1.4426950408889634f;
constexpr float ATT_EXIT = -152.f;

__device__ __forceinline__ void attn_unit(Frame& F, int b, int qblk, int parity) {
    const int lane = F.lane, h = F.wave, r = lane & 31, hh = lane >> 5;
    const bf16* proj = (const bf16*)(F.ws + WS_PROJ); bf16* ymix = (bf16*)F.out + (size_t)T * D;
    const size_t rowbase = (size_t)b * SEQ; const int t0 = qblk * 32;
    LAS unsigned char* kt = F.lds + h * 16384; LAS unsigned char* vt = kt + 8192;
    LAS float* XS = (LAS float*)(F.lds + RT_OFF) + parity * 256;
    bf16x8 qf[8];
    { const bf16* qp = proj + (rowbase + t0 + r) * NPROJ + 3 * CW + h * HD + 8 * hh;
#pragma unroll
      for (int kk = 0; kk < 8; ++kk) qf[kk] = *(const GAS bf16x8*)(qp + 16 * kk); }
    f32x16 oacc[4];
#pragma unroll
    for (int c = 0; c < 4; ++c)
#pragma unroll
        for (int i = 0; i < 16; ++i) oacc[c][i] = 0.f;
    float L = 0.f;
    const unsigned pr = (unsigned)((r & 19) | ((r & 4) << 1) | ((r & 8) >> 1));
    const unsigned ktb = (unsigned)(size_t)kt, vtb = (unsigned)(size_t)vt;
    unsigned va[2][4];
    { const unsigned blk = (lane >> 4) & 1, q = (lane & 15) >> 2, p = lane & 3;
#pragma unroll
      for (int t = 0; t < 2; ++t)
#pragma unroll
          for (int c = 0; c < 4; ++c) va[t][c] = vtb + off_b(8 * hh + 4 * t + q, 4 * c + 2 * blk + (p >> 1)) + 8 * (p & 1); }
    for (int kti = qblk; kti >= 0; --kti) {
        const int s0 = kti * 32;
        {
            v4u kreg[8], vreg[8];
            const bf16* kp = proj + (rowbase + s0 + (lane >> 4)) * NPROJ + 4 * CW + h * HD + (lane & 15) * 8;
#pragma unroll
            for (int i = 0; i < 8; ++i) { kreg[i] = *(const GAS v4u*)(kp + (size_t)(4 * i) * NPROJ); vreg[i] = *(const GAS v4u*)(kp + (size_t)(4 * i) * NPROJ + CW); }
#pragma unroll
            for (int i = 0; i < 8; ++i) { const unsigned o = off_b(4 * i + (lane >> 4), lane & 15); *(LAS v4u*)(kt + o) = kreg[i]; *(LAS v4u*)(vt + o) = vreg[i]; }
        }
        LDS_WAIT();
        f32x16 x;
#pragma unroll
        for (int i = 0; i < 16; ++i) x[i] = 0.f;
#pragma unroll
        for (int kk = 0; kk < 8; ++kk) { const bf16x8 kf = *(const LAS bf16x8*)(kt + off_b(pr, 2 * kk + hh)); x = MFMA32(kf, qf[kk], x); }
        const bool diag = (kti == qblk);
        float zz[16], suf[16];
#pragma unroll
        for (int i = 0; i < 16; ++i) {
            zz[i] = x[i] * ATT_C;
            const float e = __builtin_amdgcn_exp2f(fminf(zz[i], 126.f));
            float l = -__builtin_amdgcn_logf(1.f + e);
            const int kap = 16 * (i >> 3) + 8 * hh + (i & 7);
            if (diag && !(kap < r)) l = 0.f;
            suf[i] = l;
        }
#pragma unroll
        for (int j = 6; j >= 0; --j) { suf[j] += suf[j + 1]; suf[8 + j] += suf[8 + j + 1]; }
        const float T0 = suf[0], T1 = suf[8];
        const float T0p = __shfl_xor(T0, 32), T1p = __shfl_xor(T1, 32);
        const float base0 = L + T1 + T1p + (hh == 0 ? T0p : 0.f), base1 = L + (hh == 0 ? T1p : 0.f);
        float a[16];
#pragma unroll
        for (int i = 0; i < 16; ++i) {
            float v = __builtin_amdgcn_exp2f(zz[i] + (i < 8 ? base0 : base1) + suf[i]);
            const int kap = 16 * (i >> 3) + 8 * hh + (i & 7);
            if (diag && !(kap < r)) v = 0.f;
            a[i] = v;
        }
        L += (T0 + T1) + (T0p + T1p);
        const bf16x8 pf0 = pack8(a[0], a[1], a[2], a[3], a[4], a[5], a[6], a[7]);
        const bf16x8 pf1 = pack8(a[8], a[9], a[10], a[11], a[12], a[13], a[14], a[15]);
#pragma unroll
        for (int c = 0; c < 4; ++c) {
            s16x4 r00, r01, r10, r11; tr_read4(va[0][c], va[1][c], r00, r01, r10, r11);
            const bf16x8 vf0 = __builtin_shufflevector(r00, r01, 0, 1, 2, 3, 4, 5, 6, 7), vf1 = __builtin_shufflevector(r10, r11, 0, 1, 2, 3, 4, 5, 6, 7);
            oacc[c] = MFMA32(vf0, pf0, oacc[c]); oacc[c] = MFMA32(vf1, pf1, oacc[c]);
        }
        if (__all(L < ATT_EXIT)) break;
    }
    float ss = 0.f;
#pragma unroll
    for (int c = 0; c < 4; ++c)
#pragma unroll
        for (int i = 0; i < 16; ++i) ss += oacc[c][i] * oacc[c][i];
    ss += __shfl_xor(ss, 32);
    if (hh == 0) XS[h * 32 + r] = ss;
    __syncthreads();
    float tot = 0.f;
#pragma unroll
    for (int w = 0; w < 8; ++w) tot += XS[w * 32 + r];
    const float rs = __builtin_amdgcn_rsqf(tot * (1.f / CW) + EPS);
    bf16* yo = ymix + (rowbase + t0 + r) * D + CW + h * HD + 4 * hh;
#pragma unroll
    for (int c = 0; c < 4; ++c)
#pragma unroll
        for (int g = 0; g < 4; ++g) { v2u w; w.x = pk2(oacc[c][4 * g] * rs, oacc[c][4 * g + 1] * rs); w.y = pk2(oacc[c][4 * g + 2] * rs, oacc[c][4 * g + 3] * rs);
            *(GAS v2u*)(yo + 32 * c + 8 * g) = w; }
}
__device__ __forceinline__ void p2_mixer(Frame& F) {
    int par = 0;
    for (int u = F.bx; u < NB * (SEQ / 32); u += F.G) { attn_unit(F, u / (SEQ / 32), u % (SEQ / 32), par); par ^= 1; }
    const int gw = F.bx * NWAVES + F.wave, NGW = F.G * NWAVES;
    for (int it = gw; it < T / 16; it += NGW) conv_item(F, it);
}

__device__ __forceinline__ void router_unit(Frame& F, int unit, LAS int* hist) {
    const int lane = F.lane, r16 = lane & 15, g = lane >> 4;
    const bf16* H = (const bf16*)(F.ws + WS_H1B); const bf16* WR = (const bf16*)(F.ws + WS_WR);
    const int t0 = unit * 16;
    LAS float* LG = (LAS float*)(F.lds + F.wave * 16384); LAS float* BI = LG + 16 * 65 + 16;
    f32x4 acc[4];
#pragma unroll
    for (int nb = 0; nb < 4; ++nb) acc[nb] = (f32x4){0.f, 0.f, 0.f, 0.f};
    float ss = 0.f;
    const bf16* ap = H + (size_t)(t0 + r16) * D + 8 * g; const bf16* bp = WR + (size_t)r16 * D + 8 * g;
#pragma unroll 4
    for (int ks = 0; ks < D / 32; ++ks) {
        const v4u aw = *(const GAS v4u*)(ap + 32 * ks);
#pragma unroll
        for (int q = 0; q < 4; ++q) { const float lo = bflo(aw[q]), hi = bfhi(aw[q]); ss += lo * lo + hi * hi; }
        const bf16x8 af = __builtin_bit_cast(bf16x8, aw);
#pragma unroll
        for (int nb = 0; nb < 4; ++nb) { const bf16x8 bf = *(const GAS bf16x8*)(bp + (size_t)(16 * nb) * D + 32 * ks); acc[nb] = __builtin_amdgcn_mfma_f32_16x16x32_bf16(af, bf, acc[nb], 0, 0, 0); }
    }
    ss += __shfl_xor(ss, 16); ss += __shfl_xor(ss, 32);
#pragma unroll
    for (int nb = 0; nb < 4; ++nb)
#pragma unroll
        for (int j = 0; j < 4; ++j) LG[(4 * g + j) * 65 + 16 * nb + r16] = acc[nb][j];
    LDS_WAIT();
    if (lane < 16) {
        const int t = t0 + lane; const float rs = __builtin_amdgcn_rsqf(ss * (1.f / D) + EPS);
        ((float*)(F.ws + WS_RFFN))[t] = rs;
        LAS float* lg = LG + lane * 65; LAS float* bi = BI + lane * 65; const float* rb = F.in[I_RB];
        for (int e = 0; e < NE; ++e) { const float s = fsigmoid(lg[e] * rs); lg[e] = s; bi[e] = s + rb[e]; }
        float gs[8];
#pragma unroll
        for (int gg = 0; gg < 8; ++gg) { float m1 = -__builtin_inff(), m2 = -__builtin_inff();
#pragma unroll
            for (int j = 0; j < 8; ++j) { const float v = bi[8 * gg + j]; if (v > m1) { m2 = m1; m1 = v; } else if (v > m2) m2 = v; }
            gs[gg] = m1 + m2; }
        unsigned gmask = 0u;
#pragma unroll
        for (int gg = 0; gg < 8; ++gg) { int cnt = 0;
#pragma unroll
            for (int g2 = 0; g2 < 8; ++g2) cnt += (gs[g2] > gs[gg] || (gs[g2] == gs[gg] && g2 < gg)) ? 1 : 0;
            if (cnt < 4) gmask |= 1u << gg; }
        int se[8]; float sv[8]; float wsum = 0.f;
#pragma unroll
        for (int k = 0; k < 8; ++k) { float best = -__builtin_inff(); int be = 0;
            for (int e = 0; e < NE; ++e) { const float v = bi[e]; if (((gmask >> (e >> 3)) & 1u) && v > best) { best = v; be = e; } }
            bi[be] = -__builtin_inff(); se[k] = be; sv[k] = lg[be]; wsum += sv[k]; }
        const float inv = 2.5f / wsum;
        int* te = (int*)(F.ws + WS_TOPE) + (size_t)t * 8; float* tw = (float*)(F.ws + WS_TOPW) + (size_t)t * 8;
#pragma unroll
        for (int k = 0; k < 8; ++k) { te[k] = se[k]; tw[k] = sv[k] * inv; (void)__hip_atomic_fetch_add(hist + se[k], 1, __ATOMIC_RELAXED, __HIP_MEMORY_SCOPE_WORKGROUP); }
    }
}
__device__ __forceinline__ void p4_router(Frame& F) {
    LAS int* hist = (LAS int*)(F.lds + RT_OFF);
    for (int v = F.bx; v < 256; v += F.G) {
        if (F.tid < 64) hist[F.tid] = 0;
        __syncthreads();
        router_unit(F, v * 8 + F.wave, hist);
        __syncthreads();
        if (F.tid < 64) ((int*)(F.ws + WS_CNT))[v * 64 + F.tid] = hist[F.tid];
        __syncthreads();
    }
}

__device__ __forceinline__ void p4b_tables(Frame& F) {
    LAS int* L = (LAS int*)(F.lds + RING_OFF);
    LAS int* part_t = L;
    LAS int* part_b = L + 512;
    LAS int* totals = L + 1024;
    LAS int* below = L + 1088;
    LAS int* segst = L + 1152;
    LAS int* wcount = L + 1280;
    LAS int* pe = L + 2048;
    LAS int* rank = L + 3072;
    const int* CNT = (const int*)(F.ws + WS_CNT); const int* TOPE = (const int*)(F.ws + WS_TOPE); const float* TOPW = (const float*)(F.ws + WS_TOPW);
    const float* RFFN = (const float*)(F.ws + WS_RFFN);
    int* RTOK = (int*)(F.ws + WS_RTOK); float* RW = (float*)(F.ws + WS_RW); int* RDST = (int*)(F.ws + WS_RDST); float* RR = (float*)(F.ws + WS_RR); int* TILEE = (int*)(F.ws + WS_TILEE);
    const int tid = F.tid, lane = F.lane, wave = F.wave;
    for (int v = F.bx; v < 256; v += F.G) {
        { const int e = tid & 63, part = tid >> 6; int tot = 0, bel = 0;
          for (int vv = 32 * part; vv < 32 * part + 32; ++vv) { const int c = CNT[vv * 64 + e]; tot += c; bel += (vv < v) ? c : 0; }
          part_t[part * 64 + e] = tot; part_b[part * 64 + e] = bel; }
        for (int i = tid; i < 1024; i += NTHR) pe[i] = TOPE[(size_t)v * 1024 + i];
        __syncthreads();
        if (wave == 0) {
            int tot = 0, bel = 0;
#pragma unroll
            for (int p = 0; p < 8; ++p) { tot += part_t[p * 64 + lane]; bel += part_b[p * 64 + lane]; }
            totals[lane] = tot; below[lane] = bel;
            const int ru = (tot + 255) & ~255; int sc = ru;
#pragma unroll
            for (int o = 1; o < 64; o <<= 1) { const int n = __shfl_up(sc, o); if (lane >= o) sc += n; }
            segst[lane] = sc - ru; if (lane == 63) segst[64] = sc;
        }
        { int cnt = 0;
          for (int j = 0; j < 128; ++j) { const int p = 128 * wave + j; if (pe[p] == lane) { rank[p] = cnt; ++cnt; } }
          wcount[wave * 64 + lane] = cnt; }
        __syncthreads();
        const int SS = segst[64];
        for (int p = tid; p < 1024; p += NTHR) { const int e = pe[p], w = p >> 7; int off = 0;
            for (int w2 = 0; w2 < w; ++w2) off += wcount[w2 * 64 + e];
            const int row = segst[e] + below[e] + off + rank[p]; const int t = 128 * v + (p >> 3), k = p & 7;
            RTOK[row] = t; RW[row] = TOPW[(size_t)t * 8 + k]; RDST[row] = k * T + t; RR[row] = RFFN[t]; }
        if (tid < 128) { const int t = 128 * v + tid, row = SS + t; RTOK[row] = t; RW[row] = 1.f; RDST[row] = 8 * T + t; RR[row] = RFFN[t]; }
        if (v < NE) { const int e = v, tot = totals[e], ru = (tot + 255) & ~255, st = segst[e];
            if (tid < ru - tot) { const int row = st + tot + tid; RTOK[row] = 0; RW[row] = 0.f; RDST[row] = -1; RR[row] = 0.f; }
            if (tid < ru / 256) TILEE[st / 256 + tid] = e; }
        if (v == NE) { if (tid < T / 256) TILEE[SS / 256 + tid] = NE; if (tid == 0) TILEE[MAXTILES] = SS / 256 + T / 256; }
        __syncthreads();
    }
}

template <bool GATHER> __device__ __forceinline__ int group_setup(Frame& F, int nN) {
    const int* TILEE = (const int*)(F.ws + WS_TILEE);
    const int NT = __builtin_amdgcn_readfirstlane((int)__hip_atomic_load((unsigned*)TILEE + MAXTILES, RLX_AGENT));
    LAS int* te = (LAS int*)(F.lds + TE_OFF); LAS unsigned* rt = (LAS unsigned*)(F.lds + RT_OFF);
    for (int i = F.tid; i < NT && i < MAXTILES; i += NTHR) te[i] = TILEE[i];
    if (GATHER) {
        const int* RTOK = (const int*)(F.ws + WS_RTOK);
        for (int ui = F.tid >> 8; ui < RT_UNITS; ui += 2) { int pm, pn; if (!pg8::order_next(ui, F.G, F.bx, NT, nN, pm, pn)) break;
            rt[ui * 256 + (F.tid & 255)] = (unsigned)RTOK[pm * 256 + (F.tid & 255)] * (unsigned)(D * 2); }
    }
    __syncthreads();
    return NT;
}

__device__ __forceinline__ void p7_combine(Frame& F, int n) {
    const int gw = F.bx * NWAVES + F.wave, NGW = F.G * NWAVES, lane = F.lane;
    bf16* H = (bf16*)(F.ws + WS_H1B); const bf16* S0 = (const bf16*)F.out; const bf16* S8 = (const bf16*)(F.ws + WS_SLOT8); float* ssq2 = (float*)(F.ws + WS_SSQ2) + (size_t)n * T;
    for (int t = gw; t < T; t += NGW) {
        bf16* hp = H + (size_t)t * D + n * SLW + 8 * lane;
        v4u w[10]; w[0] = *(const GAS v4u*)hp;
#pragma unroll
        for (int k = 0; k < 8; ++k) w[1 + k] = *(const GAS v4u*)(S0 + ((size_t)k * T + t) * SLW + 8 * lane);
        w[9] = *(const GAS v4u*)(S8 + (size_t)t * SLW + 8 * lane);
        float o[8];
#pragma unroll
        for (int i = 0; i < 8; ++i) o[i] = 0.f;
#pragma unroll
        for (int k = 0; k < 10; ++k)
#pragma unroll
            for (int q = 0; q < 4; ++q) { o[2 * q] += bflo(w[k][q]); o[2 * q + 1] += bfhi(w[k][q]); }
        float ss = 0.f;
#pragma unroll
        for (int i = 0; i < 8; ++i) ss += o[i] * o[i];
        ss = wave_sum(ss);
        if (lane == 0) ssq2[t] = ss;
        v4u r; r.x = pk2(o[0], o[1]); r.y = pk2(o[2], o[3]); r.z = pk2(o[4], o[5]); r.w = pk2(o[6], o[7]);
        *(GAS v4u*)hp = r;
    }
}

__device__ __forceinline__ void p9_final(Frame& F, const bf16* H, const float* ssq, int nparts) {
    const int gw = F.bx * NWAVES + F.wave, NGW = F.G * NWAVES, lane = F.lane; const float* g = F.in[I_NFIN];
    for (int t = gw; t < T; t += NGW) {
        v4u w[4];
#pragma unroll
        for (int j = 0; j < 4; ++j) w[j] = *(const GAS v4u*)(H + (size_t)t * D + 512 * j + 8 * lane);
        float ss = 0.f;
        if (nparts > 0) { if (lane < nparts) ss = ssq[(size_t)lane * T + t]; }
        else {
#pragma unroll
            for (int j = 0; j < 4; ++j)
#pragma unroll
                for (int q = 0; q < 4; ++q) { const float lo = bflo(w[j][q]), hi = bfhi(w[j][q]); ss += lo * lo + hi * hi; }
        }
        const float r = __builtin_amdgcn_rsqf(wave_sum(ss) * (1.f / D) + EPS);
        float* o = F.out + (size_t)t * D;
#pragma unroll
        for (int j = 0; j < 4; ++j) { const int c = 512 * j + 8 * lane; const f32x4 g0 = *(const GAS f32x4*)(g + c), g1 = *(const GAS f32x4*)(g + c + 4);
            f32x4 a, b; a.x = bflo(w[j][0]) * r * g0.x; a.y = bfhi(w[j][0]) * r * g0.y; a.z = bflo(w[j][1]) * r * g0.z; a.w = bfhi(w[j][1]) * r * g0.w;
            b.x = bflo(w[j][2]) * r * g1.x; b.y = bfhi(w[j][2]) * r * g1.y; b.z = bflo(w[j][3]) * r * g1.z; b.w = bfhi(w[j][3]) * r * g1.w;
            *(GAS f32x4*)(o + c) = a; *(GAS f32x4*)(o + c + 4) = b; }
    }
}

struct Args { const float* in[21]; float* out; unsigned char* ws; int ph_lo, ph_hi, fin_mode, li; };
__global__ void __launch_bounds__(NTHR, 2) mk_fwd(Args args) {
    extern __shared__ __attribute__((aligned(16))) unsigned char lds[];
    Frame F;
    F.lds = (LAS unsigned char*)lds;
    F.tid = threadIdx.x; F.lane = F.tid & 63; F.wave = __builtin_amdgcn_readfirstlane(F.tid >> 6);
    F.G = gridDim.x; F.bx = blockIdx.x; F.ws = args.ws; F.out = args.out;
#pragma unroll
    for (int i = 0; i < 21; ++i) F.in[i] = args.in[i];
    volatile LAS unsigned* MISC = (volatile LAS unsigned*)(F.lds + MISC_OFF);
    if (F.tid < 32) MISC[F.tid] = 0u;
    __syncthreads();
    XcdBarrier bar = xcd_barrier_post((unsigned*)(F.ws + WS_CTL) + CW_BAR + args.li * XCD_BAR_WORDS, MISC + 8);
    unsigned char* ws = F.ws;
    const int lo = args.ph_lo, hi = args.ph_hi;
    LAS unsigned char* ring = F.lds + RING_OFF;
#define PHASE(k) if (lo <= (k) && (k) < hi)
#define GRID_BAR() xcd_barrier(bar)

    PHASE(0) { p0_prologue(F); GRID_BAR(); }
    PHASE(1) {
        pg8::DenseSched S{T / 256, NPROJ / 256, F.G, F.bx, D, (const char*)(ws + WS_WIN)};
        pg8::EpiBf16Scale E{(bf16*)(ws + WS_PROJ), NPROJ, (const float*)(ws + WS_RMIX)};
        pg8::gemm_phase(ring, (const char*)F.out, D, S, E);
        GRID_BAR();
    }
    PHASE(2) { p2_mixer(F); GRID_BAR(); }
    PHASE(3) {
        pg8::DenseSched S{T / 256, D / 256, F.G, F.bx, D, (const char*)(ws + WS_WOUT)};
        pg8::EpiResF32 E{(bf16*)(ws + WS_H1B), (const bf16*)F.out, D};
        pg8::gemm_phase(ring, (const char*)((bf16*)F.out + (size_t)T * D), D, S, E);
        GRID_BAR();
    }
    PHASE(4) { p4_router(F); GRID_BAR(); }
    PHASE(5) { p4b_tables(F); GRID_BAR(); }
    PHASE(6) {
        const int NT = group_setup<true>(F, 4);
        pg8::GroupSched<true> S{NT, 4, F.G, F.bx, D, 0, (const char*)(ws + WS_WGU), (size_t)1024 * D * 2, (const LAS int*)(F.lds + TE_OFF), (const LAS unsigned*)(F.lds + RT_OFF)};
        pg8::EpiGateUp E{(bf16*)(ws + WS_HPERM), (const float*)(ws + WS_RR)};
        pg8::gemm_phase(ring, (const char*)(ws + WS_H1B), D, S, E);
        GRID_BAR();
    }
    {
        for (int n = 0; n < NSLICE; ++n) {
            PHASE(7 + 2 * n) {
            const int NT = group_setup<false>(F, 2);
            pg8::GroupSched<false> S{NT, 2, F.G, F.bx, ED, 2 * n, (const char*)(ws + WS_WDN), (size_t)D * ED * 2, (const LAS int*)(F.lds + TE_OFF), (const LAS unsigned*)(F.lds + RT_OFF)};
            pg8::EpiDown E{(bf16*)F.out, (bf16*)(ws + WS_SLOT8), (const float*)(ws + WS_RW), (const int*)(ws + WS_RDST)};
            pg8::gemm_phase(ring, (const char*)(ws + WS_HPERM), ED, S, E);
            GRID_BAR();
            }
            PHASE(8 + 2 * n) {
            p7_combine(F, n);
            GRID_BAR();
            }
        }
    }
    PHASE(15) {
        pg8::DenseSched S{T / 256, D / 256, F.G, F.bx, PLE, (const char*)(ws + WS_WPP)};
        pg8::EpiBf16Scale E{(bf16*)(ws + WS_PP), D, nullptr};
        pg8::gemm_phase(ring, (const char*)(ws + WS_PB), PLE, S, E);
        GRID_BAR();
    }
    PHASE(16) {
        pg8::DenseSched S{T / 256, D / 256, F.G, F.bx, D, (const char*)(ws + WS_WPG)};
        pg8::EpiPle E{(bf16*)(ws + WS_H3), (const bf16*)(ws + WS_H1B), (const bf16*)(ws + WS_PP), (const float*)(ws + WS_SSQ2), (float*)(ws + WS_SSQ3)};
        pg8::gemm_phase(ring, (const char*)(ws + WS_H1B), D, S, E);
        GRID_BAR();
    }
    PHASE(17) {
    if (args.fin_mode == 0) p9_final(F, (const bf16*)(ws + WS_H3), (const float*)(ws + WS_SSQ3), 32);
    else p9_final(F, (const bf16*)(ws + WS_H1B), nullptr, 0);
    }
}

extern "C" void kernel_launch(void* const* d_in, const int* in_sizes, int n_in, void* d_out, int out_size, void* d_ws, size_t ws_size, hipStream_t stream) {
    static int grid = 0;
    if (grid == 0) {
        int dev = 0, cus = 0;
        if (n_in != 21 || ws_size < WS_END) { fprintf(stderr, "kernel_launch: n_in %d ws %zu (need %zu)\n", n_in, ws_size, (size_t)WS_END); grid = -1; return; }
        if (hipGetDevice(&dev) != hipSuccess || hipDeviceGetAttribute(&cus, hipDeviceAttributeMultiprocessorCount, dev) != hipSuccess) { grid = -1; return; }
        if (hipFuncSetAttribute((const void*)mk_fwd, hipFuncAttributeMaxDynamicSharedMemorySize, LDS_BYTES) != hipSuccess) { fprintf(stderr, "hipFuncSetAttribute failed\n"); grid = -1; return; }
        int per_cu = 0;
        (void)hipOccupancyMaxActiveBlocksPerMultiprocessor(&per_cu, (const void*)mk_fwd, NTHR, LDS_BYTES);
        (void)hipGetLastError();
        grid = cus > 256 ? 256 : cus;
    }
    if (grid < 0) return;
    (void)hipMemsetAsync((char*)d_ws + WS_CTL, 0, CTL_ZERO_BYTES, stream);
    Args a{};
    for (int i = 0; i < 21; ++i) a.in[i] = (const float*)d_in[i];
    a.out = (float*)d_out; a.ws = (unsigned char*)d_ws; a.fin_mode = FIN_MODE;
#if PROBE_K >= 0
    a.ph_lo = 0; a.ph_hi = PROBE_K + 1; a.li = 0;
    hipLaunchKernelGGL(mk_fwd, dim3(grid), dim3(NTHR), LDS_BYTES, stream, a);
    a.ph_lo = PROBE_K; a.ph_hi = PH_HI; a.li = 1;
    hipLaunchKernelGGL(mk_fwd, dim3(grid), dim3(NTHR), LDS_BYTES, stream, a);
#else
    a.ph_lo = 0; a.ph_hi = PH_HI; a.li = 0;
    hipLaunchKernelGGL(mk_fwd, dim3(grid), dim3(NTHR), LDS_BYTES, stream, a);
#endif
}
```

```cpp
#include <hip/hip_runtime.h>
#include <cstdio>
#ifndef PROBE_K
#define PROBE_K -1
#endif
#ifndef PH_HI
#define PH_HI 100
#endif
#ifndef FIN_MODE
#define FIN_MODE 0
#endif

#define GAS __attribute__((address_space(1)))
#define LAS __attribute__((address_space(3)))
typedef unsigned short bf16;
typedef unsigned v4u __attribute__((ext_vector_type(4)));
typedef unsigned v2u __attribute__((ext_vector_type(2)));
typedef float f32x4 __attribute__((ext_vector_type(4)));
typedef float f32x2 __attribute__((ext_vector_type(2)));
typedef float f32x16 __attribute__((ext_vector_type(16)));
typedef short bf16x8 __attribute__((ext_vector_type(8)));
typedef short s16x4 __attribute__((ext_vector_type(4)));
typedef GAS unsigned gu32;
#define RLX_AGENT __ATOMIC_RELAXED, __HIP_MEMORY_SCOPE_AGENT
#define LDS_WAIT() asm volatile("s_waitcnt lgkmcnt(0)" ::: "memory")
#define VM_WAIT() asm volatile("s_waitcnt vmcnt(0)" ::: "memory")

constexpr int NB = 8, SEQ = 4096, T = NB * SEQ, D = 2048, NPROJ = 6144, CW = 1024, HD = 128, NH = 8;
constexpr int PLE = 256, NE = 64, ED = 512, TOPK = 8, NSLOT = 9;
constexpr float EPS = 1e-6f;
constexpr int NWAVES = 8, NTHR = 512;
constexpr int MAXTILES = 1216;
constexpr int MAXROWS = MAXTILES * 256;
constexpr int NSLICE = 2, SLW = D / NSLICE;

constexpr size_t MiB = 1u << 20;
constexpr size_t WS_CTL = 0, CTL_ZERO_BYTES = 1 * MiB;
constexpr size_t WS_RMIX = 1 * MiB;
constexpr size_t WS_RFFN = WS_RMIX + 128 * 1024;
constexpr size_t WS_SSQ2 = WS_RFFN + 128 * 1024;
constexpr size_t WS_SSQ3 = WS_SSQ2 + 512 * 1024;
constexpr size_t WS_TOPE = WS_SSQ3 + 4 * MiB;
constexpr size_t WS_TOPW = WS_TOPE + 1 * MiB;
constexpr size_t WS_CNT  = WS_TOPW + 1 * MiB;
constexpr size_t WS_RTOK = WS_CNT + 64 * 1024;
constexpr size_t WS_RW   = WS_RTOK + 1280 * 1024;
constexpr size_t WS_RDST = WS_RW + 1280 * 1024;
constexpr size_t WS_RR   = WS_RDST + 1280 * 1024;
constexpr size_t WS_TILEE = WS_RR + 1280 * 1024;
constexpr size_t WS_WR   = 16 * MiB;
constexpr size_t WS_WIN  = 17 * MiB;
constexpr size_t WS_WOUT = WS_WIN + 24 * MiB;
constexpr size_t WS_WGU  = WS_WOUT + 8 * MiB;
constexpr size_t WS_WDN  = WS_WGU + 130 * MiB;
constexpr size_t WS_WPG  = WS_WDN + 65 * MiB;
constexpr size_t WS_WPP  = WS_WPG + 8 * MiB;
constexpr size_t WS_PB   = WS_WPP + 1 * MiB;
constexpr size_t WS_H1B  = WS_PB + 16 * MiB;
constexpr size_t WS_H1F8 = WS_H1B + 128 * MiB;
constexpr size_t WS_OVL  = WS_H1F8 + 64 * MiB;
constexpr size_t WS_PROJ = WS_OVL;
constexpr size_t WS_HPERM = WS_OVL;
constexpr size_t WS_SLOT8 = WS_OVL + 304 * MiB;
constexpr size_t WS_PP   = WS_OVL;
constexpr size_t WS_H3   = WS_OVL + 128 * MiB;
constexpr size_t WS_SLOT47 = WS_OVL + 384 * MiB;
constexpr size_t WS_END  = WS_SLOT47 + 256 * MiB;
constexpr int CW_BAR = 4096;

constexpr int RING_OFF = 0, RING_BYTES = 131072;
constexpr int RT_OFF = 131072, RT_UNITS = 20, RT_BYTES = RT_UNITS * 1024;
constexpr int TE_OFF = RT_OFF + RT_BYTES, TE_BYTES = 4864 + 128;
constexpr int MISC_OFF = TE_OFF + TE_BYTES;
constexpr int LDS_BYTES = MISC_OFF + 128;
static_assert(LDS_BYTES <= 163840, "LDS");

__device__ __forceinline__ unsigned f2bf(float f) { unsigned u = __builtin_bit_cast(unsigned, f); return (u + 0x7fffu + ((u >> 16) & 1u)) >> 16; }
__device__ __forceinline__ unsigned pk2(float lo, float hi) { return f2bf(lo) | (f2bf(hi) << 16); }
__device__ __forceinline__ float bflo(unsigned w) { return __builtin_bit_cast(float, w << 16); }
__device__ __forceinline__ float bfhi(unsigned w) { return __builtin_bit_cast(float, w & 0xffff0000u); }
__device__ __forceinline__ float wave_sum(float v) {
#pragma unroll
    for (int o = 1; o < 64; o <<= 1) v += __shfl_xor(v, o);
    return v;
}
__device__ __forceinline__ float fsigmoid(float v) { return __builtin_amdgcn_rcpf(1.f + __builtin_amdgcn_exp2f(-1.4426950409f * v)); }

#define XB_TMO      128
#define XB_XCNT(j)  (256  + 64 * (j))
#define XB_XSUB(j)  (1280 + 64 * (j))
#define XB_XGEN(j)  (2304 + 64 * (j))
#define XB_TOP      3328
#define XB_TOPGEN   3392
#define XCD_BAR_WORDS 3456
#define XB_SPIN_CAP (1u << 18)
__device__ __forceinline__ unsigned xb_ld(unsigned* p)              { return __hip_atomic_load(p, __ATOMIC_RELAXED, __HIP_MEMORY_SCOPE_AGENT); }
__device__ __forceinline__ unsigned xb_add(unsigned* p, unsigned v) { return __hip_atomic_fetch_add(p, v, __ATOMIC_RELAXED, __HIP_MEMORY_SCOPE_AGENT); }
__device__ __forceinline__ unsigned xb_xcc_id() { return (unsigned)__builtin_amdgcn_s_getreg((3 << 11) | 20) & 0xFu; }
#define XB_SPIN(cond, bar) do { unsigned _sp = 0; while (cond) { __builtin_amdgcn_s_sleep(1); \
    if ((++_sp & 255u) == 0u) { if (xb_ld(&(bar)[XB_TMO])) break; if (_sp > XB_SPIN_CAP) { atomicAdd(&(bar)[XB_TMO], 1u); break; } } } } while (0)
struct XcdBarrier { unsigned* bar; unsigned x; volatile LAS unsigned* st; };
__device__ __forceinline__ XcdBarrier xcd_barrier_post(unsigned* bar, volatile LAS unsigned* st) {
    XcdBarrier b; b.bar = bar; b.x = xb_xcc_id(); b.st = st;
    if (threadIdx.x == 0) (void)xb_add(&bar[XB_XCNT(b.x)], 1u);
    return b;
}
__device__ __forceinline__ void xcd_barrier_complete(unsigned* bar, unsigned x, unsigned& nloc, unsigned& nx) {
    const unsigned G = gridDim.x * gridDim.y * gridDim.z;
    unsigned sum, cnt, mine, sp = 0u;
    for (;;) {
        sum = 0u; cnt = 0u; mine = 0u;
#pragma unroll
        for (unsigned j = 0; j < 16; ++j) { const unsigned c = xb_ld(&bar[XB_XCNT(j)]); sum += c; cnt += (c > 0u) ? 1u : 0u; mine = (j == x) ? c : mine; }
        if (sum == G) break;
        __builtin_amdgcn_s_sleep(1);
        if ((++sp & 255u) == 0u) { if (xb_ld(&bar[XB_TMO])) break; if (sp > XB_SPIN_CAP) { atomicAdd(&bar[XB_TMO], 1u); break; } }
    }
    nloc = mine > 0u ? mine : 1u; nx = cnt > 0u ? cnt : 1u;
}
__device__ __forceinline__ void xcd_barrier(const XcdBarrier& b) {
    asm volatile("s_waitcnt vmcnt(0)" ::: "memory");
    __syncthreads();
    if (threadIdx.x == 0) {
        unsigned* bar = b.bar;
        __builtin_amdgcn_s_waitcnt(0);
        unsigned nloc = b.st[0], nx = b.st[1];
        if (nloc == 0u) { xcd_barrier_complete(bar, b.x, nloc, nx); b.st[0] = nloc; b.st[1] = nx; }
        const unsigned old = xb_add(&bar[XB_XSUB(b.x)], 1u);
        const unsigned gen = old / nloc;
        if (old + 1u == (gen + 1u) * nloc) {
            __builtin_amdgcn_fence(__ATOMIC_RELEASE, "agent");
            asm volatile("s_waitcnt vmcnt(0)" ::: "memory");
            const unsigned og = xb_add(&bar[XB_TOP], 1u);
            const unsigned tg = og / nx;
            if (og + 1u == (tg + 1u) * nx) xb_add(&bar[XB_TOPGEN], 1u);
            else XB_SPIN(xb_ld(&bar[XB_TOPGEN]) == tg, bar);
            __builtin_amdgcn_fence(__ATOMIC_ACQUIRE, "agent");
            xb_add(&bar[XB_XGEN(b.x)], 1u);
            asm volatile("s_waitcnt vmcnt(0)" ::: "memory");
        } else {
            XB_SPIN(xb_ld(&bar[XB_XGEN(b.x)]) == gen, bar);
            __builtin_amdgcn_fence(__ATOMIC_ACQUIRE, "agent");
            asm volatile("s_waitcnt vmcnt(0)" ::: "memory");
        }
    }
    __syncthreads();
}

namespace pg8 {
constexpr int BM = 256, BK = 64, HALF = 128, HTB = HALF * BK * 2, STAGE_BYTES = 8 * HTB, NXCD = 8, WGM = 8;
__device__ __forceinline__ int lds_byte(int r, int c) { const int st = (r >> 4) * 2 + (c >> 5), rr = r & 15, cc = c & 31, ob = rr * 64 + cc * 2; return st * 1024 + (ob ^ (((ob >> 9) & 1) << 5)); }
__device__ __forceinline__ void stage_rc(int b, int& R, int& C) { const int st = b / 1024, sb = b % 1024, swz = sb ^ (((sb >> 9) & 1) << 5); R = (st >> 1) * 16 + swz / 64; C = (st & 1) * 32 + (swz % 64) / 2; }
__device__ __forceinline__ int perm32(int rho) { const int n = rho >> 4, i = rho & 15; return 8 * (i >> 2) + 4 * n + (i & 3); }

struct Unit { int pm, pn, e; };

__device__ __forceinline__ bool order_next(int i, int G, int c, int nM, int nN, int& pm, int& pn) {
    const int nwg = nM * nN; const long L = (long)i * G + c; if (L >= nwg) return false;
    int wgid = (int)L; { const int q = nwg / NXCD, r = nwg % NXCD, xcd = wgid % NXCD, off = wgid / NXCD; wgid = (xcd < r ? xcd * (q + 1) : r * (q + 1) + (xcd - r) * q) + off; }
    const int nig = WGM * nN, gid = wgid / nig, fm = gid * WGM, gsz = (nM - fm) < WGM ? (nM - fm) : WGM;
    pm = fm + ((wgid % nig) % gsz); pn = (wgid % nig) / gsz; return true;
}

struct DenseSched {
    static constexpr bool GATHER = false;
    int nM, nN, G, c, KB; const char* Bt;
    __device__ __forceinline__ bool next(int i, Unit& u) const { u.e = 0; return order_next(i, G, c, nM, nN, u.pm, u.pn); }
    __device__ __forceinline__ const char* bbase(const Unit& u) const { return Bt + (size_t)u.pn * BM * KB; }
    __device__ __forceinline__ const char* abase(const char* A, const Unit& u) const { return A + (size_t)u.pm * BM * KB; }
    __device__ __forceinline__ void aoffs(int ui, const Unit& u, int tid, unsigned (&ao)[2][2]) const {}
};
template <bool GATHER_> struct GroupSched {
    static constexpr bool GATHER = GATHER_;
    int nM, nN, G, c, KB, pn0; const char* Bt; size_t estride; const LAS int* te; const LAS unsigned* rt;
    __device__ __forceinline__ bool next(int i, Unit& u) const { if (!order_next(i, G, c, nM, nN, u.pm, u.pn)) return false; u.e = __builtin_amdgcn_readfirstlane(te[u.pm]); return true; }
    __device__ __forceinline__ const char* bbase(const Unit& u) const { return Bt + (size_t)u.e * estride + (size_t)(pn0 + u.pn) * BM * KB; }
    __device__ __forceinline__ void aoffs(int ui, const Unit& u, int tid, unsigned (&ao)[2][2]) const {
        asm volatile("" : "+v"(tid));
#pragma unroll
        for (int i = 0; i < 2; ++i) { int R, C; stage_rc(tid * 16 + i * 8192, R, C);
#pragma unroll
            for (int h = 0; h < 2; ++h) { if (GATHER) ao[h][i] = rt[ui * 256 + h * HALF + R] + (unsigned)C * 2u; } }
    }
    __device__ __forceinline__ const char* abase(const char* A, const Unit& u) const { return GATHER ? A : A + (size_t)u.pm * BM * KB; }
};

__device__ __forceinline__ unsigned cvt_pk_bf16(float lo, float hi) { unsigned r; asm volatile("v_cvt_pk_bf16_f32 %0, %1, %2" : "=v"(r) : "v"(lo), "v"(hi)); return r; }

typedef int v8i __attribute__((ext_vector_type(8)));
typedef int v4i __attribute__((ext_vector_type(4)));
union Frag { v8i v; struct { v4i lo, hi; }; };
template <bool F8, class Epi, class Sched>
__device__ __forceinline__ void gemm_phase(const int tid, LAS unsigned char* lds, const char* Abase, const int KB, const Sched& S, const Epi& E, const int sw = 0x7f7f7f7f, const int sa = 0x7f7f7f7f) {
    const int wid = __builtin_amdgcn_readfirstlane(tid >> 6), lane = tid & 63, wr = wid >> 2, wc = wid & 3, fr = lane & 15, fq = lane >> 4;
    const int nt = KB / 128;
    constexpr bool GA = Sched::GATHER;
    unsigned voffB[2], voffA[2];
#pragma unroll
    for (int i = 0; i < 2; ++i) { int R, C; stage_rc(tid * 16 + i * 8192, R, C); const int Rb = (R & ~31) + perm32(R & 31); voffB[i] = (unsigned)Rb * (unsigned)KB + (unsigned)C * 2u; voffA[i] = (unsigned)R * (unsigned)KB + (unsigned)C * 2u; }
    const size_t kstep = (size_t)(BK * 2);
    const size_t hstep = (size_t)HALF * KB;
    const unsigned ldsw = (unsigned)wid * 1024u;
    const int aoff = lds_byte(wr * 64 + fr, fq * 8), boff = lds_byte(wc * 32 + fr, fq * 8);
#define PG8_SA(b, h) (((b) * 2 + (h)) * HTB)
#define PG8_SB(b, h) ((4 + (b) * 2 + (h)) * HTB)
#define PG8_STAGE(bufoff, gbase, voff) do { _Pragma("unroll") for (int _i = 0; _i < 2; ++_i) \
        __builtin_amdgcn_global_load_lds((const unsigned*)((const char*)(gbase) + (voff)[_i]), (LAS unsigned*)(lds + (bufoff) + ldsw + _i * 8192), 16, 0, 0); } while (0)
#define PG8_STAGEA(bufoff, gbase, half) do { if constexpr (GA) { PG8_STAGE(bufoff, gbase, ca[half]); } else { PG8_STAGE(bufoff, (gbase) + (half) * hstep, voffA); } } while (0)
#define PG8_LD1(dst, off) do { const v4i _lo = *(const LAS v4i*)(lds + (off)), _hi = *(const LAS v4i*)(lds + (off) + 1024); dst.lo = _lo; dst.hi = _hi; } while (0)
#define PG8_LDA(dst, b, h) do { _Pragma("unroll") for (int m = 0; m < 4; ++m) PG8_LD1(dst[m], PG8_SA(b, h) + aoff + m * 2048); } while (0)
#define PG8_LDB(dst, b, h) do { _Pragma("unroll") for (int n = 0; n < 2; ++n) PG8_LD1(dst[n], PG8_SB(b, h) + boff + n * 2048); } while (0)
#define PG8_MMA(ai, bj, At, Bt) do { __builtin_amdgcn_s_setprio(1); _Pragma("unroll") for (int m = 0; m < 4; ++m) _Pragma("unroll") for (int n = 0; n < 2; ++n) { \
        if constexpr (F8) { acc[ai][bj][m][n] = __builtin_amdgcn_mfma_scale_f32_16x16x128_f8f6f4(Bt[n].v, At[m].v, acc[ai][bj][m][n], 0, 0, 0, sw, 0, sa); } \
        else { acc[ai][bj][m][n] = __builtin_amdgcn_mfma_f32_16x16x32_bf16(__builtin_bit_cast(bf16x8, Bt[n].lo), __builtin_bit_cast(bf16x8, At[m].lo), acc[ai][bj][m][n], 0, 0, 0); \
               acc[ai][bj][m][n] = __builtin_amdgcn_mfma_f32_16x16x32_bf16(__builtin_bit_cast(bf16x8, Bt[n].hi), __builtin_bit_cast(bf16x8, At[m].hi), acc[ai][bj][m][n], 0, 0, 0); } } \
        __builtin_amdgcn_s_setprio(0); } while (0)
#define PG8_WAIT_V(n) asm volatile("s_waitcnt vmcnt(" #n ")" ::: "memory")
#define PG8_WAIT_L(n) asm volatile("s_waitcnt lgkmcnt(" #n ")" ::: "memory")
#define PG8_BAR __builtin_amdgcn_s_barrier()
#define PG8_SCHED __builtin_amdgcn_sched_barrier(0)
    Unit cur, nxt; int ui = 0;
    if (!S.next(0, cur)) return;
    f32x4 acc[2][2][4][2];
#pragma unroll
    for (int a = 0; a < 2; ++a)
#pragma unroll
        for (int b = 0; b < 2; ++b)
#pragma unroll
            for (int m = 0; m < 4; ++m)
#pragma unroll
                for (int n = 0; n < 2; ++n) acc[a][b][m][n] = (f32x4){0.f, 0.f, 0.f, 0.f};
    Frag At[4], B0[2], B1[2];
    unsigned ca[2][2], na[2][2];
    if constexpr (GA) S.aoffs(0, cur, tid, ca);
    const char* cB = S.bbase(cur); const char* cA = S.abase(Abase, cur);
    PG8_STAGE(PG8_SB(0, 0), cB, voffB); PG8_STAGEA(PG8_SA(0, 0), cA, 0); PG8_STAGE(PG8_SB(0, 1), cB + hstep, voffB); PG8_STAGEA(PG8_SA(0, 1), cA, 1);
    if (wr == 1) PG8_BAR;
    PG8_WAIT_V(4); PG8_BAR;
    PG8_STAGE(PG8_SB(1, 0), cB + kstep, voffB); PG8_STAGEA(PG8_SA(1, 0), cA + kstep, 0); PG8_STAGE(PG8_SB(1, 1), cB + hstep + kstep, voffB);
    PG8_WAIT_V(6); PG8_BAR;
    for (;;) {
        const bool has_next = S.next(ui + 1, nxt);
        const char* nB = has_next ? S.bbase(nxt) : cB; const char* nA = has_next ? S.abase(Abase, nxt) : cA;
        if constexpr (GA) {
            if (has_next) S.aoffs(ui + 1, nxt, tid, na);
            else {
#pragma unroll
                for (int h = 0; h < 2; ++h)
#pragma unroll
                    for (int i = 0; i < 2; ++i) na[h][i] = ca[h][i];
            }
        }
#pragma nounroll
        for (int t = 0; t < nt; t += 2) {
            const bool last = (t == nt - 2);
            const char* a1 = cA + (size_t)(t + 1) * kstep;
            const char* a2 = last ? nA : cA + (size_t)(t + 2) * kstep; const char* b2 = last ? nB : cB + (size_t)(t + 2) * kstep;
            const char* a3 = a2 + kstep; const char* b3 = b2 + kstep;
            PG8_LDB(B0, 0, 0); PG8_SCHED; PG8_LDA(At, 0, 0); PG8_STAGEA(PG8_SA(1, 1), a1, 1);
            PG8_WAIT_L(8); PG8_BAR; PG8_WAIT_L(0); PG8_MMA(0, 0, At, B0); PG8_BAR; PG8_SCHED;
            if constexpr (GA) { if (last) {
#pragma unroll
                for (int h = 0; h < 2; ++h)
#pragma unroll
                    for (int i = 0; i < 2; ++i) ca[h][i] = na[h][i];
            } }
            PG8_LDB(B1, 0, 1); PG8_STAGE(PG8_SB(0, 0), b2, voffB);
            PG8_BAR; PG8_WAIT_L(0); PG8_MMA(0, 1, At, B1); PG8_BAR;
            PG8_LDA(At, 0, 1); PG8_STAGEA(PG8_SA(0, 0), a2, 0);
            PG8_BAR; PG8_WAIT_L(0); PG8_MMA(1, 0, At, B0); PG8_BAR; PG8_SCHED;
            PG8_STAGE(PG8_SB(0, 1), b2 + hstep, voffB);
            PG8_WAIT_V(6); PG8_BAR; PG8_MMA(1, 1, At, B1); PG8_BAR;
            PG8_LDB(B0, 1, 0); PG8_SCHED; PG8_LDA(At, 1, 0); PG8_STAGEA(PG8_SA(0, 1), a2, 1);
            PG8_WAIT_L(8); PG8_BAR; PG8_WAIT_L(0); PG8_MMA(0, 0, At, B0); PG8_BAR; PG8_SCHED;
            PG8_LDB(B1, 1, 1); PG8_STAGE(PG8_SB(1, 0), b3, voffB);
            PG8_BAR; PG8_WAIT_L(0); PG8_MMA(0, 1, At, B1); PG8_BAR;
            PG8_LDA(At, 1, 1); PG8_STAGEA(PG8_SA(1, 0), a3, 0);
            PG8_BAR; PG8_WAIT_L(0); PG8_MMA(1, 0, At, B0); PG8_BAR; PG8_SCHED;
            PG8_STAGE(PG8_SB(1, 1), b3 + hstep, voffB);
            PG8_WAIT_V(6); PG8_BAR; PG8_MMA(1, 1, At, B1); PG8_BAR;
        }
        { int tz = tid; asm volatile("" : "+v"(tz)); const int l2 = tz & 63; E(acc, cur, wr, wc, l2 & 15, l2 >> 4); }
        if (!has_next) break;
#pragma unroll
        for (int a = 0; a < 2; ++a)
#pragma unroll
            for (int b = 0; b < 2; ++b)
#pragma unroll
                for (int m = 0; m < 4; ++m)
#pragma unroll
                    for (int n = 0; n < 2; ++n) acc[a][b][m][n] = (f32x4){0.f, 0.f, 0.f, 0.f};
        cur = nxt; cB = nB; cA = nA; ++ui;
    }
    PG8_WAIT_V(0);
    if (wr == 0) PG8_BAR;
    PG8_BAR;
#undef PG8_SA
#undef PG8_SB
#undef PG8_STAGE
#undef PG8_STAGEA
#undef PG8_LD1
#undef PG8_LDA
#undef PG8_LDB
#undef PG8_MMA
#undef PG8_WAIT_V
#undef PG8_WAIT_L
#undef PG8_BAR
#undef PG8_SCHED
}

struct EpiBf16Scale {
    bf16* O; int ldc; const float* rs;
    __device__ __forceinline__ void operator()(const f32x4 (&acc)[2][2][4][2], const Unit& u, int wr, int wc, int fr, int fq) const {
        const int row0 = u.pm * BM + wr * 64 + fr, col0 = u.pn * BM + wc * 32 + 8 * fq;
#pragma unroll
        for (int ai = 0; ai < 2; ++ai)
#pragma unroll
            for (int m = 0; m < 4; ++m) { const int row = row0 + ai * HALF + m * 16; const float s = rs ? rs[row] : 1.f; bf16* rowp = O + (size_t)row * ldc + col0;
#pragma unroll
                for (int bj = 0; bj < 2; ++bj) { const f32x4 v0 = acc[ai][bj][m][0] * s, v1 = acc[ai][bj][m][1] * s;
                    v4u w; w.x = cvt_pk_bf16(v0[0], v0[1]); w.y = cvt_pk_bf16(v0[2], v0[3]); w.z = cvt_pk_bf16(v1[0], v1[1]); w.w = cvt_pk_bf16(v1[2], v1[3]);
                    *(v4u*)(rowp + bj * HALF) = w; } }
    }
};
__device__ __forceinline__ unsigned cvt4_fp8(float a, float b, float c, float d) { int w = 0; w = __builtin_amdgcn_cvt_pk_fp8_f32(a, b, w, false); w = __builtin_amdgcn_cvt_pk_fp8_f32(c, d, w, true); return (unsigned)w; }
struct EpiResF32 {
    bf16* O; const bf16* X; int ldc; unsigned char* O8;
    __device__ __forceinline__ void operator()(const f32x4 (&acc)[2][2][4][2], const Unit& u, int wr, int wc, int fr, int fq) const {
        const int row0 = u.pm * BM + wr * 64 + fr, col0 = u.pn * BM + wc * 32 + 8 * fq;
#pragma unroll
        for (int ai = 0; ai < 2; ++ai)
#pragma unroll
            for (int m = 0; m < 4; ++m) { const size_t ro = (size_t)(row0 + ai * HALF + m * 16) * ldc + col0;
#pragma unroll
                for (int bj = 0; bj < 2; ++bj) { const v4u xw = *(const v4u*)(X + ro + bj * HALF);
                    const f32x4 x0 = (f32x4){bflo(xw[0]), bfhi(xw[0]), bflo(xw[1]), bfhi(xw[1])}, x1 = (f32x4){bflo(xw[2]), bfhi(xw[2]), bflo(xw[3]), bfhi(xw[3])};
                    const f32x4 v0 = acc[ai][bj][m][0] + x0, v1 = acc[ai][bj][m][1] + x1;
                    v4u w; w.x = cvt_pk_bf16(v0[0], v0[1]); w.y = cvt_pk_bf16(v0[2], v0[3]); w.z = cvt_pk_bf16(v1[0], v1[1]); w.w = cvt_pk_bf16(v1[2], v1[3]);
                    *(v4u*)(O + ro + bj * HALF) = w;
                    v2u w8; w8.x = cvt4_fp8(v0[0], v0[1], v0[2], v0[3]); w8.y = cvt4_fp8(v1[0], v1[1], v1[2], v1[3]);
                    *(v2u*)(O8 + ro + bj * HALF) = w8; } }
    }
};
struct EpiGateUp {
    unsigned char* Hp; const float* rr;
    __device__ __forceinline__ void operator()(const f32x4 (&acc)[2][2][4][2], const Unit& u, int wr, int wc, int fr, int fq) const {
        const int row0 = u.pm * BM + wr * 64 + fr, col0 = u.pn * HALF + wc * 32 + 8 * fq;
#pragma unroll
        for (int ai = 0; ai < 2; ++ai)
#pragma unroll
            for (int m = 0; m < 4; ++m) { const int row = row0 + ai * HALF + m * 16; const float s = rr[row];
                float h[8];
#pragma unroll
                for (int n = 0; n < 2; ++n)
#pragma unroll
                    for (int j = 0; j < 4; ++j) { const float g = acc[ai][0][m][n][j] * s, up = acc[ai][1][m][n][j] * s; h[n * 4 + j] = g * fsigmoid(g) * up; }
                v2u w; w.x = cvt4_fp8(h[0], h[1], h[2], h[3]); w.y = cvt4_fp8(h[4], h[5], h[6], h[7]);
                *(v2u*)(Hp + (size_t)row * ED + col0) = w; }
    }
};
struct EpiDown {
    bf16* S0; bf16* S1; bf16* S8; const float* rw; const int* rdst;
    __device__ __forceinline__ void operator()(const f32x4 (&acc)[2][2][4][2], const Unit& u, int wr, int wc, int fr, int fq) const {
        const int row0 = u.pm * BM + wr * 64 + fr, col0 = u.pn * BM + wc * 32 + 8 * fq;
#pragma unroll
        for (int ai = 0; ai < 2; ++ai)
#pragma unroll
            for (int m = 0; m < 4; ++m) { const int row = row0 + ai * HALF + m * 16; const float s = rw[row]; const int dst = rdst[row];
                if (dst >= 0) { bf16* rowp = (dst < 4 * T ? S0 + (size_t)dst * SLW : dst < 8 * T ? S1 + (size_t)(dst - 4 * T) * SLW : S8 + (size_t)(dst - 8 * T) * SLW) + col0;
#pragma unroll
                    for (int bj = 0; bj < 2; ++bj) { const f32x4 v0 = acc[ai][bj][m][0] * s, v1 = acc[ai][bj][m][1] * s;
                        v4u w; w.x = cvt_pk_bf16(v0[0], v0[1]); w.y = cvt_pk_bf16(v0[2], v0[3]); w.z = cvt_pk_bf16(v1[0], v1[1]); w.w = cvt_pk_bf16(v1[2], v1[3]);
                        *(v4u*)(rowp + bj * HALF) = w; } } }
    }
};
struct EpiPle {
    bf16* H3; const bf16* H2; const bf16* PP; const float* ssq2; float* ssq3;
    __device__ __forceinline__ void operator()(const f32x4 (&acc)[2][2][4][2], const Unit& u, int wr, int wc, int fr, int fq) const {
        const int row0 = u.pm * BM + wr * 64 + fr, col0 = u.pn * BM + wc * 32 + 8 * fq;
#pragma unroll
        for (int ai = 0; ai < 2; ++ai)
#pragma unroll
            for (int m = 0; m < 4; ++m) { const int row = row0 + ai * HALF + m * 16;
                float sq = 0.f;
#pragma unroll
                for (int sl = 0; sl < NSLICE; ++sl) sq += ssq2[sl * T + row];
                const float r = __builtin_amdgcn_rsqf(sq * (1.f / D) + EPS);
                const size_t ro = (size_t)row * D + col0; float ss = 0.f;
#pragma unroll
                for (int bj = 0; bj < 2; ++bj) { const v4u h2 = *(const v4u*)(H2 + ro + bj * HALF), pp = *(const v4u*)(PP + ro + bj * HALF);
                    float o[8];
#pragma unroll
                    for (int q = 0; q < 4; ++q) { const int n = q >> 1, j = (q & 1) * 2;
                        const float g0 = fsigmoid(acc[ai][bj][m][n][j] * r), g1 = fsigmoid(acc[ai][bj][m][n][j + 1] * r);
                        o[2 * q] = bflo(h2[q]) + g0 * bflo(pp[q]); o[2 * q + 1] = bfhi(h2[q]) + g1 * bfhi(pp[q]);
                        ss += o[2 * q] * o[2 * q] + o[2 * q + 1] * o[2 * q + 1]; }
                    v4u w; w.x = cvt_pk_bf16(o[0], o[1]); w.y = cvt_pk_bf16(o[2], o[3]); w.z = cvt_pk_bf16(o[4], o[5]); w.w = cvt_pk_bf16(o[6], o[7]);
                    *(v4u*)(H3 + ro + bj * HALF) = w; }
                ss += __shfl_xor(ss, 16); ss += __shfl_xor(ss, 32);
                if (fq == 0) ssq3[(size_t)(u.pn * 4 + wc) * T + row] = ss; }
    }
};
}

struct Frame {
    LAS unsigned char* lds;
    int tid, lane, wave, G, bx;
    unsigned char* ws;
    const float* in[21];
    float* out;
};
enum { I_X = 0, I_P, I_NMIX, I_WIN, I_CONVW, I_GCONV, I_GSB, I_WOUT, I_NFFN, I_WR, I_RB, I_WEG, I_WEU, I_WED, I_WSG, I_WSU, I_WSD, I_NPLE, I_WPG, I_WPP, I_NFIN };

__device__ __forceinline__ void p0_transpose_item(const float* W, int N, bf16* WT, int ldk, int k0, int n0, int row_off, const float* g64, LAS float* scr, int lane) {
    const int n4 = lane & 15, kr = lane >> 4;
    f32x4 v[16];
    const float* src = W + (size_t)(k0 + kr) * N + n0 + 4 * n4;
#pragma unroll
    for (int i = 0; i < 16; ++i) v[i] = *(const GAS f32x4*)(src + (size_t)(4 * i) * N);
    const int c = lane >> 3, nn = lane & 7;
    f32x4 ga = (f32x4){1.f, 1.f, 1.f, 1.f}, gb = ga;
    if (g64) { ga = *(const GAS f32x4*)(g64 + 8 * c); gb = *(const GAS f32x4*)(g64 + 8 * c + 4); }
#pragma unroll
    for (int i = 0; i < 16; ++i) { LAS float* d = scr + (4 * i + kr) * 65 + 4 * n4; d[0] = v[i].x; d[1] = v[i].y; d[2] = v[i].z; d[3] = v[i].w; }
    LDS_WAIT(); asm volatile("" ::: "memory");
#pragma unroll
    for (int j = 0; j < 8; ++j) { const int n = nn + 8 * j; const LAS float* s = scr + (8 * c) * 65 + n;
        v4u o; o.x = pg8::cvt_pk_bf16(s[0] * ga.x, s[65] * ga.y); o.y = pg8::cvt_pk_bf16(s[130] * ga.z, s[195] * ga.w); o.z = pg8::cvt_pk_bf16(s[260] * gb.x, s[325] * gb.y); o.w = pg8::cvt_pk_bf16(s[390] * gb.z, s[455] * gb.w);
        *(GAS v4u*)(WT + (size_t)(row_off + n) * ldk + k0 + 8 * c) = o; }
    LDS_WAIT(); asm volatile("" ::: "memory");
}
__device__ __forceinline__ void p0_transpose_item_f8(const float* W, int N, unsigned char* WT, int ldk, int k0, int n0, int row_off, const float* g64, LAS float* scr, int lane) {
    const int n4 = lane & 15, kr = lane >> 4;
    f32x4 v[16];
    const float* src = W + (size_t)(k0 + kr) * N + n0 + 4 * n4;
#pragma unroll
    for (int i = 0; i < 16; ++i) v[i] = *(const GAS f32x4*)(src + (size_t)(4 * i) * N);
    const int c = lane >> 4, nn = lane & 15;
    float g[16];
#pragma unroll
    for (int q = 0; q < 4; ++q) { f32x4 t = (f32x4){1.f, 1.f, 1.f, 1.f}; if (g64) t = *(const GAS f32x4*)(g64 + 16 * c + 4 * q); g[4 * q] = 64.f * t.x; g[4 * q + 1] = 64.f * t.y; g[4 * q + 2] = 64.f * t.z; g[4 * q + 3] = 64.f * t.w; }
#pragma unroll
    for (int i = 0; i < 16; ++i) { LAS float* d = scr + (4 * i + kr) * 65 + 4 * n4; d[0] = v[i].x; d[1] = v[i].y; d[2] = v[i].z; d[3] = v[i].w; }
    LDS_WAIT(); asm volatile("" ::: "memory");
#pragma unroll
    for (int j = 0; j < 4; ++j) { const int n = nn + 16 * j; const LAS float* s = scr + (16 * c) * 65 + n;
        v4u o;
        o.x = pg8::cvt4_fp8(s[0] * g[0], s[65] * g[1], s[130] * g[2], s[195] * g[3]); o.y = pg8::cvt4_fp8(s[260] * g[4], s[325] * g[5], s[390] * g[6], s[455] * g[7]);
        o.z = pg8::cvt4_fp8(s[520] * g[8], s[585] * g[9], s[650] * g[10], s[715] * g[11]); o.w = pg8::cvt4_fp8(s[780] * g[12], s[845] * g[13], s[910] * g[14], s[975] * g[15]);
        *(GAS v4u*)(WT + (size_t)(row_off + n) * ldk + k0 + 16 * c) = o; }
    LDS_WAIT(); asm volatile("" ::: "memory");
}
constexpr int P0_I_WIN = (D / 64) * (NPROJ / 64), P0_I_WOUT = (D / 64) * (D / 64), P0_I_WR = (D / 64) * (NE / 64), P0_I_WPG = (D / 64) * (D / 64), P0_I_WPP = (PLE / 64) * (D / 64);
constexpr int P0_I_EXP = 768, P0_NITEMS = P0_I_WIN + P0_I_WOUT + P0_I_WR + P0_I_WPG + P0_I_WPP + 65 * P0_I_EXP;
__device__ __forceinline__ void p0_item(Frame& F, int it, LAS float* scr) {
    unsigned char* ws = F.ws; const int lane = F.lane;
    if (it < P0_I_WIN) { const int kb = it / (NPROJ / 64), nb = it % (NPROJ / 64); p0_transpose_item(F.in[I_WIN], NPROJ, (bf16*)(ws + WS_WIN), D, 64 * kb, 64 * nb, 64 * nb, F.in[I_NMIX] + 64 * kb, scr, lane); return; } it -= P0_I_WIN;
    if (it < P0_I_WOUT) { const int kb = it / (D / 64), nb = it % (D / 64), k0 = 64 * kb; const float* g = k0 < CW ? F.in[I_GCONV] + k0 : F.in[I_GSB] + (k0 - CW);
        p0_transpose_item(F.in[I_WOUT], D, (bf16*)(ws + WS_WOUT), D, k0, 64 * nb, 64 * nb, g, scr, lane); return; } it -= P0_I_WOUT;
    if (it < P0_I_WR) { const int kb = it; p0_transpose_item(F.in[I_WR], NE, (bf16*)(ws + WS_WR), D, 64 * kb, 0, 0, F.in[I_NFFN] + 64 * kb, scr, lane); return; } it -= P0_I_WR;
    if (it < P0_I_WPG) { const int kb = it / (D / 64), nb = it % (D / 64); p0_transpose_item(F.in[I_WPG], D, (bf16*)(ws + WS_WPG), D, 64 * kb, 64 * nb, 64 * nb, F.in[I_NPLE] + 64 * kb, scr, lane); return; } it -= P0_I_WPG;
    if (it < P0_I_WPP) { const int kb = it / (D / 64), nb = it % (D / 64); p0_transpose_item(F.in[I_WPP], D, (bf16*)(ws + WS_WPP), PLE, 64 * kb, 64 * nb, 64 * nb, nullptr, scr, lane); return; } it -= P0_I_WPP;
    const int e = it / P0_I_EXP, r = it % P0_I_EXP, sub = r / 256, q = r % 256;
    if (sub < 2) {
        const float* src = e < NE ? (sub == 0 ? F.in[I_WEG] : F.in[I_WEU]) + (size_t)e * D * ED : (sub == 0 ? F.in[I_WSG] : F.in[I_WSU]);
        const int kb = q / (ED / 64), nb = q % (ED / 64), n0 = 64 * nb, ro = 256 * (n0 / 128) + (n0 % 128) + (sub == 1 ? 128 : 0);
        p0_transpose_item_f8(src, ED, ws + WS_WGU + (size_t)e * 1024 * D, D, 64 * kb, n0, ro, F.in[I_NFFN] + 64 * kb, scr, lane);
    } else {
        const float* src = e < NE ? F.in[I_WED] + (size_t)e * ED * D : F.in[I_WSD];
        const int kb = q / (D / 64), nb = q % (D / 64);
        p0_transpose_item_f8(src, D, ws + WS_WDN + (size_t)e * D * ED, ED, 64 * kb, 64 * nb, 64 * nb, nullptr, scr, lane);
    }
}
__device__ __forceinline__ void p0_prologue(Frame& F) {
    LAS float* scr = (LAS float*)(F.lds + RING_OFF + F.wave * 16896);
    const int gw = F.bx * NWAVES + F.wave, NGW = F.G * NWAVES;
    {
        bf16* XB = (bf16*)F.out; float* rmix = (float*)(F.ws + WS_RMIX); const float* x = F.in[I_X];
        for (int m = gw; m < T; m += NGW) {
            const GAS f32x4* xr = (const GAS f32x4*)(x + (size_t)m * D) + F.lane;
            f32x4 v[8]; float s = 0.f;
#pragma unroll
            for (int j = 0; j < 8; ++j) { v[j] = xr[64 * j]; s += (v[j].x * v[j].x + v[j].y * v[j].y) + (v[j].z * v[j].z + v[j].w * v[j].w); }
            s = wave_sum(s);
            if (F.lane == 0) rmix[m] = __builtin_amdgcn_rsqf(s * (1.f / D) + EPS);
            GAS v2u* o8 = (GAS v2u*)(XB + (size_t)m * D) + F.lane;
#pragma unroll
            for (int j = 0; j < 8; ++j) { v2u w; w.x = pk2(v[j].x, v[j].y); w.y = pk2(v[j].z, v[j].w); o8[64 * j] = w; }
        }
    }
    {
        const float* p = F.in[I_P]; bf16* PB = (bf16*)(F.ws + WS_PB);
        const int nchunk = T * PLE / 8, gt = F.bx * NTHR + F.tid, NGT = F.G * NTHR;
        for (int c = gt; c < nchunk; c += NGT) { const f32x4 a = *(const GAS f32x4*)(p + (size_t)c * 8), b = *(const GAS f32x4*)(p + (size_t)c * 8 + 4);
            v4u w; w.x = pk2(a.x, a.y); w.y = pk2(a.z, a.w); w.z = pk2(b.x, b.y); w.w = pk2(b.z, b.w); *(GAS v4u*)(PB + (size_t)c * 8) = w; }
    }
    for (int it = gw; it < P0_NITEMS; it += NGW) p0_item(F, it, scr);
}

__device__ __forceinline__ unsigned off_b(unsigned row, unsigned ch) { return 256u * row + 16u * (ch ^ (((row & 3) << 2) | ((row >> 2) & 3))); }
#define MFMA32(a, b, c) __builtin_amdgcn_mfma_f32_32x32x16_bf16((a), (b), (c), 0, 0, 0)

__device__ __forceinline__ void conv_item(Frame& F, int it) {
    const bf16* proj = (const bf16*)(F.ws + WS_PROJ); bf16* ymix = (bf16*)F.out + (size_t)T * D;
    const float* cw = F.in[I_CONVW]; const int lane = F.lane;
    float w0[16], w1[16], w2[16], u1[16], u2[16];
#pragma unroll
    for (int j = 0; j < 2; ++j)
#pragma unroll
        for (int i = 0; i < 8; ++i) { const int c = 512 * j + 8 * lane + i; w0[8 * j + i] = cw[c]; w1[8 * j + i] = cw[CW + c]; w2[8 * j + i] = cw[2 * CW + c]; u1[8 * j + i] = 0.f; u2[8 * j + i] = 0.f; }
    const int t0 = 16 * it; const bool seq_start = (t0 & (SEQ - 1)) == 0;
    for (int tt = -2; tt < 16; ++tt) {
        if (tt < 0 && seq_start) continue;
        const size_t t = (size_t)(t0 + tt);
        const bf16* pr = proj + t * NPROJ + 8 * lane;
        float u[16], cb[16];
#pragma unroll
        for (int j = 0; j < 2; ++j) { const v4u h = *(const GAS v4u*)(pr + 512 * j), c = *(const GAS v4u*)(pr + 2 * CW + 512 * j);
#pragma unroll
            for (int q = 0; q < 4; ++q) { u[8 * j + 2 * q] = bflo(h[q]) * bflo(c[q]); u[8 * j + 2 * q + 1] = bfhi(h[q]) * bfhi(c[q]); } }
        if (tt >= 0) {
#pragma unroll
            for (int j = 0; j < 2; ++j) { const v4u b = *(const GAS v4u*)(pr + CW + 512 * j);
#pragma unroll
                for (int q = 0; q < 4; ++q) { cb[8 * j + 2 * q] = bflo(b[q]); cb[8 * j + 2 * q + 1] = bfhi(b[q]); } }
            float y[16], ss = 0.f;
#pragma unroll
            for (int i = 0; i < 16; ++i) { y[i] = cb[i] * (w0[i] * u2[i] + w1[i] * u1[i] + w2[i] * u[i]); ss += y[i] * y[i]; }
            const float r = __builtin_amdgcn_rsqf(wave_sum(ss) * (1.f / CW) + EPS);
            bf16* yo = ymix + t * D + 8 * lane;
#pragma unroll
            for (int j = 0; j < 2; ++j) { v4u w; w.x = pk2(y[8 * j] * r, y[8 * j + 1] * r); w.y = pk2(y[8 * j + 2] * r, y[8 * j + 3] * r); w.z = pk2(y[8 * j + 4] * r, y[8 * j + 5] * r); w.w = pk2(y[8 * j + 6] * r, y[8 * j + 7] * r);
                *(GAS v4u*)(yo + 512 * j) = w; }
        }
#pragma unroll
        for (int i = 0; i < 16; ++i) { u2[i] = u1[i]; u1[i] = u[i]; }
    }
}

__device__ __forceinline__ bf16x8 pack8(float a0, float a1, float a2, float a3, float a4, float a5, float a6, float a7) {
    v4u p; p.x = pk2(a0, a1); p.y = pk2(a2, a3); p.z = pk2(a4, a5); p.w = pk2(a6, a7); return __builtin_bit_cast(bf16x8, p);
}
__device__ __forceinline__ void tr_read4(unsigned a_t0, unsigned a_t1, s16x4& r00, s16x4& r01, s16x4& r10, s16x4& r11) {
    asm volatile("ds_read_b64_tr_b16 %0, %4\n\tds_read_b64_tr_b16 %1, %5\n\tds_read_b64_tr_b16 %2, %4 offset:4096\n\tds_read_b64_tr_b16 %3, %5 offset:4096\n\ts_waitcnt lgkmcnt(0)"
                 : "=&v"(r00), "=&v"(r01), "=&v"(r10), "=&v"(r11) : "v"(a_t0), "v"(a_t1) : "memory");
}
constexpr float ATT_C = 0.08838834764831845f * 1.4426950408889634f;
constexpr float ATT_EXIT = -152.f;

__device__ __forceinline__ void attn_unit(Frame& F, int b, int qblk, int parity) {
    const int lane = F.lane, h = F.wave, r = lane & 31, hh = lane >> 5;
    const bf16* proj = (const bf16*)(F.ws + WS_PROJ); bf16* ymix = (bf16*)F.out + (size_t)T * D;
    const size_t rowbase = (size_t)b * SEQ; const int t0 = qblk * 32;
    LAS unsigned char* kt = F.lds + h * 16384; LAS unsigned char* vt = kt + 8192;
    LAS float* XS = (LAS float*)(F.lds + RT_OFF) + parity * 256;
    bf16x8 qf[8];
    { const bf16* qp = proj + (rowbase + t0 + r) * NPROJ + 3 * CW + h * HD + 8 * hh;
#pragma unroll
      for (int kk = 0; kk < 8; ++kk) qf[kk] = *(const GAS bf16x8*)(qp + 16 * kk); }
    f32x16 oacc[4];
#pragma unroll
    for (int c = 0; c < 4; ++c)
#pragma unroll
        for (int i = 0; i < 16; ++i) oacc[c][i] = 0.f;
    float L = 0.f;
    const unsigned pr = (unsigned)((r & 19) | ((r & 4) << 1) | ((r & 8) >> 1));
    const unsigned ktb = (unsigned)(size_t)kt, vtb = (unsigned)(size_t)vt;
    unsigned va[2][4];
    { const unsigned blk = (lane >> 4) & 1, q = (lane & 15) >> 2, p = lane & 3;
#pragma unroll
      for (int t = 0; t < 2; ++t)
#pragma unroll
          for (int c = 0; c < 4; ++c) va[t][c] = vtb + off_b(8 * hh + 4 * t + q, 4 * c + 2 * blk + (p >> 1)) + 8 * (p & 1); }
    for (int kti = qblk; kti >= 0; --kti) {
        const int s0 = kti * 32;
        {
            v4u kreg[8], vreg[8];
            const bf16* kp = proj + (rowbase + s0 + (lane >> 4)) * NPROJ + 4 * CW + h * HD + (lane & 15) * 8;
#pragma unroll
            for (int i = 0; i < 8; ++i) { kreg[i] = *(const GAS v4u*)(kp + (size_t)(4 * i) * NPROJ); vreg[i] = *(const GAS v4u*)(kp + (size_t)(4 * i) * NPROJ + CW); }
#pragma unroll
            for (int i = 0; i < 8; ++i) { const unsigned o = off_b(4 * i + (lane >> 4), lane & 15); *(LAS v4u*)(kt + o) = kreg[i]; *(LAS v4u*)(vt + o) = vreg[i]; }
        }
        LDS_WAIT();
        f32x16 x;
#pragma unroll
        for (int i = 0; i < 16; ++i) x[i] = 0.f;
#pragma unroll
        for (int kk = 0; kk < 8; ++kk) { const bf16x8 kf = *(const LAS bf16x8*)(kt + off_b(pr, 2 * kk + hh)); x = MFMA32(kf, qf[kk], x); }
        const bool diag = (kti == qblk);
        float zz[16], suf[16];
#pragma unroll
        for (int i = 0; i < 16; ++i) {
            zz[i] = x[i] * ATT_C;
            const float e = __builtin_amdgcn_exp2f(fminf(zz[i], 126.f));
            float l = -__builtin_amdgcn_logf(1.f + e);
            const int kap = 16 * (i >> 3) + 8 * hh + (i & 7);
            if (diag && !(kap < r)) l = 0.f;
            suf[i] = l;
        }
#pragma unroll
        for (int j = 6; j >= 0; --j) { suf[j] += suf[j + 1]; suf[8 + j] += suf[8 + j + 1]; }
        const float T0 = suf[0], T1 = suf[8];
        const float T0p = __shfl_xor(T0, 32), T1p = __shfl_xor(T1, 32);
        const float base0 = L + T1 + T1p + (hh == 0 ? T0p : 0.f), base1 = L + (hh == 0 ? T1p : 0.f);
        float a[16];
#pragma unroll
        for (int i = 0; i < 16; ++i) {
            float v = __builtin_amdgcn_exp2f(zz[i] + (i < 8 ? base0 : base1) + suf[i]);
            const int kap = 16 * (i >> 3) + 8 * hh + (i & 7);
            if (diag && !(kap < r)) v = 0.f;
            a[i] = v;
        }
        L += (T0 + T1) + (T0p + T1p);
        const bf16x8 pf0 = pack8(a[0], a[1], a[2], a[3], a[4], a[5], a[6], a[7]);
        const bf16x8 pf1 = pack8(a[8], a[9], a[10], a[11], a[12], a[13], a[14], a[15]);
#pragma unroll
        for (int c = 0; c < 4; ++c) {
            s16x4 r00, r01, r10, r11; tr_read4(va[0][c], va[1][c], r00, r01, r10, r11);
            const bf16x8 vf0 = __builtin_shufflevector(r00, r01, 0, 1, 2, 3, 4, 5, 6, 7), vf1 = __builtin_shufflevector(r10, r11, 0, 1, 2, 3, 4, 5, 6, 7);
            oacc[c] = MFMA32(vf0, pf0, oacc[c]); oacc[c] = MFMA32(vf1, pf1, oacc[c]);
        }
        if (__all(L < ATT_EXIT)) break;
    }
    float ss = 0.f;
#pragma unroll
    for (int c = 0; c < 4; ++c)
#pragma unroll
        for (int i = 0; i < 16; ++i) ss += oacc[c][i] * oacc[c][i];
    ss += __shfl_xor(ss, 32);
    if (hh == 0) XS[h * 32 + r] = ss;
    __syncthreads();
    float tot = 0.f;
#pragma unroll
    for (int w = 0; w < 8; ++w) tot += XS[w * 32 + r];
    const float rs = __builtin_amdgcn_rsqf(tot * (1.f / CW) + EPS);
    bf16* yo = ymix + (rowbase + t0 + r) * D + CW + h * HD + 4 * hh;
#pragma unroll
    for (int c = 0; c < 4; ++c)
#pragma unroll
        for (int g = 0; g < 4; ++g) { v2u w; w.x = pk2(oacc[c][4 * g] * rs, oacc[c][4 * g + 1] * rs); w.y = pk2(oacc[c][4 * g + 2] * rs, oacc[c][4 * g + 3] * rs);
            *(GAS v2u*)(yo + 32 * c + 8 * g) = w; }
}
__device__ __forceinline__ void p2_mixer(Frame& F) {
    int par = 0;
    for (int u = F.bx; u < NB * (SEQ / 32); u += F.G) { attn_unit(F, u / (SEQ / 32), u % (SEQ / 32), par); par ^= 1; }
    const int gw = F.bx * NWAVES + F.wave, NGW = F.G * NWAVES;
    for (int it = gw; it < T / 16; it += NGW) conv_item(F, it);
}

__device__ __forceinline__ void router_unit(Frame& F, int unit, LAS int* hist) {
    const int lane = F.lane, r16 = lane & 15, g = lane >> 4;
    const bf16* H = (const bf16*)(F.ws + WS_H1B); const bf16* WR = (const bf16*)(F.ws + WS_WR);
    const int t0 = unit * 16;
    LAS float* LG = (LAS float*)(F.lds + F.wave * 16384); LAS float* BI = LG + 16 * 65 + 16;
    f32x4 acc[4];
#pragma unroll
    for (int nb = 0; nb < 4; ++nb) acc[nb] = (f32x4){0.f, 0.f, 0.f, 0.f};
    float ss = 0.f;
    const bf16* ap = H + (size_t)(t0 + r16) * D + 8 * g; const bf16* bp = WR + (size_t)r16 * D + 8 * g;
#pragma unroll 4
    for (int ks = 0; ks < D / 32; ++ks) {
        const v4u aw = *(const GAS v4u*)(ap + 32 * ks);
#pragma unroll
        for (int q = 0; q < 4; ++q) { const float lo = bflo(aw[q]), hi = bfhi(aw[q]); ss += lo * lo + hi * hi; }
        const bf16x8 af = __builtin_bit_cast(bf16x8, aw);
#pragma unroll
        for (int nb = 0; nb < 4; ++nb) { const bf16x8 bf = *(const GAS bf16x8*)(bp + (size_t)(16 * nb) * D + 32 * ks); acc[nb] = __builtin_amdgcn_mfma_f32_16x16x32_bf16(af, bf, acc[nb], 0, 0, 0); }
    }
    ss += __shfl_xor(ss, 16); ss += __shfl_xor(ss, 32);
#pragma unroll
    for (int nb = 0; nb < 4; ++nb)
#pragma unroll
        for (int j = 0; j < 4; ++j) LG[(4 * g + j) * 65 + 16 * nb + r16] = acc[nb][j];
    LDS_WAIT();
    if (lane < 16) {
        const int t = t0 + lane; const float rs = __builtin_amdgcn_rsqf(ss * (1.f / D) + EPS);
        ((float*)(F.ws + WS_RFFN))[t] = rs;
        LAS float* lg = LG + lane * 65; LAS float* bi = BI + lane * 65; const float* rb = F.in[I_RB];
        for (int e = 0; e < NE; ++e) { const float s = fsigmoid(lg[e] * rs); lg[e] = s; bi[e] = s + rb[e]; }
        float gs[8];
#pragma unroll
        for (int gg = 0; gg < 8; ++gg) { float m1 = -__builtin_inff(), m2 = -__builtin_inff();
#pragma unroll
            for (int j = 0; j < 8; ++j) { const float v = bi[8 * gg + j]; if (v > m1) { m2 = m1; m1 = v; } else if (v > m2) m2 = v; }
            gs[gg] = m1 + m2; }
        unsigned gmask = 0u;
#pragma unroll
        for (int gg = 0; gg < 8; ++gg) { int cnt = 0;
#pragma unroll
            for (int g2 = 0; g2 < 8; ++g2) cnt += (gs[g2] > gs[gg] || (gs[g2] == gs[gg] && g2 < gg)) ? 1 : 0;
            if (cnt < 4) gmask |= 1u << gg; }
        int se[8]; float sv[8]; float wsum = 0.f;
#pragma unroll
        for (int k = 0; k < 8; ++k) { float best = -__builtin_inff(); int be = 0;
            for (int e = 0; e < NE; ++e) { const float v = bi[e]; if (((gmask >> (e >> 3)) & 1u) && v > best) { best = v; be = e; } }
            bi[be] = -__builtin_inff(); se[k] = be; sv[k] = lg[be]; wsum += sv[k]; }
        const float inv = 2.5f / wsum;
        int* te = (int*)(F.ws + WS_TOPE) + (size_t)t * 8; float* tw = (float*)(F.ws + WS_TOPW) + (size_t)t * 8;
#pragma unroll
        for (int k = 0; k < 8; ++k) { te[k] = se[k]; tw[k] = sv[k] * inv; (void)__hip_atomic_fetch_add(hist + se[k], 1, __ATOMIC_RELAXED, __HIP_MEMORY_SCOPE_WORKGROUP); }
    }
}
__device__ __forceinline__ void p4_router(Frame& F) {
    LAS int* hist = (LAS int*)(F.lds + RT_OFF);
    for (int v = F.bx; v < 256; v += F.G) {
        if (F.tid < 64) hist[F.tid] = 0;
        __syncthreads();
        router_unit(F, v * 8 + F.wave, hist);
        __syncthreads();
        if (F.tid < 64) ((int*)(F.ws + WS_CNT))[v * 64 + F.tid] = hist[F.tid];
        __syncthreads();
    }
}

__device__ __forceinline__ void p4b_tables(Frame& F) {
    LAS int* L = (LAS int*)(F.lds + RING_OFF);
    LAS int* part_t = L;
    LAS int* part_b = L + 512;
    LAS int* totals = L + 1024;
    LAS int* below = L + 1088;
    LAS int* segst = L + 1152;
    LAS int* wcount = L + 1280;
    LAS int* pe = L + 2048;
    LAS int* rank = L + 3072;
    const int* CNT = (const int*)(F.ws + WS_CNT); const int* TOPE = (const int*)(F.ws + WS_TOPE); const float* TOPW = (const float*)(F.ws + WS_TOPW);
    const float* RFFN = (const float*)(F.ws + WS_RFFN);
    int* RTOK = (int*)(F.ws + WS_RTOK); float* RW = (float*)(F.ws + WS_RW); int* RDST = (int*)(F.ws + WS_RDST); float* RR = (float*)(F.ws + WS_RR); int* TILEE = (int*)(F.ws + WS_TILEE);
    const int tid = F.tid, lane = F.lane, wave = F.wave;
    for (int v = F.bx; v < 256; v += F.G) {
        { const int e = tid & 63, part = tid >> 6; int tot = 0, bel = 0;
          for (int vv = 32 * part; vv < 32 * part + 32; ++vv) { const int c = CNT[vv * 64 + e]; tot += c; bel += (vv < v) ? c : 0; }
          part_t[part * 64 + e] = tot; part_b[part * 64 + e] = bel; }
        for (int i = tid; i < 1024; i += NTHR) pe[i] = TOPE[(size_t)v * 1024 + i];
        __syncthreads();
        if (wave == 0) {
            int tot = 0, bel = 0;
#pragma unroll
            for (int p = 0; p < 8; ++p) { tot += part_t[p * 64 + lane]; bel += part_b[p * 64 + lane]; }
            totals[lane] = tot; below[lane] = bel;
            const int ru = (tot + 255) & ~255; int sc = ru;
#pragma unroll
            for (int o = 1; o < 64; o <<= 1) { const int n = __shfl_up(sc, o); if (lane >= o) sc += n; }
            segst[lane] = sc - ru; if (lane == 63) segst[64] = sc;
        }
        { int cnt = 0;
          for (int j = 0; j < 128; ++j) { const int p = 128 * wave + j; if (pe[p] == lane) { rank[p] = cnt; ++cnt; } }
          wcount[wave * 64 + lane] = cnt; }
        __syncthreads();
        const int SS = segst[64];
        for (int p = tid; p < 1024; p += NTHR) { const int e = pe[p], w = p >> 7; int off = 0;
            for (int w2 = 0; w2 < w; ++w2) off += wcount[w2 * 64 + e];
            const int row = segst[e] + below[e] + off + rank[p]; const int t = 128 * v + (p >> 3), k = p & 7;
            RTOK[row] = t; RW[row] = TOPW[(size_t)t * 8 + k]; RDST[row] = k * T + t; RR[row] = RFFN[t]; }
        if (tid < 128) { const int t = 128 * v + tid, row = SS + t; RTOK[row] = t; RW[row] = 1.f; RDST[row] = 8 * T + t; RR[row] = RFFN[t]; }
        if (v < NE) { const int e = v, tot = totals[e], ru = (tot + 255) & ~255, st = segst[e];
            if (tid < ru - tot) { const int row = st + tot + tid; RTOK[row] = 0; RW[row] = 0.f; RDST[row] = -1; RR[row] = 0.f; }
            if (tid < ru / 256) TILEE[st / 256 + tid] = e; }
        if (v == NE) { if (tid < T / 256) TILEE[SS / 256 + tid] = NE; if (tid == 0) TILEE[MAXTILES] = SS / 256 + T / 256; }
        __syncthreads();
    }
}

template <int MODE> __device__ __forceinline__ int group_setup(Frame& F, int nN) {
    const int* TILEE = (const int*)(F.ws + WS_TILEE);
    const int NT = __builtin_amdgcn_readfirstlane((int)__hip_atomic_load((unsigned*)TILEE + MAXTILES, RLX_AGENT));
    LAS int* te = (LAS int*)(F.lds + TE_OFF); LAS unsigned* rt = (LAS unsigned*)(F.lds + RT_OFF);
    for (int i = F.tid; i < NT && i < MAXTILES; i += NTHR) te[i] = TILEE[i];
    if (MODE != 0) {
        const int* RTOK = (const int*)(F.ws + WS_RTOK);
        for (int ui = F.tid >> 8; ui < RT_UNITS; ui += 2) { int pm, pn; if (!pg8::order_next(ui, F.G, F.bx, NT, nN, pm, pn)) break;
            rt[ui * 256 + (F.tid & 255)] = MODE == 1 ? (unsigned)RTOK[pm * 256 + (F.tid & 255)] * (unsigned)D : (unsigned)(pm * 256 + (F.tid & 255)) * (unsigned)ED; }
    }
    __syncthreads();
    return NT;
}

__device__ __forceinline__ void p7_combine(Frame& F, int n) {
    const int gw = F.bx * NWAVES + F.wave, NGW = F.G * NWAVES, lane = F.lane;
    bf16* H = (bf16*)(F.ws + WS_H1B); const bf16* S0 = (const bf16*)F.out; const bf16* S1 = (const bf16*)(F.ws + WS_SLOT47); const bf16* S8 = (const bf16*)(F.ws + WS_SLOT8);
    float* ssq2 = (float*)(F.ws + WS_SSQ2) + (size_t)n * T;
    for (int t = gw; t < T; t += NGW) {
        float ss = 0.f;
#pragma unroll
        for (int ch = 0; ch < SLW / 512; ++ch) {
            const int co = 512 * ch + 8 * lane;
            bf16* hp = H + (size_t)t * D + n * SLW + co;
            v4u w[10]; w[0] = *(const GAS v4u*)hp;
#pragma unroll
            for (int k = 0; k < 4; ++k) { w[1 + k] = *(const GAS v4u*)(S0 + ((size_t)k * T + t) * SLW + co); w[5 + k] = *(const GAS v4u*)(S1 + ((size_t)k * T + t) * SLW + co); }
            w[9] = *(const GAS v4u*)(S8 + (size_t)t * SLW + co);
            float o[8];
#pragma unroll
            for (int i = 0; i < 8; ++i) o[i] = 0.f;
#pragma unroll
            for (int k = 0; k < 10; ++k)
#pragma unroll
                for (int q = 0; q < 4; ++q) { o[2 * q] += bflo(w[k][q]); o[2 * q + 1] += bfhi(w[k][q]); }
#pragma unroll
            for (int i = 0; i < 8; ++i) ss += o[i] * o[i];
            v4u r; r.x = pk2(o[0], o[1]); r.y = pk2(o[2], o[3]); r.z = pk2(o[4], o[5]); r.w = pk2(o[6], o[7]);
            *(GAS v4u*)hp = r;
        }
        ss = wave_sum(ss);
        if (lane == 0) ssq2[t] = ss;
    }
}

__device__ __forceinline__ void p9_final(Frame& F, const bf16* H, const float* ssq, int nparts) {
    const int gw = F.bx * NWAVES + F.wave, NGW = F.G * NWAVES, lane = F.lane; const float* g = F.in[I_NFIN];
    for (int t = gw; t < T; t += NGW) {
        v4u w[4];
#pragma unroll
        for (int j = 0; j < 4; ++j) w[j] = *(const GAS v4u*)(H + (size_t)t * D + 512 * j + 8 * lane);
        float ss = 0.f;
        if (nparts > 0) { if (lane < nparts) ss = ssq[(size_t)lane * T + t]; }
        else {
#pragma unroll
            for (int j = 0; j < 4; ++j)
#pragma unroll
                for (int q = 0; q < 4; ++q) { const float lo = bflo(w[j][q]), hi = bfhi(w[j][q]); ss += lo * lo + hi * hi; }
        }
        const float r = __builtin_amdgcn_rsqf(wave_sum(ss) * (1.f / D) + EPS);
        float* o = F.out + (size_t)t * D;
#pragma unroll
        for (int j = 0; j < 4; ++j) { const int c = 512 * j + 8 * lane; const f32x4 g0 = *(const GAS f32x4*)(g + c), g1 = *(const GAS f32x4*)(g + c + 4);
            f32x4 a, b; a.x = bflo(w[j][0]) * r * g0.x; a.y = bfhi(w[j][0]) * r * g0.y; a.z = bflo(w[j][1]) * r * g0.z; a.w = bfhi(w[j][1]) * r * g0.w;
            b.x = bflo(w[j][2]) * r * g1.x; b.y = bfhi(w[j][2]) * r * g1.y; b.z = bflo(w[j][3]) * r * g1.z; b.w = bfhi(w[j][3]) * r * g1.w;
            *(GAS f32x4*)(o + c) = a; *(GAS f32x4*)(o + c + 4) = b; }
    }
}

struct Args { const float* in[21]; float* out; unsigned char* ws; int ph_lo, ph_hi, fin_mode, li; };
__global__ void __launch_bounds__(NTHR, 2) mk_fwd(Args args) {
    extern __shared__ __attribute__((aligned(16))) unsigned char lds[];
    Frame F;
    F.lds = (LAS unsigned char*)lds;
    F.tid = threadIdx.x; F.lane = F.tid & 63; F.wave = __builtin_amdgcn_readfirstlane(F.tid >> 6);
    F.G = gridDim.x; F.bx = blockIdx.x; F.ws = args.ws; F.out = args.out;
#pragma unroll
    for (int i = 0; i < 21; ++i) F.in[i] = args.in[i];
    volatile LAS unsigned* MISC = (volatile LAS unsigned*)(F.lds + MISC_OFF);
    if (F.tid < 32) MISC[F.tid] = 0u;
    __syncthreads();
    XcdBarrier bar = xcd_barrier_post((unsigned*)(F.ws + WS_CTL) + CW_BAR + args.li * XCD_BAR_WORDS, MISC + 8);
    unsigned char* ws = F.ws;
    const int lo = args.ph_lo, hi = args.ph_hi;
    LAS unsigned char* ring = F.lds + RING_OFF;
#define PHASE(k) if (lo <= (k) && (k) < hi)
#define PH(k) PHASE(k) { RELANE();
#define GRID_BAR() xcd_barrier(bar)
#define RELANE() do { int _t = threadIdx.x; asm volatile("" : "+v"(_t)); F.tid = _t; F.lane = _t & 63; F.wave = __builtin_amdgcn_readfirstlane(_t >> 6); } while (0)

    PHASE(0) { RELANE(); p0_prologue(F); GRID_BAR(); }
    PHASE(1) { RELANE();
        pg8::DenseSched S{T / 256, NPROJ / 256, F.G, F.bx, D * 2, (const char*)(ws + WS_WIN)};
        pg8::EpiBf16Scale E{(bf16*)(ws + WS_PROJ), NPROJ, (const float*)(ws + WS_RMIX)};
        pg8::gemm_phase<false>(F.tid, ring, (const char*)F.out, D * 2, S, E);
        GRID_BAR();
    }
    PHASE(2) { RELANE(); p2_mixer(F); GRID_BAR(); }
    PHASE(3) { RELANE();
        pg8::DenseSched S{T / 256, D / 256, F.G, F.bx, D * 2, (const char*)(ws + WS_WOUT)};
        pg8::EpiResF32 E{(bf16*)(ws + WS_H1B), (const bf16*)F.out, D, ws + WS_H1F8};
        pg8::gemm_phase<false>(F.tid, ring, (const char*)((bf16*)F.out + (size_t)T * D), D * 2, S, E);
        GRID_BAR();
    }
    PHASE(4) { RELANE(); p4_router(F); GRID_BAR(); }
    PHASE(5) { RELANE(); p4b_tables(F); GRID_BAR(); }
    PHASE(6) { RELANE();
        const int NT = group_setup<1>(F, 4);
        pg8::GroupSched<true> S{NT, 4, F.G, F.bx, D, 0, (const char*)(ws + WS_WGU), (size_t)1024 * D, (const LAS int*)(F.lds + TE_OFF), (const LAS unsigned*)(F.lds + RT_OFF)};
        pg8::EpiGateUp E{ws + WS_HPERM, (const float*)(ws + WS_RR)};
        pg8::gemm_phase<true>(F.tid, ring, (const char*)(ws + WS_H1F8), D, S, E, 0x79797979, 0x7f7f7f7f);
        GRID_BAR();
    }
    {
        for (int n = 0; n < NSLICE; ++n) {
            PHASE(7 + 2 * n) { RELANE();
            const int NT = group_setup<2>(F, SLW / 256);
            pg8::GroupSched<true> S{NT, SLW / 256, F.G, F.bx, ED, (SLW / 256) * n, (const char*)(ws + WS_WDN), (size_t)D * ED, (const LAS int*)(F.lds + TE_OFF), (const LAS unsigned*)(F.lds + RT_OFF)};
            pg8::EpiDown E{(bf16*)F.out, (bf16*)(ws + WS_SLOT47), (bf16*)(ws + WS_SLOT8), (const float*)(ws + WS_RW), (const int*)(ws + WS_RDST)};
            pg8::gemm_phase<true>(F.tid, ring, (const char*)(ws + WS_HPERM), ED, S, E, 0x79797979, 0x7f7f7f7f);
            GRID_BAR();
            }
            PHASE(8 + 2 * n) { RELANE();
            p7_combine(F, n);
            GRID_BAR();
            }
        }
    }
    PHASE(15) { RELANE();
        pg8::DenseSched S{T / 256, D / 256, F.G, F.bx, PLE * 2, (const char*)(ws + WS_WPP)};
        pg8::EpiBf16Scale E{(bf16*)(ws + WS_PP), D, nullptr};
        pg8::gemm_phase<false>(F.tid, ring, (const char*)(ws + WS_PB), PLE * 2, S, E);
        GRID_BAR();
    }
    PHASE(16) { RELANE();
        pg8::DenseSched S{T / 256, D / 256, F.G, F.bx, D * 2, (const char*)(ws + WS_WPG)};
        pg8::EpiPle E{(bf16*)(ws + WS_H3), (const bf16*)(ws + WS_H1B), (const bf16*)(ws + WS_PP), (const float*)(ws + WS_SSQ2), (float*)(ws + WS_SSQ3)};
        pg8::gemm_phase<false>(F.tid, ring, (const char*)(ws + WS_H1B), D * 2, S, E);
        GRID_BAR();
    }
    PHASE(17) { RELANE();
    if (args.fin_mode == 0) p9_final(F, (const bf16*)(ws + WS_H3), (const float*)(ws + WS_SSQ3), 32);
    else p9_final(F, (const bf16*)(ws + WS_H1B), nullptr, 0);
    }
}

extern "C" void kernel_launch(void* const* d_in, const int* in_sizes, int n_in, void* d_out, int out_size, void* d_ws, size_t ws_size, hipStream_t stream) {
    static int grid = 0;
    if (grid == 0) {
        int dev = 0, cus = 0;
        if (n_in != 21 || ws_size < WS_END) { fprintf(stderr, "kernel_launch: n_in %d ws %zu (need %zu)\n", n_in, ws_size, (size_t)WS_END); grid = -1; return; }
        if (hipGetDevice(&dev) != hipSuccess || hipDeviceGetAttribute(&cus, hipDeviceAttributeMultiprocessorCount, dev) != hipSuccess) { grid = -1; return; }
        if (hipFuncSetAttribute((const void*)mk_fwd, hipFuncAttributeMaxDynamicSharedMemorySize, LDS_BYTES) != hipSuccess) { fprintf(stderr, "hipFuncSetAttribute failed\n"); grid = -1; return; }
        int per_cu = 0;
        (void)hipOccupancyMaxActiveBlocksPerMultiprocessor(&per_cu, (const void*)mk_fwd, NTHR, LDS_BYTES);
        (void)hipGetLastError();
        grid = cus > 256 ? 256 : cus;
    }
    if (grid < 0) return;
    (void)hipMemsetAsync((char*)d_ws + WS_CTL, 0, CTL_ZERO_BYTES, stream);
    Args a{};
    for (int i = 0; i < 21; ++i) a.in[i] = (const float*)d_in[i];
    a.out = (float*)d_out; a.ws = (unsigned char*)d_ws; a.fin_mode = FIN_MODE;
#if PROBE_K >= 0
    a.ph_lo = 0; a.ph_hi = PROBE_K + 1; a.li = 0;
    hipLaunchKernelGGL(mk_fwd, dim3(grid), dim3(NTHR), LDS_BYTES, stream, a);
    a.ph_lo = PROBE_K; a.ph_hi = PH_HI; a.li = 1;
    hipLaunchKernelGGL(mk_fwd, dim3(grid), dim3(NTHR), LDS_BYTES, stream, a);
#else
    a.ph_lo = 0; a.ph_hi = PH_HI; a.li = 0;
    hipLaunchKernelGGL(mk_fwd, dim3(grid), dim3(NTHR), LDS_BYTES, stream, a);
#endif
}
```

```cpp
#include <hip/hip_runtime.h>
#include <cstdio>
#ifndef PROBE_K
#define PROBE_K -1
#endif
#ifndef PH_HI
#define PH_HI 100
#endif
#ifndef FIN_MODE
#define FIN_MODE 0
#endif

#define GAS __attribute__((address_space(1)))
#define LAS __attribute__((address_space(3)))
typedef unsigned short bf16;
typedef unsigned v4u __attribute__((ext_vector_type(4)));
typedef unsigned v2u __attribute__((ext_vector_type(2)));
typedef float f32x4 __attribute__((ext_vector_type(4)));
typedef float f32x2 __attribute__((ext_vector_type(2)));
typedef float f32x16 __attribute__((ext_vector_type(16)));
typedef short bf16x8 __attribute__((ext_vector_type(8)));
typedef short s16x4 __attribute__((ext_vector_type(4)));
typedef GAS unsigned gu32;
#define RLX_AGENT __ATOMIC_RELAXED, __HIP_MEMORY_SCOPE_AGENT
#define LDS_WAIT() asm volatile("s_waitcnt lgkmcnt(0)" ::: "memory")
#define VM_WAIT() asm volatile("s_waitcnt vmcnt(0)" ::: "memory")

constexpr int NB = 8, SEQ = 4096, T = NB * SEQ, D = 2048, NPROJ = 6144, CW = 1024, HD = 128, NH = 8;
constexpr int PLE = 256, NE = 64, ED = 512, TOPK = 8, NSLOT = 9;
constexpr float EPS = 1e-6f;
constexpr int NWAVES = 8, NTHR = 512;
constexpr int MAXTILES = 1216;
constexpr int MAXROWS = MAXTILES * 256;
constexpr int NSLICE = 1, SLW = D / NSLICE;
constexpr float SLOT_SCALE = 16.f;

constexpr size_t MiB = 1u << 20;
constexpr size_t WS_CTL = 0, CTL_ZERO_BYTES = 1 * MiB;
constexpr size_t WS_RMIX = 1 * MiB;
constexpr size_t WS_RFFN = WS_RMIX + 128 * 1024;
constexpr size_t WS_SSQ2 = WS_RFFN + 128 * 1024;
constexpr size_t WS_SSQ3 = WS_SSQ2 + 512 * 1024;
constexpr size_t WS_TOPE = WS_SSQ3 + 4 * MiB;
constexpr size_t WS_TOPW = WS_TOPE + 1 * MiB;
constexpr size_t WS_CNT  = WS_TOPW + 1 * MiB;
constexpr size_t WS_RTOK = WS_CNT + 64 * 1024;
constexpr size_t WS_RW   = WS_RTOK + 1280 * 1024;
constexpr size_t WS_RDST = WS_RW + 1280 * 1024;
constexpr size_t WS_RR   = WS_RDST + 1280 * 1024;
constexpr size_t WS_TILEE = WS_RR + 1280 * 1024;
constexpr size_t WS_WR   = 16 * MiB;
constexpr size_t WS_WIN  = 17 * MiB;
constexpr size_t WS_WOUT = WS_WIN + 24 * MiB;
constexpr size_t WS_WGU  = WS_WOUT + 8 * MiB;
constexpr size_t WS_WDN  = WS_WGU + 130 * MiB;
constexpr size_t WS_WPG  = WS_WDN + 65 * MiB;
constexpr size_t WS_WPP  = WS_WPG + 8 * MiB;
constexpr size_t WS_PB   = WS_WPP + 1 * MiB;
constexpr size_t WS_H1B  = WS_PB + 16 * MiB;
constexpr size_t WS_H1F8 = WS_H1B + 128 * MiB;
constexpr size_t WS_OVL  = WS_H1F8 + 64 * MiB;
constexpr size_t WS_PROJ = WS_OVL;
constexpr size_t WS_HPERM = WS_OVL;
constexpr size_t WS_SLOT8 = WS_OVL + 304 * MiB;
constexpr size_t WS_PP   = WS_OVL;
constexpr size_t WS_H3   = WS_OVL + 128 * MiB;
constexpr size_t WS_SLOT47 = WS_OVL + 384 * MiB;
constexpr size_t WS_END  = WS_SLOT47 + 256 * MiB;
constexpr int CW_BAR = 4096;

constexpr int RING_OFF = 0, RING_BYTES = 131072;
constexpr int RT_OFF = 131072, RT_UNITS = 20, RT_BYTES = RT_UNITS * 1024;
constexpr int TE_OFF = RT_OFF + RT_BYTES, TE_BYTES = 4864 + 128;
constexpr int MISC_OFF = TE_OFF + TE_BYTES;
constexpr int LDS_BYTES = MISC_OFF + 128;
static_assert(LDS_BYTES <= 163840, "LDS");

__device__ __forceinline__ unsigned f2bf(float f) { unsigned u = __builtin_bit_cast(unsigned, f); return (u + 0x7fffu + ((u >> 16) & 1u)) >> 16; }
__device__ __forceinline__ unsigned pk2(float lo, float hi) { return f2bf(lo) | (f2bf(hi) << 16); }
__device__ __forceinline__ float bflo(unsigned w) { return __builtin_bit_cast(float, w << 16); }
__device__ __forceinline__ float bfhi(unsigned w) { return __builtin_bit_cast(float, w & 0xffff0000u); }
__device__ __forceinline__ float wave_sum(float v) {
#pragma unroll
    for (int o = 1; o < 64; o <<= 1) v += __shfl_xor(v, o);
    return v;
}
__device__ __forceinline__ float fsigmoid(float v) { return __builtin_amdgcn_rcpf(1.f + __builtin_amdgcn_exp2f(-1.4426950409f * v)); }

#define XB_TMO      128
#define XB_XCNT(j)  (256  + 64 * (j))
#define XB_XSUB(j)  (1280 + 64 * (j))
#define XB_XGEN(j)  (2304 + 64 * (j))
#define XB_TOP      3328
#define XB_TOPGEN   3392
#define XCD_BAR_WORDS 3456
#define XB_SPIN_CAP (1u << 18)
__device__ __forceinline__ unsigned xb_ld(unsigned* p)              { return __hip_atomic_load(p, __ATOMIC_RELAXED, __HIP_MEMORY_SCOPE_AGENT); }
__device__ __forceinline__ unsigned xb_add(unsigned* p, unsigned v) { return __hip_atomic_fetch_add(p, v, __ATOMIC_RELAXED, __HIP_MEMORY_SCOPE_AGENT); }
__device__ __forceinline__ unsigned xb_xcc_id() { return (unsigned)__builtin_amdgcn_s_getreg((3 << 11) | 20) & 0xFu; }
#define XB_SPIN(cond, bar) do { unsigned _sp = 0; while (cond) { __builtin_amdgcn_s_sleep(1); \
    if ((++_sp & 255u) == 0u) { if (xb_ld(&(bar)[XB_TMO])) break; if (_sp > XB_SPIN_CAP) { atomicAdd(&(bar)[XB_TMO], 1u); break; } } } } while (0)
struct XcdBarrier { unsigned* bar; unsigned x; volatile LAS unsigned* st; };
__device__ __forceinline__ XcdBarrier xcd_barrier_post(unsigned* bar, volatile LAS unsigned* st) {
    XcdBarrier b; b.bar = bar; b.x = xb_xcc_id(); b.st = st;
    if (threadIdx.x == 0) (void)xb_add(&bar[XB_XCNT(b.x)], 1u);
    return b;
}
__device__ __forceinline__ void xcd_barrier_complete(unsigned* bar, unsigned x, unsigned& nloc, unsigned& nx) {
    const unsigned G = gridDim.x * gridDim.y * gridDim.z;
    unsigned sum, cnt, mine, sp = 0u;
    for (;;) {
        sum = 0u; cnt = 0u; mine = 0u;
#pragma unroll
        for (unsigned j = 0; j < 16; ++j) { const unsigned c = xb_ld(&bar[XB_XCNT(j)]); sum += c; cnt += (c > 0u) ? 1u : 0u; mine = (j == x) ? c : mine; }
        if (sum == G) break;
        __builtin_amdgcn_s_sleep(1);
        if ((++sp & 255u) == 0u) { if (xb_ld(&bar[XB_TMO])) break; if (sp > XB_SPIN_CAP) { atomicAdd(&bar[XB_TMO], 1u); break; } }
    }
    nloc = mine > 0u ? mine : 1u; nx = cnt > 0u ? cnt : 1u;
}
__device__ __forceinline__ void xcd_barrier(const XcdBarrier& b) {
    asm volatile("s_waitcnt vmcnt(0)" ::: "memory");
    __syncthreads();
    if (threadIdx.x == 0) {
        unsigned* bar = b.bar;
        __builtin_amdgcn_s_waitcnt(0);
        unsigned nloc = b.st[0], nx = b.st[1];
        if (nloc == 0u) { xcd_barrier_complete(bar, b.x, nloc, nx); b.st[0] = nloc; b.st[1] = nx; }
        const unsigned old = xb_add(&bar[XB_XSUB(b.x)], 1u);
        const unsigned gen = old / nloc;
        if (old + 1u == (gen + 1u) * nloc) {
            __builtin_amdgcn_fence(__ATOMIC_RELEASE, "agent");
            asm volatile("s_waitcnt vmcnt(0)" ::: "memory");
            const unsigned og = xb_add(&bar[XB_TOP], 1u);
            const unsigned tg = og / nx;
            if (og + 1u == (tg + 1u) * nx) xb_add(&bar[XB_TOPGEN], 1u);
            else XB_SPIN(xb_ld(&bar[XB_TOPGEN]) == tg, bar);
            __builtin_amdgcn_fence(__ATOMIC_ACQUIRE, "agent");
            xb_add(&bar[XB_XGEN(b.x)], 1u);
            asm volatile("s_waitcnt vmcnt(0)" ::: "memory");
        } else {
            XB_SPIN(xb_ld(&bar[XB_XGEN(b.x)]) == gen, bar);
            __builtin_amdgcn_fence(__ATOMIC_ACQUIRE, "agent");
            asm volatile("s_waitcnt vmcnt(0)" ::: "memory");
        }
    }
    __syncthreads();
}

namespace pg8 {
constexpr int BM = 256, BK = 64, HALF = 128, HTB = HALF * BK * 2, STAGE_BYTES = 8 * HTB, NXCD = 8, WGM = 8;
__device__ __forceinline__ int lds_byte(int r, int c) { const int st = (r >> 4) * 2 + (c >> 5), rr = r & 15, cc = c & 31, ob = rr * 64 + cc * 2; return st * 1024 + (ob ^ (((ob >> 9) & 1) << 5)); }
__device__ __forceinline__ void stage_rc(int b, int& R, int& C) { const int st = b / 1024, sb = b % 1024, swz = sb ^ (((sb >> 9) & 1) << 5); R = (st >> 1) * 16 + swz / 64; C = (st & 1) * 32 + (swz % 64) / 2; }
__device__ __forceinline__ int brow(int R) { return 64 * (R >> 5) + 16 * ((R & 15) >> 2) + 4 * ((R >> 4) & 1) + (R & 3); }

struct Unit { int pm, pn, e; };

__device__ __forceinline__ bool order_next(int i, int G, int c, int nM, int nN, int& pm, int& pn) {
    const int nwg = nM * nN; const long L = (long)i * G + c; if (L >= nwg) return false;
    int wgid = (int)L; { const int q = nwg / NXCD, r = nwg % NXCD, xcd = wgid % NXCD, off = wgid / NXCD; wgid = (xcd < r ? xcd * (q + 1) : r * (q + 1) + (xcd - r) * q) + off; }
    const int nig = WGM * nN, gid = wgid / nig, fm = gid * WGM, gsz = (nM - fm) < WGM ? (nM - fm) : WGM;
    pm = fm + ((wgid % nig) % gsz); pn = (wgid % nig) / gsz; return true;
}

struct DenseSched {
    static constexpr bool GATHER = false;
    int nM, nN, G, c, KB; const char* Bt;
    __device__ __forceinline__ bool next(int i, Unit& u) const { u.e = 0; return order_next(i, G, c, nM, nN, u.pm, u.pn); }
    __device__ __forceinline__ const char* bbase(const Unit& u) const { return Bt + (size_t)u.pn * BM * KB; }
    __device__ __forceinline__ const char* abase(const char* A, const Unit& u) const { return A + (size_t)u.pm * BM * KB; }
    __device__ __forceinline__ void aoffs(int ui, const Unit& u, int tid, unsigned (&ao)[2][2]) const {}
};
template <int MODE> struct GroupSched {
    static constexpr bool GATHER = true;
    int nM, nN, G, c, KB, pn0; const char* Bt; size_t estride; const LAS int* te; const LAS unsigned* rt;
    __device__ __forceinline__ bool next(int i, Unit& u) const { if (!order_next(i, G, c, nM, nN, u.pm, u.pn)) return false; u.e = __builtin_amdgcn_readfirstlane(te[u.pm]); return true; }
    __device__ __forceinline__ const char* bbase(const Unit& u) const { return Bt + (size_t)u.e * estride + (size_t)(pn0 + u.pn) * BM * KB; }
    __device__ __forceinline__ void aoffs(int ui, const Unit& u, int tid, unsigned (&ao)[2][2]) const {
        asm volatile("" : "+v"(tid));
#pragma unroll
        for (int i = 0; i < 2; ++i) { int R, C; stage_rc(tid * 16 + i * 8192, R, C);
#pragma unroll
            for (int h = 0; h < 2; ++h) { if (MODE == 1) ao[h][i] = rt[ui * 256 + h * HALF + R] + (unsigned)C * 2u; else ao[h][i] = (unsigned)(u.pm * BM + h * HALF + R) * (unsigned)KB + (unsigned)C * 2u; } }
    }
    __device__ __forceinline__ const char* abase(const char* A, const Unit& u) const { return A; }
};

__device__ __forceinline__ unsigned cvt_pk_bf16(float lo, float hi) { unsigned r; asm volatile("v_cvt_pk_bf16_f32 %0, %1, %2" : "=v"(r) : "v"(lo), "v"(hi)); return r; }

typedef int v8i __attribute__((ext_vector_type(8)));
typedef int v4i __attribute__((ext_vector_type(4)));
union Frag { v8i v; struct { v4i lo, hi; }; };
template <bool F8, class Epi, class Sched>
__device__ __forceinline__ void gemm_phase(const int tid, LAS unsigned char* lds, const char* Abase, const int KB, const Sched& S, const Epi& E, const int sw = 0x7f7f7f7f, const int sa = 0x7f7f7f7f) {
    const int wid = __builtin_amdgcn_readfirstlane(tid >> 6), lane = tid & 63, wr = wid >> 2, wc = wid & 3, fr = lane & 15, fq = lane >> 4;
    const int nt = KB / 128;
    constexpr bool GA = Sched::GATHER;
    unsigned voffB[2], voffA[2];
#pragma unroll
    for (int i = 0; i < 2; ++i) { int R, C; stage_rc(tid * 16 + i * 8192, R, C); const int Rb = brow(R); voffB[i] = (unsigned)Rb * (unsigned)KB + (unsigned)C * 2u; voffA[i] = (unsigned)R * (unsigned)KB + (unsigned)C * 2u; }
    const size_t kstep = (size_t)(BK * 2);
    const size_t hstep = (size_t)HALF * KB;
    const size_t hstepB = (size_t)8 * KB;
    const unsigned ldsw = (unsigned)wid * 1024u;
    const int aoff = lds_byte(wr * 64 + fr, fq * 8), boff = lds_byte(wc * 32 + fr, fq * 8);
#define PG8_SA(b, h) (((b) * 2 + (h)) * HTB)
#define PG8_SB(b, h) ((4 + (b) * 2 + (h)) * HTB)
#define PG8_STAGE(bufoff, gbase, voff) do { _Pragma("unroll") for (int _i = 0; _i < 2; ++_i) \
        __builtin_amdgcn_global_load_lds((const unsigned*)((const char*)(gbase) + (voff)[_i]), (LAS unsigned*)(lds + (bufoff) + ldsw + _i * 8192), 16, 0, 0); } while (0)
#define PG8_STAGEA(bufoff, gbase, half) do { if constexpr (GA) { PG8_STAGE(bufoff, gbase, ca[half]); } else { PG8_STAGE(bufoff, (gbase) + (half) * hstep, voffA); } } while (0)
#define PG8_LD1(dst, off) do { const v4i _lo = *(const LAS v4i*)(lds + (off)), _hi = *(const LAS v4i*)(lds + (off) + 1024); dst.lo = _lo; dst.hi = _hi; } while (0)
#define PG8_LDA(dst, b, h) do { _Pragma("unroll") for (int m = 0; m < 4; ++m) PG8_LD1(dst[m], PG8_SA(b, h) + aoff + m * 2048); } while (0)
#define PG8_LDB(dst, b, h) do { _Pragma("unroll") for (int n = 0; n < 2; ++n) PG8_LD1(dst[n], PG8_SB(b, h) + boff + n * 2048); } while (0)
#define PG8_MMA(ai, bj, At, Bt) do { __builtin_amdgcn_s_setprio(1); _Pragma("unroll") for (int m = 0; m < 4; ++m) _Pragma("unroll") for (int n = 0; n < 2; ++n) { \
        if constexpr (F8) { acc[ai][bj][m][n] = __builtin_amdgcn_mfma_scale_f32_16x16x128_f8f6f4(Bt[n].v, At[m].v, acc[ai][bj][m][n], 0, 0, 0, sw, 0, sa); } \
        else { acc[ai][bj][m][n] = __builtin_amdgcn_mfma_f32_16x16x32_bf16(__builtin_bit_cast(bf16x8, Bt[n].lo), __builtin_bit_cast(bf16x8, At[m].lo), acc[ai][bj][m][n], 0, 0, 0); \
               acc[ai][bj][m][n] = __builtin_amdgcn_mfma_f32_16x16x32_bf16(__builtin_bit_cast(bf16x8, Bt[n].hi), __builtin_bit_cast(bf16x8, At[m].hi), acc[ai][bj][m][n], 0, 0, 0); } } \
        __builtin_amdgcn_s_setprio(0); } while (0)
#define PG8_WAIT_V(n) asm volatile("s_waitcnt vmcnt(" #n ")" ::: "memory")
#define PG8_WAIT_L(n) asm volatile("s_waitcnt lgkmcnt(" #n ")" ::: "memory")
#define PG8_BAR __builtin_amdgcn_s_barrier()
#define PG8_SCHED __builtin_amdgcn_sched_barrier(0)
    Unit cur, nxt; int ui = 0;
    if (!S.next(0, cur)) return;
    f32x4 acc[2][2][4][2];
#pragma unroll
    for (int a = 0; a < 2; ++a)
#pragma unroll
        for (int b = 0; b < 2; ++b)
#pragma unroll
            for (int m = 0; m < 4; ++m)
#pragma unroll
                for (int n = 0; n < 2; ++n) acc[a][b][m][n] = (f32x4){0.f, 0.f, 0.f, 0.f};
    Frag At[4], B0[2], B1[2];
    unsigned ca[2][2], na[2][2];
    if constexpr (GA) S.aoffs(0, cur, tid, ca);
    const char* cB = S.bbase(cur); const char* cA = S.abase(Abase, cur);
    PG8_STAGE(PG8_SB(0, 0), cB, voffB); PG8_STAGEA(PG8_SA(0, 0), cA, 0); PG8_STAGE(PG8_SB(0, 1), cB + hstepB, voffB); PG8_STAGEA(PG8_SA(0, 1), cA, 1);
    if (wr == 1) PG8_BAR;
    PG8_WAIT_V(4); PG8_BAR;
    PG8_STAGE(PG8_SB(1, 0), cB + kstep, voffB); PG8_STAGEA(PG8_SA(1, 0), cA + kstep, 0); PG8_STAGE(PG8_SB(1, 1), cB + hstepB + kstep, voffB);
    PG8_WAIT_V(6); PG8_BAR;
    for (;;) {
        const bool has_next = S.next(ui + 1, nxt);
        const char* nB = has_next ? S.bbase(nxt) : cB; const char* nA = has_next ? S.abase(Abase, nxt) : cA;
        if constexpr (GA) {
            if (has_next) S.aoffs(ui + 1, nxt, tid, na);
            else {
#pragma unroll
                for (int h = 0; h < 2; ++h)
#pragma unroll
                    for (int i = 0; i < 2; ++i) na[h][i] = ca[h][i];
            }
        }
#pragma nounroll
        for (int t = 0; t < nt; t += 2) {
            const bool last = (t == nt - 2);
            const char* a1 = cA + (size_t)(t + 1) * kstep;
            const char* a2 = last ? nA : cA + (size_t)(t + 2) * kstep; const char* b2 = last ? nB : cB + (size_t)(t + 2) * kstep;
            const char* a3 = a2 + kstep; const char* b3 = b2 + kstep;
            PG8_LDB(B0, 0, 0); PG8_SCHED; PG8_LDA(At, 0, 0); PG8_STAGEA(PG8_SA(1, 1), a1, 1);
            PG8_WAIT_L(8); PG8_BAR; PG8_WAIT_L(0); PG8_MMA(0, 0, At, B0); PG8_BAR; PG8_SCHED;
            if constexpr (GA) { if (last) {
#pragma unroll
                for (int h = 0; h < 2; ++h)
#pragma unroll
                    for (int i = 0; i < 2; ++i) ca[h][i] = na[h][i];
            } }
            PG8_LDB(B1, 0, 1); PG8_STAGE(PG8_SB(0, 0), b2, voffB);
            PG8_BAR; PG8_WAIT_L(0); PG8_MMA(0, 1, At, B1); PG8_BAR;
            PG8_LDA(At, 0, 1); PG8_STAGEA(PG8_SA(0, 0), a2, 0);
            PG8_BAR; PG8_WAIT_L(0); PG8_MMA(1, 0, At, B0); PG8_BAR; PG8_SCHED;
            PG8_STAGE(PG8_SB(0, 1), b2 + hstepB, voffB);
            PG8_WAIT_V(6); PG8_BAR; PG8_MMA(1, 1, At, B1); PG8_BAR;
            PG8_LDB(B0, 1, 0); PG8_SCHED; PG8_LDA(At, 1, 0); PG8_STAGEA(PG8_SA(0, 1), a2, 1);
            PG8_WAIT_L(8); PG8_BAR; PG8_WAIT_L(0); PG8_MMA(0, 0, At, B0); PG8_BAR; PG8_SCHED;
            PG8_LDB(B1, 1, 1); PG8_STAGE(PG8_SB(1, 0), b3, voffB);
            PG8_BAR; PG8_WAIT_L(0); PG8_MMA(0, 1, At, B1); PG8_BAR;
            PG8_LDA(At, 1, 1); PG8_STAGEA(PG8_SA(1, 0), a3, 0);
            PG8_BAR; PG8_WAIT_L(0); PG8_MMA(1, 0, At, B0); PG8_BAR; PG8_SCHED;
            PG8_STAGE(PG8_SB(1, 1), b3 + hstepB, voffB);
            PG8_WAIT_V(6); PG8_BAR; PG8_MMA(1, 1, At, B1); PG8_BAR;
        }
        { int tz = tid; asm volatile("" : "+v"(tz)); const int l2 = tz & 63; E(acc, cur, wr, wc, l2 & 15, l2 >> 4); }
        if (!has_next) break;
#pragma unroll
        for (int a = 0; a < 2; ++a)
#pragma unroll
            for (int b = 0; b < 2; ++b)
#pragma unroll
                for (int m = 0; m < 4; ++m)
#pragma unroll
                    for (int n = 0; n < 2; ++n) acc[a][b][m][n] = (f32x4){0.f, 0.f, 0.f, 0.f};
        cur = nxt; cB = nB; cA = nA; ++ui;
    }
    PG8_WAIT_V(0);
    if (wr == 0) PG8_BAR;
    PG8_BAR;
#undef PG8_SA
#undef PG8_SB
#undef PG8_STAGE
#undef PG8_STAGEA
#undef PG8_LD1
#undef PG8_LDA
#undef PG8_LDB
#undef PG8_MMA
#undef PG8_WAIT_V
#undef PG8_WAIT_L
#undef PG8_BAR
#undef PG8_SCHED
}

__device__ __forceinline__ unsigned cvt4_fp8(float a, float b, float c, float d) { int w = 0; w = __builtin_amdgcn_cvt_pk_fp8_f32(a, b, w, false); w = __builtin_amdgcn_cvt_pk_fp8_f32(c, d, w, true); return (unsigned)w; }
__device__ __forceinline__ v4u pack8_bf16(const f32x4 a, const f32x4 b) { v4u w; w.x = cvt_pk_bf16(a[0], a[1]); w.y = cvt_pk_bf16(a[2], a[3]); w.z = cvt_pk_bf16(b[0], b[1]); w.w = cvt_pk_bf16(b[2], b[3]); return w; }
__device__ __forceinline__ void unpack8(const v4u w, f32x4& a, f32x4& b) { a = (f32x4){bflo(w[0]), bfhi(w[0]), bflo(w[1]), bfhi(w[1])}; b = (f32x4){bflo(w[2]), bfhi(w[2]), bflo(w[3]), bfhi(w[3])}; }
struct EpiBf16Scale {
    bf16* O; int ldc; const float* rs;
    __device__ __forceinline__ void operator()(const f32x4 (&acc)[2][2][4][2], const Unit& u, int wr, int wc, int fr, int fq) const {
        const int row0 = u.pm * BM + wr * 64 + fr, col0 = u.pn * BM + wc * 64 + 16 * fq;
#pragma unroll
        for (int ai = 0; ai < 2; ++ai)
#pragma unroll
            for (int m = 0; m < 4; ++m) { const int row = row0 + ai * HALF + m * 16; const float s = rs ? rs[row] : 1.f; bf16* rowp = O + (size_t)row * ldc + col0;
#pragma unroll
                for (int bj = 0; bj < 2; ++bj) *(v4u*)(rowp + 8 * bj) = pack8_bf16(acc[ai][bj][m][0] * s, acc[ai][bj][m][1] * s); }
    }
};
struct EpiResF32 {
    bf16* O; const bf16* X; int ldc; unsigned char* O8;
    __device__ __forceinline__ void operator()(const f32x4 (&acc)[2][2][4][2], const Unit& u, int wr, int wc, int fr, int fq) const {
        const int row0 = u.pm * BM + wr * 64 + fr, col0 = u.pn * BM + wc * 64 + 16 * fq;
#pragma unroll
        for (int ai = 0; ai < 2; ++ai)
#pragma unroll
            for (int m = 0; m < 4; ++m) { const size_t ro = (size_t)(row0 + ai * HALF + m * 16) * ldc + col0; v4u w8;
#pragma unroll
                for (int bj = 0; bj < 2; ++bj) { f32x4 x0, x1; unpack8(*(const v4u*)(X + ro + 8 * bj), x0, x1);
                    const f32x4 v0 = acc[ai][bj][m][0] + x0, v1 = acc[ai][bj][m][1] + x1;
                    *(v4u*)(O + ro + 8 * bj) = pack8_bf16(v0, v1);
                    w8[2 * bj] = cvt4_fp8(v0[0], v0[1], v0[2], v0[3]); w8[2 * bj + 1] = cvt4_fp8(v1[0], v1[1], v1[2], v1[3]); }
                *(v4u*)(O8 + ro) = w8; }
    }
};
struct EpiGateUp {
    unsigned char* Hp; const float* rr;
    __device__ __forceinline__ void operator()(const f32x4 (&acc)[2][2][4][2], const Unit& u, int wr, int wc, int fr, int fq) const {
        const int row0 = u.pm * BM + wr * 64 + fr, col0 = u.pn * HALF + wc * 32 + 8 * fq;
#pragma unroll
        for (int ai = 0; ai < 2; ++ai)
#pragma unroll
            for (int m = 0; m < 4; ++m) { const int row = row0 + ai * HALF + m * 16; const float s = rr[row];
                float h[8];
#pragma unroll
                for (int n = 0; n < 2; ++n)
#pragma unroll
                    for (int j = 0; j < 4; ++j) { const float g = acc[ai][0][m][n][j] * s, up = acc[ai][1][m][n][j] * s; h[n * 4 + j] = g * fsigmoid(g) * up; }
                v2u w; w.x = cvt4_fp8(h[0], h[1], h[2], h[3]); w.y = cvt4_fp8(h[4], h[5], h[6], h[7]);
                *(v2u*)(Hp + (size_t)row * ED + col0) = w; }
    }
};
struct EpiDown {
    unsigned char* S0; unsigned char* S1; unsigned char* S8; const float* rw; const int* rdst;
    __device__ __forceinline__ void operator()(const f32x4 (&acc)[2][2][4][2], const Unit& u, int wr, int wc, int fr, int fq) const {
        const int row0 = u.pm * BM + wr * 64 + fr, col0 = u.pn * BM + wc * 64 + 16 * fq;
#pragma unroll
        for (int ai = 0; ai < 2; ++ai)
#pragma unroll
            for (int m = 0; m < 4; ++m) { const int row = row0 + ai * HALF + m * 16; const float s = rw[row] * SLOT_SCALE; const int dst = rdst[row];
                if (dst >= 0) { unsigned char* rowp = (dst < 4 * T ? S0 + (size_t)dst * D : dst < 8 * T ? S1 + (size_t)(dst - 4 * T) * D : S8 + (size_t)(dst - 8 * T) * D) + col0;
                    v4u w;
#pragma unroll
                    for (int bj = 0; bj < 2; ++bj) { const f32x4 v0 = acc[ai][bj][m][0] * s, v1 = acc[ai][bj][m][1] * s;
                        w[2 * bj] = cvt4_fp8(v0[0], v0[1], v0[2], v0[3]); w[2 * bj + 1] = cvt4_fp8(v1[0], v1[1], v1[2], v1[3]); }
                    *(v4u*)rowp = w; } }
    }
};
struct EpiPle {
    bf16* H3; const bf16* H2; const bf16* PP; const float* ssq2; float* ssq3;
    __device__ __forceinline__ void operator()(const f32x4 (&acc)[2][2][4][2], const Unit& u, int wr, int wc, int fr, int fq) const {
        const int row0 = u.pm * BM + wr * 64 + fr, col0 = u.pn * BM + wc * 64 + 16 * fq;
#pragma unroll
        for (int ai = 0; ai < 2; ++ai)
#pragma unroll
            for (int m = 0; m < 4; ++m) { const int row = row0 + ai * HALF + m * 16;
                const float r = __builtin_amdgcn_rsqf(ssq2[row] * (1.f / D) + EPS);
                const size_t ro = (size_t)row * D + col0; float ss = 0.f;
#pragma unroll
                for (int bj = 0; bj < 2; ++bj) { f32x4 h0, h1, p0, p1; unpack8(*(const v4u*)(H2 + ro + 8 * bj), h0, h1); unpack8(*(const v4u*)(PP + ro + 8 * bj), p0, p1);
                    f32x4 o0, o1;
#pragma unroll
                    for (int j = 0; j < 4; ++j) { o0[j] = h0[j] + fsigmoid(acc[ai][bj][m][0][j] * r) * p0[j]; o1[j] = h1[j] + fsigmoid(acc[ai][bj][m][1][j] * r) * p1[j]; ss += o0[j] * o0[j] + o1[j] * o1[j]; }
                    *(v4u*)(H3 + ro + 8 * bj) = pack8_bf16(o0, o1); }
                ss += __shfl_xor(ss, 16); ss += __shfl_xor(ss, 32);
                if (fq == 0) ssq3[(size_t)(u.pn * 4 + wc) * T + row] = ss; }
    }
};
}

struct Frame {
    LAS unsigned char* lds;
    int tid, lane, wave, G, bx;
    unsigned char* ws;
    const float* in[21];
    float* out;
};
enum { I_X = 0, I_P, I_NMIX, I_WIN, I_CONVW, I_GCONV, I_GSB, I_WOUT, I_NFFN, I_WR, I_RB, I_WEG, I_WEU, I_WED, I_WSG, I_WSU, I_WSD, I_NPLE, I_WPG, I_WPP, I_NFIN };

__device__ __forceinline__ void p0_transpose_item(const float* W, int N, bf16* WT, int ldk, int k0, int n0, int row_off, const float* g64, LAS float* scr, int lane) {
    const int n4 = lane & 15, kr = lane >> 4;
    f32x4 v[16];
    const float* src = W + (size_t)(k0 + kr) * N + n0 + 4 * n4;
#pragma unroll
    for (int i = 0; i < 16; ++i) v[i] = *(const GAS f32x4*)(src + (size_t)(4 * i) * N);
    const int c = lane >> 3, nn = lane & 7;
    f32x4 ga = (f32x4){1.f, 1.f, 1.f, 1.f}, gb = ga;
    if (g64) { ga = *(const GAS f32x4*)(g64 + 8 * c); gb = *(const GAS f32x4*)(g64 + 8 * c + 4); }
#pragma unroll
    for (int i = 0; i < 16; ++i) { LAS float* d = scr + (4 * i + kr) * 65 + 4 * n4; d[0] = v[i].x; d[1] = v[i].y; d[2] = v[i].z; d[3] = v[i].w; }
    LDS_WAIT(); asm volatile("" ::: "memory");
#pragma unroll
    for (int j = 0; j < 8; ++j) { const int n = nn + 8 * j; const LAS float* s = scr + (8 * c) * 65 + n;
        v4u o; o.x = pg8::cvt_pk_bf16(s[0] * ga.x, s[65] * ga.y); o.y = pg8::cvt_pk_bf16(s[130] * ga.z, s[195] * ga.w); o.z = pg8::cvt_pk_bf16(s[260] * gb.x, s[325] * gb.y); o.w = pg8::cvt_pk_bf16(s[390] * gb.z, s[455] * gb.w);
        *(GAS v4u*)(WT + (size_t)(row_off + n) * ldk + k0 + 8 * c) = o; }
    LDS_WAIT(); asm volatile("" ::: "memory");
}
__device__ __forceinline__ void p0_transpose_item_f8(const float* W, int N, unsigned char* WT, int ldk, int k0, int n0, int row_off, int mode, const float* g64, LAS float* scr, int lane) {
    const int n4 = lane & 15, kr = lane >> 4;
    f32x4 v[16];
    const float* src = W + (size_t)(k0 + kr) * N + n0 + 4 * n4;
#pragma unroll
    for (int i = 0; i < 16; ++i) v[i] = *(const GAS f32x4*)(src + (size_t)(4 * i) * N);
    const int c = lane >> 4, nn = lane & 15;
    float g[16];
#pragma unroll
    for (int q = 0; q < 4; ++q) { f32x4 t = (f32x4){1.f, 1.f, 1.f, 1.f}; if (g64) t = *(const GAS f32x4*)(g64 + 16 * c + 4 * q); g[4 * q] = 64.f * t.x; g[4 * q + 1] = 64.f * t.y; g[4 * q + 2] = 64.f * t.z; g[4 * q + 3] = 64.f * t.w; }
#pragma unroll
    for (int i = 0; i < 16; ++i) { LAS float* d = scr + (4 * i + kr) * 65 + 4 * n4; d[0] = v[i].x; d[1] = v[i].y; d[2] = v[i].z; d[3] = v[i].w; }
    LDS_WAIT(); asm volatile("" ::: "memory");
#pragma unroll
    for (int j = 0; j < 4; ++j) { const int n = nn + 16 * j; const LAS float* s = scr + (16 * c) * 65 + n;
        v4u o;
        o.x = pg8::cvt4_fp8(s[0] * g[0], s[65] * g[1], s[130] * g[2], s[195] * g[3]); o.y = pg8::cvt4_fp8(s[260] * g[4], s[325] * g[5], s[390] * g[6], s[455] * g[7]);
        o.z = pg8::cvt4_fp8(s[520] * g[8], s[585] * g[9], s[650] * g[10], s[715] * g[11]); o.w = pg8::cvt4_fp8(s[780] * g[12], s[845] * g[13], s[910] * g[14], s[975] * g[15]);
        const int hid = n0 + n, drow = mode == 0 ? row_off + n : 16 * (hid >> 3) + 8 * (mode - 1) + (hid & 7);
        *(GAS v4u*)(WT + (size_t)drow * ldk + k0 + 16 * c) = o; }
    LDS_WAIT(); asm volatile("" ::: "memory");
}
constexpr int P0_I_WIN = (D / 64) * (NPROJ / 64), P0_I_WOUT = (D / 64) * (D / 64), P0_I_WR = (D / 64) * (NE / 64), P0_I_WPG = (D / 64) * (D / 64), P0_I_WPP = (PLE / 64) * (D / 64);
constexpr int P0_I_EXP = 768, P0_NITEMS = P0_I_WIN + P0_I_WOUT + P0_I_WR + P0_I_WPG + P0_I_WPP + 65 * P0_I_EXP;
__device__ __forceinline__ void p0_item(Frame& F, int it, LAS float* scr) {
    unsigned char* ws = F.ws; const int lane = F.lane;
    if (it < P0_I_WIN) { const int kb = it / (NPROJ / 64), nb = it % (NPROJ / 64); p0_transpose_item(F.in[I_WIN], NPROJ, (bf16*)(ws + WS_WIN), D, 64 * kb, 64 * nb, 64 * nb, F.in[I_NMIX] + 64 * kb, scr, lane); return; } it -= P0_I_WIN;
    if (it < P0_I_WOUT) { const int kb = it / (D / 64), nb = it % (D / 64), k0 = 64 * kb; const float* g = k0 < CW ? F.in[I_GCONV] + k0 : F.in[I_GSB] + (k0 - CW);
        p0_transpose_item(F.in[I_WOUT], D, (bf16*)(ws + WS_WOUT), D, k0, 64 * nb, 64 * nb, g, scr, lane); return; } it -= P0_I_WOUT;
    if (it < P0_I_WR) { const int kb = it; p0_transpose_item(F.in[I_WR], NE, (bf16*)(ws + WS_WR), D, 64 * kb, 0, 0, F.in[I_NFFN] + 64 * kb, scr, lane); return; } it -= P0_I_WR;
    if (it < P0_I_WPG) { const int kb = it / (D / 64), nb = it % (D / 64); p0_transpose_item(F.in[I_WPG], D, (bf16*)(ws + WS_WPG), D, 64 * kb, 64 * nb, 64 * nb, F.in[I_NPLE] + 64 * kb, scr, lane); return; } it -= P0_I_WPG;
    if (it < P0_I_WPP) { const int kb = it / (D / 64), nb = it % (D / 64); p0_transpose_item(F.in[I_WPP], D, (bf16*)(ws + WS_WPP), PLE, 64 * kb, 64 * nb, 64 * nb, nullptr, scr, lane); return; } it -= P0_I_WPP;
    const int e = it / P0_I_EXP, r = it % P0_I_EXP, sub = r / 256, q = r % 256;
    if (sub < 2) {
        const float* src = e < NE ? (sub == 0 ? F.in[I_WEG] : F.in[I_WEU]) + (size_t)e * D * ED : (sub == 0 ? F.in[I_WSG] : F.in[I_WSU]);
        const int kb = q / (ED / 64), nb = q % (ED / 64), n0 = 64 * nb;
        p0_transpose_item_f8(src, ED, ws + WS_WGU + (size_t)e * 1024 * D, D, 64 * kb, n0, 0, 1 + sub, F.in[I_NFFN] + 64 * kb, scr, lane);
    } else {
        const float* src = e < NE ? F.in[I_WED] + (size_t)e * ED * D : F.in[I_WSD];
        const int kb = q / (D / 64), nb = q % (D / 64);
        p0_transpose_item_f8(src, D, ws + WS_WDN + (size_t)e * D * ED, ED, 64 * kb, 64 * nb, 64 * nb, 0, nullptr, scr, lane);
    }
}
__device__ __forceinline__ void p0_prologue(Frame& F) {
    LAS float* scr = (LAS float*)(F.lds + RING_OFF + F.wave * 16896);
    const int gw = F.bx * NWAVES + F.wave, NGW = F.G * NWAVES;
    {
        bf16* XB = (bf16*)F.out; float* rmix = (float*)(F.ws + WS_RMIX); const float* x = F.in[I_X];
        for (int m = gw; m < T; m += NGW) {
            const GAS f32x4* xr = (const GAS f32x4*)(x + (size_t)m * D) + F.lane;
            f32x4 v[8]; float s = 0.f;
#pragma unroll
            for (int j = 0; j < 8; ++j) { v[j] = xr[64 * j]; s += (v[j].x * v[j].x + v[j].y * v[j].y) + (v[j].z * v[j].z + v[j].w * v[j].w); }
            s = wave_sum(s);
            if (F.lane == 0) rmix[m] = __builtin_amdgcn_rsqf(s * (1.f / D) + EPS);
            GAS v2u* o8 = (GAS v2u*)(XB + (size_t)m * D) + F.lane;
#pragma unroll
            for (int j = 0; j < 8; ++j) { v2u w; w.x = pk2(v[j].x, v[j].y); w.y = pk2(v[j].z, v[j].w); o8[64 * j] = w; }
        }
    }
    {
        const float* p = F.in[I_P]; bf16* PB = (bf16*)(F.ws + WS_PB);
        const int nchunk = T * PLE / 8, gt = F.bx * NTHR + F.tid, NGT = F.G * NTHR;
        for (int c = gt; c < nchunk; c += NGT) { const f32x4 a = *(const GAS f32x4*)(p + (size_t)c * 8), b = *(const GAS f32x4*)(p + (size_t)c * 8 + 4);
            v4u w; w.x = pk2(a.x, a.y); w.y = pk2(a.z, a.w); w.z = pk2(b.x, b.y); w.w = pk2(b.z, b.w); *(GAS v4u*)(PB + (size_t)c * 8) = w; }
    }
    for (int it = gw; it < P0_NITEMS; it += NGW) p0_item(F, it, scr);
}

__device__ __forceinline__ unsigned off_b(unsigned row, unsigned ch) { return 256u * row + 16u * (ch ^ (((row & 3) << 2) | ((row >> 2) & 3))); }
#define MFMA32(a, b, c) __builtin_amdgcn_mfma_f32_32x32x16_bf16((a), (b), (c), 0, 0, 0)

__device__ __forceinline__ void conv_item(Frame& F, int it) {
    const bf16* proj = (const bf16*)(F.ws + WS_PROJ); bf16* ymix = (bf16*)F.out + (size_t)T * D;
    const float* cw = F.in[I_CONVW]; const int lane = F.lane;
    float w0[16], w1[16], w2[16], u1[16], u2[16];
#pragma unroll
    for (int j = 0; j < 2; ++j)
#pragma unroll
        for (int i = 0; i < 8; ++i) { const int c = 512 * j + 8 * lane + i; w0[8 * j + i] = cw[c]; w1[8 * j + i] = cw[CW + c]; w2[8 * j + i] = cw[2 * CW + c]; u1[8 * j + i] = 0.f; u2[8 * j + i] = 0.f; }
    const int t0 = 16 * it; const bool seq_start = (t0 & (SEQ - 1)) == 0;
    for (int tt = -2; tt < 16; ++tt) {
        if (tt < 0 && seq_start) continue;
        const size_t t = (size_t)(t0 + tt);
        const bf16* pr = proj + t * NPROJ + 8 * lane;
        float u[16], cb[16];
#pragma unroll
        for (int j = 0; j < 2; ++j) { const v4u h = *(const GAS v4u*)(pr + 512 * j), c = *(const GAS v4u*)(pr + 2 * CW + 512 * j);
#pragma unroll
            for (int q = 0; q < 4; ++q) { u[8 * j + 2 * q] = bflo(h[q]) * bflo(c[q]); u[8 * j + 2 * q + 1] = bfhi(h[q]) * bfhi(c[q]); } }
        if (tt >= 0) {
#pragma unroll
            for (int j = 0; j < 2; ++j) { const v4u b = *(const GAS v4u*)(pr + CW + 512 * j);
#pragma unroll
                for (int q = 0; q < 4; ++q) { cb[8 * j + 2 * q] = bflo(b[q]); cb[8 * j + 2 * q + 1] = bfhi(b[q]); } }
            float y[16], ss = 0.f;
#pragma unroll
            for (int i = 0; i < 16; ++i) { y[i] = cb[i] * (w0[i] * u2[i] + w1[i] * u1[i] + w2[i] * u[i]); ss += y[i] * y[i]; }
            const float r = __builtin_amdgcn_rsqf(wave_sum(ss) * (1.f / CW) + EPS);
            bf16* yo = ymix + t * D + 8 * lane;
#pragma unroll
            for (int j = 0; j < 2; ++j) { v4u w; w.x = pk2(y[8 * j] * r, y[8 * j + 1] * r); w.y = pk2(y[8 * j + 2] * r, y[8 * j + 3] * r); w.z = pk2(y[8 * j + 4] * r, y[8 * j + 5] * r); w.w = pk2(y[8 * j + 6] * r, y[8 * j + 7] * r);
                *(GAS v4u*)(yo + 512 * j) = w; }
        }
#pragma unroll
        for (int i = 0; i < 16; ++i) { u2[i] = u1[i]; u1[i] = u[i]; }
    }
}

__device__ __forceinline__ bf16x8 pack8(float a0, float a1, float a2, float a3, float a4, float a5, float a6, float a7) {
    v4u p; p.x = pk2(a0, a1); p.y = pk2(a2, a3); p.z = pk2(a4, a5); p.w = pk2(a6, a7); return __builtin_bit_cast(bf16x8, p);
}
__device__ __forceinline__ void tr_read4(unsigned a_t0, unsigned a_t1, s16x4& r00, s16x4& r01, s16x4& r10, s16x4& r11) {
    asm volatile("ds_read_b64_tr_b16 %0, %4\n\tds_read_b64_tr_b16 %1, %5\n\tds_read_b64_tr_b16 %2, %4 offset:4096\n\tds_read_b64_tr_b16 %3, %5 offset:4096\n\ts_waitcnt lgkmcnt(0)"
                 : "=&v"(r00), "=&v"(r01), "=&v"(r10), "=&v"(r11) : "v"(a_t0), "v"(a_t1) : "memory");
}
constexpr float ATT_C = 0.08838834764831845f * 1.4426950408889634f;
constexpr float ATT_EXIT = -152.f;

__device__ __forceinline__ void attn_unit(Frame& F, int b, int qblk, int parity) {
    const int lane = F.lane, h = F.wave, r = lane & 31, hh = lane >> 5;
    const bf16* proj = (const bf16*)(F.ws + WS_PROJ); bf16* ymix = (bf16*)F.out + (size_t)T * D;
    const size_t rowbase = (size_t)b * SEQ; const int t0 = qblk * 32;
    LAS unsigned char* kt = F.lds + h * 16384; LAS unsigned char* vt = kt + 8192;
    LAS float* XS = (LAS float*)(F.lds + RT_OFF) + parity * 256;
    bf16x8 qf[8];
    { const bf16* qp = proj + (rowbase + t0 + r) * NPROJ + 3 * CW + h * HD + 8 * hh;
#pragma unroll
      for (int kk = 0; kk < 8; ++kk) qf[kk] = *(const GAS bf16x8*)(qp + 16 * kk); }
    f32x16 oacc[4];
#pragma unroll
    for (int c = 0; c < 4; ++c)
#pragma unroll
        for (int i = 0; i < 16; ++i) oacc[c][i] = 0.f;
    float L = 0.f;
    const unsigned pr = (unsigned)((r & 19) | ((r & 4) << 1) | ((r & 8) >> 1));
    const unsigned ktb = (unsigned)(size_t)kt, vtb = (unsigned)(size_t)vt;
    unsigned va[2][4];
    { const unsigned blk = (lane >> 4) & 1, q = (lane & 15) >> 2, p = lane & 3;
#pragma unroll
      for (int t = 0; t < 2; ++t)
#pragma unroll
          for (int c = 0; c < 4; ++c) va[t][c] = vtb + off_b(8 * hh + 4 * t + q, 4 * c + 2 * blk + (p >> 1)) + 8 * (p & 1); }
    for (int kti = qblk; kti >= 0; --kti) {
        const int s0 = kti * 32;
        {
            v4u kreg[8], vreg[8];
            const bf16* kp = proj + (rowbase + s0 + (lane >> 4)) * NPROJ + 4 * CW + h * HD + (lane & 15) * 8;
#pragma unroll
            for (int i = 0; i < 8; ++i) { kreg[i] = *(const GAS v4u*)(kp + (size_t)(4 * i) * NPROJ); vreg[i] = *(const GAS v4u*)(kp + (size_t)(4 * i) * NPROJ + CW); }
#pragma unroll
            for (int i = 0; i < 8; ++i) { const unsigned o = off_b(4 * i + (lane >> 4), lane & 15); *(LAS v4u*)(kt + o) = kreg[i]; *(LAS v4u*)(vt + o) = vreg[i]; }
        }
        LDS_WAIT();
        f32x16 x;
#pragma unroll
        for (int i = 0; i < 16; ++i) x[i] = 0.f;
#pragma unroll
        for (int kk = 0; kk < 8; ++kk) { const bf16x8 kf = *(const LAS bf16x8*)(kt + off_b(pr, 2 * kk + hh)); x = MFMA32(kf, qf[kk], x); }
        const bool diag = (kti == qblk);
        float zz[16], suf[16];
#pragma unroll
        for (int i = 0; i < 16; ++i) {
            zz[i] = x[i] * ATT_C;
            const float e = __builtin_amdgcn_exp2f(fminf(zz[i], 126.f));
            float l = -__builtin_amdgcn_logf(1.f + e);
            const int kap = 16 * (i >> 3) + 8 * hh + (i & 7);
            if (diag && !(kap < r)) l = 0.f;
            suf[i] = l;
        }
#pragma unroll
        for (int j = 6; j >= 0; --j) { suf[j] += suf[j + 1]; suf[8 + j] += suf[8 + j + 1]; }
        const float T0 = suf[0], T1 = suf[8];
        const float T0p = __shfl_xor(T0, 32), T1p = __shfl_xor(T1, 32);
        const float base0 = L + T1 + T1p + (hh == 0 ? T0p : 0.f), base1 = L + (hh == 0 ? T1p : 0.f);
        float a[16];
#pragma unroll
        for (int i = 0; i < 16; ++i) {
            float v = __builtin_amdgcn_exp2f(zz[i] + (i < 8 ? base0 : base1) + suf[i]);
            const int kap = 16 * (i >> 3) + 8 * hh + (i & 7);
            if (diag && !(kap < r)) v = 0.f;
            a[i] = v;
        }
        L += (T0 + T1) + (T0p + T1p);
        const bf16x8 pf0 = pack8(a[0], a[1], a[2], a[3], a[4], a[5], a[6], a[7]);
        const bf16x8 pf1 = pack8(a[8], a[9], a[10], a[11], a[12], a[13], a[14], a[15]);
#pragma unroll
        for (int c = 0; c < 4; ++c) {
            s16x4 r00, r01, r10, r11; tr_read4(va[0][c], va[1][c], r00, r01, r10, r11);
            const bf16x8 vf0 = __builtin_shufflevector(r00, r01, 0, 1, 2, 3, 4, 5, 6, 7), vf1 = __builtin_shufflevector(r10, r11, 0, 1, 2, 3, 4, 5, 6, 7);
            oacc[c] = MFMA32(vf0, pf0, oacc[c]); oacc[c] = MFMA32(vf1, pf1, oacc[c]);
        }
        if (__all(L < ATT_EXIT)) break;
    }
    float ss = 0.f;
#pragma unroll
    for (int c = 0; c < 4; ++c)
#pragma unroll
        for (int i = 0; i < 16; ++i) ss += oacc[c][i] * oacc[c][i];
    ss += __shfl_xor(ss, 32);
    if (hh == 0) XS[h * 32 + r] = ss;
    __syncthreads();
    float tot = 0.f;
#pragma unroll
    for (int w = 0; w < 8; ++w) tot += XS[w * 32 + r];
    const float rs = __builtin_amdgcn_rsqf(tot * (1.f / CW) + EPS);
    bf16* yo = ymix + (rowbase + t0 + r) * D + CW + h * HD + 4 * hh;
#pragma unroll
    for (int c = 0; c < 4; ++c)
#pragma unroll
        for (int g = 0; g < 4; ++g) { v2u w; w.x = pk2(oacc[c][4 * g] * rs, oacc[c][4 * g + 1] * rs); w.y = pk2(oacc[c][4 * g + 2] * rs, oacc[c][4 * g + 3] * rs);
            *(GAS v2u*)(yo + 32 * c + 8 * g) = w; }
}
__device__ __forceinline__ void p2_mixer(Frame& F) {
    int par = 0;
    for (int u = F.bx; u < NB * (SEQ / 32); u += F.G) { attn_unit(F, u / (SEQ / 32), u % (SEQ / 32), par); par ^= 1; }
    const int gw = F.bx * NWAVES + F.wave, NGW = F.G * NWAVES;
    for (int it = gw; it < T / 16; it += NGW) conv_item(F, it);
}

__device__ __forceinline__ void router_unit(Frame& F, int unit, LAS int* hist) {
    const int lane = F.lane, r16 = lane & 15, g = lane >> 4;
    const bf16* H = (const bf16*)(F.ws + WS_H1B); const bf16* WR = (const bf16*)(F.ws + WS_WR);
    const int t0 = unit * 16;
    LAS float* LG = (LAS float*)(F.lds + F.wave * 16384); LAS float* BI = LG + 16 * 65 + 16;
    f32x4 acc[4];
#pragma unroll
    for (int nb = 0; nb < 4; ++nb) acc[nb] = (f32x4){0.f, 0.f, 0.f, 0.f};
    float ss = 0.f;
    const bf16* ap = H + (size_t)(t0 + r16) * D + 8 * g; const bf16* bp = WR + (size_t)r16 * D + 8 * g;
#pragma unroll 4
    for (int ks = 0; ks < D / 32; ++ks) {
        const v4u aw = *(const GAS v4u*)(ap + 32 * ks);
#pragma unroll
        for (int q = 0; q < 4; ++q) { const float lo = bflo(aw[q]), hi = bfhi(aw[q]); ss += lo * lo + hi * hi; }
        const bf16x8 af = __builtin_bit_cast(bf16x8, aw);
#pragma unroll
        for (int nb = 0; nb < 4; ++nb) { const bf16x8 bf = *(const GAS bf16x8*)(bp + (size_t)(16 * nb) * D + 32 * ks); acc[nb] = __builtin_amdgcn_mfma_f32_16x16x32_bf16(af, bf, acc[nb], 0, 0, 0); }
    }
    ss += __shfl_xor(ss, 16); ss += __shfl_xor(ss, 32);
#pragma unroll
    for (int nb = 0; nb < 4; ++nb)
#pragma unroll
        for (int j = 0; j < 4; ++j) LG[(4 * g + j) * 65 + 16 * nb + r16] = acc[nb][j];
    LDS_WAIT();
    if (lane < 16) {
        const int t = t0 + lane; const float rs = __builtin_amdgcn_rsqf(ss * (1.f / D) + EPS);
        ((float*)(F.ws + WS_RFFN))[t] = rs;
        LAS float* lg = LG + lane * 65; LAS float* bi = BI + lane * 65; const float* rb = F.in[I_RB];
        for (int e = 0; e < NE; ++e) { const float s = fsigmoid(lg[e] * rs); lg[e] = s; bi[e] = s + rb[e]; }
        float gs[8];
#pragma unroll
        for (int gg = 0; gg < 8; ++gg) { float m1 = -__builtin_inff(), m2 = -__builtin_inff();
#pragma unroll
            for (int j = 0; j < 8; ++j) { const float v = bi[8 * gg + j]; if (v > m1) { m2 = m1; m1 = v; } else if (v > m2) m2 = v; }
            gs[gg] = m1 + m2; }
        unsigned gmask = 0u;
#pragma unroll
        for (int gg = 0; gg < 8; ++gg) { int cnt = 0;
#pragma unroll
            for (int g2 = 0; g2 < 8; ++g2) cnt += (gs[g2] > gs[gg] || (gs[g2] == gs[gg] && g2 < gg)) ? 1 : 0;
            if (cnt < 4) gmask |= 1u << gg; }
        int se[8]; float sv[8]; float wsum = 0.f;
#pragma unroll
        for (int k = 0; k < 8; ++k) { float best = -__builtin_inff(); int be = 0;
            for (int e = 0; e < NE; ++e) { const float v = bi[e]; if (((gmask >> (e >> 3)) & 1u) && v > best) { best = v; be = e; } }
            bi[be] = -__builtin_inff(); se[k] = be; sv[k] = lg[be]; wsum += sv[k]; }
        const float inv = 2.5f / wsum;
        int* te = (int*)(F.ws + WS_TOPE) + (size_t)t * 8; float* tw = (float*)(F.ws + WS_TOPW) + (size_t)t * 8;
#pragma unroll
        for (int k = 0; k < 8; ++k) { te[k] = se[k]; tw[k] = sv[k] * inv; (void)__hip_atomic_fetch_add(hist + se[k], 1, __ATOMIC_RELAXED, __HIP_MEMORY_SCOPE_WORKGROUP); }
    }
}
__device__ __forceinline__ void p4_router(Frame& F) {
    LAS int* hist = (LAS int*)(F.lds + RT_OFF);
    for (int v = F.bx; v < 256; v += F.G) {
        if (F.tid < 64) hist[F.tid] = 0;
        __syncthreads();
        router_unit(F, v * 8 + F.wave, hist);
        __syncthreads();
        if (F.tid < 64) ((int*)(F.ws + WS_CNT))[v * 64 + F.tid] = hist[F.tid];
        __syncthreads();
    }
}

__device__ __forceinline__ void p4b_tables(Frame& F) {
    LAS int* L = (LAS int*)(F.lds + RING_OFF);
    LAS int* part_t = L;
    LAS int* part_b = L + 512;
    LAS int* totals = L + 1024;
    LAS int* below = L + 1088;
    LAS int* segst = L + 1152;
    LAS int* wcount = L + 1280;
    LAS int* pe = L + 2048;
    LAS int* rank = L + 3072;
    const int* CNT = (const int*)(F.ws + WS_CNT); const int* TOPE = (const int*)(F.ws + WS_TOPE); const float* TOPW = (const float*)(F.ws + WS_TOPW);
    const float* RFFN = (const float*)(F.ws + WS_RFFN);
    int* RTOK = (int*)(F.ws + WS_RTOK); float* RW = (float*)(F.ws + WS_RW); int* RDST = (int*)(F.ws + WS_RDST); float* RR = (float*)(F.ws + WS_RR); int* TILEE = (int*)(F.ws + WS_TILEE);
    const int tid = F.tid, lane = F.lane, wave = F.wave;
    for (int v = F.bx; v < 256; v += F.G) {
        { const int e = tid & 63, part = tid >> 6; int tot = 0, bel = 0;
          for (int vv = 32 * part; vv < 32 * part + 32; ++vv) { const int c = CNT[vv * 64 + e]; tot += c; bel += (vv < v) ? c : 0; }
          part_t[part * 64 + e] = tot; part_b[part * 64 + e] = bel; }
        for (int i = tid; i < 1024; i += NTHR) pe[i] = TOPE[(size_t)v * 1024 + i];
        __syncthreads();
        if (wave == 0) {
            int tot = 0, bel = 0;
#pragma unroll
            for (int p = 0; p < 8; ++p) { tot += part_t[p * 64 + lane]; bel += part_b[p * 64 + lane]; }
            totals[lane] = tot; below[lane] = bel;
            const int ru = (tot + 255) & ~255; int sc = ru;
#pragma unroll
            for (int o = 1; o < 64; o <<= 1) { const int n = __shfl_up(sc, o); if (lane >= o) sc += n; }
            segst[lane] = sc - ru; if (lane == 63) segst[64] = sc;
        }
        { int cnt = 0;
          for (int j = 0; j < 128; ++j) { const int p = 128 * wave + j; if (pe[p] == lane) { rank[p] = cnt; ++cnt; } }
          wcount[wave * 64 + lane] = cnt; }
        __syncthreads();
        const int SS = segst[64];
        for (int p = tid; p < 1024; p += NTHR) { const int e = pe[p], w = p >> 7; int off = 0;
            for (int w2 = 0; w2 < w; ++w2) off += wcount[w2 * 64 + e];
            const int row = segst[e] + below[e] + off + rank[p]; const int t = 128 * v + (p >> 3), k = p & 7;
            RTOK[row] = t; RW[row] = TOPW[(size_t)t * 8 + k]; RDST[row] = k * T + t; RR[row] = RFFN[t]; }
        if (tid < 128) { const int t = 128 * v + tid, row = SS + t; RTOK[row] = t; RW[row] = 1.f; RDST[row] = 8 * T + t; RR[row] = RFFN[t]; }
        if (v < NE) { const int e = v, tot = totals[e], ru = (tot + 255) & ~255, st = segst[e];
            if (tid < ru - tot) { const int row = st + tot + tid; RTOK[row] = 0; RW[row] = 0.f; RDST[row] = -1; RR[row] = 0.f; }
            if (tid < ru / 256) TILEE[st / 256 + tid] = e; }
        if (v == NE) { if (tid < T / 256) TILEE[SS / 256 + tid] = NE; if (tid == 0) TILEE[MAXTILES] = SS / 256 + T / 256; }
        __syncthreads();
    }
}

template <int MODE> __device__ __forceinline__ int group_setup(Frame& F, int nN) {
    const int* TILEE = (const int*)(F.ws + WS_TILEE);
    const int NT = __builtin_amdgcn_readfirstlane((int)__hip_atomic_load((unsigned*)TILEE + MAXTILES, RLX_AGENT));
    LAS int* te = (LAS int*)(F.lds + TE_OFF); LAS unsigned* rt = (LAS unsigned*)(F.lds + RT_OFF);
    for (int i = F.tid; i < NT && i < MAXTILES; i += NTHR) te[i] = TILEE[i];
    if (MODE == 1) {
        const int* RTOK = (const int*)(F.ws + WS_RTOK);
        for (int ui = F.tid >> 8; ui < RT_UNITS; ui += 2) { int pm, pn; if (!pg8::order_next(ui, F.G, F.bx, NT, nN, pm, pn)) break;
            rt[ui * 256 + (F.tid & 255)] = (unsigned)RTOK[pm * 256 + (F.tid & 255)] * (unsigned)D; }
    }
    __syncthreads();
    return NT;
}

__device__ __forceinline__ void acc_fp8x16(const v4u w, float (&o)[16]) {
#pragma unroll
    for (int q = 0; q < 4; ++q) { const f32x2 lo = __builtin_amdgcn_cvt_pk_f32_fp8((int)w[q], false), hi = __builtin_amdgcn_cvt_pk_f32_fp8((int)w[q], true);
        o[4 * q] += lo.x; o[4 * q + 1] += lo.y; o[4 * q + 2] += hi.x; o[4 * q + 3] += hi.y; }
}
__device__ __forceinline__ void p7_combine(Frame& F, int n) {
    const int gw = F.bx * NWAVES + F.wave, NGW = F.G * NWAVES, lane = F.lane;
    bf16* H = (bf16*)(F.ws + WS_H1B); const unsigned char* S0 = (const unsigned char*)F.out; const unsigned char* S1 = F.ws + WS_SLOT47; const unsigned char* S8 = F.ws + WS_SLOT8;
    float* ssq2 = (float*)(F.ws + WS_SSQ2);
    for (int t = gw; t < T; t += NGW) {
        float ss = 0.f;
#pragma unroll
        for (int ch = 0; ch < 2; ++ch) {
            const int co = 1024 * ch + 16 * lane;
            bf16* hp = H + (size_t)t * D + co;
            const v4u h0 = *(const GAS v4u*)hp, h1 = *(const GAS v4u*)(hp + 8);
            v4u w[9];
#pragma unroll
            for (int k = 0; k < 4; ++k) { w[k] = *(const GAS v4u*)(S0 + ((size_t)k * T + t) * D + co); w[4 + k] = *(const GAS v4u*)(S1 + ((size_t)k * T + t) * D + co); }
            w[8] = *(const GAS v4u*)(S8 + (size_t)t * D + co);
            float o[16];
#pragma unroll
            for (int i = 0; i < 16; ++i) o[i] = 0.f;
#pragma unroll
            for (int k = 0; k < 9; ++k) acc_fp8x16(w[k], o);
            f32x4 a0, a1, a2, a3; pg8::unpack8(h0, a0, a1); pg8::unpack8(h1, a2, a3);
#pragma unroll
            for (int j = 0; j < 4; ++j) { a0[j] += o[j] * (1.f / SLOT_SCALE); a1[j] += o[4 + j] * (1.f / SLOT_SCALE); a2[j] += o[8 + j] * (1.f / SLOT_SCALE); a3[j] += o[12 + j] * (1.f / SLOT_SCALE);
                ss += (a0[j] * a0[j] + a1[j] * a1[j]) + (a2[j] * a2[j] + a3[j] * a3[j]); }
            *(GAS v4u*)hp = pg8::pack8_bf16(a0, a1); *(GAS v4u*)(hp + 8) = pg8::pack8_bf16(a2, a3);
        }
        ss = wave_sum(ss);
        if (lane == 0) ssq2[t] = ss;
    }
}

__device__ __forceinline__ void p9_final(Frame& F, const bf16* H, const float* ssq, int nparts) {
    const int gw = F.bx * NWAVES + F.wave, NGW = F.G * NWAVES, lane = F.lane; const float* g = F.in[I_NFIN];
    for (int t = gw; t < T; t += NGW) {
        v4u w[4];
#pragma unroll
        for (int j = 0; j < 4; ++j) w[j] = *(const GAS v4u*)(H + (size_t)t * D + 512 * j + 8 * lane);
        float ss = 0.f;
        if (nparts > 0) { if (lane < nparts) ss = ssq[(size_t)lane * T + t]; }
        else {
#pragma unroll
            for (int j = 0; j < 4; ++j)
#pragma unroll
                for (int q = 0; q < 4; ++q) { const float lo = bflo(w[j][q]), hi = bfhi(w[j][q]); ss += lo * lo + hi * hi; }
        }
        const float r = __builtin_amdgcn_rsqf(wave_sum(ss) * (1.f / D) + EPS);
        float* o = F.out + (size_t)t * D;
#pragma unroll
        for (int j = 0; j < 4; ++j) { const int c = 512 * j + 8 * lane; const f32x4 g0 = *(const GAS f32x4*)(g + c), g1 = *(const GAS f32x4*)(g + c + 4);
            f32x4 a, b; a.x = bflo(w[j][0]) * r * g0.x; a.y = bfhi(w[j][0]) * r * g0.y; a.z = bflo(w[j][1]) * r * g0.z; a.w = bfhi(w[j][1]) * r * g0.w;
            b.x = bflo(w[j][2]) * r * g1.x; b.y = bfhi(w[j][2]) * r * g1.y; b.z = bflo(w[j][3]) * r * g1.z; b.w = bfhi(w[j][3]) * r * g1.w;
            *(GAS f32x4*)(o + c) = a; *(GAS f32x4*)(o + c + 4) = b; }
    }
}

struct Args { const float* in[21]; float* out; unsigned char* ws; int ph_lo, ph_hi, fin_mode, li; };
__global__ void __launch_bounds__(NTHR, 2) mk_fwd(Args args) {
    extern __shared__ __attribute__((aligned(16))) unsigned char lds[];
    Frame F;
    F.lds = (LAS unsigned char*)lds;
    F.tid = threadIdx.x; F.lane = F.tid & 63; F.wave = __builtin_amdgcn_readfirstlane(F.tid >> 6);
    F.G = gridDim.x; F.bx = blockIdx.x; F.ws = args.ws; F.out = args.out;
#pragma unroll
    for (int i = 0; i < 21; ++i) F.in[i] = args.in[i];
    volatile LAS unsigned* MISC = (volatile LAS unsigned*)(F.lds + MISC_OFF);
    if (F.tid < 32) MISC[F.tid] = 0u;
    __syncthreads();
    XcdBarrier bar = xcd_barrier_post((unsigned*)(F.ws + WS_CTL) + CW_BAR + args.li * XCD_BAR_WORDS, MISC + 8);
    unsigned char* ws = F.ws;
    const int lo = args.ph_lo, hi = args.ph_hi;
    LAS unsigned char* ring = F.lds + RING_OFF;
#define PHASE(k) if (lo <= (k) && (k) < hi)
#define PH(k) PHASE(k) { RELANE();
#define GRID_BAR() xcd_barrier(bar)
#define RELANE() do { int _t = threadIdx.x; asm volatile("" : "+v"(_t)); F.tid = _t; F.lane = _t & 63; F.wave = __builtin_amdgcn_readfirstlane(_t >> 6); } while (0)

    PHASE(0) { RELANE(); p0_prologue(F); GRID_BAR(); }
    PHASE(1) { RELANE();
        pg8::DenseSched S{T / 256, NPROJ / 256, F.G, F.bx, D * 2, (const char*)(ws + WS_WIN)};
        pg8::EpiBf16Scale E{(bf16*)(ws + WS_PROJ), NPROJ, (const float*)(ws + WS_RMIX)};
        pg8::gemm_phase<false>(F.tid, ring, (const char*)F.out, D * 2, S, E);
        GRID_BAR();
    }
    PHASE(2) { RELANE(); p2_mixer(F); GRID_BAR(); }
    PHASE(3) { RELANE();
        pg8::DenseSched S{T / 256, D / 256, F.G, F.bx, D * 2, (const char*)(ws + WS_WOUT)};
        pg8::EpiResF32 E{(bf16*)(ws + WS_H1B), (const bf16*)F.out, D, ws + WS_H1F8};
        pg8::gemm_phase<false>(F.tid, ring, (const char*)((bf16*)F.out + (size_t)T * D), D * 2, S, E);
        GRID_BAR();
    }
    PHASE(4) { RELANE(); p4_router(F); GRID_BAR(); }
    PHASE(5) { RELANE(); p4b_tables(F); GRID_BAR(); }
    PHASE(6) { RELANE();
        const int NT = group_setup<1>(F, 4);
        pg8::GroupSched<1> S{NT, 4, F.G, F.bx, D, 0, (const char*)(ws + WS_WGU), (size_t)1024 * D, (const LAS int*)(F.lds + TE_OFF), (const LAS unsigned*)(F.lds + RT_OFF)};
        pg8::EpiGateUp E{ws + WS_HPERM, (const float*)(ws + WS_RR)};
        pg8::gemm_phase<true>(F.tid, ring, (const char*)(ws + WS_H1F8), D, S, E, 0x79797979, 0x7f7f7f7f);
        GRID_BAR();
    }
    {
        for (int n = 0; n < NSLICE; ++n) {
            PHASE(7 + 2 * n) { RELANE();
            const int NT = group_setup<2>(F, SLW / 256);
            pg8::GroupSched<2> S{NT, SLW / 256, F.G, F.bx, ED, (SLW / 256) * n, (const char*)(ws + WS_WDN), (size_t)D * ED, (const LAS int*)(F.lds + TE_OFF), (const LAS unsigned*)(F.lds + RT_OFF)};
            pg8::EpiDown E{(unsigned char*)F.out, ws + WS_SLOT47, ws + WS_SLOT8, (const float*)(ws + WS_RW), (const int*)(ws + WS_RDST)};
            pg8::gemm_phase<true>(F.tid, ring, (const char*)(ws + WS_HPERM), ED, S, E, 0x79797979, 0x7f7f7f7f);
            GRID_BAR();
            }
            PHASE(8 + 2 * n) { RELANE();
            p7_combine(F, n);
            GRID_BAR();
            }
        }
    }
    PHASE(15) { RELANE();
        pg8::DenseSched S{T / 256, D / 256, F.G, F.bx, PLE * 2, (const char*)(ws + WS_WPP)};
        pg8::EpiBf16Scale E{(bf16*)(ws + WS_PP), D, nullptr};
        pg8::gemm_phase<false>(F.tid, ring, (const char*)(ws + WS_PB), PLE * 2, S, E);
        GRID_BAR();
    }
    PHASE(16) { RELANE();
        pg8::DenseSched S{T / 256, D / 256, F.G, F.bx, D * 2, (const char*)(ws + WS_WPG)};
        pg8::EpiPle E{(bf16*)(ws + WS_H3), (const bf16*)(ws + WS_H1B), (const bf16*)(ws + WS_PP), (const float*)(ws + WS_SSQ2), (float*)(ws + WS_SSQ3)};
        pg8::gemm_phase<false>(F.tid, ring, (const char*)(ws + WS_H1B), D * 2, S, E);
        GRID_BAR();
    }
    PHASE(17) { RELANE();
    if (args.fin_mode == 0) p9_final(F, (const bf16*)(ws + WS_H3), (const float*)(ws + WS_SSQ3), 32);
    else p9_final(F, (const bf16*)(ws + WS_H1B), nullptr, 0);
    }
}

extern "C" void kernel_launch(void* const* d_in, const int* in_sizes, int n_in, void* d_out, int out_size, void* d_ws, size_t ws_size, hipStream_t stream) {
    static int grid = 0;
    if (grid == 0) {
        int dev = 0, cus = 0;
        if (n_in != 21 || ws_size < WS_END) { fprintf(stderr, "kernel_launch: n_in %d ws %zu (need %zu)\n", n_in, ws_size, (size_t)WS_END); grid = -1; return; }
        if (hipGetDevice(&dev) != hipSuccess || hipDeviceGetAttribute(&cus, hipDeviceAttributeMultiprocessorCount, dev) != hipSuccess) { grid = -1; return; }
        if (hipFuncSetAttribute((const void*)mk_fwd, hipFuncAttributeMaxDynamicSharedMemorySize, LDS_BYTES) != hipSuccess) { fprintf(stderr, "hipFuncSetAttribute failed\n"); grid = -1; return; }
        int per_cu = 0;
        (void)hipOccupancyMaxActiveBlocksPerMultiprocessor(&per_cu, (const void*)mk_fwd, NTHR, LDS_BYTES);
        (void)hipGetLastError();
        grid = cus > 256 ? 256 : cus;
    }
    if (grid < 0) return;
    (void)hipMemsetAsync((char*)d_ws + WS_CTL, 0, CTL_ZERO_BYTES, stream);
    Args a{};
    for (int i = 0; i < 21; ++i) a.in[i] = (const float*)d_in[i];
    a.out = (float*)d_out; a.ws = (unsigned char*)d_ws; a.fin_mode = FIN_MODE;
#if PROBE_K >= 0
    a.ph_lo = 0; a.ph_hi = PROBE_K + 1; a.li = 0;
    hipLaunchKernelGGL(mk_fwd, dim3(grid), dim3(NTHR), LDS_BYTES, stream, a);
    a.ph_lo = PROBE_K; a.ph_hi = PH_HI; a.li = 1;
    hipLaunchKernelGGL(mk_fwd, dim3(grid), dim3(NTHR), LDS_BYTES, stream, a);
#else
    a.ph_lo = 0; a.ph_hi = PH_HI; a.li = 0;
    hipLaunchKernelGGL(mk_fwd, dim3(grid), dim3(NTHR), LDS_BYTES, stream, a);
#endif
}
```

```cpp
#include <hip/hip_runtime.h>
#include <cstdio>
#ifndef PROBE_K
#define PROBE_K -1
#endif
#ifndef PH_HI
#define PH_HI 100
#endif
#ifndef FIN_MODE
#define FIN_MODE 0
#endif

#define GAS __attribute__((address_space(1)))
#define LAS __attribute__((address_space(3)))
typedef unsigned short bf16;
typedef unsigned v4u __attribute__((ext_vector_type(4)));
typedef unsigned v2u __attribute__((ext_vector_type(2)));
typedef float f32x4 __attribute__((ext_vector_type(4)));
typedef float f32x2 __attribute__((ext_vector_type(2)));
typedef float f32x16 __attribute__((ext_vector_type(16)));
typedef short bf16x8 __attribute__((ext_vector_type(8)));
typedef short s16x4 __attribute__((ext_vector_type(4)));
typedef GAS unsigned gu32;
#define RLX_AGENT __ATOMIC_RELAXED, __HIP_MEMORY_SCOPE_AGENT
#define LDS_WAIT() asm volatile("s_waitcnt lgkmcnt(0)" ::: "memory")
#define VM_WAIT() asm volatile("s_waitcnt vmcnt(0)" ::: "memory")

constexpr int NB = 8, SEQ = 4096, T = NB * SEQ, D = 2048, NPROJ = 6144, CW = 1024, HD = 128, NH = 8;
constexpr int PLE = 256, NE = 64, ED = 512, TOPK = 8, NSLOT = 9;
constexpr float EPS = 1e-6f;
constexpr int NWAVES = 8, NTHR = 512;
constexpr int MAXTILES = 1216;
constexpr int MAXROWS = MAXTILES * 256;
constexpr int NSLICE = 1, SLW = D / NSLICE;
constexpr float SLOT_SCALE = 16.f;

constexpr size_t MiB = 1u << 20;
constexpr size_t WS_CTL = 0, CTL_ZERO_BYTES = 1 * MiB;
constexpr size_t WS_RMIX = 1 * MiB;
constexpr size_t WS_RFFN = WS_RMIX + 128 * 1024;
constexpr size_t WS_SSQ2 = WS_RFFN + 128 * 1024;
constexpr size_t WS_SSQ3 = WS_SSQ2 + 512 * 1024;
constexpr size_t WS_TOPE = WS_SSQ3 + 4 * MiB;
constexpr size_t WS_TOPW = WS_TOPE + 1 * MiB;
constexpr size_t WS_CNT  = WS_TOPW + 1 * MiB;
constexpr size_t WS_RTOK = WS_CNT + 64 * 1024;
constexpr size_t WS_RW   = WS_RTOK + 1280 * 1024;
constexpr size_t WS_RDST = WS_RW + 1280 * 1024;
constexpr size_t WS_RR   = WS_RDST + 1280 * 1024;
constexpr size_t WS_TILEE = WS_RR + 1280 * 1024;
constexpr size_t WS_WR   = 16 * MiB;
constexpr size_t WS_WIN  = 17 * MiB;
constexpr size_t WS_WOUT = WS_WIN + 24 * MiB;
constexpr size_t WS_WGU  = WS_WOUT + 8 * MiB;
constexpr size_t WS_WDN  = WS_WGU + 130 * MiB;
constexpr size_t WS_WPG  = WS_WDN + 65 * MiB;
constexpr size_t WS_WPP  = WS_WPG + 8 * MiB;
constexpr size_t WS_PB   = WS_WPP + 1 * MiB;
constexpr size_t WS_H1B  = WS_PB + 16 * MiB;
constexpr size_t WS_H1F8 = WS_H1B + 128 * MiB;
constexpr size_t WS_OVL  = WS_H1F8 + 64 * MiB;
constexpr size_t WS_PROJ = WS_OVL;
constexpr size_t WS_HPERM = WS_OVL;
constexpr size_t WS_SLOT8 = WS_OVL + 304 * MiB;
constexpr size_t WS_PP   = WS_OVL;
constexpr size_t WS_H3   = WS_OVL + 128 * MiB;
constexpr size_t WS_SLOT47 = WS_OVL + 384 * MiB;
constexpr size_t WS_END  = WS_SLOT47 + 256 * MiB;
constexpr int CW_BAR = 4096;

constexpr int RING_OFF = 0, RING_BYTES = 131072;
constexpr int RT_OFF = 131072, RT_UNITS = 20, RT_BYTES = RT_UNITS * 1024;
constexpr int TE_OFF = RT_OFF + RT_BYTES, TE_BYTES = 4864 + 128;
constexpr int MISC_OFF = TE_OFF + TE_BYTES;
constexpr int LDS_BYTES = MISC_OFF + 128;
static_assert(LDS_BYTES <= 163840, "LDS");

__device__ __forceinline__ unsigned f2bf(float f) { unsigned u = __builtin_bit_cast(unsigned, f); return (u + 0x7fffu + ((u >> 16) & 1u)) >> 16; }
__device__ __forceinline__ unsigned pk2(float lo, float hi) { return f2bf(lo) | (f2bf(hi) << 16); }
__device__ __forceinline__ float bflo(unsigned w) { return __builtin_bit_cast(float, w << 16); }
__device__ __forceinline__ float bfhi(unsigned w) { return __builtin_bit_cast(float, w & 0xffff0000u); }
__device__ __forceinline__ float wave_sum(float v) {
#pragma unroll
    for (int o = 1; o < 64; o <<= 1) v += __shfl_xor(v, o);
    return v;
}
__device__ __forceinline__ float fsigmoid(float v) { return __builtin_amdgcn_rcpf(1.f + __builtin_amdgcn_exp2f(-1.4426950409f * v)); }

#define XB_TMO      128
#define XB_XCNT(j)  (256  + 64 * (j))
#define XB_XSUB(j)  (1280 + 64 * (j))
#define XB_XGEN(j)  (2304 + 64 * (j))
#define XB_TOP      3328
#define XB_TOPGEN   3392
#define XCD_BAR_WORDS 3456
#define XB_SPIN_CAP (1u << 18)
__device__ __forceinline__ unsigned xb_ld(unsigned* p)              { return __hip_atomic_load(p, __ATOMIC_RELAXED, __HIP_MEMORY_SCOPE_AGENT); }
__device__ __forceinline__ unsigned xb_add(unsigned* p, unsigned v) { return __hip_atomic_fetch_add(p, v, __ATOMIC_RELAXED, __HIP_MEMORY_SCOPE_AGENT); }
__device__ __forceinline__ unsigned xb_xcc_id() { return (unsigned)__builtin_amdgcn_s_getreg((3 << 11) | 20) & 0xFu; }
#define XB_SPIN(cond, bar) do { unsigned _sp = 0; while (cond) { __builtin_amdgcn_s_sleep(1); \
    if ((++_sp & 255u) == 0u) { if (xb_ld(&(bar)[XB_TMO])) break; if (_sp > XB_SPIN_CAP) { atomicAdd(&(bar)[XB_TMO], 1u); break; } } } } while (0)
struct XcdBarrier { unsigned* bar; unsigned x; volatile LAS unsigned* st; };
__device__ __forceinline__ XcdBarrier xcd_barrier_post(unsigned* bar, volatile LAS unsigned* st) {
    XcdBarrier b; b.bar = bar; b.x = xb_xcc_id(); b.st = st;
    if (threadIdx.x == 0) (void)xb_add(&bar[XB_XCNT(b.x)], 1u);
    return b;
}
__device__ __forceinline__ void xcd_barrier_complete(unsigned* bar, unsigned x, unsigned& nloc, unsigned& nx) {
    const unsigned G = gridDim.x * gridDim.y * gridDim.z;
    unsigned sum, cnt, mine, sp = 0u;
    for (;;) {
        sum = 0u; cnt = 0u; mine = 0u;
#pragma unroll
        for (unsigned j = 0; j < 16; ++j) { const unsigned c = xb_ld(&bar[XB_XCNT(j)]); sum += c; cnt += (c > 0u) ? 1u : 0u; mine = (j == x) ? c : mine; }
        if (sum == G) break;
        __builtin_amdgcn_s_sleep(1);
        if ((++sp & 255u) == 0u) { if (xb_ld(&bar[XB_TMO])) break; if (sp > XB_SPIN_CAP) { atomicAdd(&bar[XB_TMO], 1u); break; } }
    }
    nloc = mine > 0u ? mine : 1u; nx = cnt > 0u ? cnt : 1u;
}
__device__ __forceinline__ void xcd_barrier(const XcdBarrier& b) {
    asm volatile("s_waitcnt vmcnt(0)" ::: "memory");
    __syncthreads();
    if (threadIdx.x == 0) {
        unsigned* bar = b.bar;
        __builtin_amdgcn_s_waitcnt(0);
        unsigned nloc = b.st[0], nx = b.st[1];
        if (nloc == 0u) { xcd_barrier_complete(bar, b.x, nloc, nx); b.st[0] = nloc; b.st[1] = nx; }
        const unsigned old = xb_add(&bar[XB_XSUB(b.x)], 1u);
        const unsigned gen = old / nloc;
        if (old + 1u == (gen + 1u) * nloc) {
            __builtin_amdgcn_fence(__ATOMIC_RELEASE, "agent");
            asm volatile("s_waitcnt vmcnt(0)" ::: "memory");
            const unsigned og = xb_add(&bar[XB_TOP], 1u);
            const unsigned tg = og / nx;
            if (og + 1u == (tg + 1u) * nx) xb_add(&bar[XB_TOPGEN], 1u);
            else XB_SPIN(xb_ld(&bar[XB_TOPGEN]) == tg, bar);
            __builtin_amdgcn_fence(__ATOMIC_ACQUIRE, "agent");
            xb_add(&bar[XB_XGEN(b.x)], 1u);
            asm volatile("s_waitcnt vmcnt(0)" ::: "memory");
        } else {
            XB_SPIN(xb_ld(&bar[XB_XGEN(b.x)]) == gen, bar);
            __builtin_amdgcn_fence(__ATOMIC_ACQUIRE, "agent");
            asm volatile("s_waitcnt vmcnt(0)" ::: "memory");
        }
    }
    __syncthreads();
}

namespace pg8 {
constexpr int BM = 256, BK = 64, HALF = 128, HTB = HALF * BK * 2, STAGE_BYTES = 8 * HTB, NXCD = 8, WGM = 8;
__device__ __forceinline__ int lds_byte(int r, int c) { const int st = (r >> 4) * 2 + (c >> 5), rr = r & 15, cc = c & 31, ob = rr * 64 + cc * 2; return st * 1024 + (ob ^ (((ob >> 9) & 1) << 5)); }
__device__ __forceinline__ void stage_rc(int b, int& R, int& C) { const int st = b / 1024, sb = b % 1024, swz = sb ^ (((sb >> 9) & 1) << 5); R = (st >> 1) * 16 + swz / 64; C = (st & 1) * 32 + (swz % 64) / 2; }
__device__ __forceinline__ int brow(int R) { return 64 * (R >> 5) + 16 * ((R & 15) >> 2) + 4 * ((R >> 4) & 1) + (R & 3); }
__device__ __forceinline__ int brow1(int R) { return 64 * (R >> 5) + 8 * ((R & 15) >> 2) + 4 * ((R >> 4) & 1) + (R & 3); }

struct Unit { int pm, pn, e; };

__device__ __forceinline__ bool order_next(int i, int G, int c, int nM, int nN, int& pm, int& pn) {
    const int nwg = nM * nN; const long L = (long)i * G + c; if (L >= nwg) return false;
    int wgid = (int)L; { const int q = nwg / NXCD, r = nwg % NXCD, xcd = wgid % NXCD, off = wgid / NXCD; wgid = (xcd < r ? xcd * (q + 1) : r * (q + 1) + (xcd - r) * q) + off; }
    const int nig = WGM * nN, gid = wgid / nig, fm = gid * WGM, gsz = (nM - fm) < WGM ? (nM - fm) : WGM;
    pm = fm + ((wgid % nig) % gsz); pn = (wgid % nig) / gsz; return true;
}

struct DenseSched {
    static constexpr bool GATHER = false;
    int nM, nN, G, c, KB; const char* Bt;
    __device__ __forceinline__ bool next(int i, Unit& u) const { u.e = 0; return order_next(i, G, c, nM, nN, u.pm, u.pn); }
    __device__ __forceinline__ const char* bbase(const Unit& u) const { return Bt + (size_t)u.pn * BM * KB; }
    __device__ __forceinline__ const char* abase(const char* A, const Unit& u) const { return A + (size_t)u.pm * BM * KB; }
    __device__ __forceinline__ void aoffs(int ui, const Unit& u, int tid, unsigned (&ao)[2][2]) const {}
};
template <int MODE> struct GroupSched {
    static constexpr bool GATHER = true;
    int nM, nN, G, c, KB, pn0; const char* Bt; size_t estride; const LAS int* te; const LAS unsigned* rt;
    __device__ __forceinline__ bool next(int i, Unit& u) const { if (!order_next(i, G, c, nM, nN, u.pm, u.pn)) return false; u.e = __builtin_amdgcn_readfirstlane(te[u.pm]); return true; }
    __device__ __forceinline__ const char* bbase(const Unit& u) const { return Bt + (size_t)u.e * estride + (size_t)(pn0 + u.pn) * BM * KB; }
    __device__ __forceinline__ void aoffs(int ui, const Unit& u, int tid, unsigned (&ao)[2][2]) const {
        asm volatile("" : "+v"(tid));
#pragma unroll
        for (int i = 0; i < 2; ++i) { int R, C; stage_rc(tid * 16 + i * 8192, R, C);
#pragma unroll
            for (int h = 0; h < 2; ++h) { if (MODE == 1) ao[h][i] = rt[ui * 256 + h * HALF + R] + (unsigned)C * 2u; else ao[h][i] = (unsigned)(u.pm * BM + h * HALF + R) * (unsigned)KB + (unsigned)C * 2u; } }
    }
    __device__ __forceinline__ const char* abase(const char* A, const Unit& u) const { return A; }
};

__device__ __forceinline__ unsigned cvt_pk_bf16(float lo, float hi) { unsigned r; asm volatile("v_cvt_pk_bf16_f32 %0, %1, %2" : "=v"(r) : "v"(lo), "v"(hi)); return r; }

typedef int v8i __attribute__((ext_vector_type(8)));
typedef int v4i __attribute__((ext_vector_type(4)));
union Frag { v8i v; struct { v4i lo, hi; }; };
template <bool F8, int LAY, class Epi, class Sched>
__device__ __forceinline__ void gemm_phase(const int tid, LAS unsigned char* lds, const char* Abase, const int KB, const Sched& S, const Epi& E, const int sw = 0x7f7f7f7f, const int sa = 0x7f7f7f7f) {
    const int wid = __builtin_amdgcn_readfirstlane(tid >> 6), lane = tid & 63, wr = wid >> 2, wc = wid & 3, fr = lane & 15, fq = lane >> 4;
    const int nt = KB / 128;
    constexpr bool GA = Sched::GATHER;
    unsigned voffB[2], voffA[2];
#pragma unroll
    for (int i = 0; i < 2; ++i) { int R, C; stage_rc(tid * 16 + i * 8192, R, C); const int Rb = LAY ? brow1(R) : brow(R); voffB[i] = (unsigned)Rb * (unsigned)KB + (unsigned)C * 2u; voffA[i] = (unsigned)R * (unsigned)KB + (unsigned)C * 2u; }
    const size_t kstep = (size_t)(BK * 2);
    const size_t hstep = (size_t)HALF * KB;
    const size_t hstepB = (size_t)(LAY ? 32 : 8) * KB;
    const unsigned ldsw = (unsigned)wid * 1024u;
    const int aoff = lds_byte(wr * 64 + fr, fq * 8), boff = lds_byte(wc * 32 + fr, fq * 8);
#define PG8_SA(b, h) (((b) * 2 + (h)) * HTB)
#define PG8_SB(b, h) ((4 + (b) * 2 + (h)) * HTB)
#define PG8_STAGE(bufoff, gbase, voff) do { _Pragma("unroll") for (int _i = 0; _i < 2; ++_i) \
        __builtin_amdgcn_global_load_lds((const unsigned*)((const char*)(gbase) + (voff)[_i]), (LAS unsigned*)(lds + (bufoff) + ldsw + _i * 8192), 16, 0, 0); } while (0)
#define PG8_STAGEA(bufoff, gbase, half) do { if constexpr (GA) { PG8_STAGE(bufoff, gbase, ca[half]); } else { PG8_STAGE(bufoff, (gbase) + (half) * hstep, voffA); } } while (0)
#define PG8_LD1(dst, off) do { const v4i _lo = *(const LAS v4i*)(lds + (off)), _hi = *(const LAS v4i*)(lds + (off) + 1024); dst.lo = _lo; dst.hi = _hi; } while (0)
#define PG8_LDA(dst, b, h) do { _Pragma("unroll") for (int m = 0; m < 4; ++m) PG8_LD1(dst[m], PG8_SA(b, h) + aoff + m * 2048); } while (0)
#define PG8_LDB(dst, b, h) do { _Pragma("unroll") for (int n = 0; n < 2; ++n) PG8_LD1(dst[n], PG8_SB(b, h) + boff + n * 2048); } while (0)
#define PG8_MMA(ai, bj, At, Bt) do { __builtin_amdgcn_s_setprio(1); _Pragma("unroll") for (int m = 0; m < 4; ++m) _Pragma("unroll") for (int n = 0; n < 2; ++n) { \
        if constexpr (F8) { acc[ai][bj][m][n] = __builtin_amdgcn_mfma_scale_f32_16x16x128_f8f6f4(Bt[n].v, At[m].v, acc[ai][bj][m][n], 0, 0, 0, sw, 0, sa); } \
        else { acc[ai][bj][m][n] = __builtin_amdgcn_mfma_f32_16x16x32_bf16(__builtin_bit_cast(bf16x8, Bt[n].lo), __builtin_bit_cast(bf16x8, At[m].lo), acc[ai][bj][m][n], 0, 0, 0); \
               acc[ai][bj][m][n] = __builtin_amdgcn_mfma_f32_16x16x32_bf16(__builtin_bit_cast(bf16x8, Bt[n].hi), __builtin_bit_cast(bf16x8, At[m].hi), acc[ai][bj][m][n], 0, 0, 0); } } \
        __builtin_amdgcn_s_setprio(0); } while (0)
#define PG8_WAIT_V(n) asm volatile("s_waitcnt vmcnt(" #n ")" ::: "memory")
#define PG8_WAIT_L(n) asm volatile("s_waitcnt lgkmcnt(" #n ")" ::: "memory")
#define PG8_BAR __builtin_amdgcn_s_barrier()
#define PG8_SCHED __builtin_amdgcn_sched_barrier(0)
    Unit cur, nxt; int ui = 0;
    if (!S.next(0, cur)) return;
    f32x4 acc[2][2][4][2];
#pragma unroll
    for (int a = 0; a < 2; ++a)
#pragma unroll
        for (int b = 0; b < 2; ++b)
#pragma unroll
            for (int m = 0; m < 4; ++m)
#pragma unroll
                for (int n = 0; n < 2; ++n) acc[a][b][m][n] = (f32x4){0.f, 0.f, 0.f, 0.f};
    Frag At[4], B0[2], B1[2];
    unsigned ca[2][2], na[2][2];
    if constexpr (GA) S.aoffs(0, cur, tid, ca);
    const char* cB = S.bbase(cur); const char* cA = S.abase(Abase, cur);
    PG8_STAGE(PG8_SB(0, 0), cB, voffB); PG8_STAGEA(PG8_SA(0, 0), cA, 0); PG8_STAGE(PG8_SB(0, 1), cB + hstepB, voffB); PG8_STAGEA(PG8_SA(0, 1), cA, 1);
    if (wr == 1) PG8_BAR;
    PG8_WAIT_V(4); PG8_BAR;
    PG8_STAGE(PG8_SB(1, 0), cB + kstep, voffB); PG8_STAGEA(PG8_SA(1, 0), cA + kstep, 0); PG8_STAGE(PG8_SB(1, 1), cB + hstepB + kstep, voffB);
    PG8_WAIT_V(6); PG8_BAR;
    for (;;) {
        const bool has_next = S.next(ui + 1, nxt);
        const char* nB = has_next ? S.bbase(nxt) : cB; const char* nA = has_next ? S.abase(Abase, nxt) : cA;
        if constexpr (GA) {
            if (has_next) S.aoffs(ui + 1, nxt, tid, na);
            else {
#pragma unroll
                for (int h = 0; h < 2; ++h)
#pragma unroll
                    for (int i = 0; i < 2; ++i) na[h][i] = ca[h][i];
            }
        }
#pragma nounroll
        for (int t = 0; t < nt; t += 2) {
            const bool last = (t == nt - 2);
            const char* a1 = cA + (size_t)(t + 1) * kstep;
            const char* a2 = last ? nA : cA + (size_t)(t + 2) * kstep; const char* b2 = last ? nB : cB + (size_t)(t + 2) * kstep;
            const char* a3 = a2 + kstep; const char* b3 = b2 + kstep;
            PG8_LDB(B0, 0, 0); PG8_SCHED; PG8_LDA(At, 0, 0); PG8_STAGEA(PG8_SA(1, 1), a1, 1);
            PG8_WAIT_L(8); PG8_BAR; PG8_WAIT_L(0); PG8_MMA(0, 0, At, B0); PG8_BAR; PG8_SCHED;
            if constexpr (GA) { if (last) {
#pragma unroll
                for (int h = 0; h < 2; ++h)
#pragma unroll
                    for (int i = 0; i < 2; ++i) ca[h][i] = na[h][i];
            } }
            PG8_LDB(B1, 0, 1); PG8_STAGE(PG8_SB(0, 0), b2, voffB);
            PG8_BAR; PG8_WAIT_L(0); PG8_MMA(0, 1, At, B1); PG8_BAR;
            PG8_LDA(At, 0, 1); PG8_STAGEA(PG8_SA(0, 0), a2, 0);
            PG8_BAR; PG8_WAIT_L(0); PG8_MMA(1, 0, At, B0); PG8_BAR; PG8_SCHED;
            PG8_STAGE(PG8_SB(0, 1), b2 + hstepB, voffB);
            PG8_WAIT_V(6); PG8_BAR; PG8_MMA(1, 1, At, B1); PG8_BAR;
            PG8_LDB(B0, 1, 0); PG8_SCHED; PG8_LDA(At, 1, 0); PG8_STAGEA(PG8_SA(0, 1), a2, 1);
            PG8_WAIT_L(8); PG8_BAR; PG8_WAIT_L(0); PG8_MMA(0, 0, At, B0); PG8_BAR; PG8_SCHED;
            PG8_LDB(B1, 1, 1); PG8_STAGE(PG8_SB(1, 0), b3, voffB);
            PG8_BAR; PG8_WAIT_L(0); PG8_MMA(0, 1, At, B1); PG8_BAR;
            PG8_LDA(At, 1, 1); PG8_STAGEA(PG8_SA(1, 0), a3, 0);
            PG8_BAR; PG8_WAIT_L(0); PG8_MMA(1, 0, At, B0); PG8_BAR; PG8_SCHED;
            PG8_STAGE(PG8_SB(1, 1), b3 + hstepB, voffB);
            PG8_WAIT_V(6); PG8_BAR; PG8_MMA(1, 1, At, B1); PG8_BAR;
        }
        { int tz = tid; asm volatile("" : "+v"(tz)); const int l2 = tz & 63; E(acc, cur, wr, wc, l2 & 15, l2 >> 4); }
        if (!has_next) break;
#pragma unroll
        for (int a = 0; a < 2; ++a)
#pragma unroll
            for (int b = 0; b < 2; ++b)
#pragma unroll
                for (int m = 0; m < 4; ++m)
#pragma unroll
                    for (int n = 0; n < 2; ++n) acc[a][b][m][n] = (f32x4){0.f, 0.f, 0.f, 0.f};
        cur = nxt; cB = nB; cA = nA; ++ui;
    }
    PG8_WAIT_V(0);
    if (wr == 0) PG8_BAR;
    PG8_BAR;
#undef PG8_SA
#undef PG8_SB
#undef PG8_STAGE
#undef PG8_STAGEA
#undef PG8_LD1
#undef PG8_LDA
#undef PG8_LDB
#undef PG8_MMA
#undef PG8_WAIT_V
#undef PG8_WAIT_L
#undef PG8_BAR
#undef PG8_SCHED
}

__device__ __forceinline__ unsigned cvt4_fp8(float a, float b, float c, float d) { int w = 0; w = __builtin_amdgcn_cvt_pk_fp8_f32(a, b, w, false); w = __builtin_amdgcn_cvt_pk_fp8_f32(c, d, w, true); return (unsigned)w; }
__device__ __forceinline__ v4u pack8_bf16(const f32x4 a, const f32x4 b) { v4u w; w.x = cvt_pk_bf16(a[0], a[1]); w.y = cvt_pk_bf16(a[2], a[3]); w.z = cvt_pk_bf16(b[0], b[1]); w.w = cvt_pk_bf16(b[2], b[3]); return w; }
__device__ __forceinline__ void unpack8(const v4u w, f32x4& a, f32x4& b) { a = (f32x4){bflo(w[0]), bfhi(w[0]), bflo(w[1]), bfhi(w[1])}; b = (f32x4){bflo(w[2]), bfhi(w[2]), bflo(w[3]), bfhi(w[3])}; }
struct EpiBf16Scale {
    bf16* O; int ldc; const float* rs;
    __device__ __forceinline__ void operator()(const f32x4 (&acc)[2][2][4][2], const Unit& u, int wr, int wc, int fr, int fq) const {
        const int row0 = u.pm * BM + wr * 64 + fr, col0 = u.pn * BM + wc * 64 + 8 * fq;
        float sc[8];
#pragma unroll
        for (int q = 0; q < 8; ++q) sc[q] = rs ? rs[row0 + (q >> 2) * HALF + (q & 3) * 16] : 1.f;
#pragma unroll
        for (int ai = 0; ai < 2; ++ai)
#pragma unroll
            for (int m = 0; m < 4; ++m) { const int row = row0 + ai * HALF + m * 16; const float s = sc[ai * 4 + m]; bf16* rowp = O + (size_t)row * ldc + col0;
#pragma unroll
                for (int bj = 0; bj < 2; ++bj) *(v4u*)(rowp + 32 * bj) = pack8_bf16(acc[ai][bj][m][0] * s, acc[ai][bj][m][1] * s); }
    }
};
struct EpiResF32 {
    bf16* O; const bf16* X; int ldc; unsigned char* O8;
    __device__ __forceinline__ void operator()(const f32x4 (&acc)[2][2][4][2], const Unit& u, int wr, int wc, int fr, int fq) const {
        const int row0 = u.pm * BM + wr * 64 + fr, col0 = u.pn * BM + wc * 64 + 8 * fq;
#pragma unroll
        for (int ai = 0; ai < 2; ++ai) {
            v4u xw[4][2];
#pragma unroll
            for (int m = 0; m < 4; ++m)
#pragma unroll
                for (int bj = 0; bj < 2; ++bj) xw[m][bj] = *(const v4u*)(X + (size_t)(row0 + ai * HALF + m * 16) * ldc + col0 + 32 * bj);
#pragma unroll
            for (int m = 0; m < 4; ++m) { const size_t ro = (size_t)(row0 + ai * HALF + m * 16) * ldc + col0;
#pragma unroll
                for (int bj = 0; bj < 2; ++bj) { f32x4 x0, x1; unpack8(xw[m][bj], x0, x1);
                    const f32x4 v0 = acc[ai][bj][m][0] + x0, v1 = acc[ai][bj][m][1] + x1;
                    *(v4u*)(O + ro + 32 * bj) = pack8_bf16(v0, v1);
                    v2u w8; w8.x = cvt4_fp8(v0[0], v0[1], v0[2], v0[3]); w8.y = cvt4_fp8(v1[0], v1[1], v1[2], v1[3]);
                    *(v2u*)(O8 + ro + 32 * bj) = w8; } }
        }
    }
};
struct EpiGateUp {
    unsigned char* Hp; const float* rr;
    __device__ __forceinline__ void operator()(const f32x4 (&acc)[2][2][4][2], const Unit& u, int wr, int wc, int fr, int fq) const {
        const int row0 = u.pm * BM + wr * 64 + fr, col0 = u.pn * HALF + wc * 32 + 8 * fq;
        float sc[8];
#pragma unroll
        for (int q = 0; q < 8; ++q) sc[q] = rr[row0 + (q >> 2) * HALF + (q & 3) * 16];
#pragma unroll
        for (int ai = 0; ai < 2; ++ai)
#pragma unroll
            for (int m = 0; m < 4; ++m) { const int row = row0 + ai * HALF + m * 16; const float s = sc[ai * 4 + m];
                float h[8];
#pragma unroll
                for (int n = 0; n < 2; ++n)
#pragma unroll
                    for (int j = 0; j < 4; ++j) { const float g = acc[ai][0][m][n][j] * s, up = acc[ai][1][m][n][j] * s; h[n * 4 + j] = g * fsigmoid(g) * up; }
                v2u w; w.x = cvt4_fp8(h[0], h[1], h[2], h[3]); w.y = cvt4_fp8(h[4], h[5], h[6], h[7]);
                *(v2u*)(Hp + (size_t)row * ED + col0) = w; }
    }
};
struct EpiDown {
    unsigned char* S0; unsigned char* S1; unsigned char* S8; const float* rw; const int* rdst;
    __device__ __forceinline__ void operator()(const f32x4 (&acc)[2][2][4][2], const Unit& u, int wr, int wc, int fr, int fq) const {
        const int row0 = u.pm * BM + wr * 64 + fr, col0 = u.pn * BM + wc * 64 + 16 * fq;
        float sc[8]; int ds[8];
#pragma unroll
        for (int q = 0; q < 8; ++q) { const int row = row0 + (q >> 2) * HALF + (q & 3) * 16; sc[q] = rw[row]; ds[q] = rdst[row]; }
#pragma unroll
        for (int ai = 0; ai < 2; ++ai)
#pragma unroll
            for (int m = 0; m < 4; ++m) { const float s = sc[ai * 4 + m] * SLOT_SCALE; const int dst = ds[ai * 4 + m];
                if (dst >= 0) { unsigned char* rowp = (dst < 4 * T ? S0 + (size_t)dst * D : dst < 8 * T ? S1 + (size_t)(dst - 4 * T) * D : S8 + (size_t)(dst - 8 * T) * D) + col0;
                    v4u w;
#pragma unroll
                    for (int bj = 0; bj < 2; ++bj) { const f32x4 v0 = acc[ai][bj][m][0] * s, v1 = acc[ai][bj][m][1] * s;
                        w[2 * bj] = cvt4_fp8(v0[0], v0[1], v0[2], v0[3]); w[2 * bj + 1] = cvt4_fp8(v1[0], v1[1], v1[2], v1[3]); }
                    *(v4u*)rowp = w; } }
    }
};
struct EpiPle {
    bf16* H3; const bf16* H2; const bf16* PP; const float* ssq2; float* ssq3;
    __device__ __forceinline__ void operator()(const f32x4 (&acc)[2][2][4][2], const Unit& u, int wr, int wc, int fr, int fq) const {
        const int row0 = u.pm * BM + wr * 64 + fr, col0 = u.pn * BM + wc * 64 + 8 * fq;
#pragma unroll
        for (int ai = 0; ai < 2; ++ai) {
            v4u hw[4][2], pw[4][2]; float sq[4];
#pragma unroll
            for (int m = 0; m < 4; ++m) { const int row = row0 + ai * HALF + m * 16; sq[m] = ssq2[row];
#pragma unroll
                for (int bj = 0; bj < 2; ++bj) { const size_t o = (size_t)row * D + col0 + 32 * bj; hw[m][bj] = *(const v4u*)(H2 + o); pw[m][bj] = *(const v4u*)(PP + o); } }
#pragma unroll
            for (int m = 0; m < 4; ++m) { const int row = row0 + ai * HALF + m * 16;
                const float r = __builtin_amdgcn_rsqf(sq[m] * (1.f / D) + EPS);
                const size_t ro = (size_t)row * D + col0; float ss = 0.f;
#pragma unroll
                for (int bj = 0; bj < 2; ++bj) { f32x4 h0, h1, p0, p1; unpack8(hw[m][bj], h0, h1); unpack8(pw[m][bj], p0, p1);
                    f32x4 o0, o1;
#pragma unroll
                    for (int j = 0; j < 4; ++j) { o0[j] = h0[j] + fsigmoid(acc[ai][bj][m][0][j] * r) * p0[j]; o1[j] = h1[j] + fsigmoid(acc[ai][bj][m][1][j] * r) * p1[j]; ss += o0[j] * o0[j] + o1[j] * o1[j]; }
                    *(v4u*)(H3 + ro + 32 * bj) = pack8_bf16(o0, o1); }
                ss += __shfl_xor(ss, 16); ss += __shfl_xor(ss, 32);
                if (fq == 0) ssq3[(size_t)(u.pn * 4 + wc) * T + row] = ss; }
        }
    }
};
}

struct Frame {
    LAS unsigned char* lds;
    int tid, lane, wave, G, bx;
    unsigned char* ws;
    const float* in[21];
    float* out;
};
enum { I_X = 0, I_P, I_NMIX, I_WIN, I_CONVW, I_GCONV, I_GSB, I_WOUT, I_NFFN, I_WR, I_RB, I_WEG, I_WEU, I_WED, I_WSG, I_WSU, I_WSD, I_NPLE, I_WPG, I_WPP, I_NFIN };

__device__ __forceinline__ void p0_transpose_item(const float* W, int N, bf16* WT, int ldk, int k0, int n0, int row_off, const float* g64, LAS float* scr, int lane) {
    const int n4 = lane & 15, kr = lane >> 4;
    f32x4 v[16];
    const float* src = W + (size_t)(k0 + kr) * N + n0 + 4 * n4;
#pragma unroll
    for (int i = 0; i < 16; ++i) v[i] = *(const GAS f32x4*)(src + (size_t)(4 * i) * N);
    const int c = lane >> 3, nn = lane & 7;
    f32x4 ga = (f32x4){1.f, 1.f, 1.f, 1.f}, gb = ga;
    if (g64) { ga = *(const GAS f32x4*)(g64 + 8 * c); gb = *(const GAS f32x4*)(g64 + 8 * c + 4); }
#pragma unroll
    for (int i = 0; i < 16; ++i) { LAS float* d = scr + (4 * i + kr) * 65 + 4 * n4; d[0] = v[i].x; d[1] = v[i].y; d[2] = v[i].z; d[3] = v[i].w; }
    LDS_WAIT(); asm volatile("" ::: "memory");
#pragma unroll
    for (int j = 0; j < 8; ++j) { const int n = nn + 8 * j; const LAS float* s = scr + (8 * c) * 65 + n;
        v4u o; o.x = pg8::cvt_pk_bf16(s[0] * ga.x, s[65] * ga.y); o.y = pg8::cvt_pk_bf16(s[130] * ga.z, s[195] * ga.w); o.z = pg8::cvt_pk_bf16(s[260] * gb.x, s[325] * gb.y); o.w = pg8::cvt_pk_bf16(s[390] * gb.z, s[455] * gb.w);
        *(GAS v4u*)(WT + (size_t)(row_off + n) * ldk + k0 + 8 * c) = o; }
    LDS_WAIT(); asm volatile("" ::: "memory");
}
__device__ __forceinline__ void p0_transpose_item_f8(const float* W, int N, unsigned char* WT, int ldk, int k0, int n0, int row_off, int mode, const float* g64, LAS float* scr, int lane) {
    const int n4 = lane & 15, kr = lane >> 4;
    f32x4 v[16];
    const float* src = W + (size_t)(k0 + kr) * N + n0 + 4 * n4;
#pragma unroll
    for (int i = 0; i < 16; ++i) v[i] = *(const GAS f32x4*)(src + (size_t)(4 * i) * N);
    const int c = lane >> 4, nn = lane & 15;
    float g[16];
#pragma unroll
    for (int q = 0; q < 4; ++q) { f32x4 t = (f32x4){1.f, 1.f, 1.f, 1.f}; if (g64) t = *(const GAS f32x4*)(g64 + 16 * c + 4 * q); g[4 * q] = 64.f * t.x; g[4 * q + 1] = 64.f * t.y; g[4 * q + 2] = 64.f * t.z; g[4 * q + 3] = 64.f * t.w; }
#pragma unroll
    for (int i = 0; i < 16; ++i) { LAS float* d = scr + (4 * i + kr) * 65 + 4 * n4; d[0] = v[i].x; d[1] = v[i].y; d[2] = v[i].z; d[3] = v[i].w; }
    LDS_WAIT(); asm volatile("" ::: "memory");
#pragma unroll
    for (int j = 0; j < 4; ++j) { const int n = nn + 16 * j; const LAS float* s = scr + (16 * c) * 65 + n;
        v4u o;
        o.x = pg8::cvt4_fp8(s[0] * g[0], s[65] * g[1], s[130] * g[2], s[195] * g[3]); o.y = pg8::cvt4_fp8(s[260] * g[4], s[325] * g[5], s[390] * g[6], s[455] * g[7]);
        o.z = pg8::cvt4_fp8(s[520] * g[8], s[585] * g[9], s[650] * g[10], s[715] * g[11]); o.w = pg8::cvt4_fp8(s[780] * g[12], s[845] * g[13], s[910] * g[14], s[975] * g[15]);
        const int hid = n0 + n, drow = mode == 0 ? row_off + n : 16 * (hid >> 3) + 8 * (mode - 1) + (hid & 7);
        *(GAS v4u*)(WT + (size_t)drow * ldk + k0 + 16 * c) = o; }
    LDS_WAIT(); asm volatile("" ::: "memory");
}
constexpr int P0_I_WIN = (D / 64) * (NPROJ / 64), P0_I_WOUT = (D / 64) * (D / 64), P0_I_WR = (D / 64) * (NE / 64), P0_I_WPG = (D / 64) * (D / 64), P0_I_WPP = (PLE / 64) * (D / 64);
constexpr int P0_I_EXP = 768, P0_NITEMS = P0_I_WIN + P0_I_WOUT + P0_I_WR + P0_I_WPG + P0_I_WPP + 65 * P0_I_EXP;
__device__ __forceinline__ void p0_item(Frame& F, int it, LAS float* scr) {
    unsigned char* ws = F.ws; const int lane = F.lane;
    if (it < P0_I_WIN) { const int kb = it / (NPROJ / 64), nb = it % (NPROJ / 64); p0_transpose_item(F.in[I_WIN], NPROJ, (bf16*)(ws + WS_WIN), D, 64 * kb, 64 * nb, 64 * nb, F.in[I_NMIX] + 64 * kb, scr, lane); return; } it -= P0_I_WIN;
    if (it < P0_I_WOUT) { const int kb = it / (D / 64), nb = it % (D / 64), k0 = 64 * kb; const float* g = k0 < CW ? F.in[I_GCONV] + k0 : F.in[I_GSB] + (k0 - CW);
        p0_transpose_item(F.in[I_WOUT], D, (bf16*)(ws + WS_WOUT), D, k0, 64 * nb, 64 * nb, g, scr, lane); return; } it -= P0_I_WOUT;
    if (it < P0_I_WR) { const int kb = it; p0_transpose_item(F.in[I_WR], NE, (bf16*)(ws + WS_WR), D, 64 * kb, 0, 0, F.in[I_NFFN] + 64 * kb, scr, lane); return; } it -= P0_I_WR;
    if (it < P0_I_WPG) { const int kb = it / (D / 64), nb = it % (D / 64); p0_transpose_item(F.in[I_WPG], D, (bf16*)(ws + WS_WPG), D, 64 * kb, 64 * nb, 64 * nb, F.in[I_NPLE] + 64 * kb, scr, lane); return; } it -= P0_I_WPG;
    if (it < P0_I_WPP) { const int kb = it / (D / 64), nb = it % (D / 64); p0_transpose_item(F.in[I_WPP], D, (bf16*)(ws + WS_WPP), PLE, 64 * kb, 64 * nb, 64 * nb, nullptr, scr, lane); return; } it -= P0_I_WPP;
    const int e = it / P0_I_EXP, r = it % P0_I_EXP, sub = r / 256, q = r % 256;
    if (sub < 2) {
        const float* src = e < NE ? (sub == 0 ? F.in[I_WEG] : F.in[I_WEU]) + (size_t)e * D * ED : (sub == 0 ? F.in[I_WSG] : F.in[I_WSU]);
        const int kb = q / (ED / 64), nb = q % (ED / 64), n0 = 64 * nb;
        p0_transpose_item_f8(src, ED, ws + WS_WGU + (size_t)e * 1024 * D, D, 64 * kb, n0, 0, 1 + sub, F.in[I_NFFN] + 64 * kb, scr, lane);
    } else {
        const float* src = e < NE ? F.in[I_WED] + (size_t)e * ED * D : F.in[I_WSD];
        const int kb = q / (D / 64), nb = q % (D / 64);
        p0_transpose_item_f8(src, D, ws + WS_WDN + (size_t)e * D * ED, ED, 64 * kb, 64 * nb, 64 * nb, 0, nullptr, scr, lane);
    }
}
__device__ __forceinline__ void p0_prologue(Frame& F) {
    LAS float* scr = (LAS float*)(F.lds + RING_OFF + F.wave * 16896);
    const int gw = F.bx * NWAVES + F.wave, NGW = F.G * NWAVES;
    {
        bf16* XB = (bf16*)F.out; float* rmix = (float*)(F.ws + WS_RMIX); const float* x = F.in[I_X];
        for (int m = gw; m < T; m += NGW) {
            const GAS f32x4* xr = (const GAS f32x4*)(x + (size_t)m * D) + F.lane;
            f32x4 v[8]; float s = 0.f;
#pragma unroll
            for (int j = 0; j < 8; ++j) { v[j] = xr[64 * j]; s += (v[j].x * v[j].x + v[j].y * v[j].y) + (v[j].z * v[j].z + v[j].w * v[j].w); }
            s = wave_sum(s);
            if (F.lane == 0) rmix[m] = __builtin_amdgcn_rsqf(s * (1.f / D) + EPS);
            GAS v2u* o8 = (GAS v2u*)(XB + (size_t)m * D) + F.lane;
#pragma unroll
            for (int j = 0; j < 8; ++j) { v2u w; w.x = pk2(v[j].x, v[j].y); w.y = pk2(v[j].z, v[j].w); o8[64 * j] = w; }
        }
    }
    {
        const float* p = F.in[I_P]; bf16* PB = (bf16*)(F.ws + WS_PB);
        const int nchunk = T * PLE / 8, gt = F.bx * NTHR + F.tid, NGT = F.G * NTHR;
        for (int c = gt; c < nchunk; c += NGT) { const f32x4 a = *(const GAS f32x4*)(p + (size_t)c * 8), b = *(const GAS f32x4*)(p + (size_t)c * 8 + 4);
            v4u w; w.x = pk2(a.x, a.y); w.y = pk2(a.z, a.w); w.z = pk2(b.x, b.y); w.w = pk2(b.z, b.w); *(GAS v4u*)(PB + (size_t)c * 8) = w; }
    }
    for (int it = gw; it < P0_NITEMS; it += NGW) p0_item(F, it, scr);
}

__device__ __forceinline__ unsigned off_b(unsigned row, unsigned ch) { return 256u * row + 16u * (ch ^ (((row & 3) << 2) | ((row >> 2) & 3))); }
#define MFMA32(a, b, c) __builtin_amdgcn_mfma_f32_32x32x16_bf16((a), (b), (c), 0, 0, 0)

__device__ __forceinline__ void conv_item(Frame& F, int it) {
    const bf16* proj = (const bf16*)(F.ws + WS_PROJ); bf16* ymix = (bf16*)F.out + (size_t)T * D;
    const float* cw = F.in[I_CONVW]; const int lane = F.lane;
    float w0[16], w1[16], w2[16], u1[16], u2[16];
#pragma unroll
    for (int j = 0; j < 2; ++j)
#pragma unroll
        for (int i = 0; i < 8; ++i) { const int c = 512 * j + 8 * lane + i; w0[8 * j + i] = cw[c]; w1[8 * j + i] = cw[CW + c]; w2[8 * j + i] = cw[2 * CW + c]; u1[8 * j + i] = 0.f; u2[8 * j + i] = 0.f; }
    const int t0 = 16 * it; const bool seq_start = (t0 & (SEQ - 1)) == 0;
    for (int tt = -2; tt < 16; ++tt) {
        if (tt < 0 && seq_start) continue;
        const size_t t = (size_t)(t0 + tt);
        const bf16* pr = proj + t * NPROJ + 8 * lane;
        float u[16], cb[16];
#pragma unroll
        for (int j = 0; j < 2; ++j) { const v4u h = *(const GAS v4u*)(pr + 512 * j), c = *(const GAS v4u*)(pr + 2 * CW + 512 * j);
#pragma unroll
            for (int q = 0; q < 4; ++q) { u[8 * j + 2 * q] = bflo(h[q]) * bflo(c[q]); u[8 * j + 2 * q + 1] = bfhi(h[q]) * bfhi(c[q]); } }
        if (tt >= 0) {
#pragma unroll
            for (int j = 0; j < 2; ++j) { const v4u b = *(const GAS v4u*)(pr + CW + 512 * j);
#pragma unroll
                for (int q = 0; q < 4; ++q) { cb[8 * j + 2 * q] = bflo(b[q]); cb[8 * j + 2 * q + 1] = bfhi(b[q]); } }
            float y[16], ss = 0.f;
#pragma unroll
            for (int i = 0; i < 16; ++i) { y[i] = cb[i] * (w0[i] * u2[i] + w1[i] * u1[i] + w2[i] * u[i]); ss += y[i] * y[i]; }
            const float r = __builtin_amdgcn_rsqf(wave_sum(ss) * (1.f / CW) + EPS);
            bf16* yo = ymix + t * D + 8 * lane;
#pragma unroll
            for (int j = 0; j < 2; ++j) { v4u w; w.x = pk2(y[8 * j] * r, y[8 * j + 1] * r); w.y = pk2(y[8 * j + 2] * r, y[8 * j + 3] * r); w.z = pk2(y[8 * j + 4] * r, y[8 * j + 5] * r); w.w = pk2(y[8 * j + 6] * r, y[8 * j + 7] * r);
                *(GAS v4u*)(yo + 512 * j) = w; }
        }
#pragma unroll
        for (int i = 0; i < 16; ++i) { u2[i] = u1[i]; u1[i] = u[i]; }
    }
}

__device__ __forceinline__ bf16x8 pack8(float a0, float a1, float a2, float a3, float a4, float a5, float a6, float a7) {
    v4u p; p.x = pk2(a0, a1); p.y = pk2(a2, a3); p.z = pk2(a4, a5); p.w = pk2(a6, a7); return __builtin_bit_cast(bf16x8, p);
}
__device__ __forceinline__ void tr_read4(unsigned a_t0, unsigned a_t1, s16x4& r00, s16x4& r01, s16x4& r10, s16x4& r11) {
    asm volatile("ds_read_b64_tr_b16 %0, %4\n\tds_read_b64_tr_b16 %1, %5\n\tds_read_b64_tr_b16 %2, %4 offset:4096\n\tds_read_b64_tr_b16 %3, %5 offset:4096\n\ts_waitcnt lgkmcnt(0)"
                 : "=&v"(r00), "=&v"(r01), "=&v"(r10), "=&v"(r11) : "v"(a_t0), "v"(a_t1) : "memory");
}
constexpr float ATT_C = 0.08838834764831845f * 1.4426950408889634f;
constexpr float ATT_EXIT = -152.f;

__device__ __forceinline__ void attn_unit(Frame& F, int b, int qblk, int parity) {
    const int lane = F.lane, h = F.wave, r = lane & 31, hh = lane >> 5;
    const bf16* proj = (const bf16*)(F.ws + WS_PROJ); bf16* ymix = (bf16*)F.out + (size_t)T * D;
    const size_t rowbase = (size_t)b * SEQ; const int t0 = qblk * 32;
    LAS unsigned char* kt = F.lds + h * 16384; LAS unsigned char* vt = kt + 8192;
    LAS float* XS = (LAS float*)(F.lds + RT_OFF) + parity * 256;
    bf16x8 qf[8];
    { const bf16* qp = proj + (rowbase + t0 + r) * NPROJ + 3 * CW + h * HD + 8 * hh;
#pragma unroll
      for (int kk = 0; kk < 8; ++kk) qf[kk] = *(const GAS bf16x8*)(qp + 16 * kk); }
    f32x16 oacc[4];
#pragma unroll
    for (int c = 0; c < 4; ++c)
#pragma unroll
        for (int i = 0; i < 16; ++i) oacc[c][i] = 0.f;
    float L = 0.f;
    const unsigned pr = (unsigned)((r & 19) | ((r & 4) << 1) | ((r & 8) >> 1));
    const unsigned ktb = (unsigned)(size_t)kt, vtb = (unsigned)(size_t)vt;
    unsigned va[2][4];
    { const unsigned blk = (lane >> 4) & 1, q = (lane & 15) >> 2, p = lane & 3;
#pragma unroll
      for (int t = 0; t < 2; ++t)
#pragma unroll
          for (int c = 0; c < 4; ++c) va[t][c] = vtb + off_b(8 * hh + 4 * t + q, 4 * c + 2 * blk + (p >> 1)) + 8 * (p & 1); }
    for (int kti = qblk; kti >= 0; --kti) {
        const int s0 = kti * 32;
        {
            v4u kreg[8], vreg[8];
            const bf16* kp = proj + (rowbase + s0 + (lane >> 4)) * NPROJ + 4 * CW + h * HD + (lane & 15) * 8;
#pragma unroll
            for (int i = 0; i < 8; ++i) { kreg[i] = *(const GAS v4u*)(kp + (size_t)(4 * i) * NPROJ); vreg[i] = *(const GAS v4u*)(kp + (size_t)(4 * i) * NPROJ + CW); }
#pragma unroll
            for (int i = 0; i < 8; ++i) { const unsigned o = off_b(4 * i + (lane >> 4), lane & 15); *(LAS v4u*)(kt + o) = kreg[i]; *(LAS v4u*)(vt + o) = vreg[i]; }
        }
        LDS_WAIT();
        f32x16 x;
#pragma unroll
        for (int i = 0; i < 16; ++i) x[i] = 0.f;
#pragma unroll
        for (int kk = 0; kk < 8; ++kk) { const bf16x8 kf = *(const LAS bf16x8*)(kt + off_b(pr, 2 * kk + hh)); x = MFMA32(kf, qf[kk], x); }
        const bool diag = (kti == qblk);
        float zz[16], suf[16];
#pragma unroll
        for (int i = 0; i < 16; ++i) {
            zz[i] = x[i] * ATT_C;
            const float e = __builtin_amdgcn_exp2f(fminf(zz[i], 126.f));
            float l = -__builtin_amdgcn_logf(1.f + e);
            const int kap = 16 * (i >> 3) + 8 * hh + (i & 7);
            if (diag && !(kap < r)) l = 0.f;
            suf[i] = l;
        }
#pragma unroll
        for (int j = 6; j >= 0; --j) { suf[j] += suf[j + 1]; suf[8 + j] += suf[8 + j + 1]; }
        const float T0 = suf[0], T1 = suf[8];
        const float T0p = __shfl_xor(T0, 32), T1p = __shfl_xor(T1, 32);
        const float base0 = L + T1 + T1p + (hh == 0 ? T0p : 0.f), base1 = L + (hh == 0 ? T1p : 0.f);
        float a[16];
#pragma unroll
        for (int i = 0; i < 16; ++i) {
            float v = __builtin_amdgcn_exp2f(zz[i] + (i < 8 ? base0 : base1) + suf[i]);
            const int kap = 16 * (i >> 3) + 8 * hh + (i & 7);
            if (diag && !(kap < r)) v = 0.f;
            a[i] = v;
        }
        L += (T0 + T1) + (T0p + T1p);
        const bf16x8 pf0 = pack8(a[0], a[1], a[2], a[3], a[4], a[5], a[6], a[7]);
        const bf16x8 pf1 = pack8(a[8], a[9], a[10], a[11], a[12], a[13], a[14], a[15]);
#pragma unroll
        for (int c = 0; c < 4; ++c) {
            s16x4 r00, r01, r10, r11; tr_read4(va[0][c], va[1][c], r00, r01, r10, r11);
            const bf16x8 vf0 = __builtin_shufflevector(r00, r01, 0, 1, 2, 3, 4, 5, 6, 7), vf1 = __builtin_shufflevector(r10, r11, 0, 1, 2, 3, 4, 5, 6, 7);
            oacc[c] = MFMA32(vf0, pf0, oacc[c]); oacc[c] = MFMA32(vf1, pf1, oacc[c]);
        }
        if (__all(L < ATT_EXIT)) break;
    }
    float ss = 0.f;
#pragma unroll
    for (int c = 0; c < 4; ++c)
#pragma unroll
        for (int i = 0; i < 16; ++i) ss += oacc[c][i] * oacc[c][i];
    ss += __shfl_xor(ss, 32);
    if (hh == 0) XS[h * 32 + r] = ss;
    __syncthreads();
    float tot = 0.f;
#pragma unroll
    for (int w = 0; w < 8; ++w) tot += XS[w * 32 + r];
    const float rs = __builtin_amdgcn_rsqf(tot * (1.f / CW) + EPS);
    bf16* yo = ymix + (rowbase + t0 + r) * D + CW + h * HD + 4 * hh;
#pragma unroll
    for (int c = 0; c < 4; ++c)
#pragma unroll
        for (int g = 0; g < 4; ++g) { v2u w; w.x = pk2(oacc[c][4 * g] * rs, oacc[c][4 * g + 1] * rs); w.y = pk2(oacc[c][4 * g + 2] * rs, oacc[c][4 * g + 3] * rs);
            *(GAS v2u*)(yo + 32 * c + 8 * g) = w; }
}
__device__ __forceinline__ void p2_mixer(Frame& F) {
    int par = 0;
    for (int u = F.bx; u < NB * (SEQ / 32); u += F.G) { attn_unit(F, u / (SEQ / 32), u % (SEQ / 32), par); par ^= 1; }
    const int gw = F.bx * NWAVES + F.wave, NGW = F.G * NWAVES;
    for (int it = gw; it < T / 16; it += NGW) conv_item(F, it);
}

__device__ __forceinline__ void router_unit(Frame& F, int unit, LAS int* hist) {
    const int lane = F.lane, r16 = lane & 15, g = lane >> 4;
    const bf16* H = (const bf16*)(F.ws + WS_H1B); const bf16* WR = (const bf16*)(F.ws + WS_WR);
    const int t0 = unit * 16;
    LAS float* LG = (LAS float*)(F.lds + F.wave * 16384); LAS float* BI = LG + 16 * 65 + 16;
    f32x4 acc[4];
#pragma unroll
    for (int nb = 0; nb < 4; ++nb) acc[nb] = (f32x4){0.f, 0.f, 0.f, 0.f};
    float ss = 0.f;
    const bf16* ap = H + (size_t)(t0 + r16) * D + 8 * g; const bf16* bp = WR + (size_t)r16 * D + 8 * g;
#pragma unroll 4
    for (int ks = 0; ks < D / 32; ++ks) {
        const v4u aw = *(const GAS v4u*)(ap + 32 * ks);
#pragma unroll
        for (int q = 0; q < 4; ++q) { const float lo = bflo(aw[q]), hi = bfhi(aw[q]); ss += lo * lo + hi * hi; }
        const bf16x8 af = __builtin_bit_cast(bf16x8, aw);
#pragma unroll
        for (int nb = 0; nb < 4; ++nb) { const bf16x8 bf = *(const GAS bf16x8*)(bp + (size_t)(16 * nb) * D + 32 * ks); acc[nb] = __builtin_amdgcn_mfma_f32_16x16x32_bf16(af, bf, acc[nb], 0, 0, 0); }
    }
    ss += __shfl_xor(ss, 16); ss += __shfl_xor(ss, 32);
#pragma unroll
    for (int nb = 0; nb < 4; ++nb)
#pragma unroll
        for (int j = 0; j < 4; ++j) LG[(4 * g + j) * 65 + 16 * nb + r16] = acc[nb][j];
    LDS_WAIT();
    if (lane < 16) {
        const int t = t0 + lane; const float rs = __builtin_amdgcn_rsqf(ss * (1.f / D) + EPS);
        ((float*)(F.ws + WS_RFFN))[t] = rs;
        LAS float* lg = LG + lane * 65; LAS float* bi = BI + lane * 65; const float* rb = F.in[I_RB];
        for (int e = 0; e < NE; ++e) { const float s = fsigmoid(lg[e] * rs); lg[e] = s; bi[e] = s + rb[e]; }
        float gs[8];
#pragma unroll
        for (int gg = 0; gg < 8; ++gg) { float m1 = -__builtin_inff(), m2 = -__builtin_inff();
#pragma unroll
            for (int j = 0; j < 8; ++j) { const float v = bi[8 * gg + j]; if (v > m1) { m2 = m1; m1 = v; } else if (v > m2) m2 = v; }
            gs[gg] = m1 + m2; }
        unsigned gmask = 0u;
#pragma unroll
        for (int gg = 0; gg < 8; ++gg) { int cnt = 0;
#pragma unroll
            for (int g2 = 0; g2 < 8; ++g2) cnt += (gs[g2] > gs[gg] || (gs[g2] == gs[gg] && g2 < gg)) ? 1 : 0;
            if (cnt < 4) gmask |= 1u << gg; }
        int se[8]; float sv[8]; float wsum = 0.f;
#pragma unroll
        for (int k = 0; k < 8; ++k) { float best = -__builtin_inff(); int be = 0;
            for (int e = 0; e < NE; ++e) { const float v = bi[e]; if (((gmask >> (e >> 3)) & 1u) && v > best) { best = v; be = e; } }
            bi[be] = -__builtin_inff(); se[k] = be; sv[k] = lg[be]; wsum += sv[k]; }
        const float inv = 2.5f / wsum;
        int* te = (int*)(F.ws + WS_TOPE) + (size_t)t * 8; float* tw = (float*)(F.ws + WS_TOPW) + (size_t)t * 8;
#pragma unroll
        for (int k = 0; k < 8; ++k) { te[k] = se[k]; tw[k] = sv[k] * inv; (void)__hip_atomic_fetch_add(hist + se[k], 1, __ATOMIC_RELAXED, __HIP_MEMORY_SCOPE_WORKGROUP); }
    }
}
__device__ __forceinline__ void p4_router(Frame& F) {
    LAS int* hist = (LAS int*)(F.lds + RT_OFF);
    for (int v = F.bx; v < 256; v += F.G) {
        if (F.tid < 64) hist[F.tid] = 0;
        __syncthreads();
        router_unit(F, v * 8 + F.wave, hist);
        __syncthreads();
        if (F.tid < 64) ((int*)(F.ws + WS_CNT))[v * 64 + F.tid] = hist[F.tid];
        __syncthreads();
    }
}

__device__ __forceinline__ void p4b_tables(Frame& F) {
    LAS int* L = (LAS int*)(F.lds + RING_OFF);
    LAS int* part_t = L;
    LAS int* part_b = L + 512;
    LAS int* totals = L + 1024;
    LAS int* below = L + 1088;
    LAS int* segst = L + 1152;
    LAS int* wcount = L + 1280;
    LAS int* pe = L + 2048;
    LAS int* rank = L + 3072;
    const int* CNT = (const int*)(F.ws + WS_CNT); const int* TOPE = (const int*)(F.ws + WS_TOPE); const float* TOPW = (const float*)(F.ws + WS_TOPW);
    const float* RFFN = (const float*)(F.ws + WS_RFFN);
    int* RTOK = (int*)(F.ws + WS_RTOK); float* RW = (float*)(F.ws + WS_RW); int* RDST = (int*)(F.ws + WS_RDST); float* RR = (float*)(F.ws + WS_RR); int* TILEE = (int*)(F.ws + WS_TILEE);
    const int tid = F.tid, lane = F.lane, wave = F.wave;
    for (int v = F.bx; v < 256; v += F.G) {
        { const int e = tid & 63, part = tid >> 6; int tot = 0, bel = 0;
          for (int vv = 32 * part; vv < 32 * part + 32; ++vv) { const int c = CNT[vv * 64 + e]; tot += c; bel += (vv < v) ? c : 0; }
          part_t[part * 64 + e] = tot; part_b[part * 64 + e] = bel; }
        for (int i = tid; i < 1024; i += NTHR) pe[i] = TOPE[(size_t)v * 1024 + i];
        __syncthreads();
        if (wave == 0) {
            int tot = 0, bel = 0;
#pragma unroll
            for (int p = 0; p < 8; ++p) { tot += part_t[p * 64 + lane]; bel += part_b[p * 64 + lane]; }
            totals[lane] = tot; below[lane] = bel;
            const int ru = (tot + 255) & ~255; int sc = ru;
#pragma unroll
            for (int o = 1; o < 64; o <<= 1) { const int n = __shfl_up(sc, o); if (lane >= o) sc += n; }
            segst[lane] = sc - ru; if (lane == 63) segst[64] = sc;
        }
        { int cnt = 0;
          for (int j = 0; j < 128; ++j) { const int p = 128 * wave + j; if (pe[p] == lane) { rank[p] = cnt; ++cnt; } }
          wcount[wave * 64 + lane] = cnt; }
        __syncthreads();
        const int SS = segst[64];
        for (int p = tid; p < 1024; p += NTHR) { const int e = pe[p], w = p >> 7; int off = 0;
            for (int w2 = 0; w2 < w; ++w2) off += wcount[w2 * 64 + e];
            const int row = segst[e] + below[e] + off + rank[p]; const int t = 128 * v + (p >> 3), k = p & 7;
            RTOK[row] = t; RW[row] = TOPW[(size_t)t * 8 + k]; RDST[row] = k * T + t; RR[row] = RFFN[t]; }
        if (tid < 128) { const int t = 128 * v + tid, row = SS + t; RTOK[row] = t; RW[row] = 1.f; RDST[row] = 8 * T + t; RR[row] = RFFN[t]; }
        if (v < NE) { const int e = v, tot = totals[e], ru = (tot + 255) & ~255, st = segst[e];
            if (tid < ru - tot) { const int row = st + tot + tid; RTOK[row] = 0; RW[row] = 0.f; RDST[row] = -1; RR[row] = 0.f; }
            if (tid < ru / 256) TILEE[st / 256 + tid] = e; }
        if (v == NE) { if (tid < T / 256) TILEE[SS / 256 + tid] = NE; if (tid == 0) TILEE[MAXTILES] = SS / 256 + T / 256; }
        __syncthreads();
    }
}

template <int MODE> __device__ __forceinline__ int group_setup(Frame& F, int nN) {
    const int* TILEE = (const int*)(F.ws + WS_TILEE);
    const int NT = __builtin_amdgcn_readfirstlane((int)__hip_atomic_load((unsigned*)TILEE + MAXTILES, RLX_AGENT));
    LAS int* te = (LAS int*)(F.lds + TE_OFF); LAS unsigned* rt = (LAS unsigned*)(F.lds + RT_OFF);
    for (int i = F.tid; i < NT && i < MAXTILES; i += NTHR) te[i] = TILEE[i];
    if (MODE == 1) {
        const int* RTOK = (const int*)(F.ws + WS_RTOK);
        for (int ui = F.tid >> 8; ui < RT_UNITS; ui += 2) { int pm, pn; if (!pg8::order_next(ui, F.G, F.bx, NT, nN, pm, pn)) break;
            rt[ui * 256 + (F.tid & 255)] = (unsigned)RTOK[pm * 256 + (F.tid & 255)] * (unsigned)D; }
    }
    __syncthreads();
    return NT;
}

__device__ __forceinline__ void acc_fp8x16(const v4u w, float (&o)[16]) {
#pragma unroll
    for (int q = 0; q < 4; ++q) { const f32x2 lo = __builtin_amdgcn_cvt_pk_f32_fp8((int)w[q], false), hi = __builtin_amdgcn_cvt_pk_f32_fp8((int)w[q], true);
        o[4 * q] += lo.x; o[4 * q + 1] += lo.y; o[4 * q + 2] += hi.x; o[4 * q + 3] += hi.y; }
}
__device__ __forceinline__ void p7_combine(Frame& F, int n) {
    const int gw = F.bx * NWAVES + F.wave, NGW = F.G * NWAVES, lane = F.lane;
    bf16* H = (bf16*)(F.ws + WS_H1B); const unsigned char* S0 = (const unsigned char*)F.out; const unsigned char* S1 = F.ws + WS_SLOT47; const unsigned char* S8 = F.ws + WS_SLOT8;
    float* ssq2 = (float*)(F.ws + WS_SSQ2);
    for (int t = gw; t < T; t += NGW) {
        float ss = 0.f;
#pragma unroll
        for (int ch = 0; ch < 2; ++ch) {
            const int co = 1024 * ch + 16 * lane;
            bf16* hp = H + (size_t)t * D + co;
            const v4u h0 = *(const GAS v4u*)hp, h1 = *(const GAS v4u*)(hp + 8);
            v4u w[9];
#pragma unroll
            for (int k = 0; k < 4; ++k) { w[k] = *(const GAS v4u*)(S0 + ((size_t)k * T + t) * D + co); w[4 + k] = *(const GAS v4u*)(S1 + ((size_t)k * T + t) * D + co); }
            w[8] = *(const GAS v4u*)(S8 + (size_t)t * D + co);
            float o[16];
#pragma unroll
            for (int i = 0; i < 16; ++i) o[i] = 0.f;
#pragma unroll
            for (int k = 0; k < 9; ++k) acc_fp8x16(w[k], o);
            f32x4 a0, a1, a2, a3; pg8::unpack8(h0, a0, a1); pg8::unpack8(h1, a2, a3);
#pragma unroll
            for (int j = 0; j < 4; ++j) { a0[j] += o[j] * (1.f / SLOT_SCALE); a1[j] += o[4 + j] * (1.f / SLOT_SCALE); a2[j] += o[8 + j] * (1.f / SLOT_SCALE); a3[j] += o[12 + j] * (1.f / SLOT_SCALE);
                ss += (a0[j] * a0[j] + a1[j] * a1[j]) + (a2[j] * a2[j] + a3[j] * a3[j]); }
            *(GAS v4u*)hp = pg8::pack8_bf16(a0, a1); *(GAS v4u*)(hp + 8) = pg8::pack8_bf16(a2, a3);
        }
        ss = wave_sum(ss);
        if (lane == 0) ssq2[t] = ss;
    }
}

__device__ __forceinline__ void p9_final(Frame& F, const bf16* H, const float* ssq, int nparts) {
    const int gw = F.bx * NWAVES + F.wave, NGW = F.G * NWAVES, lane = F.lane; const float* g = F.in[I_NFIN];
    for (int t = gw; t < T; t += NGW) {
        v4u w[4];
#pragma unroll
        for (int j = 0; j < 4; ++j) w[j] = *(const GAS v4u*)(H + (size_t)t * D + 512 * j + 8 * lane);
        float ss = 0.f;
        if (nparts > 0) { if (lane < nparts) ss = ssq[(size_t)lane * T + t]; }
        else {
#pragma unroll
            for (int j = 0; j < 4; ++j)
#pragma unroll
                for (int q = 0; q < 4; ++q) { const float lo = bflo(w[j][q]), hi = bfhi(w[j][q]); ss += lo * lo + hi * hi; }
        }
        const float r = __builtin_amdgcn_rsqf(wave_sum(ss) * (1.f / D) + EPS);
        float* o = F.out + (size_t)t * D;
#pragma unroll
        for (int j = 0; j < 4; ++j) { const int c = 512 * j + 8 * lane; const f32x4 g0 = *(const GAS f32x4*)(g + c), g1 = *(const GAS f32x4*)(g + c + 4);
            f32x4 a, b; a.x = bflo(w[j][0]) * r * g0.x; a.y = bfhi(w[j][0]) * r * g0.y; a.z = bflo(w[j][1]) * r * g0.z; a.w = bfhi(w[j][1]) * r * g0.w;
            b.x = bflo(w[j][2]) * r * g1.x; b.y = bfhi(w[j][2]) * r * g1.y; b.z = bflo(w[j][3]) * r * g1.z; b.w = bfhi(w[j][3]) * r * g1.w;
            *(GAS f32x4*)(o + c) = a; *(GAS f32x4*)(o + c + 4) = b; }
    }
}

struct Args { const float* in[21]; float* out; unsigned char* ws; int ph_lo, ph_hi, fin_mode, li; };
__global__ void __launch_bounds__(NTHR, 2) mk_fwd(Args args) {
    extern __shared__ __attribute__((aligned(16))) unsigned char lds[];
    Frame F;
    F.lds = (LAS unsigned char*)lds;
    F.tid = threadIdx.x; F.lane = F.tid & 63; F.wave = __builtin_amdgcn_readfirstlane(F.tid >> 6);
    F.G = gridDim.x; F.bx = blockIdx.x; F.ws = args.ws; F.out = args.out;
#pragma unroll
    for (int i = 0; i < 21; ++i) F.in[i] = args.in[i];
    volatile LAS unsigned* MISC = (volatile LAS unsigned*)(F.lds + MISC_OFF);
    if (F.tid < 32) MISC[F.tid] = 0u;
    __syncthreads();
    XcdBarrier bar = xcd_barrier_post((unsigned*)(F.ws + WS_CTL) + CW_BAR + args.li * XCD_BAR_WORDS, MISC + 8);
    unsigned char* ws = F.ws;
    const int lo = args.ph_lo, hi = args.ph_hi;
    LAS unsigned char* ring = F.lds + RING_OFF;
#define PHASE(k) if (lo <= (k) && (k) < hi)
#define PH(k) PHASE(k) { RELANE();
#define GRID_BAR() xcd_barrier(bar)
#define RELANE() do { int _t = threadIdx.x; asm volatile("" : "+v"(_t)); F.tid = _t; F.lane = _t & 63; F.wave = __builtin_amdgcn_readfirstlane(_t >> 6); } while (0)

    PHASE(0) { RELANE(); p0_prologue(F); GRID_BAR(); }
    PHASE(1) { RELANE();
        pg8::DenseSched S{T / 256, NPROJ / 256, F.G, F.bx, D * 2, (const char*)(ws + WS_WIN)};
        pg8::EpiBf16Scale E{(bf16*)(ws + WS_PROJ), NPROJ, (const float*)(ws + WS_RMIX)};
        pg8::gemm_phase<false, 1>(F.tid, ring, (const char*)F.out, D * 2, S, E);
        GRID_BAR();
    }
    PHASE(2) { RELANE(); p2_mixer(F); GRID_BAR(); }
    PHASE(3) { RELANE();
        pg8::DenseSched S{T / 256, D / 256, F.G, F.bx, D * 2, (const char*)(ws + WS_WOUT)};
        pg8::EpiResF32 E{(bf16*)(ws + WS_H1B), (const bf16*)F.out, D, ws + WS_H1F8};
        pg8::gemm_phase<false, 1>(F.tid, ring, (const char*)((bf16*)F.out + (size_t)T * D), D * 2, S, E);
        GRID_BAR();
    }
    PHASE(4) { RELANE(); p4_router(F); GRID_BAR(); }
    PHASE(5) { RELANE(); p4b_tables(F); GRID_BAR(); }
    PHASE(6) { RELANE();
        const int NT = group_setup<1>(F, 4);
        pg8::GroupSched<1> S{NT, 4, F.G, F.bx, D, 0, (const char*)(ws + WS_WGU), (size_t)1024 * D, (const LAS int*)(F.lds + TE_OFF), (const LAS unsigned*)(F.lds + RT_OFF)};
        pg8::EpiGateUp E{ws + WS_HPERM, (const float*)(ws + WS_RR)};
        pg8::gemm_phase<true, 0>(F.tid, ring, (const char*)(ws + WS_H1F8), D, S, E, 0x79797979, 0x7f7f7f7f);
        GRID_BAR();
    }
    {
        for (int n = 0; n < NSLICE; ++n) {
            PHASE(7 + 2 * n) { RELANE();
            const int NT = group_setup<2>(F, SLW / 256);
            pg8::GroupSched<2> S{NT, SLW / 256, F.G, F.bx, ED, (SLW / 256) * n, (const char*)(ws + WS_WDN), (size_t)D * ED, (const LAS int*)(F.lds + TE_OFF), (const LAS unsigned*)(F.lds + RT_OFF)};
            pg8::EpiDown E{(unsigned char*)F.out, ws + WS_SLOT47, ws + WS_SLOT8, (const float*)(ws + WS_RW), (const int*)(ws + WS_RDST)};
            pg8::gemm_phase<true, 0>(F.tid, ring, (const char*)(ws + WS_HPERM), ED, S, E, 0x79797979, 0x7f7f7f7f);
            GRID_BAR();
            }
            PHASE(8 + 2 * n) { RELANE();
            p7_combine(F, n);
            GRID_BAR();
            }
        }
    }
    PHASE(15) { RELANE();
        pg8::DenseSched S{T / 256, D / 256, F.G, F.bx, PLE * 2, (const char*)(ws + WS_WPP)};
        pg8::EpiBf16Scale E{(bf16*)(ws + WS_PP), D, nullptr};
        pg8::gemm_phase<false, 1>(F.tid, ring, (const char*)(ws + WS_PB), PLE * 2, S, E);
        GRID_BAR();
    }
    PHASE(16) { RELANE();
        pg8::DenseSched S{T / 256, D / 256, F.G, F.bx, D * 2, (const char*)(ws + WS_WPG)};
        pg8::EpiPle E{(bf16*)(ws + WS_H3), (const bf16*)(ws + WS_H1B), (const bf16*)(ws + WS_PP), (const float*)(ws + WS_SSQ2), (float*)(ws + WS_SSQ3)};
        pg8::gemm_phase<false, 1>(F.tid, ring, (const char*)(ws + WS_H1B), D * 2, S, E);
        GRID_BAR();
    }
    PHASE(17) { RELANE();
    if (args.fin_mode == 0) p9_final(F, (const bf16*)(ws + WS_H3), (const float*)(ws + WS_SSQ3), 32);
    else p9_final(F, (const bf16*)(ws + WS_H1B), nullptr, 0);
    }
}

extern "C" void kernel_launch(void* const* d_in, const int* in_sizes, int n_in, void* d_out, int out_size, void* d_ws, size_t ws_size, hipStream_t stream) {
    static int grid = 0;
    if (grid == 0) {
        int dev = 0, cus = 0;
        if (n_in != 21 || ws_size < WS_END) { fprintf(stderr, "kernel_launch: n_in %d ws %zu (need %zu)\n", n_in, ws_size, (size_t)WS_END); grid = -1; return; }
        if (hipGetDevice(&dev) != hipSuccess || hipDeviceGetAttribute(&cus, hipDeviceAttributeMultiprocessorCount, dev) != hipSuccess) { grid = -1; return; }
        if (hipFuncSetAttribute((const void*)mk_fwd, hipFuncAttributeMaxDynamicSharedMemorySize, LDS_BYTES) != hipSuccess) { fprintf(stderr, "hipFuncSetAttribute failed\n"); grid = -1; return; }
        int per_cu = 0;
        (void)hipOccupancyMaxActiveBlocksPerMultiprocessor(&per_cu, (const void*)mk_fwd, NTHR, LDS_BYTES);
        (void)hipGetLastError();
        grid = cus > 256 ? 256 : cus;
    }
    if (grid < 0) return;
    (void)hipMemsetAsync((char*)d_ws + WS_CTL, 0, CTL_ZERO_BYTES, stream);
    Args a{};
    for (int i = 0; i < 21; ++i) a.in[i] = (const float*)d_in[i];
    a.out = (float*)d_out; a.ws = (unsigned char*)d_ws; a.fin_mode = FIN_MODE;
#if PROBE_K >= 0
    a.ph_lo = 0; a.ph_hi = PROBE_K + 1; a.li = 0;
    hipLaunchKernelGGL(mk_fwd, dim3(grid), dim3(NTHR), LDS_BYTES, stream, a);
    a.ph_lo = PROBE_K; a.ph_hi = PH_HI; a.li = 1;
    hipLaunchKernelGGL(mk_fwd, dim3(grid), dim3(NTHR), LDS_BYTES, stream, a);
#else
    a.ph_lo = 0; a.ph_hi = PH_HI; a.li = 0;
    hipLaunchKernelGGL(mk_fwd, dim3(grid), dim3(NTHR), LDS_BYTES, stream, a);
#endif
}
```

```cpp
#include <hip/hip_runtime.h>
#include <cstdio>
#ifndef PROBE_K
#define PROBE_K -1
#endif
#ifndef PH_HI
#define PH_HI 100
#endif
#ifndef FIN_MODE
#define FIN_MODE 0
#endif

#define GAS __attribute__((address_space(1)))
#define LAS __attribute__((address_space(3)))
typedef unsigned short bf16;
typedef unsigned v4u __attribute__((ext_vector_type(4)));
typedef unsigned v2u __attribute__((ext_vector_type(2)));
typedef float f32x4 __attribute__((ext_vector_type(4)));
typedef float f32x2 __attribute__((ext_vector_type(2)));
typedef float f32x16 __attribute__((ext_vector_type(16)));
typedef short bf16x8 __attribute__((ext_vector_type(8)));
typedef short s16x4 __attribute__((ext_vector_type(4)));
typedef GAS unsigned gu32;
#define RLX_AGENT __ATOMIC_RELAXED, __HIP_MEMORY_SCOPE_AGENT
#define LDS_WAIT() asm volatile("s_waitcnt lgkmcnt(0)" ::: "memory")
#define VM_WAIT() asm volatile("s_waitcnt vmcnt(0)" ::: "memory")

constexpr int NB = 8, SEQ = 4096, T = NB * SEQ, D = 2048, NPROJ = 6144, CW = 1024, HD = 128, NH = 8;
constexpr int PLE = 256, NE = 64, ED = 512, TOPK = 8, NSLOT = 9;
constexpr float EPS = 1e-6f;
constexpr int NWAVES = 8, NTHR = 512;
constexpr int MAXTILES = 1216;
constexpr int MAXROWS = MAXTILES * 256;
constexpr int NSLICE = 1, SLW = D / NSLICE;
constexpr float SLOT_SCALE = 16.f;

constexpr size_t MiB = 1u << 20;
constexpr size_t WS_CTL = 0, CTL_ZERO_BYTES = 1 * MiB;
constexpr size_t WS_RMIX = 1 * MiB;
constexpr size_t WS_RFFN = WS_RMIX + 128 * 1024;
constexpr size_t WS_SSQ2 = WS_RFFN + 128 * 1024;
constexpr size_t WS_SSQ3 = WS_SSQ2 + 512 * 1024;
constexpr size_t WS_TOPE = WS_SSQ3 + 4 * MiB;
constexpr size_t WS_TOPW = WS_TOPE + 1 * MiB;
constexpr size_t WS_CNT  = WS_TOPW + 1 * MiB;
constexpr size_t WS_RTOK = WS_CNT + 64 * 1024;
constexpr size_t WS_RW   = WS_RTOK + 1280 * 1024;
constexpr size_t WS_RDST = WS_RW + 1280 * 1024;
constexpr size_t WS_RR   = WS_RDST + 1280 * 1024;
constexpr size_t WS_TILEE = WS_RR + 1280 * 1024;
constexpr size_t WS_WR   = 16 * MiB;
constexpr size_t WS_WIN  = 17 * MiB;
constexpr size_t WS_WOUT = WS_WIN + 24 * MiB;
constexpr size_t WS_WGU  = WS_WOUT + 8 * MiB;
constexpr size_t WS_WDN  = WS_WGU + 130 * MiB;
constexpr size_t WS_WPG  = WS_WDN + 65 * MiB;
constexpr size_t WS_WPP  = WS_WPG + 8 * MiB;
constexpr size_t WS_PB   = WS_WPP + 1 * MiB;
constexpr size_t WS_H1B  = WS_PB + 16 * MiB;
constexpr size_t WS_H1F8 = WS_H1B + 128 * MiB;
constexpr size_t WS_OVL  = WS_H1F8 + 64 * MiB;
constexpr size_t WS_PROJ = WS_OVL;
constexpr size_t WS_HPERM = WS_OVL;
constexpr size_t WS_SLOT8 = WS_OVL + 304 * MiB;
constexpr size_t WS_PP   = WS_OVL;
constexpr size_t WS_H3   = WS_OVL + 128 * MiB;
constexpr size_t WS_SLOT47 = WS_OVL + 384 * MiB;
constexpr size_t WS_END  = WS_SLOT47 + 256 * MiB;
constexpr int CW_BAR = 4096;

constexpr int RING_OFF = 0, RING_BYTES = 131072;
constexpr int RT_OFF = 131072, RT_UNITS = 20, RT_BYTES = RT_UNITS * 1024;
constexpr int TE_OFF = RT_OFF + RT_BYTES, TE_BYTES = 4864 + 128;
constexpr int MISC_OFF = TE_OFF + TE_BYTES;
constexpr int LDS_BYTES = MISC_OFF + 128;
static_assert(LDS_BYTES <= 163840, "LDS");

__device__ __forceinline__ unsigned f2bf(float f) { unsigned u = __builtin_bit_cast(unsigned, f); return (u + 0x7fffu + ((u >> 16) & 1u)) >> 16; }
__device__ __forceinline__ unsigned pk2(float lo, float hi) { return f2bf(lo) | (f2bf(hi) << 16); }
__device__ __forceinline__ float bflo(unsigned w) { return __builtin_bit_cast(float, w << 16); }
__device__ __forceinline__ float bfhi(unsigned w) { return __builtin_bit_cast(float, w & 0xffff0000u); }
__device__ __forceinline__ float wave_sum(float v) {
#pragma unroll
    for (int o = 1; o < 64; o <<= 1) v += __shfl_xor(v, o);
    return v;
}
__device__ __forceinline__ float fsigmoid(float v) { return __builtin_amdgcn_rcpf(1.f + __builtin_amdgcn_exp2f(-1.4426950409f * v)); }

#define XB_TMO      128
#define XB_XCNT(j)  (256  + 64 * (j))
#define XB_XSUB(j)  (1280 + 64 * (j))
#define XB_XGEN(j)  (2304 + 64 * (j))
#define XB_TOP      3328
#define XB_TOPGEN   3392
#define XCD_BAR_WORDS 3456
#define XB_SPIN_CAP (1u << 18)
__device__ __forceinline__ unsigned xb_ld(unsigned* p)              { return __hip_atomic_load(p, __ATOMIC_RELAXED, __HIP_MEMORY_SCOPE_AGENT); }
__device__ __forceinline__ unsigned xb_add(unsigned* p, unsigned v) { return __hip_atomic_fetch_add(p, v, __ATOMIC_RELAXED, __HIP_MEMORY_SCOPE_AGENT); }
__device__ __forceinline__ unsigned xb_xcc_id() { return (unsigned)__builtin_amdgcn_s_getreg((3 << 11) | 20) & 0xFu; }
#define XB_SPIN(cond, bar) do { unsigned _sp = 0; while (cond) { __builtin_amdgcn_s_sleep(1); \
    if ((++_sp & 255u) == 0u) { if (xb_ld(&(bar)[XB_TMO])) break; if (_sp > XB_SPIN_CAP) { atomicAdd(&(bar)[XB_TMO], 1u); break; } } } } while (0)
struct XcdBarrier { unsigned* bar; unsigned x; volatile LAS unsigned* st; };
__device__ __forceinline__ XcdBarrier xcd_barrier_post(unsigned* bar, volatile LAS unsigned* st) {
    XcdBarrier b; b.bar = bar; b.x = xb_xcc_id(); b.st = st;
    if (threadIdx.x == 0) (void)xb_add(&bar[XB_XCNT(b.x)], 1u);
    return b;
}
__device__ __forceinline__ void xcd_barrier_complete(unsigned* bar, unsigned x, unsigned& nloc, unsigned& nx) {
    const unsigned G = gridDim.x * gridDim.y * gridDim.z;
    unsigned sum, cnt, mine, sp = 0u;
    for (;;) {
        sum = 0u; cnt = 0u; mine = 0u;
#pragma unroll
        for (unsigned j = 0; j < 16; ++j) { const unsigned c = xb_ld(&bar[XB_XCNT(j)]); sum += c; cnt += (c > 0u) ? 1u : 0u; mine = (j == x) ? c : mine; }
        if (sum == G) break;
        __builtin_amdgcn_s_sleep(1);
        if ((++sp & 255u) == 0u) { if (xb_ld(&bar[XB_TMO])) break; if (sp > XB_SPIN_CAP) { atomicAdd(&bar[XB_TMO], 1u); break; } }
    }
    nloc = mine > 0u ? mine : 1u; nx = cnt > 0u ? cnt : 1u;
}
__device__ __forceinline__ void xcd_barrier(const XcdBarrier& b) {
    asm volatile("s_waitcnt vmcnt(0)" ::: "memory");
    __syncthreads();
    if (threadIdx.x == 0) {
        unsigned* bar = b.bar;
        __builtin_amdgcn_s_waitcnt(0);
        unsigned nloc = b.st[0], nx = b.st[1];
        if (nloc == 0u) { xcd_barrier_complete(bar, b.x, nloc, nx); b.st[0] = nloc; b.st[1] = nx; }
        const unsigned old = xb_add(&bar[XB_XSUB(b.x)], 1u);
        const unsigned gen = old / nloc;
        if (old + 1u == (gen + 1u) * nloc) {
            __builtin_amdgcn_fence(__ATOMIC_RELEASE, "agent");
            asm volatile("s_waitcnt vmcnt(0)" ::: "memory");
            const unsigned og = xb_add(&bar[XB_TOP], 1u);
            const unsigned tg = og / nx;
            if (og + 1u == (tg + 1u) * nx) xb_add(&bar[XB_TOPGEN], 1u);
            else XB_SPIN(xb_ld(&bar[XB_TOPGEN]) == tg, bar);
            __builtin_amdgcn_fence(__ATOMIC_ACQUIRE, "agent");
            xb_add(&bar[XB_XGEN(b.x)], 1u);
            asm volatile("s_waitcnt vmcnt(0)" ::: "memory");
        } else {
            XB_SPIN(xb_ld(&bar[XB_XGEN(b.x)]) == gen, bar);
            __builtin_amdgcn_fence(__ATOMIC_ACQUIRE, "agent");
            asm volatile("s_waitcnt vmcnt(0)" ::: "memory");
        }
    }
    __syncthreads();
}

namespace pg8 {
constexpr int BM = 256, BK = 64, HALF = 128, HTB = HALF * BK * 2, STAGE_BYTES = 8 * HTB, NXCD = 8, WGM = 8;
__device__ __forceinline__ int lds_byte(int r, int c) { const int st = (r >> 4) * 2 + (c >> 5), rr = r & 15, cc = c & 31, ob = rr * 64 + cc * 2; return st * 1024 + (ob ^ (((ob >> 9) & 1) << 5)); }
__device__ __forceinline__ void stage_rc(int b, int& R, int& C) { const int st = b / 1024, sb = b % 1024, swz = sb ^ (((sb >> 9) & 1) << 5); R = (st >> 1) * 16 + swz / 64; C = (st & 1) * 32 + (swz % 64) / 2; }
__device__ __forceinline__ int brow(int R) { return 64 * (R >> 5) + 16 * ((R & 15) >> 2) + 4 * ((R >> 4) & 1) + (R & 3); }
__device__ __forceinline__ int brow1(int R) { return 64 * (R >> 5) + 8 * ((R & 15) >> 2) + 4 * ((R >> 4) & 1) + (R & 3); }

struct Unit { int pm, pn, e; };

__device__ __forceinline__ bool order_next(int i, int G, int c, int nM, int nN, int& pm, int& pn) {
    const int nwg = nM * nN; const long L = (long)i * G + c; if (L >= nwg) return false;
    int wgid = (int)L; { const int q = nwg / NXCD, r = nwg % NXCD, xcd = wgid % NXCD, off = wgid / NXCD; wgid = (xcd < r ? xcd * (q + 1) : r * (q + 1) + (xcd - r) * q) + off; }
    const int nig = WGM * nN, gid = wgid / nig, fm = gid * WGM, gsz = (nM - fm) < WGM ? (nM - fm) : WGM;
    pm = fm + ((wgid % nig) % gsz); pn = (wgid % nig) / gsz; return true;
}

struct DenseSched {
    static constexpr bool GATHER = false;
    int nM, nN, G, c, KB; const char* Bt;
    __device__ __forceinline__ bool next(int i, Unit& u) const { u.e = 0; return order_next(i, G, c, nM, nN, u.pm, u.pn); }
    __device__ __forceinline__ const char* bbase(const Unit& u) const { return Bt + (size_t)u.pn * BM * KB; }
    __device__ __forceinline__ const char* abase(const char* A, const Unit& u) const { return A + (size_t)u.pm * BM * KB; }
    __device__ __forceinline__ void aoffs(int ui, const Unit& u, int tid, unsigned (&ao)[2][2]) const {}
};
struct DenseSchedG {
    static constexpr bool GATHER = true;
    int nM, nN, G, c, KB; const char* Bt;
    __device__ __forceinline__ bool next(int i, Unit& u) const { u.e = 0; return order_next(i, G, c, nM, nN, u.pm, u.pn); }
    __device__ __forceinline__ const char* bbase(const Unit& u) const { return Bt + (size_t)u.pn * BM * KB; }
    __device__ __forceinline__ const char* abase(const char* A, const Unit& u) const { return A; }
    __device__ __forceinline__ void aoffs(int ui, const Unit& u, int tid, unsigned (&ao)[2][2]) const {
        asm volatile("" : "+v"(tid));
#pragma unroll
        for (int i = 0; i < 2; ++i) { int R, C; stage_rc(tid * 16 + i * 8192, R, C);
#pragma unroll
            for (int h = 0; h < 2; ++h) ao[h][i] = (unsigned)(u.pm * BM + h * HALF + R) * (unsigned)KB + (unsigned)C * 2u; }
    }
};
template <int MODE> struct GroupSched {
    static constexpr bool GATHER = true;
    int nM, nN, G, c, KB, pn0; const char* Bt; size_t estride; const LAS int* te; const LAS unsigned* rt;
    __device__ __forceinline__ bool next(int i, Unit& u) const { if (!order_next(i, G, c, nM, nN, u.pm, u.pn)) return false; u.e = __builtin_amdgcn_readfirstlane(te[u.pm]); return true; }
    __device__ __forceinline__ const char* bbase(const Unit& u) const { return Bt + (size_t)u.e * estride + (size_t)(pn0 + u.pn) * BM * KB; }
    __device__ __forceinline__ void aoffs(int ui, const Unit& u, int tid, unsigned (&ao)[2][2]) const {
        asm volatile("" : "+v"(tid));
#pragma unroll
        for (int i = 0; i < 2; ++i) { int R, C; stage_rc(tid * 16 + i * 8192, R, C);
#pragma unroll
            for (int h = 0; h < 2; ++h) { if (MODE == 1) ao[h][i] = rt[ui * 256 + h * HALF + R] + (unsigned)C * 2u; else ao[h][i] = (unsigned)(u.pm * BM + h * HALF + R) * (unsigned)KB + (unsigned)C * 2u; } }
    }
    __device__ __forceinline__ const char* abase(const char* A, const Unit& u) const { return A; }
};

__device__ __forceinline__ unsigned cvt_pk_bf16(float lo, float hi) { unsigned r; asm volatile("v_cvt_pk_bf16_f32 %0, %1, %2" : "=v"(r) : "v"(lo), "v"(hi)); return r; }

typedef int v8i __attribute__((ext_vector_type(8)));
typedef int v4i __attribute__((ext_vector_type(4)));
union Frag { v8i v; struct { v4i lo, hi; }; };
template <bool F8, int LAY, class Epi, class Sched>
__device__ __forceinline__ void gemm_phase(const int tid, LAS unsigned char* lds, const char* Abase, const int KB, const Sched& S, const Epi& E, const int sw = 0x7f7f7f7f, const int sa = 0x7f7f7f7f) {
    const int wid = __builtin_amdgcn_readfirstlane(tid >> 6), lane = tid & 63, wr = wid >> 2, wc = wid & 3, fr = lane & 15, fq = lane >> 4;
    const int nt = KB / 128;
    constexpr bool GA = Sched::GATHER;
    unsigned voffB[2], voffA[2];
#pragma unroll
    for (int i = 0; i < 2; ++i) { int R, C; stage_rc(tid * 16 + i * 8192, R, C); const int Rb = LAY ? brow1(R) : brow(R); voffB[i] = (unsigned)Rb * (unsigned)KB + (unsigned)C * 2u; voffA[i] = (unsigned)R * (unsigned)KB + (unsigned)C * 2u; }
    const size_t kstep = (size_t)(BK * 2);
    const size_t hstep = (size_t)HALF * KB;
    const size_t hstepB = (size_t)(LAY ? 32 : 8) * KB;
    const unsigned ldsw = (unsigned)wid * 1024u;
    const int aoff = lds_byte(wr * 64 + fr, fq * 8), boff = lds_byte(wc * 32 + fr, fq * 8);
#define PG8_SA(b, h) (((b) * 2 + (h)) * HTB)
#define PG8_SB(b, h) ((4 + (b) * 2 + (h)) * HTB)
#define PG8_STAGE(bufoff, gbase, voff) do { _Pragma("unroll") for (int _i = 0; _i < 2; ++_i) \
        __builtin_amdgcn_global_load_lds((const unsigned*)((const char*)(gbase) + (voff)[_i]), (LAS unsigned*)(lds + (bufoff) + ldsw + _i * 8192), 16, 0, 0); } while (0)
#define PG8_STAGEA(bufoff, gbase, half) do { if constexpr (GA) { PG8_STAGE(bufoff, gbase, ca[half]); } else { PG8_STAGE(bufoff, (gbase) + (half) * hstep, voffA); } } while (0)
#define PG8_LD1(dst, off) do { const v4i _lo = *(const LAS v4i*)(lds + (off)), _hi = *(const LAS v4i*)(lds + (off) + 1024); dst.lo = _lo; dst.hi = _hi; } while (0)
#define PG8_LDA(dst, b, h) do { _Pragma("unroll") for (int m = 0; m < 4; ++m) PG8_LD1(dst[m], PG8_SA(b, h) + aoff + m * 2048); } while (0)
#define PG8_LDB(dst, b, h) do { _Pragma("unroll") for (int n = 0; n < 2; ++n) PG8_LD1(dst[n], PG8_SB(b, h) + boff + n * 2048); } while (0)
#define PG8_MMA(ai, bj, At, Bt) do { __builtin_amdgcn_s_setprio(1); _Pragma("unroll") for (int m = 0; m < 4; ++m) _Pragma("unroll") for (int n = 0; n < 2; ++n) { \
        if constexpr (F8) { acc[ai][bj][m][n] = __builtin_amdgcn_mfma_scale_f32_16x16x128_f8f6f4(Bt[n].v, At[m].v, acc[ai][bj][m][n], 0, 0, 0, sw, 0, sa); } \
        else { acc[ai][bj][m][n] = __builtin_amdgcn_mfma_f32_16x16x32_bf16(__builtin_bit_cast(bf16x8, Bt[n].lo), __builtin_bit_cast(bf16x8, At[m].lo), acc[ai][bj][m][n], 0, 0, 0); \
               acc[ai][bj][m][n] = __builtin_amdgcn_mfma_f32_16x16x32_bf16(__builtin_bit_cast(bf16x8, Bt[n].hi), __builtin_bit_cast(bf16x8, At[m].hi), acc[ai][bj][m][n], 0, 0, 0); } } \
        __builtin_amdgcn_s_setprio(0); } while (0)
#define PG8_WAIT_V(n) asm volatile("s_waitcnt vmcnt(" #n ")" ::: "memory")
#define PG8_WAIT_L(n) asm volatile("s_waitcnt lgkmcnt(" #n ")" ::: "memory")
#define PG8_BAR __builtin_amdgcn_s_barrier()
#define PG8_SCHED __builtin_amdgcn_sched_barrier(0)
    Unit cur, nxt; int ui = 0;
    if (!S.next(0, cur)) return;
    f32x4 acc[2][2][4][2];
#pragma unroll
    for (int a = 0; a < 2; ++a)
#pragma unroll
        for (int b = 0; b < 2; ++b)
#pragma unroll
            for (int m = 0; m < 4; ++m)
#pragma unroll
                for (int n = 0; n < 2; ++n) acc[a][b][m][n] = (f32x4){0.f, 0.f, 0.f, 0.f};
    Frag At[4], B0[2], B1[2];
    unsigned ca[2][2], na[2][2];
    if constexpr (GA) S.aoffs(0, cur, tid, ca);
    const char* cB = S.bbase(cur); const char* cA = S.abase(Abase, cur);
    PG8_STAGE(PG8_SB(0, 0), cB, voffB); PG8_STAGEA(PG8_SA(0, 0), cA, 0); PG8_STAGE(PG8_SB(0, 1), cB + hstepB, voffB); PG8_STAGEA(PG8_SA(0, 1), cA, 1);
    if (wr == 1) PG8_BAR;
    PG8_WAIT_V(4); PG8_BAR;
    PG8_STAGE(PG8_SB(1, 0), cB + kstep, voffB); PG8_STAGEA(PG8_SA(1, 0), cA + kstep, 0); PG8_STAGE(PG8_SB(1, 1), cB + hstepB + kstep, voffB);
    PG8_WAIT_V(6); PG8_BAR;
    for (;;) {
        const bool has_next = S.next(ui + 1, nxt);
        const char* nB = has_next ? S.bbase(nxt) : cB; const char* nA = has_next ? S.abase(Abase, nxt) : cA;
        if constexpr (GA) {
            if (has_next) S.aoffs(ui + 1, nxt, tid, na);
            else {
#pragma unroll
                for (int h = 0; h < 2; ++h)
#pragma unroll
                    for (int i = 0; i < 2; ++i) na[h][i] = ca[h][i];
            }
        }
#pragma nounroll
        for (int t = 0; t < nt; t += 2) {
            const bool last = (t == nt - 2);
            const char* a1 = cA + (size_t)(t + 1) * kstep;
            const char* a2 = last ? nA : cA + (size_t)(t + 2) * kstep; const char* b2 = last ? nB : cB + (size_t)(t + 2) * kstep;
            const char* a3 = a2 + kstep; const char* b3 = b2 + kstep;
            PG8_LDB(B0, 0, 0); PG8_SCHED; PG8_LDA(At, 0, 0); PG8_STAGEA(PG8_SA(1, 1), a1, 1);
            PG8_WAIT_L(8); PG8_BAR; PG8_WAIT_L(0); PG8_MMA(0, 0, At, B0); PG8_BAR; PG8_SCHED;
            if constexpr (GA) { if (last) {
#pragma unroll
                for (int h = 0; h < 2; ++h)
#pragma unroll
                    for (int i = 0; i < 2; ++i) ca[h][i] = na[h][i];
            } }
            PG8_LDB(B1, 0, 1); PG8_STAGE(PG8_SB(0, 0), b2, voffB);
            PG8_BAR; PG8_WAIT_L(0); PG8_MMA(0, 1, At, B1); PG8_BAR;
            PG8_LDA(At, 0, 1); PG8_STAGEA(PG8_SA(0, 0), a2, 0);
            PG8_BAR; PG8_WAIT_L(0); PG8_MMA(1, 0, At, B0); PG8_BAR; PG8_SCHED;
            PG8_STAGE(PG8_SB(0, 1), b2 + hstepB, voffB);
            PG8_WAIT_V(6); PG8_BAR; PG8_MMA(1, 1, At, B1); PG8_BAR;
            PG8_LDB(B0, 1, 0); PG8_SCHED; PG8_LDA(At, 1, 0); PG8_STAGEA(PG8_SA(0, 1), a2, 1);
            PG8_WAIT_L(8); PG8_BAR; PG8_WAIT_L(0); PG8_MMA(0, 0, At, B0); PG8_BAR; PG8_SCHED;
            PG8_LDB(B1, 1, 1); PG8_STAGE(PG8_SB(1, 0), b3, voffB);
            PG8_BAR; PG8_WAIT_L(0); PG8_MMA(0, 1, At, B1); PG8_BAR;
            PG8_LDA(At, 1, 1); PG8_STAGEA(PG8_SA(1, 0), a3, 0);
            PG8_BAR; PG8_WAIT_L(0); PG8_MMA(1, 0, At, B0); PG8_BAR; PG8_SCHED;
            PG8_STAGE(PG8_SB(1, 1), b3 + hstepB, voffB);
            PG8_WAIT_V(6); PG8_BAR; PG8_MMA(1, 1, At, B1); PG8_BAR;
        }
        { int tz = tid; asm volatile("" : "+v"(tz)); const int l2 = tz & 63; E(acc, cur, wr, wc, l2 & 15, l2 >> 4); }
        if (!has_next) break;
#pragma unroll
        for (int a = 0; a < 2; ++a)
#pragma unroll
            for (int b = 0; b < 2; ++b)
#pragma unroll
                for (int m = 0; m < 4; ++m)
#pragma unroll
                    for (int n = 0; n < 2; ++n) acc[a][b][m][n] = (f32x4){0.f, 0.f, 0.f, 0.f};
        cur = nxt; cB = nB; cA = nA; ++ui;
    }
    PG8_WAIT_V(0);
    if (wr == 0) PG8_BAR;
    PG8_BAR;
#undef PG8_SA
#undef PG8_SB
#undef PG8_STAGE
#undef PG8_STAGEA
#undef PG8_LD1
#undef PG8_LDA
#undef PG8_LDB
#undef PG8_MMA
#undef PG8_WAIT_V
#undef PG8_WAIT_L
#undef PG8_BAR
#undef PG8_SCHED
}

__device__ __forceinline__ unsigned cvt4_fp8(float a, float b, float c, float d) { int w = 0; w = __builtin_amdgcn_cvt_pk_fp8_f32(a, b, w, false); w = __builtin_amdgcn_cvt_pk_fp8_f32(c, d, w, true); return (unsigned)w; }
__device__ __forceinline__ v4u pack8_bf16(const f32x4 a, const f32x4 b) { v4u w; w.x = cvt_pk_bf16(a[0], a[1]); w.y = cvt_pk_bf16(a[2], a[3]); w.z = cvt_pk_bf16(b[0], b[1]); w.w = cvt_pk_bf16(b[2], b[3]); return w; }
__device__ __forceinline__ void unpack8(const v4u w, f32x4& a, f32x4& b) { a = (f32x4){bflo(w[0]), bfhi(w[0]), bflo(w[1]), bfhi(w[1])}; b = (f32x4){bflo(w[2]), bfhi(w[2]), bflo(w[3]), bfhi(w[3])}; }
struct EpiBf16Scale {
    bf16* O; int ldc; const float* rs;
    __device__ __forceinline__ void operator()(const f32x4 (&acc)[2][2][4][2], const Unit& u, int wr, int wc, int fr, int fq) const {
        const int row0 = u.pm * BM + wr * 64 + fr, col0 = u.pn * BM + wc * 64 + 8 * fq;
        float sc[8];
#pragma unroll
        for (int q = 0; q < 8; ++q) sc[q] = rs ? rs[row0 + (q >> 2) * HALF + (q & 3) * 16] : 1.f;
#pragma unroll
        for (int ai = 0; ai < 2; ++ai)
#pragma unroll
            for (int m = 0; m < 4; ++m) { const int row = row0 + ai * HALF + m * 16; const float s = sc[ai * 4 + m]; bf16* rowp = O + (size_t)row * ldc + col0;
#pragma unroll
                for (int bj = 0; bj < 2; ++bj) *(v4u*)(rowp + 32 * bj) = pack8_bf16(acc[ai][bj][m][0] * s, acc[ai][bj][m][1] * s); }
    }
};
struct EpiResF32 {
    bf16* O; const bf16* X; int ldc; unsigned char* O8;
    __device__ __forceinline__ void operator()(const f32x4 (&acc)[2][2][4][2], const Unit& u, int wr, int wc, int fr, int fq) const {
        const int row0 = u.pm * BM + wr * 64 + fr, col0 = u.pn * BM + wc * 64 + 8 * fq;
#pragma unroll
        for (int ai = 0; ai < 2; ++ai) {
            v4u xw[4][2];
#pragma unroll
            for (int m = 0; m < 4; ++m)
#pragma unroll
                for (int bj = 0; bj < 2; ++bj) xw[m][bj] = *(const v4u*)(X + (size_t)(row0 + ai * HALF + m * 16) * ldc + col0 + 32 * bj);
#pragma unroll
            for (int m = 0; m < 4; ++m) { const size_t ro = (size_t)(row0 + ai * HALF + m * 16) * ldc + col0;
#pragma unroll
                for (int bj = 0; bj < 2; ++bj) { f32x4 x0, x1; unpack8(xw[m][bj], x0, x1);
                    const f32x4 v0 = acc[ai][bj][m][0] + x0, v1 = acc[ai][bj][m][1] + x1;
                    *(v4u*)(O + ro + 32 * bj) = pack8_bf16(v0, v1);
                    v2u w8; w8.x = cvt4_fp8(v0[0], v0[1], v0[2], v0[3]); w8.y = cvt4_fp8(v1[0], v1[1], v1[2], v1[3]);
                    *(v2u*)(O8 + ro + 32 * bj) = w8; } }
        }
    }
};
struct EpiGateUp {
    unsigned char* Hp; const float* rr;
    __device__ __forceinline__ void operator()(const f32x4 (&acc)[2][2][4][2], const Unit& u, int wr, int wc, int fr, int fq) const {
        const int row0 = u.pm * BM + wr * 64 + fr, col0 = u.pn * HALF + wc * 32 + 8 * fq;
        float sc[8];
#pragma unroll
        for (int q = 0; q < 8; ++q) sc[q] = rr[row0 + (q >> 2) * HALF + (q & 3) * 16];
#pragma unroll
        for (int ai = 0; ai < 2; ++ai)
#pragma unroll
            for (int m = 0; m < 4; ++m) { const int row = row0 + ai * HALF + m * 16; const float s = sc[ai * 4 + m];
                float h[8];
#pragma unroll
                for (int n = 0; n < 2; ++n)
#pragma unroll
                    for (int j = 0; j < 4; ++j) { const float g = acc[ai][0][m][n][j] * s, up = acc[ai][1][m][n][j] * s; h[n * 4 + j] = g * fsigmoid(g) * up; }
                v2u w; w.x = cvt4_fp8(h[0], h[1], h[2], h[3]); w.y = cvt4_fp8(h[4], h[5], h[6], h[7]);
                *(v2u*)(Hp + (size_t)row * ED + col0) = w; }
    }
};
struct EpiDown {
    unsigned char* S0; unsigned char* S1; unsigned char* S8; const float* rw; const int* rdst;
    __device__ __forceinline__ void operator()(const f32x4 (&acc)[2][2][4][2], const Unit& u, int wr, int wc, int fr, int fq) const {
        const int row0 = u.pm * BM + wr * 64 + fr, col0 = u.pn * BM + wc * 64 + 16 * fq;
        float sc[8]; int ds[8];
#pragma unroll
        for (int q = 0; q < 8; ++q) { const int row = row0 + (q >> 2) * HALF + (q & 3) * 16; sc[q] = rw[row]; ds[q] = rdst[row]; }
#pragma unroll
        for (int ai = 0; ai < 2; ++ai)
#pragma unroll
            for (int m = 0; m < 4; ++m) { const float s = sc[ai * 4 + m] * SLOT_SCALE; const int dst = ds[ai * 4 + m];
                if (dst >= 0) { unsigned char* rowp = (dst < 4 * T ? S0 + (size_t)dst * D : dst < 8 * T ? S1 + (size_t)(dst - 4 * T) * D : S8 + (size_t)(dst - 8 * T) * D) + col0;
                    v4u w;
#pragma unroll
                    for (int bj = 0; bj < 2; ++bj) { const f32x4 v0 = acc[ai][bj][m][0] * s, v1 = acc[ai][bj][m][1] * s;
                        w[2 * bj] = cvt4_fp8(v0[0], v0[1], v0[2], v0[3]); w[2 * bj + 1] = cvt4_fp8(v1[0], v1[1], v1[2], v1[3]); }
                    *(v4u*)rowp = w; } }
    }
};
struct EpiPle {
    bf16* H3; const bf16* H2; const bf16* PP; const float* ssq2; float* ssq3;
    __device__ __forceinline__ void operator()(const f32x4 (&acc)[2][2][4][2], const Unit& u, int wr, int wc, int fr, int fq) const {
        const int row0 = u.pm * BM + wr * 64 + fr, col0 = u.pn * BM + wc * 64 + 8 * fq;
        float sq[8];
#pragma unroll
        for (int q = 0; q < 8; ++q) sq[q] = ssq2[row0 + (q >> 2) * HALF + (q & 3) * 16];
#pragma unroll
        for (int ai = 0; ai < 2; ++ai)
#pragma unroll
            for (int mp = 0; mp < 2; ++mp) {
                v4u hw[2][2], pw[2][2];
#pragma unroll
                for (int mm = 0; mm < 2; ++mm)
#pragma unroll
                    for (int bj = 0; bj < 2; ++bj) { const size_t o = (size_t)(row0 + ai * HALF + (2 * mp + mm) * 16) * D + col0 + 32 * bj; hw[mm][bj] = *(const v4u*)(H2 + o); pw[mm][bj] = *(const v4u*)(PP + o); }
#pragma unroll
                for (int mm = 0; mm < 2; ++mm) { const int m = 2 * mp + mm, row = row0 + ai * HALF + m * 16;
                    const float r = __builtin_amdgcn_rsqf(sq[ai * 4 + m] * (1.f / D) + EPS);
                    const size_t ro = (size_t)row * D + col0; float ss = 0.f;
#pragma unroll
                    for (int bj = 0; bj < 2; ++bj) { f32x4 h0, h1, p0, p1; unpack8(hw[mm][bj], h0, h1); unpack8(pw[mm][bj], p0, p1);
                        f32x4 o0, o1;
#pragma unroll
                        for (int j = 0; j < 4; ++j) { o0[j] = h0[j] + fsigmoid(acc[ai][bj][m][0][j] * r) * p0[j]; o1[j] = h1[j] + fsigmoid(acc[ai][bj][m][1][j] * r) * p1[j]; ss += o0[j] * o0[j] + o1[j] * o1[j]; }
                        *(v4u*)(H3 + ro + 32 * bj) = pack8_bf16(o0, o1); }
                    ss += __shfl_xor(ss, 16); ss += __shfl_xor(ss, 32);
                    if (fq == 0) ssq3[(size_t)(u.pn * 4 + wc) * T + row] = ss; }
            }
    }
};
}

struct Frame {
    LAS unsigned char* lds;
    int tid, lane, wave, G, bx;
    unsigned char* ws;
    const float* in[21];
    float* out;
};
enum { I_X = 0, I_P, I_NMIX, I_WIN, I_CONVW, I_GCONV, I_GSB, I_WOUT, I_NFFN, I_WR, I_RB, I_WEG, I_WEU, I_WED, I_WSG, I_WSU, I_WSD, I_NPLE, I_WPG, I_WPP, I_NFIN };

__device__ __forceinline__ void p0_transpose_item(const float* W, int N, bf16* WT, int ldk, int k0, int n0, int row_off, const float* g64, LAS float* scr, int lane) {
    const int n4 = lane & 15, kr = lane >> 4;
    f32x4 v[16];
    const float* src = W + (size_t)(k0 + kr) * N + n0 + 4 * n4;
#pragma unroll
    for (int i = 0; i < 16; ++i) v[i] = *(const GAS f32x4*)(src + (size_t)(4 * i) * N);
    const int c = lane >> 3, nn = lane & 7;
    f32x4 ga = (f32x4){1.f, 1.f, 1.f, 1.f}, gb = ga;
    if (g64) { ga = *(const GAS f32x4*)(g64 + 8 * c); gb = *(const GAS f32x4*)(g64 + 8 * c + 4); }
#pragma unroll
    for (int i = 0; i < 16; ++i) { LAS float* d = scr + (4 * i + kr) * 65 + 4 * n4; d[0] = v[i].x; d[1] = v[i].y; d[2] = v[i].z; d[3] = v[i].w; }
    LDS_WAIT(); asm volatile("" ::: "memory");
#pragma unroll
    for (int j = 0; j < 8; ++j) { const int n = nn + 8 * j; const LAS float* s = scr + (8 * c) * 65 + n;
        v4u o; o.x = pg8::cvt_pk_bf16(s[0] * ga.x, s[65] * ga.y); o.y = pg8::cvt_pk_bf16(s[130] * ga.z, s[195] * ga.w); o.z = pg8::cvt_pk_bf16(s[260] * gb.x, s[325] * gb.y); o.w = pg8::cvt_pk_bf16(s[390] * gb.z, s[455] * gb.w);
        *(GAS v4u*)(WT + (size_t)(row_off + n) * ldk + k0 + 8 * c) = o; }
    LDS_WAIT(); asm volatile("" ::: "memory");
}
__device__ __forceinline__ void p0_transpose_item_f8(const float* W, int N, unsigned char* WT, int ldk, int k0, int n0, int row_off, int mode, const float* g64, LAS float* scr, int lane) {
    const int n4 = lane & 15, kr = lane >> 4;
    f32x4 v[16];
    const float* src = W + (size_t)(k0 + kr) * N + n0 + 4 * n4;
#pragma unroll
    for (int i = 0; i < 16; ++i) v[i] = *(const GAS f32x4*)(src + (size_t)(4 * i) * N);
    const int c = lane >> 4, nn = lane & 15;
    float g[16];
#pragma unroll
    for (int q = 0; q < 4; ++q) { f32x4 t = (f32x4){1.f, 1.f, 1.f, 1.f}; if (g64) t = *(const GAS f32x4*)(g64 + 16 * c + 4 * q); g[4 * q] = 64.f * t.x; g[4 * q + 1] = 64.f * t.y; g[4 * q + 2] = 64.f * t.z; g[4 * q + 3] = 64.f * t.w; }
#pragma unroll
    for (int i = 0; i < 16; ++i) { LAS float* d = scr + (4 * i + kr) * 65 + 4 * n4; d[0] = v[i].x; d[1] = v[i].y; d[2] = v[i].z; d[3] = v[i].w; }
    LDS_WAIT(); asm volatile("" ::: "memory");
#pragma unroll
    for (int j = 0; j < 4; ++j) { const int n = nn + 16 * j; const LAS float* s = scr + (16 * c) * 65 + n;
        v4u o;
        o.x = pg8::cvt4_fp8(s[0] * g[0], s[65] * g[1], s[130] * g[2], s[195] * g[3]); o.y = pg8::cvt4_fp8(s[260] * g[4], s[325] * g[5], s[390] * g[6], s[455] * g[7]);
        o.z = pg8::cvt4_fp8(s[520] * g[8], s[585] * g[9], s[650] * g[10], s[715] * g[11]); o.w = pg8::cvt4_fp8(s[780] * g[12], s[845] * g[13], s[910] * g[14], s[975] * g[15]);
        const int hid = n0 + n, drow = mode == 0 ? row_off + n : 16 * (hid >> 3) + 8 * (mode - 1) + (hid & 7);
        *(GAS v4u*)(WT + (size_t)drow * ldk + k0 + 16 * c) = o; }
    LDS_WAIT(); asm volatile("" ::: "memory");
}
constexpr int P0_I_WIN = (D / 64) * (NPROJ / 64), P0_I_WOUT = (D / 64) * (D / 64), P0_I_WR = (D / 64) * (NE / 64), P0_I_WPG = (D / 64) * (D / 64), P0_I_WPP = (PLE / 64) * (D / 64);
constexpr int P0_I_EXP = 768, P0_NITEMS = P0_I_WIN + P0_I_WOUT + P0_I_WR + P0_I_WPG + P0_I_WPP + 65 * P0_I_EXP;
__device__ __forceinline__ void p0_item(Frame& F, int it, LAS float* scr) {
    unsigned char* ws = F.ws; const int lane = F.lane;
    if (it < P0_I_WIN) { const int kb = it / (NPROJ / 64), nb = it % (NPROJ / 64); p0_transpose_item(F.in[I_WIN], NPROJ, (bf16*)(ws + WS_WIN), D, 64 * kb, 64 * nb, 64 * nb, F.in[I_NMIX] + 64 * kb, scr, lane); return; } it -= P0_I_WIN;
    if (it < P0_I_WOUT) { const int kb = it / (D / 64), nb = it % (D / 64), k0 = 64 * kb; const float* g = k0 < CW ? F.in[I_GCONV] + k0 : F.in[I_GSB] + (k0 - CW);
        p0_transpose_item(F.in[I_WOUT], D, (bf16*)(ws + WS_WOUT), D, k0, 64 * nb, 64 * nb, g, scr, lane); return; } it -= P0_I_WOUT;
    if (it < P0_I_WR) { const int kb = it; p0_transpose_item(F.in[I_WR], NE, (bf16*)(ws + WS_WR), D, 64 * kb, 0, 0, F.in[I_NFFN] + 64 * kb, scr, lane); return; } it -= P0_I_WR;
    if (it < P0_I_WPG) { const int kb = it / (D / 64), nb = it % (D / 64); p0_transpose_item_f8(F.in[I_WPG], D, ws + WS_WPG, D, 64 * kb, 64 * nb, 64 * nb, 0, F.in[I_NPLE] + 64 * kb, scr, lane); return; } it -= P0_I_WPG;
    if (it < P0_I_WPP) { const int kb = it / (D / 64), nb = it % (D / 64); p0_transpose_item(F.in[I_WPP], D, (bf16*)(ws + WS_WPP), PLE, 64 * kb, 64 * nb, 64 * nb, nullptr, scr, lane); return; } it -= P0_I_WPP;
    const int e = it / P0_I_EXP, r = it % P0_I_EXP, sub = r / 256, q = r % 256;
    if (sub < 2) {
        const float* src = e < NE ? (sub == 0 ? F.in[I_WEG] : F.in[I_WEU]) + (size_t)e * D * ED : (sub == 0 ? F.in[I_WSG] : F.in[I_WSU]);
        const int kb = q / (ED / 64), nb = q % (ED / 64), n0 = 64 * nb;
        p0_transpose_item_f8(src, ED, ws + WS_WGU + (size_t)e * 1024 * D, D, 64 * kb, n0, 0, 1 + sub, F.in[I_NFFN] + 64 * kb, scr, lane);
    } else {
        const float* src = e < NE ? F.in[I_WED] + (size_t)e * ED * D : F.in[I_WSD];
        const int kb = q / (D / 64), nb = q % (D / 64);
        p0_transpose_item_f8(src, D, ws + WS_WDN + (size_t)e * D * ED, ED, 64 * kb, 64 * nb, 64 * nb, 0, nullptr, scr, lane);
    }
}
__device__ __forceinline__ void p0_prologue(Frame& F) {
    LAS float* scr = (LAS float*)(F.lds + RING_OFF + F.wave * 16896);
    const int gw = F.bx * NWAVES + F.wave, NGW = F.G * NWAVES;
    {
        bf16* XB = (bf16*)F.out; float* rmix = (float*)(F.ws + WS_RMIX); const float* x = F.in[I_X];
        for (int m = gw; m < T; m += NGW) {
            const GAS f32x4* xr = (const GAS f32x4*)(x + (size_t)m * D) + F.lane;
            f32x4 v[8]; float s = 0.f;
#pragma unroll
            for (int j = 0; j < 8; ++j) { v[j] = xr[64 * j]; s += (v[j].x * v[j].x + v[j].y * v[j].y) + (v[j].z * v[j].z + v[j].w * v[j].w); }
            s = wave_sum(s);
            if (F.lane == 0) rmix[m] = __builtin_amdgcn_rsqf(s * (1.f / D) + EPS);
            GAS v2u* o8 = (GAS v2u*)(XB + (size_t)m * D) + F.lane;
#pragma unroll
            for (int j = 0; j < 8; ++j) { v2u w; w.x = pk2(v[j].x, v[j].y); w.y = pk2(v[j].z, v[j].w); o8[64 * j] = w; }
        }
    }
    {
        const float* p = F.in[I_P]; bf16* PB = (bf16*)(F.ws + WS_PB);
        const int nchunk = T * PLE / 8, gt = F.bx * NTHR + F.tid, NGT = F.G * NTHR;
        for (int c = gt; c < nchunk; c += NGT) { const f32x4 a = *(const GAS f32x4*)(p + (size_t)c * 8), b = *(const GAS f32x4*)(p + (size_t)c * 8 + 4);
            v4u w; w.x = pk2(a.x, a.y); w.y = pk2(a.z, a.w); w.z = pk2(b.x, b.y); w.w = pk2(b.z, b.w); *(GAS v4u*)(PB + (size_t)c * 8) = w; }
    }
    for (int it = gw; it < P0_NITEMS; it += NGW) p0_item(F, it, scr);
}

__device__ __forceinline__ unsigned off_b(unsigned row, unsigned ch) { return 256u * row + 16u * (ch ^ (((row & 3) << 2) | ((row >> 2) & 3))); }
#define MFMA32(a, b, c) __builtin_amdgcn_mfma_f32_32x32x16_bf16((a), (b), (c), 0, 0, 0)

__device__ __forceinline__ void conv_item(Frame& F, int it) {
    const bf16* proj = (const bf16*)(F.ws + WS_PROJ); bf16* ymix = (bf16*)F.out + (size_t)T * D;
    const float* cw = F.in[I_CONVW]; const int lane = F.lane;
    float w0[16], w1[16], w2[16], u1[16], u2[16];
#pragma unroll
    for (int j = 0; j < 2; ++j)
#pragma unroll
        for (int i = 0; i < 8; ++i) { const int c = 512 * j + 8 * lane + i; w0[8 * j + i] = cw[c]; w1[8 * j + i] = cw[CW + c]; w2[8 * j + i] = cw[2 * CW + c]; u1[8 * j + i] = 0.f; u2[8 * j + i] = 0.f; }
    const int t0 = 16 * it; const bool seq_start = (t0 & (SEQ - 1)) == 0;
    for (int tt = -2; tt < 16; ++tt) {
        if (tt < 0 && seq_start) continue;
        const size_t t = (size_t)(t0 + tt);
        const bf16* pr = proj + t * NPROJ + 8 * lane;
        float u[16], cb[16];
#pragma unroll
        for (int j = 0; j < 2; ++j) { const v4u h = *(const GAS v4u*)(pr + 512 * j), c = *(const GAS v4u*)(pr + 2 * CW + 512 * j);
#pragma unroll
            for (int q = 0; q < 4; ++q) { u[8 * j + 2 * q] = bflo(h[q]) * bflo(c[q]); u[8 * j + 2 * q + 1] = bfhi(h[q]) * bfhi(c[q]); } }
        if (tt >= 0) {
#pragma unroll
            for (int j = 0; j < 2; ++j) { const v4u b = *(const GAS v4u*)(pr + CW + 512 * j);
#pragma unroll
                for (int q = 0; q < 4; ++q) { cb[8 * j + 2 * q] = bflo(b[q]); cb[8 * j + 2 * q + 1] = bfhi(b[q]); } }
            float y[16], ss = 0.f;
#pragma unroll
            for (int i = 0; i < 16; ++i) { y[i] = cb[i] * (w0[i] * u2[i] + w1[i] * u1[i] + w2[i] * u[i]); ss += y[i] * y[i]; }
            const float r = __builtin_amdgcn_rsqf(wave_sum(ss) * (1.f / CW) + EPS);
            bf16* yo = ymix + t * D + 8 * lane;
#pragma unroll
            for (int j = 0; j < 2; ++j) { v4u w; w.x = pk2(y[8 * j] * r, y[8 * j + 1] * r); w.y = pk2(y[8 * j + 2] * r, y[8 * j + 3] * r); w.z = pk2(y[8 * j + 4] * r, y[8 * j + 5] * r); w.w = pk2(y[8 * j + 6] * r, y[8 * j + 7] * r);
                *(GAS v4u*)(yo + 512 * j) = w; }
        }
#pragma unroll
        for (int i = 0; i < 16; ++i) { u2[i] = u1[i]; u1[i] = u[i]; }
    }
}

__device__ __forceinline__ bf16x8 pack8(float a0, float a1, float a2, float a3, float a4, float a5, float a6, float a7) {
    v4u p; p.x = pk2(a0, a1); p.y = pk2(a2, a3); p.z = pk2(a4, a5); p.w = pk2(a6, a7); return __builtin_bit_cast(bf16x8, p);
}
__device__ __forceinline__ void tr_read4(unsigned a_t0, unsigned a_t1, s16x4& r00, s16x4& r01, s16x4& r10, s16x4& r11) {
    asm volatile("ds_read_b64_tr_b16 %0, %4\n\tds_read_b64_tr_b16 %1, %5\n\tds_read_b64_tr_b16 %2, %4 offset:4096\n\tds_read_b64_tr_b16 %3, %5 offset:4096\n\ts_waitcnt lgkmcnt(0)"
                 : "=&v"(r00), "=&v"(r01), "=&v"(r10), "=&v"(r11) : "v"(a_t0), "v"(a_t1) : "memory");
}
constexpr float ATT_C = 0.08838834764831845f * 1.4426950408889634f;
constexpr float ATT_EXIT = -152.f;

__device__ __forceinline__ void attn_unit(Frame& F, int b, int qblk, int parity) {
    const int lane = F.lane, h = F.wave, r = lane & 31, hh = lane >> 5;
    const bf16* proj = (const bf16*)(F.ws + WS_PROJ); bf16* ymix = (bf16*)F.out + (size_t)T * D;
    const size_t rowbase = (size_t)b * SEQ; const int t0 = qblk * 32;
    LAS unsigned char* kt = F.lds + h * 16384; LAS unsigned char* vt = kt + 8192;
    LAS float* XS = (LAS float*)(F.lds + RT_OFF) + parity * 256;
    bf16x8 qf[8];
    { const bf16* qp = proj + (rowbase + t0 + r) * NPROJ + 3 * CW + h * HD + 8 * hh;
#pragma unroll
      for (int kk = 0; kk < 8; ++kk) qf[kk] = *(const GAS bf16x8*)(qp + 16 * kk); }
    f32x16 oacc[4];
#pragma unroll
    for (int c = 0; c < 4; ++c)
#pragma unroll
        for (int i = 0; i < 16; ++i) oacc[c][i] = 0.f;
    float L = 0.f;
    const unsigned pr = (unsigned)((r & 19) | ((r & 4) << 1) | ((r & 8) >> 1));
    const unsigned ktb = (unsigned)(size_t)kt, vtb = (unsigned)(size_t)vt;
    unsigned va[2][4];
    { const unsigned blk = (lane >> 4) & 1, q = (lane & 15) >> 2, p = lane & 3;
#pragma unroll
      for (int t = 0; t < 2; ++t)
#pragma unroll
          for (int c = 0; c < 4; ++c) va[t][c] = vtb + off_b(8 * hh + 4 * t + q, 4 * c + 2 * blk + (p >> 1)) + 8 * (p & 1); }
    for (int kti = qblk; kti >= 0; --kti) {
        const int s0 = kti * 32;
        {
            v4u kreg[8], vreg[8];
            const bf16* kp = proj + (rowbase + s0 + (lane >> 4)) * NPROJ + 4 * CW + h * HD + (lane & 15) * 8;
#pragma unroll
            for (int i = 0; i < 8; ++i) { kreg[i] = *(const GAS v4u*)(kp + (size_t)(4 * i) * NPROJ); vreg[i] = *(const GAS v4u*)(kp + (size_t)(4 * i) * NPROJ + CW); }
#pragma unroll
            for (int i = 0; i < 8; ++i) { const unsigned o = off_b(4 * i + (lane >> 4), lane & 15); *(LAS v4u*)(kt + o) = kreg[i]; *(LAS v4u*)(vt + o) = vreg[i]; }
        }
        LDS_WAIT();
        f32x16 x;
#pragma unroll
        for (int i = 0; i < 16; ++i) x[i] = 0.f;
#pragma unroll
        for (int kk = 0; kk < 8; ++kk) { const bf16x8 kf = *(const LAS bf16x8*)(kt + off_b(pr, 2 * kk + hh)); x = MFMA32(kf, qf[kk], x); }
        const bool diag = (kti == qblk);
        float zz[16], suf[16];
#pragma unroll
        for (int i = 0; i < 16; ++i) {
            zz[i] = x[i] * ATT_C;
            const float e = __builtin_amdgcn_exp2f(fminf(zz[i], 126.f));
            float l = -__builtin_amdgcn_logf(1.f + e);
            const int kap = 16 * (i >> 3) + 8 * hh + (i & 7);
            if (diag && !(kap < r)) l = 0.f;
            suf[i] = l;
        }
#pragma unroll
        for (int j = 6; j >= 0; --j) { suf[j] += suf[j + 1]; suf[8 + j] += suf[8 + j + 1]; }
        const float T0 = suf[0], T1 = suf[8];
        const float T0p = __shfl_xor(T0, 32), T1p = __shfl_xor(T1, 32);
        const float base0 = L + T1 + T1p + (hh == 0 ? T0p : 0.f), base1 = L + (hh == 0 ? T1p : 0.f);
        float a[16];
#pragma unroll
        for (int i = 0; i < 16; ++i) {
            float v = __builtin_amdgcn_exp2f(zz[i] + (i < 8 ? base0 : base1) + suf[i]);
            const int kap = 16 * (i >> 3) + 8 * hh + (i & 7);
            if (diag && !(kap < r)) v = 0.f;
            a[i] = v;
        }
        L += (T0 + T1) + (T0p + T1p);
        const bf16x8 pf0 = pack8(a[0], a[1], a[2], a[3], a[4], a[5], a[6], a[7]);
        const bf16x8 pf1 = pack8(a[8], a[9], a[10], a[11], a[12], a[13], a[14], a[15]);
#pragma unroll
        for (int c = 0; c < 4; ++c) {
            s16x4 r00, r01, r10, r11; tr_read4(va[0][c], va[1][c], r00, r01, r10, r11);
            const bf16x8 vf0 = __builtin_shufflevector(r00, r01, 0, 1, 2, 3, 4, 5, 6, 7), vf1 = __builtin_shufflevector(r10, r11, 0, 1, 2, 3, 4, 5, 6, 7);
            oacc[c] = MFMA32(vf0, pf0, oacc[c]); oacc[c] = MFMA32(vf1, pf1, oacc[c]);
        }
        if (__all(L < ATT_EXIT)) break;
    }
    float ss = 0.f;
#pragma unroll
    for (int c = 0; c < 4; ++c)
#pragma unroll
        for (int i = 0; i < 16; ++i) ss += oacc[c][i] * oacc[c][i];
    ss += __shfl_xor(ss, 32);
    if (hh == 0) XS[h * 32 + r] = ss;
    __syncthreads();
    float tot = 0.f;
#pragma unroll
    for (int w = 0; w < 8; ++w) tot += XS[w * 32 + r];
    const float rs = __builtin_amdgcn_rsqf(tot * (1.f / CW) + EPS);
    bf16* yo = ymix + (rowbase + t0 + r) * D + CW + h * HD + 4 * hh;
#pragma unroll
    for (int c = 0; c < 4; ++c)
#pragma unroll
        for (int g = 0; g < 4; ++g) { v2u w; w.x = pk2(oacc[c][4 * g] * rs, oacc[c][4 * g + 1] * rs); w.y = pk2(oacc[c][4 * g + 2] * rs, oacc[c][4 * g + 3] * rs);
            *(GAS v2u*)(yo + 32 * c + 8 * g) = w; }
}
__device__ __forceinline__ void p2_mixer(Frame& F) {
    int par = 0;
    for (int u = F.bx; u < NB * (SEQ / 32); u += F.G) { attn_unit(F, u / (SEQ / 32), u % (SEQ / 32), par); par ^= 1; }
    const int gw = F.bx * NWAVES + F.wave, NGW = F.G * NWAVES;
    for (int it = gw; it < T / 16; it += NGW) conv_item(F, it);
}

__device__ __forceinline__ void router_unit(Frame& F, int unit, LAS int* hist) {
    const int lane = F.lane, r16 = lane & 15, g = lane >> 4;
    const bf16* H = (const bf16*)(F.ws + WS_H1B); const bf16* WR = (const bf16*)(F.ws + WS_WR);
    const int t0 = unit * 16;
    LAS float* LG = (LAS float*)(F.lds + F.wave * 16384); LAS float* BI = LG + 16 * 65 + 16;
    f32x4 acc[4];
#pragma unroll
    for (int nb = 0; nb < 4; ++nb) acc[nb] = (f32x4){0.f, 0.f, 0.f, 0.f};
    float ss = 0.f;
    const bf16* ap = H + (size_t)(t0 + r16) * D + 8 * g; const bf16* bp = WR + (size_t)r16 * D + 8 * g;
#pragma unroll 4
    for (int ks = 0; ks < D / 32; ++ks) {
        const v4u aw = *(const GAS v4u*)(ap + 32 * ks);
#pragma unroll
        for (int q = 0; q < 4; ++q) { const float lo = bflo(aw[q]), hi = bfhi(aw[q]); ss += lo * lo + hi * hi; }
        const bf16x8 af = __builtin_bit_cast(bf16x8, aw);
#pragma unroll
        for (int nb = 0; nb < 4; ++nb) { const bf16x8 bf = *(const GAS bf16x8*)(bp + (size_t)(16 * nb) * D + 32 * ks); acc[nb] = __builtin_amdgcn_mfma_f32_16x16x32_bf16(af, bf, acc[nb], 0, 0, 0); }
    }
    ss += __shfl_xor(ss, 16); ss += __shfl_xor(ss, 32);
#pragma unroll
    for (int nb = 0; nb < 4; ++nb)
#pragma unroll
        for (int j = 0; j < 4; ++j) LG[(4 * g + j) * 65 + 16 * nb + r16] = acc[nb][j];
    LDS_WAIT();
    if (lane < 16) {
        const int t = t0 + lane; const float rs = __builtin_amdgcn_rsqf(ss * (1.f / D) + EPS);
        ((float*)(F.ws + WS_RFFN))[t] = rs;
        LAS float* lg = LG + lane * 65; LAS float* bi = BI + lane * 65; const float* rb = F.in[I_RB];
        for (int e = 0; e < NE; ++e) { const float s = fsigmoid(lg[e] * rs); lg[e] = s; bi[e] = s + rb[e]; }
        float gs[8];
#pragma unroll
        for (int gg = 0; gg < 8; ++gg) { float m1 = -__builtin_inff(), m2 = -__builtin_inff();
#pragma unroll
            for (int j = 0; j < 8; ++j) { const float v = bi[8 * gg + j]; if (v > m1) { m2 = m1; m1 = v; } else if (v > m2) m2 = v; }
            gs[gg] = m1 + m2; }
        unsigned gmask = 0u;
#pragma unroll
        for (int gg = 0; gg < 8; ++gg) { int cnt = 0;
#pragma unroll
            for (int g2 = 0; g2 < 8; ++g2) cnt += (gs[g2] > gs[gg] || (gs[g2] == gs[gg] && g2 < gg)) ? 1 : 0;
            if (cnt < 4) gmask |= 1u << gg; }
        int se[8]; float sv[8]; float wsum = 0.f;
#pragma unroll
        for (int k = 0; k < 8; ++k) { float best = -__builtin_inff(); int be = 0;
            for (int e = 0; e < NE; ++e) { const float v = bi[e]; if (((gmask >> (e >> 3)) & 1u) && v > best) { best = v; be = e; } }
            bi[be] = -__builtin_inff(); se[k] = be; sv[k] = lg[be]; wsum += sv[k]; }
        const float inv = 2.5f / wsum;
        int* te = (int*)(F.ws + WS_TOPE) + (size_t)t * 8; float* tw = (float*)(F.ws + WS_TOPW) + (size_t)t * 8;
#pragma unroll
        for (int k = 0; k < 8; ++k) { te[k] = se[k]; tw[k] = sv[k] * inv; (void)__hip_atomic_fetch_add(hist + se[k], 1, __ATOMIC_RELAXED, __HIP_MEMORY_SCOPE_WORKGROUP); }
    }
}
__device__ __forceinline__ void p4_router(Frame& F) {
    LAS int* hist = (LAS int*)(F.lds + RT_OFF);
    for (int v = F.bx; v < 256; v += F.G) {
        if (F.tid < 64) hist[F.tid] = 0;
        __syncthreads();
        router_unit(F, v * 8 + F.wave, hist);
        __syncthreads();
        if (F.tid < 64) ((int*)(F.ws + WS_CNT))[v * 64 + F.tid] = hist[F.tid];
        __syncthreads();
    }
}

__device__ __forceinline__ void p4b_tables(Frame& F) {
    LAS int* L = (LAS int*)(F.lds + RING_OFF);
    LAS int* part_t = L;
    LAS int* part_b = L + 512;
    LAS int* totals = L + 1024;
    LAS int* below = L + 1088;
    LAS int* segst = L + 1152;
    LAS int* wcount = L + 1280;
    LAS int* pe = L + 2048;
    LAS int* rank = L + 3072;
    const int* CNT = (const int*)(F.ws + WS_CNT); const int* TOPE = (const int*)(F.ws + WS_TOPE); const float* TOPW = (const float*)(F.ws + WS_TOPW);
    const float* RFFN = (const float*)(F.ws + WS_RFFN);
    int* RTOK = (int*)(F.ws + WS_RTOK); float* RW = (float*)(F.ws + WS_RW); int* RDST = (int*)(F.ws + WS_RDST); float* RR = (float*)(F.ws + WS_RR); int* TILEE = (int*)(F.ws + WS_TILEE);
    const int tid = F.tid, lane = F.lane, wave = F.wave;
    for (int v = F.bx; v < 256; v += F.G) {
        { const int e = tid & 63, part = tid >> 6; int tot = 0, bel = 0;
          for (int vv = 32 * part; vv < 32 * part + 32; ++vv) { const int c = CNT[vv * 64 + e]; tot += c; bel += (vv < v) ? c : 0; }
          part_t[part * 64 + e] = tot; part_b[part * 64 + e] = bel; }
        for (int i = tid; i < 1024; i += NTHR) pe[i] = TOPE[(size_t)v * 1024 + i];
        __syncthreads();
        if (wave == 0) {
            int tot = 0, bel = 0;
#pragma unroll
            for (int p = 0; p < 8; ++p) { tot += part_t[p * 64 + lane]; bel += part_b[p * 64 + lane]; }
            totals[lane] = tot; below[lane] = bel;
            const int ru = (tot + 255) & ~255; int sc = ru;
#pragma unroll
            for (int o = 1; o < 64; o <<= 1) { const int n = __shfl_up(sc, o); if (lane >= o) sc += n; }
            segst[lane] = sc - ru; if (lane == 63) segst[64] = sc;
        }
        { int cnt = 0;
          for (int j = 0; j < 128; ++j) { const int p = 128 * wave + j; if (pe[p] == lane) { rank[p] = cnt; ++cnt; } }
          wcount[wave * 64 + lane] = cnt; }
        __syncthreads();
        const int SS = segst[64];
        for (int p = tid; p < 1024; p += NTHR) { const int e = pe[p], w = p >> 7; int off = 0;
            for (int w2 = 0; w2 < w; ++w2) off += wcount[w2 * 64 + e];
            const int row = segst[e] + below[e] + off + rank[p]; const int t = 128 * v + (p >> 3), k = p & 7;
            RTOK[row] = t; RW[row] = TOPW[(size_t)t * 8 + k]; RDST[row] = k * T + t; RR[row] = RFFN[t]; }
        if (tid < 128) { const int t = 128 * v + tid, row = SS + t; RTOK[row] = t; RW[row] = 1.f; RDST[row] = 8 * T + t; RR[row] = RFFN[t]; }
        if (v < NE) { const int e = v, tot = totals[e], ru = (tot + 255) & ~255, st = segst[e];
            if (tid < ru - tot) { const int row = st + tot + tid; RTOK[row] = 0; RW[row] = 0.f; RDST[row] = -1; RR[row] = 0.f; }
            if (tid < ru / 256) TILEE[st / 256 + tid] = e; }
        if (v == NE) { if (tid < T / 256) TILEE[SS / 256 + tid] = NE; if (tid == 0) TILEE[MAXTILES] = SS / 256 + T / 256; }
        __syncthreads();
    }
}

template <int MODE> __device__ __forceinline__ int group_setup(Frame& F, int nN) {
    const int* TILEE = (const int*)(F.ws + WS_TILEE);
    const int NT = __builtin_amdgcn_readfirstlane((int)__hip_atomic_load((unsigned*)TILEE + MAXTILES, RLX_AGENT));
    LAS int* te = (LAS int*)(F.lds + TE_OFF); LAS unsigned* rt = (LAS unsigned*)(F.lds + RT_OFF);
    for (int i = F.tid; i < NT && i < MAXTILES; i += NTHR) te[i] = TILEE[i];
    if (MODE == 1) {
        const int* RTOK = (const int*)(F.ws + WS_RTOK);
        for (int ui = F.tid >> 8; ui < RT_UNITS; ui += 2) { int pm, pn; if (!pg8::order_next(ui, F.G, F.bx, NT, nN, pm, pn)) break;
            rt[ui * 256 + (F.tid & 255)] = (unsigned)RTOK[pm * 256 + (F.tid & 255)] * (unsigned)D; }
    }
    __syncthreads();
    return NT;
}

__device__ __forceinline__ void acc_fp8x16(const v4u w, float (&o)[16]) {
#pragma unroll
    for (int q = 0; q < 4; ++q) { const f32x2 lo = __builtin_amdgcn_cvt_pk_f32_fp8((int)w[q], false), hi = __builtin_amdgcn_cvt_pk_f32_fp8((int)w[q], true);
        o[4 * q] += lo.x; o[4 * q + 1] += lo.y; o[4 * q + 2] += hi.x; o[4 * q + 3] += hi.y; }
}
__device__ __forceinline__ void p7_combine(Frame& F, int n) {
    const int gw = F.bx * NWAVES + F.wave, NGW = F.G * NWAVES, lane = F.lane;
    bf16* H = (bf16*)(F.ws + WS_H1B); const unsigned char* S0 = (const unsigned char*)F.out; const unsigned char* S1 = F.ws + WS_SLOT47; const unsigned char* S8 = F.ws + WS_SLOT8;
    float* ssq2 = (float*)(F.ws + WS_SSQ2);
    for (int t = gw; t < T; t += NGW) {
        float ss = 0.f;
#pragma unroll
        for (int ch = 0; ch < 2; ++ch) {
            const int co = 1024 * ch + 16 * lane;
            bf16* hp = H + (size_t)t * D + co;
            const v4u h0 = *(const GAS v4u*)hp, h1 = *(const GAS v4u*)(hp + 8);
            v4u w[9];
#pragma unroll
            for (int k = 0; k < 4; ++k) { w[k] = *(const GAS v4u*)(S0 + ((size_t)k * T + t) * D + co); w[4 + k] = *(const GAS v4u*)(S1 + ((size_t)k * T + t) * D + co); }
            w[8] = *(const GAS v4u*)(S8 + (size_t)t * D + co);
            float o[16];
#pragma unroll
            for (int i = 0; i < 16; ++i) o[i] = 0.f;
#pragma unroll
            for (int k = 0; k < 9; ++k) acc_fp8x16(w[k], o);
            f32x4 a0, a1, a2, a3; pg8::unpack8(h0, a0, a1); pg8::unpack8(h1, a2, a3);
#pragma unroll
            for (int j = 0; j < 4; ++j) { a0[j] += o[j] * (1.f / SLOT_SCALE); a1[j] += o[4 + j] * (1.f / SLOT_SCALE); a2[j] += o[8 + j] * (1.f / SLOT_SCALE); a3[j] += o[12 + j] * (1.f / SLOT_SCALE);
                ss += (a0[j] * a0[j] + a1[j] * a1[j]) + (a2[j] * a2[j] + a3[j] * a3[j]); }
            *(GAS v4u*)hp = pg8::pack8_bf16(a0, a1); *(GAS v4u*)(hp + 8) = pg8::pack8_bf16(a2, a3);
            { v4u w8; w8.x = pg8::cvt4_fp8(a0[0], a0[1], a0[2], a0[3]); w8.y = pg8::cvt4_fp8(a1[0], a1[1], a1[2], a1[3]); w8.z = pg8::cvt4_fp8(a2[0], a2[1], a2[2], a2[3]); w8.w = pg8::cvt4_fp8(a3[0], a3[1], a3[2], a3[3]);
              *(GAS v4u*)(F.ws + WS_H1F8 + (size_t)t * D + co) = w8; }
        }
        ss = wave_sum(ss);
        if (lane == 0) ssq2[t] = ss;
    }
}

__device__ __forceinline__ void p9_final(Frame& F, const bf16* H, const float* ssq, int nparts) {
    const int gw = F.bx * NWAVES + F.wave, NGW = F.G * NWAVES, lane = F.lane; const float* g = F.in[I_NFIN];
    for (int t = gw; t < T; t += NGW) {
        v4u w[4];
#pragma unroll
        for (int j = 0; j < 4; ++j) w[j] = *(const GAS v4u*)(H + (size_t)t * D + 512 * j + 8 * lane);
        float ss = 0.f;
        if (nparts > 0) { if (lane < nparts) ss = ssq[(size_t)lane * T + t]; }
        else {
#pragma unroll
            for (int j = 0; j < 4; ++j)
#pragma unroll
                for (int q = 0; q < 4; ++q) { const float lo = bflo(w[j][q]), hi = bfhi(w[j][q]); ss += lo * lo + hi * hi; }
        }
        const float r = __builtin_amdgcn_rsqf(wave_sum(ss) * (1.f / D) + EPS);
        float* o = F.out + (size_t)t * D;
#pragma unroll
        for (int j = 0; j < 4; ++j) { const int c = 512 * j + 8 * lane; const f32x4 g0 = *(const GAS f32x4*)(g + c), g1 = *(const GAS f32x4*)(g + c + 4);
            f32x4 a, b; a.x = bflo(w[j][0]) * r * g0.x; a.y = bfhi(w[j][0]) * r * g0.y; a.z = bflo(w[j][1]) * r * g0.z; a.w = bfhi(w[j][1]) * r * g0.w;
            b.x = bflo(w[j][2]) * r * g1.x; b.y = bfhi(w[j][2]) * r * g1.y; b.z = bflo(w[j][3]) * r * g1.z; b.w = bfhi(w[j][3]) * r * g1.w;
            *(GAS f32x4*)(o + c) = a; *(GAS f32x4*)(o + c + 4) = b; }
    }
}

struct Args { const float* in[21]; float* out; unsigned char* ws; int ph_lo, ph_hi, fin_mode, li; };
__global__ void __launch_bounds__(NTHR, 2) mk_fwd(Args args) {
    extern __shared__ __attribute__((aligned(16))) unsigned char lds[];
    Frame F;
    F.lds = (LAS unsigned char*)lds;
    F.tid = threadIdx.x; F.lane = F.tid & 63; F.wave = __builtin_amdgcn_readfirstlane(F.tid >> 6);
    F.G = gridDim.x; F.bx = blockIdx.x; F.ws = args.ws; F.out = args.out;
#pragma unroll
    for (int i = 0; i < 21; ++i) F.in[i] = args.in[i];
    volatile LAS unsigned* MISC = (volatile LAS unsigned*)(F.lds + MISC_OFF);
    if (F.tid < 32) MISC[F.tid] = 0u;
    __syncthreads();
    XcdBarrier bar = xcd_barrier_post((unsigned*)(F.ws + WS_CTL) + CW_BAR + args.li * XCD_BAR_WORDS, MISC + 8);
    unsigned char* ws = F.ws;
    const int lo = args.ph_lo, hi = args.ph_hi;
    LAS unsigned char* ring = F.lds + RING_OFF;
#define PHASE(k) if (lo <= (k) && (k) < hi)
#define PH(k) PHASE(k) { RELANE();
#define GRID_BAR() xcd_barrier(bar)
#define RELANE() do { int _t = threadIdx.x; asm volatile("" : "+v"(_t)); F.tid = _t; F.lane = _t & 63; F.wave = __builtin_amdgcn_readfirstlane(_t >> 6); } while (0)

    PHASE(0) { RELANE(); p0_prologue(F); GRID_BAR(); }
    PHASE(1) { RELANE();
        pg8::DenseSched S{T / 256, NPROJ / 256, F.G, F.bx, D * 2, (const char*)(ws + WS_WIN)};
        pg8::EpiBf16Scale E{(bf16*)(ws + WS_PROJ), NPROJ, (const float*)(ws + WS_RMIX)};
        pg8::gemm_phase<false, 1>(F.tid, ring, (const char*)F.out, D * 2, S, E);
        GRID_BAR();
    }
    PHASE(2) { RELANE(); p2_mixer(F); GRID_BAR(); }
    PHASE(3) { RELANE();
        pg8::DenseSched S{T / 256, D / 256, F.G, F.bx, D * 2, (const char*)(ws + WS_WOUT)};
        pg8::EpiResF32 E{(bf16*)(ws + WS_H1B), (const bf16*)F.out, D, ws + WS_H1F8};
        pg8::gemm_phase<false, 1>(F.tid, ring, (const char*)((bf16*)F.out + (size_t)T * D), D * 2, S, E);
        GRID_BAR();
    }
    PHASE(4) { RELANE(); p4_router(F); GRID_BAR(); }
    PHASE(5) { RELANE(); p4b_tables(F); GRID_BAR(); }
    PHASE(6) { RELANE();
        const int NT = group_setup<1>(F, 4);
        pg8::GroupSched<1> S{NT, 4, F.G, F.bx, D, 0, (const char*)(ws + WS_WGU), (size_t)1024 * D, (const LAS int*)(F.lds + TE_OFF), (const LAS unsigned*)(F.lds + RT_OFF)};
        pg8::EpiGateUp E{ws + WS_HPERM, (const float*)(ws + WS_RR)};
        pg8::gemm_phase<true, 0>(F.tid, ring, (const char*)(ws + WS_H1F8), D, S, E, 0x79797979, 0x7f7f7f7f);
        GRID_BAR();
    }
    {
        for (int n = 0; n < NSLICE; ++n) {
            PHASE(7 + 2 * n) { RELANE();
            const int NT = group_setup<2>(F, SLW / 256);
            pg8::GroupSched<2> S{NT, SLW / 256, F.G, F.bx, ED, (SLW / 256) * n, (const char*)(ws + WS_WDN), (size_t)D * ED, (const LAS int*)(F.lds + TE_OFF), (const LAS unsigned*)(F.lds + RT_OFF)};
            pg8::EpiDown E{(unsigned char*)F.out, ws + WS_SLOT47, ws + WS_SLOT8, (const float*)(ws + WS_RW), (const int*)(ws + WS_RDST)};
            pg8::gemm_phase<true, 0>(F.tid, ring, (const char*)(ws + WS_HPERM), ED, S, E, 0x79797979, 0x7f7f7f7f);
            GRID_BAR();
            }
            PHASE(8 + 2 * n) { RELANE();
            p7_combine(F, n);
            GRID_BAR();
            }
        }
    }
    PHASE(15) { RELANE();
        pg8::DenseSched S{T / 256, D / 256, F.G, F.bx, PLE * 2, (const char*)(ws + WS_WPP)};
        pg8::EpiBf16Scale E{(bf16*)(ws + WS_PP), D, nullptr};
        pg8::gemm_phase<false, 1>(F.tid, ring, (const char*)(ws + WS_PB), PLE * 2, S, E);
        GRID_BAR();
    }
    PHASE(16) { RELANE();
        pg8::DenseSchedG S{T / 256, D / 256, F.G, F.bx, D, (const char*)(ws + WS_WPG)};
        pg8::EpiPle E{(bf16*)(ws + WS_H3), (const bf16*)(ws + WS_H1B), (const bf16*)(ws + WS_PP), (const float*)(ws + WS_SSQ2), (float*)(ws + WS_SSQ3)};
        pg8::gemm_phase<true, 1>(F.tid, ring, (const char*)(ws + WS_H1F8), D, S, E, 0x79797979, 0x7f7f7f7f);
        GRID_BAR();
    }
    PHASE(17) { RELANE();
    if (args.fin_mode == 0) p9_final(F, (const bf16*)(ws + WS_H3), (const float*)(ws + WS_SSQ3), 32);
    else p9_final(F, (const bf16*)(ws + WS_H1B), nullptr, 0);
    }
}

extern "C" void kernel_launch(void* const* d_in, const int* in_sizes, int n_in, void* d_out, int out_size, void* d_ws, size_t ws_size, hipStream_t stream) {
    static int grid = 0;
    if (grid == 0) {
        int dev = 0, cus = 0;
        if (n_in != 21 || ws_size < WS_END) { fprintf(stderr, "kernel_launch: n_in %d ws %zu (need %zu)\n", n_in, ws_size, (size_t)WS_END); grid = -1; return; }
        if (hipGetDevice(&dev) != hipSuccess || hipDeviceGetAttribute(&cus, hipDeviceAttributeMultiprocessorCount, dev) != hipSuccess) { grid = -1; return; }
        if (hipFuncSetAttribute((const void*)mk_fwd, hipFuncAttributeMaxDynamicSharedMemorySize, LDS_BYTES) != hipSuccess) { fprintf(stderr, "hipFuncSetAttribute failed\n"); grid = -1; return; }
        int per_cu = 0;
        (void)hipOccupancyMaxActiveBlocksPerMultiprocessor(&per_cu, (const void*)mk_fwd, NTHR, LDS_BYTES);
        (void)hipGetLastError();
        grid = cus > 256 ? 256 : cus;
    }
    if (grid < 0) return;
    (void)hipMemsetAsync((char*)d_ws + WS_CTL, 0, CTL_ZERO_BYTES, stream);
    Args a{};
    for (int i = 0; i < 21; ++i) a.in[i] = (const float*)d_in[i];
    a.out = (float*)d_out; a.ws = (unsigned char*)d_ws; a.fin_mode = FIN_MODE;
#if PROBE_K >= 0
    a.ph_lo = 0; a.ph_hi = PROBE_K + 1; a.li = 0;
    hipLaunchKernelGGL(mk_fwd, dim3(grid), dim3(NTHR), LDS_BYTES, stream, a);
    a.ph_lo = PROBE_K; a.ph_hi = PH_HI; a.li = 1;
    hipLaunchKernelGGL(mk_fwd, dim3(grid), dim3(NTHR), LDS_BYTES, stream, a);
#else
    a.ph_lo = 0; a.ph_hi = PH_HI; a.li = 0;
    hipLaunchKernelGGL(mk_fwd, dim3(grid), dim3(NTHR), LDS_BYTES, stream, a);
#endif
}
```

```cpp
#include <hip/hip_runtime.h>
#include <cstdio>
#ifndef PROBE_K
#define PROBE_K -1
#endif
#ifndef PH_HI
#define PH_HI 100
#endif
#ifndef FIN_MODE
#define FIN_MODE 0
#endif

#define GAS __attribute__((address_space(1)))
#define LAS __attribute__((address_space(3)))
typedef unsigned short bf16;
typedef unsigned v4u __attribute__((ext_vector_type(4)));
typedef unsigned v2u __attribute__((ext_vector_type(2)));
typedef float f32x4 __attribute__((ext_vector_type(4)));
typedef float f32x2 __attribute__((ext_vector_type(2)));
typedef float f32x16 __attribute__((ext_vector_type(16)));
typedef short bf16x8 __attribute__((ext_vector_type(8)));
typedef short s16x4 __attribute__((ext_vector_type(4)));
typedef GAS unsigned gu32;
#define RLX_AGENT __ATOMIC_RELAXED, __HIP_MEMORY_SCOPE_AGENT
#define LDS_WAIT() asm volatile("s_waitcnt lgkmcnt(0)" ::: "memory")
#define VM_WAIT() asm volatile("s_waitcnt vmcnt(0)" ::: "memory")

constexpr int NB = 8, SEQ = 4096, T = NB * SEQ, D = 2048, NPROJ = 6144, CW = 1024, HD = 128, NH = 8;
constexpr int PLE = 256, NE = 64, ED = 512, TOPK = 8, NSLOT = 9;
constexpr float EPS = 1e-6f;
constexpr int NWAVES = 8, NTHR = 512;
constexpr int MAXTILES = 1216;
constexpr int MAXROWS = MAXTILES * 256;
constexpr int NSLICE = 1, SLW = D / NSLICE;
constexpr float SLOT_SCALE = 16.f;

constexpr size_t MiB = 1u << 20;
constexpr size_t WS_CTL = 0, CTL_ZERO_BYTES = 1 * MiB;
constexpr size_t WS_RMIX = 1 * MiB;
constexpr size_t WS_RFFN = WS_RMIX + 128 * 1024;
constexpr size_t WS_SSQ2 = WS_RFFN + 128 * 1024;
constexpr size_t WS_SSQ3 = WS_SSQ2 + 512 * 1024;
constexpr size_t WS_TOPE = WS_SSQ3 + 4 * MiB;
constexpr size_t WS_TOPW = WS_TOPE + 1 * MiB;
constexpr size_t WS_CNT  = WS_TOPW + 1 * MiB;
constexpr size_t WS_RTOK = WS_CNT + 64 * 1024;
constexpr size_t WS_RW   = WS_RTOK + 1280 * 1024;
constexpr size_t WS_RDST = WS_RW + 1280 * 1024;
constexpr size_t WS_RR   = WS_RDST + 1280 * 1024;
constexpr size_t WS_TILEE = WS_RR + 1280 * 1024;
constexpr size_t WS_WR   = 16 * MiB;
constexpr size_t WS_WIN  = 17 * MiB;
constexpr size_t WS_WOUT = WS_WIN + 24 * MiB;
constexpr size_t WS_WGU  = WS_WOUT + 8 * MiB;
constexpr size_t WS_WDN  = WS_WGU + 130 * MiB;
constexpr size_t WS_WPG  = WS_WDN + 65 * MiB;
constexpr size_t WS_WPP  = WS_WPG + 8 * MiB;
constexpr size_t WS_PB   = WS_WPP + 1 * MiB;
constexpr size_t WS_H1B  = WS_PB + 16 * MiB;
constexpr size_t WS_H1F8 = WS_H1B + 128 * MiB;
constexpr size_t WS_OVL  = WS_H1F8 + 64 * MiB;
constexpr size_t WS_PROJ = WS_OVL;
constexpr size_t WS_HPERM = WS_OVL;
constexpr size_t WS_SLOT8 = WS_OVL + 304 * MiB;
constexpr size_t WS_PP   = WS_OVL;
constexpr size_t WS_H3   = WS_OVL + 128 * MiB;
constexpr size_t WS_SLOT47 = WS_OVL + 384 * MiB;
constexpr size_t WS_END  = WS_SLOT47 + 256 * MiB;
constexpr int CW_BAR = 4096;

constexpr int RING_OFF = 0, RING_BYTES = 131072;
constexpr int RT_OFF = 131072, RT_UNITS = 20, RT_BYTES = RT_UNITS * 1024;
constexpr int TE_OFF = RT_OFF + RT_BYTES, TE_BYTES = 4864 + 128;
constexpr int EPT_OFF = TE_OFF + TE_BYTES, EPT_BYTES = 4096;
constexpr int MISC_OFF = EPT_OFF + EPT_BYTES;
constexpr int LDS_BYTES = MISC_OFF + 128;
static_assert(LDS_BYTES <= 163840, "LDS");

__device__ __forceinline__ unsigned f2bf(float f) { unsigned u = __builtin_bit_cast(unsigned, f); return (u + 0x7fffu + ((u >> 16) & 1u)) >> 16; }
__device__ __forceinline__ unsigned pk2(float lo, float hi) { return f2bf(lo) | (f2bf(hi) << 16); }
__device__ __forceinline__ float bflo(unsigned w) { return __builtin_bit_cast(float, w << 16); }
__device__ __forceinline__ float bfhi(unsigned w) { return __builtin_bit_cast(float, w & 0xffff0000u); }
__device__ __forceinline__ float wave_sum(float v) {
#pragma unroll
    for (int o = 1; o < 64; o <<= 1) v += __shfl_xor(v, o);
    return v;
}
__device__ __forceinline__ float fsigmoid(float v) { return __builtin_amdgcn_rcpf(1.f + __builtin_amdgcn_exp2f(-1.4426950409f * v)); }

#define XB_TMO      128
#define XB_XCNT(j)  (256  + 64 * (j))
#define XB_XSUB(j)  (1280 + 64 * (j))
#define XB_XGEN(j)  (2304 + 64 * (j))
#define XB_TOP      3328
#define XB_TOPGEN   3392
#define XCD_BAR_WORDS 3456
#define XB_SPIN_CAP (1u << 18)
__device__ __forceinline__ unsigned xb_ld(unsigned* p)              { return __hip_atomic_load(p, __ATOMIC_RELAXED, __HIP_MEMORY_SCOPE_AGENT); }
__device__ __forceinline__ unsigned xb_add(unsigned* p, unsigned v) { return __hip_atomic_fetch_add(p, v, __ATOMIC_RELAXED, __HIP_MEMORY_SCOPE_AGENT); }
__device__ __forceinline__ unsigned xb_xcc_id() { return (unsigned)__builtin_amdgcn_s_getreg((3 << 11) | 20) & 0xFu; }
#define XB_SPIN(cond, bar) do { unsigned _sp = 0; while (cond) { __builtin_amdgcn_s_sleep(1); \
    if ((++_sp & 255u) == 0u) { if (xb_ld(&(bar)[XB_TMO])) break; if (_sp > XB_SPIN_CAP) { atomicAdd(&(bar)[XB_TMO], 1u); break; } } } } while (0)
struct XcdBarrier { unsigned* bar; unsigned x; volatile LAS unsigned* st; };
__device__ __forceinline__ XcdBarrier xcd_barrier_post(unsigned* bar, volatile LAS unsigned* st) {
    XcdBarrier b; b.bar = bar; b.x = xb_xcc_id(); b.st = st;
    if (threadIdx.x == 0) (void)xb_add(&bar[XB_XCNT(b.x)], 1u);
    return b;
}
__device__ __forceinline__ void xcd_barrier_complete(unsigned* bar, unsigned x, unsigned& nloc, unsigned& nx) {
    const unsigned G = gridDim.x * gridDim.y * gridDim.z;
    unsigned sum, cnt, mine, sp = 0u;
    for (;;) {
        sum = 0u; cnt = 0u; mine = 0u;
#pragma unroll
        for (unsigned j = 0; j < 16; ++j) { const unsigned c = xb_ld(&bar[XB_XCNT(j)]); sum += c; cnt += (c > 0u) ? 1u : 0u; mine = (j == x) ? c : mine; }
        if (sum == G) break;
        __builtin_amdgcn_s_sleep(1);
        if ((++sp & 255u) == 0u) { if (xb_ld(&bar[XB_TMO])) break; if (sp > XB_SPIN_CAP) { atomicAdd(&bar[XB_TMO], 1u); break; } }
    }
    nloc = mine > 0u ? mine : 1u; nx = cnt > 0u ? cnt : 1u;
}
__device__ __forceinline__ void xcd_barrier(const XcdBarrier& b) {
    asm volatile("s_waitcnt vmcnt(0)" ::: "memory");
    __syncthreads();
    if (threadIdx.x == 0) {
        unsigned* bar = b.bar;
        __builtin_amdgcn_s_waitcnt(0);
        unsigned nloc = b.st[0], nx = b.st[1];
        if (nloc == 0u) { xcd_barrier_complete(bar, b.x, nloc, nx); b.st[0] = nloc; b.st[1] = nx; }
        const unsigned old = xb_add(&bar[XB_XSUB(b.x)], 1u);
        const unsigned gen = old / nloc;
        if (old + 1u == (gen + 1u) * nloc) {
            __builtin_amdgcn_fence(__ATOMIC_RELEASE, "agent");
            asm volatile("s_waitcnt vmcnt(0)" ::: "memory");
            const unsigned og = xb_add(&bar[XB_TOP], 1u);
            const unsigned tg = og / nx;
            if (og + 1u == (tg + 1u) * nx) xb_add(&bar[XB_TOPGEN], 1u);
            else XB_SPIN(xb_ld(&bar[XB_TOPGEN]) == tg, bar);
            __builtin_amdgcn_fence(__ATOMIC_ACQUIRE, "agent");
            xb_add(&bar[XB_XGEN(b.x)], 1u);
            asm volatile("s_waitcnt vmcnt(0)" ::: "memory");
        } else {
            XB_SPIN(xb_ld(&bar[XB_XGEN(b.x)]) == gen, bar);
            __builtin_amdgcn_fence(__ATOMIC_ACQUIRE, "agent");
            asm volatile("s_waitcnt vmcnt(0)" ::: "memory");
        }
    }
    __syncthreads();
}

namespace pg8 {
constexpr int BM = 256, BK = 64, HALF = 128, HTB = HALF * BK * 2, STAGE_BYTES = 8 * HTB, NXCD = 8, WGM = 8;
__device__ __forceinline__ int lds_byte(int r, int c) { const int st = (r >> 4) * 2 + (c >> 5), rr = r & 15, cc = c & 31, ob = rr * 64 + cc * 2; return st * 1024 + (ob ^ (((ob >> 9) & 1) << 5)); }
__device__ __forceinline__ void stage_rc(int b, int& R, int& C) { const int st = b / 1024, sb = b % 1024, swz = sb ^ (((sb >> 9) & 1) << 5); R = (st >> 1) * 16 + swz / 64; C = (st & 1) * 32 + (swz % 64) / 2; }
__device__ __forceinline__ int brow(int R) { return 64 * (R >> 5) + 16 * ((R & 15) >> 2) + 4 * ((R >> 4) & 1) + (R & 3); }
__device__ __forceinline__ int brow1(int R) { return 64 * (R >> 5) + 8 * ((R & 15) >> 2) + 4 * ((R >> 4) & 1) + (R & 3); }

struct Unit { int pm, pn, e; };

__device__ __forceinline__ bool order_next(int i, int G, int c, int nM, int nN, int& pm, int& pn) {
    const int nwg = nM * nN; const long L = (long)i * G + c; if (L >= nwg) return false;
    int wgid = (int)L; { const int q = nwg / NXCD, r = nwg % NXCD, xcd = wgid % NXCD, off = wgid / NXCD; wgid = (xcd < r ? xcd * (q + 1) : r * (q + 1) + (xcd - r) * q) + off; }
    const int nig = WGM * nN, gid = wgid / nig, fm = gid * WGM, gsz = (nM - fm) < WGM ? (nM - fm) : WGM;
    pm = fm + ((wgid % nig) % gsz); pn = (wgid % nig) / gsz; return true;
}

struct DenseSched {
    static constexpr bool GATHER = false;
    int nM, nN, G, c, KB; const char* Bt;
    __device__ __forceinline__ bool next(int i, Unit& u) const { u.e = 0; return order_next(i, G, c, nM, nN, u.pm, u.pn); }
    __device__ __forceinline__ const char* bbase(const Unit& u) const { return Bt + (size_t)u.pn * BM * KB; }
    __device__ __forceinline__ const char* abase(const char* A, const Unit& u) const { return A + (size_t)u.pm * BM * KB; }
    __device__ __forceinline__ void aoffs(int ui, const Unit& u, int tid, unsigned (&ao)[2][2]) const {}
};
struct DenseSchedG {
    static constexpr bool GATHER = true;
    int nM, nN, G, c, KB; const char* Bt;
    __device__ __forceinline__ bool next(int i, Unit& u) const { u.e = 0; return order_next(i, G, c, nM, nN, u.pm, u.pn); }
    __device__ __forceinline__ const char* bbase(const Unit& u) const { return Bt + (size_t)u.pn * BM * KB; }
    __device__ __forceinline__ const char* abase(const char* A, const Unit& u) const { return A; }
    __device__ __forceinline__ void aoffs(int ui, const Unit& u, int tid, unsigned (&ao)[2][2]) const {
        asm volatile("" : "+v"(tid));
#pragma unroll
        for (int i = 0; i < 2; ++i) { int R, C; stage_rc(tid * 16 + i * 8192, R, C);
#pragma unroll
            for (int h = 0; h < 2; ++h) ao[h][i] = (unsigned)(u.pm * BM + h * HALF + R) * (unsigned)KB + (unsigned)C * 2u; }
    }
};
template <int MODE> struct GroupSched {
    static constexpr bool GATHER = true;
    int nM, nN, G, c, KB, pn0; const char* Bt; size_t estride; const LAS int* te; const LAS unsigned* rt;
    __device__ __forceinline__ bool next(int i, Unit& u) const { if (!order_next(i, G, c, nM, nN, u.pm, u.pn)) return false; u.e = __builtin_amdgcn_readfirstlane(te[u.pm]); return true; }
    __device__ __forceinline__ const char* bbase(const Unit& u) const { return Bt + (size_t)u.e * estride + (size_t)(pn0 + u.pn) * BM * KB; }
    __device__ __forceinline__ void aoffs(int ui, const Unit& u, int tid, unsigned (&ao)[2][2]) const {
        asm volatile("" : "+v"(tid));
#pragma unroll
        for (int i = 0; i < 2; ++i) { int R, C; stage_rc(tid * 16 + i * 8192, R, C);
#pragma unroll
            for (int h = 0; h < 2; ++h) { if (MODE == 1) ao[h][i] = rt[ui * 256 + h * HALF + R] + (unsigned)C * 2u; else ao[h][i] = (unsigned)(u.pm * BM + h * HALF + R) * (unsigned)KB + (unsigned)C * 2u; } }
    }
    __device__ __forceinline__ const char* abase(const char* A, const Unit& u) const { return A; }
};

__device__ __forceinline__ unsigned cvt_pk_bf16(float lo, float hi) { unsigned r; asm volatile("v_cvt_pk_bf16_f32 %0, %1, %2" : "=v"(r) : "v"(lo), "v"(hi)); return r; }

typedef int v8i __attribute__((ext_vector_type(8)));
typedef int v4i __attribute__((ext_vector_type(4)));
union Frag { v8i v; struct { v4i lo, hi; }; };
template <bool F8, int LAY, class Epi, class Sched>
__device__ __forceinline__ void gemm_phase(const int tid, LAS unsigned char* lds, const char* Abase, const int KB, const Sched& S, const Epi& E, const int sw = 0x7f7f7f7f, const int sa = 0x7f7f7f7f) {
    LAS unsigned char* const ept = lds + (EPT_OFF - RING_OFF);
    const int wid = __builtin_amdgcn_readfirstlane(tid >> 6), lane = tid & 63, wr = wid >> 2, wc = wid & 3, fr = lane & 15, fq = lane >> 4;
    const int nt = KB / 128;
    constexpr bool GA = Sched::GATHER;
    unsigned voffB[2], voffA[2];
#pragma unroll
    for (int i = 0; i < 2; ++i) { int R, C; stage_rc(tid * 16 + i * 8192, R, C); const int Rb = LAY ? brow1(R) : brow(R); voffB[i] = (unsigned)Rb * (unsigned)KB + (unsigned)C * 2u; voffA[i] = (unsigned)R * (unsigned)KB + (unsigned)C * 2u; }
    const size_t kstep = (size_t)(BK * 2);
    const size_t hstep = (size_t)HALF * KB;
    const size_t hstepB = (size_t)(LAY ? 32 : 8) * KB;
    const unsigned ldsw = (unsigned)wid * 1024u;
    const int aoff = lds_byte(wr * 64 + fr, fq * 8), boff = lds_byte(wc * 32 + fr, fq * 8);
#define PG8_SA(b, h) (((b) * 2 + (h)) * HTB)
#define PG8_SB(b, h) ((4 + (b) * 2 + (h)) * HTB)
#define PG8_STAGE(bufoff, gbase, voff) do { _Pragma("unroll") for (int _i = 0; _i < 2; ++_i) \
        __builtin_amdgcn_global_load_lds((const unsigned*)((const char*)(gbase) + (voff)[_i]), (LAS unsigned*)(lds + (bufoff) + ldsw + _i * 8192), 16, 0, 0); } while (0)
#define PG8_STAGEA(bufoff, gbase, half) do { if constexpr (GA) { PG8_STAGE(bufoff, gbase, ca[half]); } else { PG8_STAGE(bufoff, (gbase) + (half) * hstep, voffA); } } while (0)
#define PG8_LD1(dst, off) do { const v4i _lo = *(const LAS v4i*)(lds + (off)), _hi = *(const LAS v4i*)(lds + (off) + 1024); dst.lo = _lo; dst.hi = _hi; } while (0)
#define PG8_LDA(dst, b, h) do { _Pragma("unroll") for (int m = 0; m < 4; ++m) PG8_LD1(dst[m], PG8_SA(b, h) + aoff + m * 2048); } while (0)
#define PG8_LDB(dst, b, h) do { _Pragma("unroll") for (int n = 0; n < 2; ++n) PG8_LD1(dst[n], PG8_SB(b, h) + boff + n * 2048); } while (0)
#define PG8_MMA(ai, bj, At, Bt) do { __builtin_amdgcn_s_setprio(1); _Pragma("unroll") for (int m = 0; m < 4; ++m) _Pragma("unroll") for (int n = 0; n < 2; ++n) { \
        if constexpr (F8) { acc[ai][bj][m][n] = __builtin_amdgcn_mfma_scale_f32_16x16x128_f8f6f4(Bt[n].v, At[m].v, acc[ai][bj][m][n], 0, 0, 0, sw, 0, sa); } \
        else { acc[ai][bj][m][n] = __builtin_amdgcn_mfma_f32_16x16x32_bf16(__builtin_bit_cast(bf16x8, Bt[n].lo), __builtin_bit_cast(bf16x8, At[m].lo), acc[ai][bj][m][n], 0, 0, 0); \
               acc[ai][bj][m][n] = __builtin_amdgcn_mfma_f32_16x16x32_bf16(__builtin_bit_cast(bf16x8, Bt[n].hi), __builtin_bit_cast(bf16x8, At[m].hi), acc[ai][bj][m][n], 0, 0, 0); } } \
        __builtin_amdgcn_s_setprio(0); } while (0)
#define PG8_WAIT_V(n) asm volatile("s_waitcnt vmcnt(" #n ")" ::: "memory")
#define PG8_WAIT_L(n) asm volatile("s_waitcnt lgkmcnt(" #n ")" ::: "memory")
#define PG8_BAR __builtin_amdgcn_s_barrier()
#define PG8_SCHED __builtin_amdgcn_sched_barrier(0)
    Unit cur, nxt; int ui = 0;
    if (!S.next(0, cur)) return;
    f32x4 acc[2][2][4][2];
#pragma unroll
    for (int a = 0; a < 2; ++a)
#pragma unroll
        for (int b = 0; b < 2; ++b)
#pragma unroll
            for (int m = 0; m < 4; ++m)
#pragma unroll
                for (int n = 0; n < 2; ++n) acc[a][b][m][n] = (f32x4){0.f, 0.f, 0.f, 0.f};
    Frag At[4], B0[2], B1[2];
    unsigned ca[2][2], na[2][2];
    if constexpr (GA) S.aoffs(0, cur, tid, ca);
    const char* cB = S.bbase(cur); const char* cA = S.abase(Abase, cur);
    PG8_STAGE(PG8_SB(0, 0), cB, voffB); PG8_STAGEA(PG8_SA(0, 0), cA, 0); PG8_STAGE(PG8_SB(0, 1), cB + hstepB, voffB); PG8_STAGEA(PG8_SA(0, 1), cA, 1);
    if (wr == 1) PG8_BAR;
    PG8_WAIT_V(4); PG8_BAR;
    PG8_STAGE(PG8_SB(1, 0), cB + kstep, voffB); PG8_STAGEA(PG8_SA(1, 0), cA + kstep, 0); PG8_STAGE(PG8_SB(1, 1), cB + hstepB + kstep, voffB);
    PG8_WAIT_V(6); PG8_BAR;
    for (;;) {
        const bool has_next = S.next(ui + 1, nxt);
        const char* nB = has_next ? S.bbase(nxt) : cB; const char* nA = has_next ? S.abase(Abase, nxt) : cA;
        if constexpr (GA) {
            if (has_next) S.aoffs(ui + 1, nxt, tid, na);
            else {
#pragma unroll
                for (int h = 0; h < 2; ++h)
#pragma unroll
                    for (int i = 0; i < 2; ++i) na[h][i] = ca[h][i];
            }
        }
#pragma nounroll
        for (int t = 0; t < nt; t += 2) {
            const bool last = (t == nt - 2);
            const char* a1 = cA + (size_t)(t + 1) * kstep;
            const char* a2 = last ? nA : cA + (size_t)(t + 2) * kstep; const char* b2 = last ? nB : cB + (size_t)(t + 2) * kstep;
            const char* a3 = a2 + kstep; const char* b3 = b2 + kstep;
            if (t == 0 && wid == 0) { int tz = tid; asm volatile("" : "+v"(tz)); E.prefetch(cur, ept + (ui & 1) * 2048, tz & 63); }
            PG8_LDB(B0, 0, 0); PG8_SCHED; PG8_LDA(At, 0, 0); PG8_STAGEA(PG8_SA(1, 1), a1, 1);
            PG8_WAIT_L(8); PG8_BAR; PG8_WAIT_L(0); PG8_MMA(0, 0, At, B0); PG8_BAR; PG8_SCHED;
            if constexpr (GA) { if (last) {
#pragma unroll
                for (int h = 0; h < 2; ++h)
#pragma unroll
                    for (int i = 0; i < 2; ++i) ca[h][i] = na[h][i];
            } }
            PG8_LDB(B1, 0, 1); PG8_STAGE(PG8_SB(0, 0), b2, voffB);
            PG8_BAR; PG8_WAIT_L(0); PG8_MMA(0, 1, At, B1); PG8_BAR;
            PG8_LDA(At, 0, 1); PG8_STAGEA(PG8_SA(0, 0), a2, 0);
            PG8_BAR; PG8_WAIT_L(0); PG8_MMA(1, 0, At, B0); PG8_BAR; PG8_SCHED;
            PG8_STAGE(PG8_SB(0, 1), b2 + hstepB, voffB);
            PG8_WAIT_V(6); PG8_BAR; PG8_MMA(1, 1, At, B1); PG8_BAR;
            PG8_LDB(B0, 1, 0); PG8_SCHED; PG8_LDA(At, 1, 0); PG8_STAGEA(PG8_SA(0, 1), a2, 1);
            PG8_WAIT_L(8); PG8_BAR; PG8_WAIT_L(0); PG8_MMA(0, 0, At, B0); PG8_BAR; PG8_SCHED;
            PG8_LDB(B1, 1, 1); PG8_STAGE(PG8_SB(1, 0), b3, voffB);
            PG8_BAR; PG8_WAIT_L(0); PG8_MMA(0, 1, At, B1); PG8_BAR;
            PG8_LDA(At, 1, 1); PG8_STAGEA(PG8_SA(1, 0), a3, 0);
            PG8_BAR; PG8_WAIT_L(0); PG8_MMA(1, 0, At, B0); PG8_BAR; PG8_SCHED;
            PG8_STAGE(PG8_SB(1, 1), b3 + hstepB, voffB);
            PG8_WAIT_V(6); PG8_BAR; PG8_MMA(1, 1, At, B1); PG8_BAR;
        }
        { int tz = tid; asm volatile("" : "+v"(tz)); const int l2 = tz & 63; E(acc, cur, wr, wc, l2 & 15, l2 >> 4, ept + (ui & 1) * 2048); }
        if (!has_next) break;
#pragma unroll
        for (int a = 0; a < 2; ++a)
#pragma unroll
            for (int b = 0; b < 2; ++b)
#pragma unroll
                for (int m = 0; m < 4; ++m)
#pragma unroll
                    for (int n = 0; n < 2; ++n) acc[a][b][m][n] = (f32x4){0.f, 0.f, 0.f, 0.f};
        cur = nxt; cB = nB; cA = nA; ++ui;
    }
    PG8_WAIT_V(0);
    if (wr == 0) PG8_BAR;
    PG8_BAR;
#undef PG8_SA
#undef PG8_SB
#undef PG8_STAGE
#undef PG8_STAGEA
#undef PG8_LD1
#undef PG8_LDA
#undef PG8_LDB
#undef PG8_MMA
#undef PG8_WAIT_V
#undef PG8_WAIT_L
#undef PG8_BAR
#undef PG8_SCHED
}

__device__ __forceinline__ unsigned cvt4_fp8(float a, float b, float c, float d) { int w = 0; w = __builtin_amdgcn_cvt_pk_fp8_f32(a, b, w, false); w = __builtin_amdgcn_cvt_pk_fp8_f32(c, d, w, true); return (unsigned)w; }
__device__ __forceinline__ v4u pack8_bf16(const f32x4 a, const f32x4 b) { v4u w; w.x = cvt_pk_bf16(a[0], a[1]); w.y = cvt_pk_bf16(a[2], a[3]); w.z = cvt_pk_bf16(b[0], b[1]); w.w = cvt_pk_bf16(b[2], b[3]); return w; }
__device__ __forceinline__ void unpack8(const v4u w, f32x4& a, f32x4& b) { a = (f32x4){bflo(w[0]), bfhi(w[0]), bflo(w[1]), bfhi(w[1])}; b = (f32x4){bflo(w[2]), bfhi(w[2]), bflo(w[3]), bfhi(w[3])}; }
struct EpiBf16Scale {
    bf16* O; int ldc; const float* rs;
    __device__ __forceinline__ void prefetch(const Unit& u, LAS unsigned char* tab, int lane) const {
        if (rs) __builtin_amdgcn_global_load_lds((const unsigned*)(rs + u.pm * BM + 4 * lane), (LAS unsigned*)tab, 16, 0, 0);
    }
    __device__ __forceinline__ void operator()(const f32x4 (&acc)[2][2][4][2], const Unit& u, int wr, int wc, int fr, int fq, const LAS unsigned char* tab) const {
        const int row0 = u.pm * BM + wr * 64 + fr, col0 = u.pn * BM + wc * 64 + 8 * fq;
        float sc[8];
#pragma unroll
        for (int q = 0; q < 8; ++q) sc[q] = rs ? ((const LAS float*)tab)[wr * 64 + fr + (q >> 2) * HALF + (q & 3) * 16] : 1.f;
#pragma unroll
        for (int ai = 0; ai < 2; ++ai)
#pragma unroll
            for (int m = 0; m < 4; ++m) { const int row = row0 + ai * HALF + m * 16; const float s = sc[ai * 4 + m]; bf16* rowp = O + (size_t)row * ldc + col0;
#pragma unroll
                for (int bj = 0; bj < 2; ++bj) *(v4u*)(rowp + 32 * bj) = pack8_bf16(acc[ai][bj][m][0] * s, acc[ai][bj][m][1] * s); }
    }
};
struct EpiResF32 {
    bf16* O; const bf16* X; int ldc; unsigned char* O8;
    __device__ __forceinline__ void prefetch(const Unit&, LAS unsigned char*, int) const {}
    __device__ __forceinline__ void operator()(const f32x4 (&acc)[2][2][4][2], const Unit& u, int wr, int wc, int fr, int fq, const LAS unsigned char*) const {
        const int row0 = u.pm * BM + wr * 64 + fr, col0 = u.pn * BM + wc * 64 + 8 * fq;
#pragma unroll
        for (int ai = 0; ai < 2; ++ai) {
            v4u xw[4][2];
#pragma unroll
            for (int m = 0; m < 4; ++m)
#pragma unroll
                for (int bj = 0; bj < 2; ++bj) xw[m][bj] = *(const v4u*)(X + (size_t)(row0 + ai * HALF + m * 16) * ldc + col0 + 32 * bj);
#pragma unroll
            for (int m = 0; m < 4; ++m) { const size_t ro = (size_t)(row0 + ai * HALF + m * 16) * ldc + col0;
#pragma unroll
                for (int bj = 0; bj < 2; ++bj) { f32x4 x0, x1; unpack8(xw[m][bj], x0, x1);
                    const f32x4 v0 = acc[ai][bj][m][0] + x0, v1 = acc[ai][bj][m][1] + x1;
                    *(v4u*)(O + ro + 32 * bj) = pack8_bf16(v0, v1);
                    v2u w8; w8.x = cvt4_fp8(v0[0], v0[1], v0[2], v0[3]); w8.y = cvt4_fp8(v1[0], v1[1], v1[2], v1[3]);
                    *(v2u*)(O8 + ro + 32 * bj) = w8; } }
        }
    }
};
struct EpiGateUp {
    unsigned char* Hp; const float* rr;
    __device__ __forceinline__ void prefetch(const Unit& u, LAS unsigned char* tab, int lane) const {
        __builtin_amdgcn_global_load_lds((const unsigned*)(rr + u.pm * BM + 4 * lane), (LAS unsigned*)tab, 16, 0, 0);
    }
    __device__ __forceinline__ void operator()(const f32x4 (&acc)[2][2][4][2], const Unit& u, int wr, int wc, int fr, int fq, const LAS unsigned char* tab) const {
        const int row0 = u.pm * BM + wr * 64 + fr, col0 = u.pn * HALF + wc * 32 + 8 * fq;
        float sc[8];
#pragma unroll
        for (int q = 0; q < 8; ++q) sc[q] = ((const LAS float*)tab)[wr * 64 + fr + (q >> 2) * HALF + (q & 3) * 16];
#pragma unroll
        for (int ai = 0; ai < 2; ++ai)
#pragma unroll
            for (int m = 0; m < 4; ++m) { const int row = row0 + ai * HALF + m * 16; const float s = sc[ai * 4 + m];
                float h[8];
#pragma unroll
                for (int n = 0; n < 2; ++n)
#pragma unroll
                    for (int j = 0; j < 4; ++j) { const float g = acc[ai][0][m][n][j] * s, up = acc[ai][1][m][n][j] * s; h[n * 4 + j] = g * fsigmoid(g) * up; }
                v2u w; w.x = cvt4_fp8(h[0], h[1], h[2], h[3]); w.y = cvt4_fp8(h[4], h[5], h[6], h[7]);
                *(v2u*)(Hp + (size_t)row * ED + col0) = w; }
    }
};
struct EpiDown {
    unsigned char* S0; unsigned char* S1; unsigned char* S8; const float* rw; const int* rdst;
    __device__ __forceinline__ void prefetch(const Unit& u, LAS unsigned char* tab, int lane) const {
        __builtin_amdgcn_global_load_lds((const unsigned*)(rw + u.pm * BM + 4 * lane), (LAS unsigned*)tab, 16, 0, 0);
        __builtin_amdgcn_global_load_lds((const unsigned*)(rdst + u.pm * BM + 4 * lane), (LAS unsigned*)(tab + 1024), 16, 0, 0);
    }
    __device__ __forceinline__ void operator()(const f32x4 (&acc)[2][2][4][2], const Unit& u, int wr, int wc, int fr, int fq, const LAS unsigned char* tab) const {
        const int row0 = u.pm * BM + wr * 64 + fr, col0 = u.pn * BM + wc * 64 + 16 * fq;
        float sc[8]; int ds[8];
#pragma unroll
        for (int q = 0; q < 8; ++q) { const int lr = wr * 64 + fr + (q >> 2) * HALF + (q & 3) * 16; sc[q] = ((const LAS float*)tab)[lr]; ds[q] = ((const LAS int*)(tab + 1024))[lr]; }
#pragma unroll
        for (int ai = 0; ai < 2; ++ai)
#pragma unroll
            for (int m = 0; m < 4; ++m) { const float s = sc[ai * 4 + m] * SLOT_SCALE; const int dst = ds[ai * 4 + m];
                if (dst >= 0) { unsigned char* rowp = (dst < 4 * T ? S0 + (size_t)dst * D : dst < 8 * T ? S1 + (size_t)(dst - 4 * T) * D : S8 + (size_t)(dst - 8 * T) * D) + col0;
                    v4u w;
#pragma unroll
                    for (int bj = 0; bj < 2; ++bj) { const f32x4 v0 = acc[ai][bj][m][0] * s, v1 = acc[ai][bj][m][1] * s;
                        w[2 * bj] = cvt4_fp8(v0[0], v0[1], v0[2], v0[3]); w[2 * bj + 1] = cvt4_fp8(v1[0], v1[1], v1[2], v1[3]); }
                    *(v4u*)rowp = w; } }
    }
};
struct EpiPle {
    bf16* H3; const bf16* H2; const bf16* PP; const float* ssq2; float* ssq3;
    __device__ __forceinline__ void prefetch(const Unit&, LAS unsigned char*, int) const {}
    __device__ __forceinline__ void operator()(const f32x4 (&acc)[2][2][4][2], const Unit& u, int wr, int wc, int fr, int fq, const LAS unsigned char*) const {
        const int row0 = u.pm * BM + wr * 64 + fr, col0 = u.pn * BM + wc * 64 + 8 * fq;
        float sq[8];
#pragma unroll
        for (int q = 0; q < 8; ++q) sq[q] = ssq2[row0 + (q >> 2) * HALF + (q & 3) * 16];
#pragma unroll
        for (int ai = 0; ai < 2; ++ai)
#pragma unroll
            for (int mp = 0; mp < 2; ++mp) {
                v4u hw[2][2], pw[2][2];
#pragma unroll
                for (int mm = 0; mm < 2; ++mm)
#pragma unroll
                    for (int bj = 0; bj < 2; ++bj) { const size_t o = (size_t)(row0 + ai * HALF + (2 * mp + mm) * 16) * D + col0 + 32 * bj; hw[mm][bj] = *(const v4u*)(H2 + o); pw[mm][bj] = *(const v4u*)(PP + o); }
#pragma unroll
                for (int mm = 0; mm < 2; ++mm) { const int m = 2 * mp + mm, row = row0 + ai * HALF + m * 16;
                    const float r = __builtin_amdgcn_rsqf(sq[ai * 4 + m] * (1.f / D) + EPS);
                    const size_t ro = (size_t)row * D + col0; float ss = 0.f;
#pragma unroll
                    for (int bj = 0; bj < 2; ++bj) { f32x4 h0, h1, p0, p1; unpack8(hw[mm][bj], h0, h1); unpack8(pw[mm][bj], p0, p1);
                        f32x4 o0, o1;
#pragma unroll
                        for (int j = 0; j < 4; ++j) { o0[j] = h0[j] + fsigmoid(acc[ai][bj][m][0][j] * r) * p0[j]; o1[j] = h1[j] + fsigmoid(acc[ai][bj][m][1][j] * r) * p1[j]; ss += o0[j] * o0[j] + o1[j] * o1[j]; }
                        *(v4u*)(H3 + ro + 32 * bj) = pack8_bf16(o0, o1); }
                    ss += __shfl_xor(ss, 16); ss += __shfl_xor(ss, 32);
                    if (fq == 0) ssq3[(size_t)(u.pn * 4 + wc) * T + row] = ss; }
            }
    }
};
}

struct Frame {
    LAS unsigned char* lds;
    int tid, lane, wave, G, bx;
    unsigned char* ws;
    const float* in[21];
    float* out;
};
enum { I_X = 0, I_P, I_NMIX, I_WIN, I_CONVW, I_GCONV, I_GSB, I_WOUT, I_NFFN, I_WR, I_RB, I_WEG, I_WEU, I_WED, I_WSG, I_WSU, I_WSD, I_NPLE, I_WPG, I_WPP, I_NFIN };

__device__ __forceinline__ void p0_transpose_item(const float* W, int N, bf16* WT, int ldk, int k0, int n0, int row_off, const float* g64, LAS float* scr, int lane) {
    const int n4 = lane & 15, kr = lane >> 4;
    f32x4 v[16];
    const float* src = W + (size_t)(k0 + kr) * N + n0 + 4 * n4;
#pragma unroll
    for (int i = 0; i < 16; ++i) v[i] = *(const GAS f32x4*)(src + (size_t)(4 * i) * N);
    const int c = lane >> 3, nn = lane & 7;
    f32x4 ga = (f32x4){1.f, 1.f, 1.f, 1.f}, gb = ga;
    if (g64) { ga = *(const GAS f32x4*)(g64 + 8 * c); gb = *(const GAS f32x4*)(g64 + 8 * c + 4); }
#pragma unroll
    for (int i = 0; i < 16; ++i) { LAS float* d = scr + (4 * i + kr) * 65 + 4 * n4; d[0] = v[i].x; d[1] = v[i].y; d[2] = v[i].z; d[3] = v[i].w; }
    LDS_WAIT(); asm volatile("" ::: "memory");
#pragma unroll
    for (int j = 0; j < 8; ++j) { const int n = nn + 8 * j; const LAS float* s = scr + (8 * c) * 65 + n;
        v4u o; o.x = pg8::cvt_pk_bf16(s[0] * ga.x, s[65] * ga.y); o.y = pg8::cvt_pk_bf16(s[130] * ga.z, s[195] * ga.w); o.z = pg8::cvt_pk_bf16(s[260] * gb.x, s[325] * gb.y); o.w = pg8::cvt_pk_bf16(s[390] * gb.z, s[455] * gb.w);
        *(GAS v4u*)(WT + (size_t)(row_off + n) * ldk + k0 + 8 * c) = o; }
    LDS_WAIT(); asm volatile("" ::: "memory");
}
__device__ __forceinline__ void p0_transpose_item_f8(const float* W, int N, unsigned char* WT, int ldk, int k0, int n0, int row_off, int mode, const float* g64, LAS float* scr, int lane) {
    const int n4 = lane & 15, kr = lane >> 4;
    f32x4 v[16];
    const float* src = W + (size_t)(k0 + kr) * N + n0 + 4 * n4;
#pragma unroll
    for (int i = 0; i < 16; ++i) v[i] = *(const GAS f32x4*)(src + (size_t)(4 * i) * N);
    const int c = lane >> 4, nn = lane & 15;
    float g[16];
#pragma unroll
    for (int q = 0; q < 4; ++q) { f32x4 t = (f32x4){1.f, 1.f, 1.f, 1.f}; if (g64) t = *(const GAS f32x4*)(g64 + 16 * c + 4 * q); g[4 * q] = 64.f * t.x; g[4 * q + 1] = 64.f * t.y; g[4 * q + 2] = 64.f * t.z; g[4 * q + 3] = 64.f * t.w; }
#pragma unroll
    for (int i = 0; i < 16; ++i) { LAS float* d = scr + (4 * i + kr) * 65 + 4 * n4; d[0] = v[i].x; d[1] = v[i].y; d[2] = v[i].z; d[3] = v[i].w; }
    LDS_WAIT(); asm volatile("" ::: "memory");
#pragma unroll
    for (int j = 0; j < 4; ++j) { const int n = nn + 16 * j; const LAS float* s = scr + (16 * c) * 65 + n;
        v4u o;
        o.x = pg8::cvt4_fp8(s[0] * g[0], s[65] * g[1], s[130] * g[2], s[195] * g[3]); o.y = pg8::cvt4_fp8(s[260] * g[4], s[325] * g[5], s[390] * g[6], s[455] * g[7]);
        o.z = pg8::cvt4_fp8(s[520] * g[8], s[585] * g[9], s[650] * g[10], s[715] * g[11]); o.w = pg8::cvt4_fp8(s[780] * g[12], s[845] * g[13], s[910] * g[14], s[975] * g[15]);
        const int hid = n0 + n, drow = mode == 0 ? row_off + n : 16 * (hid >> 3) + 8 * (mode - 1) + (hid & 7);
        *(GAS v4u*)(WT + (size_t)drow * ldk + k0 + 16 * c) = o; }
    LDS_WAIT(); asm volatile("" ::: "memory");
}
constexpr int P0_I_WIN = (D / 64) * (NPROJ / 64), P0_I_WOUT = (D / 64) * (D / 64), P0_I_WR = (D / 64) * (NE / 64), P0_I_WPG = (D / 64) * (D / 64), P0_I_WPP = (PLE / 64) * (D / 64);
constexpr int P0_I_EXP = 768, P0_NITEMS = P0_I_WIN + P0_I_WOUT + P0_I_WR + P0_I_WPG + P0_I_WPP + 65 * P0_I_EXP;
__device__ __forceinline__ void p0_item(Frame& F, int it, LAS float* scr) {
    unsigned char* ws = F.ws; const int lane = F.lane;
    if (it < P0_I_WIN) { const int kb = it / (NPROJ / 64), nb = it % (NPROJ / 64); p0_transpose_item(F.in[I_WIN], NPROJ, (bf16*)(ws + WS_WIN), D, 64 * kb, 64 * nb, 64 * nb, F.in[I_NMIX] + 64 * kb, scr, lane); return; } it -= P0_I_WIN;
    if (it < P0_I_WOUT) { const int kb = it / (D / 64), nb = it % (D / 64), k0 = 64 * kb; const float* g = k0 < CW ? F.in[I_GCONV] + k0 : F.in[I_GSB] + (k0 - CW);
        p0_transpose_item(F.in[I_WOUT], D, (bf16*)(ws + WS_WOUT), D, k0, 64 * nb, 64 * nb, g, scr, lane); return; } it -= P0_I_WOUT;
    if (it < P0_I_WR) { const int kb = it; p0_transpose_item(F.in[I_WR], NE, (bf16*)(ws + WS_WR), D, 64 * kb, 0, 0, F.in[I_NFFN] + 64 * kb, scr, lane); return; } it -= P0_I_WR;
    if (it < P0_I_WPG) { const int kb = it / (D / 64), nb = it % (D / 64); p0_transpose_item_f8(F.in[I_WPG], D, ws + WS_WPG, D, 64 * kb, 64 * nb, 64 * nb, 0, F.in[I_NPLE] + 64 * kb, scr, lane); return; } it -= P0_I_WPG;
    if (it < P0_I_WPP) { const int kb = it / (D / 64), nb = it % (D / 64); p0_transpose_item(F.in[I_WPP], D, (bf16*)(ws + WS_WPP), PLE, 64 * kb, 64 * nb, 64 * nb, nullptr, scr, lane); return; } it -= P0_I_WPP;
    const int e = it / P0_I_EXP, r = it % P0_I_EXP, sub = r / 256, q = r % 256;
    if (sub < 2) {
        const float* src = e < NE ? (sub == 0 ? F.in[I_WEG] : F.in[I_WEU]) + (size_t)e * D * ED : (sub == 0 ? F.in[I_WSG] : F.in[I_WSU]);
        const int kb = q / (ED / 64), nb = q % (ED / 64), n0 = 64 * nb;
        p0_transpose_item_f8(src, ED, ws + WS_WGU + (size_t)e * 1024 * D, D, 64 * kb, n0, 0, 1 + sub, F.in[I_NFFN] + 64 * kb, scr, lane);
    } else {
        const float* src = e < NE ? F.in[I_WED] + (size_t)e * ED * D : F.in[I_WSD];
        const int kb = q / (D / 64), nb = q % (D / 64);
        p0_transpose_item_f8(src, D, ws + WS_WDN + (size_t)e * D * ED, ED, 64 * kb, 64 * nb, 64 * nb, 0, nullptr, scr, lane);
    }
}
__device__ __forceinline__ void p0_prologue(Frame& F) {
    LAS float* scr = (LAS float*)(F.lds + RING_OFF + F.wave * 16896);
    const int gw = F.bx * NWAVES + F.wave, NGW = F.G * NWAVES;
    {
        bf16* XB = (bf16*)F.out; float* rmix = (float*)(F.ws + WS_RMIX); const float* x = F.in[I_X];
        for (int m = gw; m < T; m += NGW) {
            const GAS f32x4* xr = (const GAS f32x4*)(x + (size_t)m * D) + F.lane;
            f32x4 v[8]; float s = 0.f;
#pragma unroll
            for (int j = 0; j < 8; ++j) { v[j] = xr[64 * j]; s += (v[j].x * v[j].x + v[j].y * v[j].y) + (v[j].z * v[j].z + v[j].w * v[j].w); }
            s = wave_sum(s);
            if (F.lane == 0) rmix[m] = __builtin_amdgcn_rsqf(s * (1.f / D) + EPS);
            GAS v2u* o8 = (GAS v2u*)(XB + (size_t)m * D) + F.lane;
#pragma unroll
            for (int j = 0; j < 8; ++j) { v2u w; w.x = pk2(v[j].x, v[j].y); w.y = pk2(v[j].z, v[j].w); o8[64 * j] = w; }
        }
    }
    {
        const float* p = F.in[I_P]; bf16* PB = (bf16*)(F.ws + WS_PB);
        const int nchunk = T * PLE / 8, gt = F.bx * NTHR + F.tid, NGT = F.G * NTHR;
        for (int c = gt; c < nchunk; c += NGT) { const f32x4 a = *(const GAS f32x4*)(p + (size_t)c * 8), b = *(const GAS f32x4*)(p + (size_t)c * 8 + 4);
            v4u w; w.x = pk2(a.x, a.y); w.y = pk2(a.z, a.w); w.z = pk2(b.x, b.y); w.w = pk2(b.z, b.w); *(GAS v4u*)(PB + (size_t)c * 8) = w; }
    }
    for (int it = gw; it < P0_NITEMS; it += NGW) p0_item(F, it, scr);
}

__device__ __forceinline__ unsigned off_b(unsigned row, unsigned ch) { return 256u * row + 16u * (ch ^ (((row & 3) << 2) | ((row >> 2) & 3))); }
#define MFMA32(a, b, c) __builtin_amdgcn_mfma_f32_32x32x16_bf16((a), (b), (c), 0, 0, 0)

__device__ __forceinline__ void conv_item(Frame& F, int it) {
    const bf16* proj = (const bf16*)(F.ws + WS_PROJ); bf16* ymix = (bf16*)F.out + (size_t)T * D;
    const float* cw = F.in[I_CONVW]; const int lane = F.lane;
    float w0[16], w1[16], w2[16], u1[16], u2[16];
#pragma unroll
    for (int j = 0; j < 2; ++j)
#pragma unroll
        for (int i = 0; i < 8; ++i) { const int c = 512 * j + 8 * lane + i; w0[8 * j + i] = cw[c]; w1[8 * j + i] = cw[CW + c]; w2[8 * j + i] = cw[2 * CW + c]; u1[8 * j + i] = 0.f; u2[8 * j + i] = 0.f; }
    const int t0 = 16 * it; const bool seq_start = (t0 & (SEQ - 1)) == 0;
    for (int tt = -2; tt < 16; ++tt) {
        if (tt < 0 && seq_start) continue;
        const size_t t = (size_t)(t0 + tt);
        const bf16* pr = proj + t * NPROJ + 8 * lane;
        float u[16], cb[16];
#pragma unroll
        for (int j = 0; j < 2; ++j) { const v4u h = *(const GAS v4u*)(pr + 512 * j), c = *(const GAS v4u*)(pr + 2 * CW + 512 * j);
#pragma unroll
            for (int q = 0; q < 4; ++q) { u[8 * j + 2 * q] = bflo(h[q]) * bflo(c[q]); u[8 * j + 2 * q + 1] = bfhi(h[q]) * bfhi(c[q]); } }
        if (tt >= 0) {
#pragma unroll
            for (int j = 0; j < 2; ++j) { const v4u b = *(const GAS v4u*)(pr + CW + 512 * j);
#pragma unroll
                for (int q = 0; q < 4; ++q) { cb[8 * j + 2 * q] = bflo(b[q]); cb[8 * j + 2 * q + 1] = bfhi(b[q]); } }
            float y[16], ss = 0.f;
#pragma unroll
            for (int i = 0; i < 16; ++i) { y[i] = cb[i] * (w0[i] * u2[i] + w1[i] * u1[i] + w2[i] * u[i]); ss += y[i] * y[i]; }
            const float r = __builtin_amdgcn_rsqf(wave_sum(ss) * (1.f / CW) + EPS);
            bf16* yo = ymix + t * D + 8 * lane;
#pragma unroll
            for (int j = 0; j < 2; ++j) { v4u w; w.x = pk2(y[8 * j] * r, y[8 * j + 1] * r); w.y = pk2(y[8 * j + 2] * r, y[8 * j + 3] * r); w.z = pk2(y[8 * j + 4] * r, y[8 * j + 5] * r); w.w = pk2(y[8 * j + 6] * r, y[8 * j + 7] * r);
                *(GAS v4u*)(yo + 512 * j) = w; }
        }
#pragma unroll
        for (int i = 0; i < 16; ++i) { u2[i] = u1[i]; u1[i] = u[i]; }
    }
}

__device__ __forceinline__ bf16x8 pack8(float a0, float a1, float a2, float a3, float a4, float a5, float a6, float a7) {
    v4u p; p.x = pk2(a0, a1); p.y = pk2(a2, a3); p.z = pk2(a4, a5); p.w = pk2(a6, a7); return __builtin_bit_cast(bf16x8, p);
}
__device__ __forceinline__ void tr_read4(unsigned a_t0, unsigned a_t1, s16x4& r00, s16x4& r01, s16x4& r10, s16x4& r11) {
    asm volatile("ds_read_b64_tr_b16 %0, %4\n\tds_read_b64_tr_b16 %1, %5\n\tds_read_b64_tr_b16 %2, %4 offset:4096\n\tds_read_b64_tr_b16 %3, %5 offset:4096\n\ts_waitcnt lgkmcnt(0)"
                 : "=&v"(r00), "=&v"(r01), "=&v"(r10), "=&v"(r11) : "v"(a_t0), "v"(a_t1) : "memory");
}
constexpr float ATT_C = 0.08838834764831845f * 1.4426950408889634f;
constexpr float ATT_EXIT = -152.f;

__device__ __forceinline__ void attn_unit(Frame& F, int b, int qblk, int parity) {
    const int lane = F.lane, h = F.wave, r = lane & 31, hh = lane >> 5;
    const bf16* proj = (const bf16*)(F.ws + WS_PROJ); bf16* ymix = (bf16*)F.out + (size_t)T * D;
    const size_t rowbase = (size_t)b * SEQ; const int t0 = qblk * 32;
    LAS unsigned char* kt = F.lds + h * 16384; LAS unsigned char* vt = kt + 8192;
    LAS float* XS = (LAS float*)(F.lds + RT_OFF) + parity * 256;
    bf16x8 qf[8];
    { const bf16* qp = proj + (rowbase + t0 + r) * NPROJ + 3 * CW + h * HD + 8 * hh;
#pragma unroll
      for (int kk = 0; kk < 8; ++kk) qf[kk] = *(const GAS bf16x8*)(qp + 16 * kk); }
    f32x16 oacc[4];
#pragma unroll
    for (int c = 0; c < 4; ++c)
#pragma unroll
        for (int i = 0; i < 16; ++i) oacc[c][i] = 0.f;
    float L = 0.f;
    const unsigned pr = (unsigned)((r & 19) | ((r & 4) << 1) | ((r & 8) >> 1));
    const unsigned ktb = (unsigned)(size_t)kt, vtb = (unsigned)(size_t)vt;
    unsigned va[2][4];
    { const unsigned blk = (lane >> 4) & 1, q = (lane & 15) >> 2, p = lane & 3;
#pragma unroll
      for (int t = 0; t < 2; ++t)
#pragma unroll
          for (int c = 0; c < 4; ++c) va[t][c] = vtb + off_b(8 * hh + 4 * t + q, 4 * c + 2 * blk + (p >> 1)) + 8 * (p & 1); }
    unsigned loff[8];
#pragma unroll
    for (int i = 0; i < 8; ++i) { const unsigned row = 4 * i + (lane >> 4), ch = (lane & 15) ^ (((row & 3) << 2) | ((row >> 2) & 3)); loff[i] = (row * NPROJ + ch * 8) * 2; }
    const char* kvb = (const char*)(proj + rowbase * NPROJ + 4 * CW + h * HD);
#define ATT_DMA(ldsb, gp) do { _Pragma("unroll") for (int _i = 0; _i < 8; ++_i) \
        __builtin_amdgcn_global_load_lds((const unsigned*)((gp) + loff[_i]), (LAS unsigned*)((ldsb) + _i * 1024), 16, 0, 0); } while (0)
    { const char* g0 = kvb + (size_t)(qblk * 32) * NPROJ * 2; ATT_DMA(kt, g0); ATT_DMA(vt, g0 + CW * 2); }
    for (int kti = qblk; kti >= 0; --kti) {
        const int s0 = kti * 32;
        const char* gn = kvb + (size_t)((kti > 0 ? kti - 1 : 0) * 32) * NPROJ * 2;
        asm volatile("s_waitcnt vmcnt(8)" ::: "memory");
        f32x16 x;
#pragma unroll
        for (int i = 0; i < 16; ++i) x[i] = 0.f;
        bf16x8 kf[8];
#pragma unroll
        for (int kk = 0; kk < 8; ++kk) kf[kk] = *(const LAS bf16x8*)(kt + off_b(pr, 2 * kk + hh));
        LDS_WAIT();
        ATT_DMA(kt, gn);
#pragma unroll
        for (int kk = 0; kk < 8; ++kk) x = MFMA32(kf[kk], qf[kk], x);
        const bool diag = (kti == qblk);
        float zz[16], suf[16];
#pragma unroll
        for (int i = 0; i < 16; ++i) {
            zz[i] = x[i] * ATT_C;
            const float e = __builtin_amdgcn_exp2f(fminf(zz[i], 126.f));
            float l = -__builtin_amdgcn_logf(1.f + e);
            const int kap = 16 * (i >> 3) + 8 * hh + (i & 7);
            if (diag && !(kap < r)) l = 0.f;
            suf[i] = l;
        }
#pragma unroll
        for (int j = 6; j >= 0; --j) { suf[j] += suf[j + 1]; suf[8 + j] += suf[8 + j + 1]; }
        const float T0 = suf[0], T1 = suf[8];
        const float T0p = __shfl_xor(T0, 32), T1p = __shfl_xor(T1, 32);
        const float base0 = L + T1 + T1p + (hh == 0 ? T0p : 0.f), base1 = L + (hh == 0 ? T1p : 0.f);
        float a[16];
#pragma unroll
        for (int i = 0; i < 16; ++i) {
            float v = __builtin_amdgcn_exp2f(zz[i] + (i < 8 ? base0 : base1) + suf[i]);
            const int kap = 16 * (i >> 3) + 8 * hh + (i & 7);
            if (diag && !(kap < r)) v = 0.f;
            a[i] = v;
        }
        L += (T0 + T1) + (T0p + T1p);
        const bf16x8 pf0 = pack8(a[0], a[1], a[2], a[3], a[4], a[5], a[6], a[7]);
        const bf16x8 pf1 = pack8(a[8], a[9], a[10], a[11], a[12], a[13], a[14], a[15]);
        asm volatile("s_waitcnt vmcnt(8)" ::: "memory");
#pragma unroll
        for (int c = 0; c < 4; ++c) {
            s16x4 r00, r01, r10, r11; tr_read4(va[0][c], va[1][c], r00, r01, r10, r11);
            const bf16x8 vf0 = __builtin_shufflevector(r00, r01, 0, 1, 2, 3, 4, 5, 6, 7), vf1 = __builtin_shufflevector(r10, r11, 0, 1, 2, 3, 4, 5, 6, 7);
            oacc[c] = MFMA32(vf0, pf0, oacc[c]); oacc[c] = MFMA32(vf1, pf1, oacc[c]);
        }
        ATT_DMA(vt, gn + CW * 2);
        if (__all(L < ATT_EXIT)) break;
    }
    VM_WAIT();
#undef ATT_DMA
    float ss = 0.f;
#pragma unroll
    for (int c = 0; c < 4; ++c)
#pragma unroll
        for (int i = 0; i < 16; ++i) ss += oacc[c][i] * oacc[c][i];
    ss += __shfl_xor(ss, 32);
    if (hh == 0) XS[h * 32 + r] = ss;
    __syncthreads();
    float tot = 0.f;
#pragma unroll
    for (int w = 0; w < 8; ++w) tot += XS[w * 32 + r];
    const float rs = __builtin_amdgcn_rsqf(tot * (1.f / CW) + EPS);
    bf16* yo = ymix + (rowbase + t0 + r) * D + CW + h * HD + 4 * hh;
#pragma unroll
    for (int c = 0; c < 4; ++c)
#pragma unroll
        for (int g = 0; g < 4; ++g) { v2u w; w.x = pk2(oacc[c][4 * g] * rs, oacc[c][4 * g + 1] * rs); w.y = pk2(oacc[c][4 * g + 2] * rs, oacc[c][4 * g + 3] * rs);
            *(GAS v2u*)(yo + 32 * c + 8 * g) = w; }
}
__device__ __forceinline__ void p2_mixer(Frame& F) {
    int par = 0;
    for (int u = F.bx; u < NB * (SEQ / 32); u += F.G) { attn_unit(F, u / (SEQ / 32), u % (SEQ / 32), par); par ^= 1; }
    const int gw = F.bx * NWAVES + F.wave, NGW = F.G * NWAVES;
    for (int it = gw; it < T / 16; it += NGW) conv_item(F, it);
}

__device__ __forceinline__ void router_unit(Frame& F, int unit, LAS int* hist) {
    const int lane = F.lane, r16 = lane & 15, g = lane >> 4;
    const bf16* H = (const bf16*)(F.ws + WS_H1B); const bf16* WR = (const bf16*)(F.ws + WS_WR);
    const int t0 = unit * 16;
    LAS float* LG = (LAS float*)(F.lds + F.wave * 16384); LAS float* BI = LG + 16 * 65 + 16;
    f32x4 acc[4];
#pragma unroll
    for (int nb = 0; nb < 4; ++nb) acc[nb] = (f32x4){0.f, 0.f, 0.f, 0.f};
    float ss = 0.f;
    const bf16* ap = H + (size_t)(t0 + r16) * D + 8 * g; const bf16* bp = WR + (size_t)r16 * D + 8 * g;
#pragma unroll 4
    for (int ks = 0; ks < D / 32; ++ks) {
        const v4u aw = *(const GAS v4u*)(ap + 32 * ks);
#pragma unroll
        for (int q = 0; q < 4; ++q) { const float lo = bflo(aw[q]), hi = bfhi(aw[q]); ss += lo * lo + hi * hi; }
        const bf16x8 af = __builtin_bit_cast(bf16x8, aw);
#pragma unroll
        for (int nb = 0; nb < 4; ++nb) { const bf16x8 bf = *(const GAS bf16x8*)(bp + (size_t)(16 * nb) * D + 32 * ks); acc[nb] = __builtin_amdgcn_mfma_f32_16x16x32_bf16(af, bf, acc[nb], 0, 0, 0); }
    }
    ss += __shfl_xor(ss, 16); ss += __shfl_xor(ss, 32);
#pragma unroll
    for (int nb = 0; nb < 4; ++nb)
#pragma unroll
        for (int j = 0; j < 4; ++j) LG[(4 * g + j) * 65 + 16 * nb + r16] = acc[nb][j];
    LDS_WAIT();
    if (lane < 16) {
        const int t = t0 + lane; const float rs = __builtin_amdgcn_rsqf(ss * (1.f / D) + EPS);
        ((float*)(F.ws + WS_RFFN))[t] = rs;
        LAS float* lg = LG + lane * 65; LAS float* bi = BI + lane * 65; const float* rb = F.in[I_RB];
        for (int e = 0; e < NE; ++e) { const float s = fsigmoid(lg[e] * rs); lg[e] = s; bi[e] = s + rb[e]; }
        float gs[8];
#pragma unroll
        for (int gg = 0; gg < 8; ++gg) { float m1 = -__builtin_inff(), m2 = -__builtin_inff();
#pragma unroll
            for (int j = 0; j < 8; ++j) { const float v = bi[8 * gg + j]; if (v > m1) { m2 = m1; m1 = v; } else if (v > m2) m2 = v; }
            gs[gg] = m1 + m2; }
        unsigned gmask = 0u;
#pragma unroll
        for (int gg = 0; gg < 8; ++gg) { int cnt = 0;
#pragma unroll
            for (int g2 = 0; g2 < 8; ++g2) cnt += (gs[g2] > gs[gg] || (gs[g2] == gs[gg] && g2 < gg)) ? 1 : 0;
            if (cnt < 4) gmask |= 1u << gg; }
        int se[8]; float sv[8]; float wsum = 0.f;
#pragma unroll
        for (int k = 0; k < 8; ++k) { float best = -__builtin_inff(); int be = 0;
            for (int e = 0; e < NE; ++e) { const float v = bi[e]; if (((gmask >> (e >> 3)) & 1u) && v > best) { best = v; be = e; } }
            bi[be] = -__builtin_inff(); se[k] = be; sv[k] = lg[be]; wsum += sv[k]; }
        const float inv = 2.5f / wsum;
        int* te = (int*)(F.ws + WS_TOPE) + (size_t)t * 8; float* tw = (float*)(F.ws + WS_TOPW) + (size_t)t * 8;
#pragma unroll
        for (int k = 0; k < 8; ++k) { te[k] = se[k]; tw[k] = sv[k] * inv; (void)__hip_atomic_fetch_add(hist + se[k], 1, __ATOMIC_RELAXED, __HIP_MEMORY_SCOPE_WORKGROUP); }
    }
}
__device__ __forceinline__ void p4_router(Frame& F) {
    LAS int* hist = (LAS int*)(F.lds + RT_OFF);
    for (int v = F.bx; v < 256; v += F.G) {
        if (F.tid < 64) hist[F.tid] = 0;
        __syncthreads();
        router_unit(F, v * 8 + F.wave, hist);
        __syncthreads();
        if (F.tid < 64) ((int*)(F.ws + WS_CNT))[v * 64 + F.tid] = hist[F.tid];
        __syncthreads();
    }
}

__device__ __forceinline__ void p4b_tables(Frame& F) {
    LAS int* L = (LAS int*)(F.lds + RING_OFF);
    LAS int* part_t = L;
    LAS int* part_b = L + 512;
    LAS int* totals = L + 1024;
    LAS int* below = L + 1088;
    LAS int* segst = L + 1152;
    LAS int* wcount = L + 1280;
    LAS int* pe = L + 2048;
    LAS int* rank = L + 3072;
    const int* CNT = (const int*)(F.ws + WS_CNT); const int* TOPE = (const int*)(F.ws + WS_TOPE); const float* TOPW = (const float*)(F.ws + WS_TOPW);
    const float* RFFN = (const float*)(F.ws + WS_RFFN);
    int* RTOK = (int*)(F.ws + WS_RTOK); float* RW = (float*)(F.ws + WS_RW); int* RDST = (int*)(F.ws + WS_RDST); float* RR = (float*)(F.ws + WS_RR); int* TILEE = (int*)(F.ws + WS_TILEE);
    const int tid = F.tid, lane = F.lane, wave = F.wave;
    for (int v = F.bx; v < 256; v += F.G) {
        { const int e = tid & 63, part = tid >> 6; int tot = 0, bel = 0;
          for (int vv = 32 * part; vv < 32 * part + 32; ++vv) { const int c = CNT[vv * 64 + e]; tot += c; bel += (vv < v) ? c : 0; }
          part_t[part * 64 + e] = tot; part_b[part * 64 + e] = bel; }
        for (int i = tid; i < 1024; i += NTHR) pe[i] = TOPE[(size_t)v * 1024 + i];
        __syncthreads();
        if (wave == 0) {
            int tot = 0, bel = 0;
#pragma unroll
            for (int p = 0; p < 8; ++p) { tot += part_t[p * 64 + lane]; bel += part_b[p * 64 + lane]; }
            totals[lane] = tot; below[lane] = bel;
            const int ru = (tot + 255) & ~255; int sc = ru;
#pragma unroll
            for (int o = 1; o < 64; o <<= 1) { const int n = __shfl_up(sc, o); if (lane >= o) sc += n; }
            segst[lane] = sc - ru; if (lane == 63) segst[64] = sc;
        }
        { int cnt = 0;
          for (int j = 0; j < 128; ++j) { const int p = 128 * wave + j; if (pe[p] == lane) { rank[p] = cnt; ++cnt; } }
          wcount[wave * 64 + lane] = cnt; }
        __syncthreads();
        const int SS = segst[64];
        for (int p = tid; p < 1024; p += NTHR) { const int e = pe[p], w = p >> 7; int off = 0;
            for (int w2 = 0; w2 < w; ++w2) off += wcount[w2 * 64 + e];
            const int row = segst[e] + below[e] + off + rank[p]; const int t = 128 * v + (p >> 3), k = p & 7;
            RTOK[row] = t; RW[row] = TOPW[(size_t)t * 8 + k]; RDST[row] = k * T + t; RR[row] = RFFN[t]; }
        if (tid < 128) { const int t = 128 * v + tid, row = SS + t; RTOK[row] = t; RW[row] = 1.f; RDST[row] = 8 * T + t; RR[row] = RFFN[t]; }
        if (v < NE) { const int e = v, tot = totals[e], ru = (tot + 255) & ~255, st = segst[e];
            if (tid < ru - tot) { const int row = st + tot + tid; RTOK[row] = 0; RW[row] = 0.f; RDST[row] = -1; RR[row] = 0.f; }
            if (tid < ru / 256) TILEE[st / 256 + tid] = e; }
        if (v == NE) { if (tid < T / 256) TILEE[SS / 256 + tid] = NE; if (tid == 0) TILEE[MAXTILES] = SS / 256 + T / 256; }
        __syncthreads();
    }
}

template <int MODE> __device__ __forceinline__ int group_setup(Frame& F, int nN) {
    const int* TILEE = (const int*)(F.ws + WS_TILEE);
    const int NT = __builtin_amdgcn_readfirstlane((int)__hip_atomic_load((unsigned*)TILEE + MAXTILES, RLX_AGENT));
    LAS int* te = (LAS int*)(F.lds + TE_OFF); LAS unsigned* rt = (LAS unsigned*)(F.lds + RT_OFF);
    for (int i = F.tid; i < NT && i < MAXTILES; i += NTHR) te[i] = TILEE[i];
    if (MODE == 1) {
        const int* RTOK = (const int*)(F.ws + WS_RTOK);
        for (int ui = F.tid >> 8; ui < RT_UNITS; ui += 2) { int pm, pn; if (!pg8::order_next(ui, F.G, F.bx, NT, nN, pm, pn)) break;
            rt[ui * 256 + (F.tid & 255)] = (unsigned)RTOK[pm * 256 + (F.tid & 255)] * (unsigned)D; }
    }
    __syncthreads();
    return NT;
}

__device__ __forceinline__ void acc_fp8x16(const v4u w, float (&o)[16]) {
#pragma unroll
    for (int q = 0; q < 4; ++q) { const f32x2 lo = __builtin_amdgcn_cvt_pk_f32_fp8((int)w[q], false), hi = __builtin_amdgcn_cvt_pk_f32_fp8((int)w[q], true);
        o[4 * q] += lo.x; o[4 * q + 1] += lo.y; o[4 * q + 2] += hi.x; o[4 * q + 3] += hi.y; }
}
__device__ __forceinline__ void p7_combine(Frame& F, int n) {
    const int gw = F.bx * NWAVES + F.wave, NGW = F.G * NWAVES, lane = F.lane;
    bf16* H = (bf16*)(F.ws + WS_H1B); const unsigned char* S0 = (const unsigned char*)F.out; const unsigned char* S1 = F.ws + WS_SLOT47; const unsigned char* S8 = F.ws + WS_SLOT8;
    float* ssq2 = (float*)(F.ws + WS_SSQ2);
    for (int t = gw; t < T; t += NGW) {
        float ss = 0.f;
#pragma unroll
        for (int ch = 0; ch < 2; ++ch) {
            const int co = 1024 * ch + 16 * lane;
            bf16* hp = H + (size_t)t * D + co;
            const v4u h0 = *(const GAS v4u*)hp, h1 = *(const GAS v4u*)(hp + 8);
            v4u w[9];
#pragma unroll
            for (int k = 0; k < 4; ++k) { w[k] = *(const GAS v4u*)(S0 + ((size_t)k * T + t) * D + co); w[4 + k] = *(const GAS v4u*)(S1 + ((size_t)k * T + t) * D + co); }
            w[8] = *(const GAS v4u*)(S8 + (size_t)t * D + co);
            float o[16];
#pragma unroll
            for (int i = 0; i < 16; ++i) o[i] = 0.f;
#pragma unroll
            for (int k = 0; k < 9; ++k) acc_fp8x16(w[k], o);
            f32x4 a0, a1, a2, a3; pg8::unpack8(h0, a0, a1); pg8::unpack8(h1, a2, a3);
#pragma unroll
            for (int j = 0; j < 4; ++j) { a0[j] += o[j] * (1.f / SLOT_SCALE); a1[j] += o[4 + j] * (1.f / SLOT_SCALE); a2[j] += o[8 + j] * (1.f / SLOT_SCALE); a3[j] += o[12 + j] * (1.f / SLOT_SCALE);
                ss += (a0[j] * a0[j] + a1[j] * a1[j]) + (a2[j] * a2[j] + a3[j] * a3[j]); }
            *(GAS v4u*)hp = pg8::pack8_bf16(a0, a1); *(GAS v4u*)(hp + 8) = pg8::pack8_bf16(a2, a3);
            { v4u w8; w8.x = pg8::cvt4_fp8(a0[0], a0[1], a0[2], a0[3]); w8.y = pg8::cvt4_fp8(a1[0], a1[1], a1[2], a1[3]); w8.z = pg8::cvt4_fp8(a2[0], a2[1], a2[2], a2[3]); w8.w = pg8::cvt4_fp8(a3[0], a3[1], a3[2], a3[3]);
              *(GAS v4u*)(F.ws + WS_H1F8 + (size_t)t * D + co) = w8; }
        }
        ss = wave_sum(ss);
        if (lane == 0) ssq2[t] = ss;
    }
}

__device__ __forceinline__ void p9_final(Frame& F, const bf16* H, const float* ssq, int nparts) {
    const int gw = F.bx * NWAVES + F.wave, NGW = F.G * NWAVES, lane = F.lane; const float* g = F.in[I_NFIN];
    for (int t = gw; t < T; t += NGW) {
        v4u w[4];
#pragma unroll
        for (int j = 0; j < 4; ++j) w[j] = *(const GAS v4u*)(H + (size_t)t * D + 512 * j + 8 * lane);
        float ss = 0.f;
        if (nparts > 0) { if (lane < nparts) ss = ssq[(size_t)lane * T + t]; }
        else {
#pragma unroll
            for (int j = 0; j < 4; ++j)
#pragma unroll
                for (int q = 0; q < 4; ++q) { const float lo = bflo(w[j][q]), hi = bfhi(w[j][q]); ss += lo * lo + hi * hi; }
        }
        const float r = __builtin_amdgcn_rsqf(wave_sum(ss) * (1.f / D) + EPS);
        float* o = F.out + (size_t)t * D;
#pragma unroll
        for (int j = 0; j < 4; ++j) { const int c = 512 * j + 8 * lane; const f32x4 g0 = *(const GAS f32x4*)(g + c), g1 = *(const GAS f32x4*)(g + c + 4);
            f32x4 a, b; a.x = bflo(w[j][0]) * r * g0.x; a.y = bfhi(w[j][0]) * r * g0.y; a.z = bflo(w[j][1]) * r * g0.z; a.w = bfhi(w[j][1]) * r * g0.w;
            b.x = bflo(w[j][2]) * r * g1.x; b.y = bfhi(w[j][2]) * r * g1.y; b.z = bflo(w[j][3]) * r * g1.z; b.w = bfhi(w[j][3]) * r * g1.w;
            *(GAS f32x4*)(o + c) = a; *(GAS f32x4*)(o + c + 4) = b; }
    }
}

struct Args { const float* in[21]; float* out; unsigned char* ws; int ph_lo, ph_hi, fin_mode, li; };
__global__ void __launch_bounds__(NTHR, 2) mk_fwd(Args args) {
    extern __shared__ __attribute__((aligned(16))) unsigned char lds[];
    Frame F;
    F.lds = (LAS unsigned char*)lds;
    F.tid = threadIdx.x; F.lane = F.tid & 63; F.wave = __builtin_amdgcn_readfirstlane(F.tid >> 6);
    F.G = gridDim.x; F.bx = blockIdx.x; F.ws = args.ws; F.out = args.out;
#pragma unroll
    for (int i = 0; i < 21; ++i) F.in[i] = args.in[i];
    volatile LAS unsigned* MISC = (volatile LAS unsigned*)(F.lds + MISC_OFF);
    if (F.tid < 32) MISC[F.tid] = 0u;
    __syncthreads();
    XcdBarrier bar = xcd_barrier_post((unsigned*)(F.ws + WS_CTL) + CW_BAR + args.li * XCD_BAR_WORDS, MISC + 8);
    unsigned char* ws = F.ws;
    const int lo = args.ph_lo, hi = args.ph_hi;
    LAS unsigned char* ring = F.lds + RING_OFF;
#define PHASE(k) if (lo <= (k) && (k) < hi)
#define PH(k) PHASE(k) { RELANE();
#define GRID_BAR() xcd_barrier(bar)
#define RELANE() do { int _t = threadIdx.x; asm volatile("" : "+v"(_t)); F.tid = _t; F.lane = _t & 63; F.wave = __builtin_amdgcn_readfirstlane(_t >> 6); } while (0)

    PHASE(0) { RELANE(); p0_prologue(F); GRID_BAR(); }
    PHASE(1) { RELANE();
        pg8::DenseSched S{T / 256, NPROJ / 256, F.G, F.bx, D * 2, (const char*)(ws + WS_WIN)};
        pg8::EpiBf16Scale E{(bf16*)(ws + WS_PROJ), NPROJ, (const float*)(ws + WS_RMIX)};
        pg8::gemm_phase<false, 1>(F.tid, ring, (const char*)F.out, D * 2, S, E);
        GRID_BAR();
    }
    PHASE(2) { RELANE(); p2_mixer(F); GRID_BAR(); }
    PHASE(3) { RELANE();
        pg8::DenseSched S{T / 256, D / 256, F.G, F.bx, D * 2, (const char*)(ws + WS_WOUT)};
        pg8::EpiResF32 E{(bf16*)(ws + WS_H1B), (const bf16*)F.out, D, ws + WS_H1F8};
        pg8::gemm_phase<false, 1>(F.tid, ring, (const char*)((bf16*)F.out + (size_t)T * D), D * 2, S, E);
        GRID_BAR();
    }
    PHASE(4) { RELANE(); p4_router(F); GRID_BAR(); }
    PHASE(5) { RELANE(); p4b_tables(F); GRID_BAR(); }
    PHASE(6) { RELANE();
        const int NT = group_setup<1>(F, 4);
        pg8::GroupSched<1> S{NT, 4, F.G, F.bx, D, 0, (const char*)(ws + WS_WGU), (size_t)1024 * D, (const LAS int*)(F.lds + TE_OFF), (const LAS unsigned*)(F.lds + RT_OFF)};
        pg8::EpiGateUp E{ws + WS_HPERM, (const float*)(ws + WS_RR)};
        pg8::gemm_phase<true, 0>(F.tid, ring, (const char*)(ws + WS_H1F8), D, S, E, 0x79797979, 0x7f7f7f7f);
        GRID_BAR();
    }
    {
        for (int n = 0; n < NSLICE; ++n) {
            PHASE(7 + 2 * n) { RELANE();
            const int NT = group_setup<2>(F, SLW / 256);
            pg8::GroupSched<2> S{NT, SLW / 256, F.G, F.bx, ED, (SLW / 256) * n, (const char*)(ws + WS_WDN), (size_t)D * ED, (const LAS int*)(F.lds + TE_OFF), (const LAS unsigned*)(F.lds + RT_OFF)};
            pg8::EpiDown E{(unsigned char*)F.out, ws + WS_SLOT47, ws + WS_SLOT8, (const float*)(ws + WS_RW), (const int*)(ws + WS_RDST)};
            pg8::gemm_phase<true, 0>(F.tid, ring, (const char*)(ws + WS_HPERM), ED, S, E, 0x79797979, 0x7f7f7f7f);
            GRID_BAR();
            }
            PHASE(8 + 2 * n) { RELANE();
            p7_combine(F, n);
            GRID_BAR();
            }
        }
    }
    PHASE(15) { RELANE();
        pg8::DenseSched S{T / 256, D / 256, F.G, F.bx, PLE * 2, (const char*)(ws + WS_WPP)};
        pg8::EpiBf16Scale E{(bf16*)(ws + WS_PP), D, nullptr};
        pg8::gemm_phase<false, 1>(F.tid, ring, (const char*)(ws + WS_PB), PLE * 2, S, E);
        GRID_BAR();
    }
    PHASE(16) { RELANE();
        pg8::DenseSchedG S{T / 256, D / 256, F.G, F.bx, D, (const char*)(ws + WS_WPG)};
        pg8::EpiPle E{(bf16*)(ws + WS_H3), (const bf16*)(ws + WS_H1B), (const bf16*)(ws + WS_PP), (const float*)(ws + WS_SSQ2), (float*)(ws + WS_SSQ3)};
        pg8::gemm_phase<true, 1>(F.tid, ring, (const char*)(ws + WS_H1F8), D, S, E, 0x79797979, 0x7f7f7f7f);
        GRID_BAR();
    }
    PHASE(17) { RELANE();
    if (args.fin_mode == 0) p9_final(F, (const bf16*)(ws + WS_H3), (const float*)(ws + WS_SSQ3), 32);
    else p9_final(F, (const bf16*)(ws + WS_H1B), nullptr, 0);
    }
}

extern "C" void kernel_launch(void* const* d_in, const int* in_sizes, int n_in, void* d_out, int out_size, void* d_ws, size_t ws_size, hipStream_t stream) {
    static int grid = 0;
    if (grid == 0) {
        int dev = 0, cus = 0;
        if (n_in != 21 || ws_size < WS_END) { fprintf(stderr, "kernel_launch: n_in %d ws %zu (need %zu)\n", n_in, ws_size, (size_t)WS_END); grid = -1; return; }
        if (hipGetDevice(&dev) != hipSuccess || hipDeviceGetAttribute(&cus, hipDeviceAttributeMultiprocessorCount, dev) != hipSuccess) { grid = -1; return; }
        if (hipFuncSetAttribute((const void*)mk_fwd, hipFuncAttributeMaxDynamicSharedMemorySize, LDS_BYTES) != hipSuccess) { fprintf(stderr, "hipFuncSetAttribute failed\n"); grid = -1; return; }
        int per_cu = 0;
        (void)hipOccupancyMaxActiveBlocksPerMultiprocessor(&per_cu, (const void*)mk_fwd, NTHR, LDS_BYTES);
        (void)hipGetLastError();
        grid = cus > 256 ? 256 : cus;
    }
    if (grid < 0) return;
    (void)hipMemsetAsync((char*)d_ws + WS_CTL, 0, CTL_ZERO_BYTES, stream);
    Args a{};
    for (int i = 0; i < 21; ++i) a.in[i] = (const float*)d_in[i];
    a.out = (float*)d_out; a.ws = (unsigned char*)d_ws; a.fin_mode = FIN_MODE;
#if PROBE_K >= 0
    a.ph_lo = 0; a.ph_hi = PROBE_K + 1; a.li = 0;
    hipLaunchKernelGGL(mk_fwd, dim3(grid), dim3(NTHR), LDS_BYTES, stream, a);
    a.ph_lo = PROBE_K; a.ph_hi = PH_HI; a.li = 1;
    hipLaunchKernelGGL(mk_fwd, dim3(grid), dim3(NTHR), LDS_BYTES, stream, a);
#else
    a.ph_lo = 0; a.ph_hi = PH_HI; a.li = 0;
    hipLaunchKernelGGL(mk_fwd, dim3(grid), dim3(NTHR), LDS_BYTES, stream, a);
#endif
}
```

```cpp
#include <hip/hip_runtime.h>
#include <cstdio>
#ifndef PROBE_K
#define PROBE_K -1
#endif
#ifndef PH_HI
#define PH_HI 100
#endif
#ifndef FIN_MODE
#define FIN_MODE 0
#endif

#define GAS __attribute__((address_space(1)))
#define LAS __attribute__((address_space(3)))
typedef unsigned short bf16;
typedef unsigned v4u __attribute__((ext_vector_type(4)));
typedef unsigned v2u __attribute__((ext_vector_type(2)));
typedef float f32x4 __attribute__((ext_vector_type(4)));
typedef float f32x2 __attribute__((ext_vector_type(2)));
typedef float f32x16 __attribute__((ext_vector_type(16)));
typedef short bf16x8 __attribute__((ext_vector_type(8)));
typedef short s16x4 __attribute__((ext_vector_type(4)));
typedef GAS unsigned gu32;
#define RLX_AGENT __ATOMIC_RELAXED, __HIP_MEMORY_SCOPE_AGENT
#define LDS_WAIT() asm volatile("s_waitcnt lgkmcnt(0)" ::: "memory")
#define VM_WAIT() asm volatile("s_waitcnt vmcnt(0)" ::: "memory")

constexpr int NB = 8, SEQ = 4096, T = NB * SEQ, D = 2048, NPROJ = 6144, CW = 1024, HD = 128, NH = 8;
constexpr int PLE = 256, NE = 64, ED = 512, TOPK = 8, NSLOT = 9;
constexpr float EPS = 1e-6f;
constexpr int NWAVES = 8, NTHR = 512;
constexpr int MAXTILES = 1216;
constexpr int MAXROWS = MAXTILES * 256;
constexpr int NSLICE = 1, SLW = D / NSLICE;
constexpr float SLOT_SCALE = 16.f;

constexpr size_t MiB = 1u << 20;
constexpr size_t WS_CTL = 0, CTL_ZERO_BYTES = 1 * MiB;
constexpr size_t WS_RMIX = 1 * MiB;
constexpr size_t WS_RFFN = WS_RMIX + 128 * 1024;
constexpr size_t WS_SSQ2 = WS_RFFN + 128 * 1024;
constexpr size_t WS_SSQ3 = WS_SSQ2 + 512 * 1024;
constexpr size_t WS_TOPE = WS_SSQ3 + 4 * MiB;
constexpr size_t WS_TOPW = WS_TOPE + 1 * MiB;
constexpr size_t WS_CNT  = WS_TOPW + 1 * MiB;
constexpr size_t WS_RTOK = WS_CNT + 64 * 1024;
constexpr size_t WS_RW   = WS_RTOK + 1280 * 1024;
constexpr size_t WS_RDST = WS_RW + 1280 * 1024;
constexpr size_t WS_RR   = WS_RDST + 1280 * 1024;
constexpr size_t WS_TILEE = WS_RR + 1280 * 1024;
constexpr size_t WS_WR   = 16 * MiB;
constexpr size_t WS_WIN  = 17 * MiB;
constexpr size_t WS_WOUT = WS_WIN + 24 * MiB;
constexpr size_t WS_WGU  = WS_WOUT + 8 * MiB;
constexpr size_t WS_WDN  = WS_WGU + 130 * MiB;
constexpr size_t WS_WPG  = WS_WDN + 65 * MiB;
constexpr size_t WS_WPP  = WS_WPG + 8 * MiB;
constexpr size_t WS_PB   = WS_WPP + 1 * MiB;
constexpr size_t WS_H1B  = WS_PB + 16 * MiB;
constexpr size_t WS_H1F8 = WS_H1B + 128 * MiB;
constexpr size_t WS_OVL  = WS_H1F8 + 64 * MiB;
constexpr size_t WS_PROJ = WS_OVL;
constexpr size_t WS_HPERM = WS_OVL;
constexpr size_t WS_SLOT8 = WS_OVL + 304 * MiB;
constexpr size_t WS_PP   = WS_OVL;
constexpr size_t WS_H3   = WS_OVL + 128 * MiB;
constexpr size_t WS_SLOT47 = WS_OVL + 384 * MiB;
constexpr size_t WS_END  = WS_SLOT47 + 256 * MiB;
constexpr int CW_BAR = 4096;

constexpr int RING_OFF = 0, RING_BYTES = 131072;
constexpr int RT_OFF = 131072, RT_UNITS = 20, RT_BYTES = RT_UNITS * 1024;
constexpr int TE_OFF = RT_OFF + RT_BYTES, TE_BYTES = 4864 + 128;
constexpr int EPT_OFF = TE_OFF + TE_BYTES, EPT_BYTES = 4096;
constexpr int MISC_OFF = EPT_OFF + EPT_BYTES;
constexpr int LDS_BYTES = MISC_OFF + 128;
static_assert(LDS_BYTES <= 163840, "LDS");

__device__ __forceinline__ unsigned f2bf(float f) { unsigned u = __builtin_bit_cast(unsigned, f); return (u + 0x7fffu + ((u >> 16) & 1u)) >> 16; }
__device__ __forceinline__ unsigned pk2(float lo, float hi) { return f2bf(lo) | (f2bf(hi) << 16); }
__device__ __forceinline__ float bflo(unsigned w) { return __builtin_bit_cast(float, w << 16); }
__device__ __forceinline__ float bfhi(unsigned w) { return __builtin_bit_cast(float, w & 0xffff0000u); }
__device__ __forceinline__ float wave_sum(float v) {
#pragma unroll
    for (int o = 1; o < 64; o <<= 1) v += __shfl_xor(v, o);
    return v;
}
__device__ __forceinline__ float fsigmoid(float v) { return __builtin_amdgcn_rcpf(1.f + __builtin_amdgcn_exp2f(-1.4426950409f * v)); }

#define XB_TMO      128
#define XB_XCNT(j)  (256  + 64 * (j))
#define XB_XSUB(j)  (1280 + 64 * (j))
#define XB_XGEN(j)  (2304 + 64 * (j))
#define XB_TOP      3328
#define XB_TOPGEN   3392
#define XCD_BAR_WORDS 3456
#define XB_SPIN_CAP (1u << 18)
__device__ __forceinline__ unsigned xb_ld(unsigned* p)              { return __hip_atomic_load(p, __ATOMIC_RELAXED, __HIP_MEMORY_SCOPE_AGENT); }
__device__ __forceinline__ unsigned xb_add(unsigned* p, unsigned v) { return __hip_atomic_fetch_add(p, v, __ATOMIC_RELAXED, __HIP_MEMORY_SCOPE_AGENT); }
__device__ __forceinline__ unsigned xb_xcc_id() { return (unsigned)__builtin_amdgcn_s_getreg((3 << 11) | 20) & 0xFu; }
#define XB_SPIN(cond, bar) do { unsigned _sp = 0; while (cond) { __builtin_amdgcn_s_sleep(1); \
    if ((++_sp & 255u) == 0u) { if (xb_ld(&(bar)[XB_TMO])) break; if (_sp > XB_SPIN_CAP) { atomicAdd(&(bar)[XB_TMO], 1u); break; } } } } while (0)
struct XcdBarrier { unsigned* bar; unsigned x; volatile LAS unsigned* st; };
__device__ __forceinline__ XcdBarrier xcd_barrier_post(unsigned* bar, volatile LAS unsigned* st) {
    XcdBarrier b; b.bar = bar; b.x = xb_xcc_id(); b.st = st;
    if (threadIdx.x == 0) (void)xb_add(&bar[XB_XCNT(b.x)], 1u);
    return b;
}
__device__ __forceinline__ void xcd_barrier_complete(unsigned* bar, unsigned x, unsigned& nloc, unsigned& nx) {
    const unsigned G = gridDim.x * gridDim.y * gridDim.z;
    unsigned sum, cnt, mine, sp = 0u;
    for (;;) {
        sum = 0u; cnt = 0u; mine = 0u;
#pragma unroll
        for (unsigned j = 0; j < 16; ++j) { const unsigned c = xb_ld(&bar[XB_XCNT(j)]); sum += c; cnt += (c > 0u) ? 1u : 0u; mine = (j == x) ? c : mine; }
        if (sum == G) break;
        __builtin_amdgcn_s_sleep(1);
        if ((++sp & 255u) == 0u) { if (xb_ld(&bar[XB_TMO])) break; if (sp > XB_SPIN_CAP) { atomicAdd(&bar[XB_TMO], 1u); break; } }
    }
    nloc = mine > 0u ? mine : 1u; nx = cnt > 0u ? cnt : 1u;
}
__device__ __forceinline__ void xcd_barrier(const XcdBarrier& b) {
    asm volatile("s_waitcnt vmcnt(0)" ::: "memory");
    __syncthreads();
    if (threadIdx.x == 0) {
        unsigned* bar = b.bar;
        __builtin_amdgcn_s_waitcnt(0);
        unsigned nloc = b.st[0], nx = b.st[1];
        if (nloc == 0u) { xcd_barrier_complete(bar, b.x, nloc, nx); b.st[0] = nloc; b.st[1] = nx; }
        const unsigned old = xb_add(&bar[XB_XSUB(b.x)], 1u);
        const unsigned gen = old / nloc;
        if (old + 1u == (gen + 1u) * nloc) {
            __builtin_amdgcn_fence(__ATOMIC_RELEASE, "agent");
            asm volatile("s_waitcnt vmcnt(0)" ::: "memory");
            const unsigned og = xb_add(&bar[XB_TOP], 1u);
            const unsigned tg = og / nx;
            if (og + 1u == (tg + 1u) * nx) xb_add(&bar[XB_TOPGEN], 1u);
            else XB_SPIN(xb_ld(&bar[XB_TOPGEN]) == tg, bar);
            __builtin_amdgcn_fence(__ATOMIC_ACQUIRE, "agent");
            xb_add(&bar[XB_XGEN(b.x)], 1u);
            asm volatile("s_waitcnt vmcnt(0)" ::: "memory");
        } else {
            XB_SPIN(xb_ld(&bar[XB_XGEN(b.x)]) == gen, bar);
            __builtin_amdgcn_fence(__ATOMIC_ACQUIRE, "agent");
            asm volatile("s_waitcnt vmcnt(0)" ::: "memory");
        }
    }
    __syncthreads();
}

namespace pg8 {
constexpr int BM = 256, BK = 64, HALF = 128, HTB = HALF * BK * 2, STAGE_BYTES = 8 * HTB, NXCD = 8, WGM = 8;
__device__ __forceinline__ int lds_byte(int r, int c) { const int st = (r >> 4) * 2 + (c >> 5), rr = r & 15, cc = c & 31, ob = rr * 64 + cc * 2; return st * 1024 + (ob ^ (((ob >> 9) & 1) << 5)); }
__device__ __forceinline__ void stage_rc(int b, int& R, int& C) { const int st = b / 1024, sb = b % 1024, swz = sb ^ (((sb >> 9) & 1) << 5); R = (st >> 1) * 16 + swz / 64; C = (st & 1) * 32 + (swz % 64) / 2; }
__device__ __forceinline__ int brow(int R) { return 64 * (R >> 5) + 16 * ((R & 15) >> 2) + 4 * ((R >> 4) & 1) + (R & 3); }
__device__ __forceinline__ int brow1(int R) { return 64 * (R >> 5) + 8 * ((R & 15) >> 2) + 4 * ((R >> 4) & 1) + (R & 3); }

struct Unit { int pm, pn, e; };

__device__ __forceinline__ bool order_next(int i, int G, int c, int nM, int nN, int& pm, int& pn) {
    const int nwg = nM * nN; const long L = (long)i * G + c; if (L >= nwg) return false;
    int wgid = (int)L; { const int q = nwg / NXCD, r = nwg % NXCD, xcd = wgid % NXCD, off = wgid / NXCD; wgid = (xcd < r ? xcd * (q + 1) : r * (q + 1) + (xcd - r) * q) + off; }
    const int nig = WGM * nN, gid = wgid / nig, fm = gid * WGM, gsz = (nM - fm) < WGM ? (nM - fm) : WGM;
    pm = fm + ((wgid % nig) % gsz); pn = (wgid % nig) / gsz; return true;
}

struct DenseSched {
    static constexpr bool GATHER = false;
    int nM, nN, G, c, KB; const char* Bt;
    __device__ __forceinline__ bool next(int i, Unit& u) const { u.e = 0; return order_next(i, G, c, nM, nN, u.pm, u.pn); }
    __device__ __forceinline__ const char* bbase(const Unit& u) const { return Bt + (size_t)u.pn * BM * KB; }
    __device__ __forceinline__ const char* abase(const char* A, const Unit& u) const { return A + (size_t)u.pm * BM * KB; }
    __device__ __forceinline__ void aoffs(int ui, const Unit& u, int tid, unsigned (&ao)[2][2]) const {}
};
struct DenseSchedG {
    static constexpr bool GATHER = true;
    int nM, nN, G, c, KB; const char* Bt;
    __device__ __forceinline__ bool next(int i, Unit& u) const { u.e = 0; return order_next(i, G, c, nM, nN, u.pm, u.pn); }
    __device__ __forceinline__ const char* bbase(const Unit& u) const { return Bt + (size_t)u.pn * BM * KB; }
    __device__ __forceinline__ const char* abase(const char* A, const Unit& u) const { return A; }
    __device__ __forceinline__ void aoffs(int ui, const Unit& u, int tid, unsigned (&ao)[2][2]) const {
        asm volatile("" : "+v"(tid));
#pragma unroll
        for (int i = 0; i < 2; ++i) { int R, C; stage_rc(tid * 16 + i * 8192, R, C);
#pragma unroll
            for (int h = 0; h < 2; ++h) ao[h][i] = (unsigned)(u.pm * BM + h * HALF + R) * (unsigned)KB + (unsigned)C * 2u; }
    }
};
template <int MODE> struct GroupSched {
    static constexpr bool GATHER = true;
    int nM, nN, G, c, KB, pn0; const char* Bt; size_t estride; const LAS int* te; const LAS unsigned* rt;
    __device__ __forceinline__ bool next(int i, Unit& u) const { if (!order_next(i, G, c, nM, nN, u.pm, u.pn)) return false; u.e = __builtin_amdgcn_readfirstlane(te[u.pm]); return true; }
    __device__ __forceinline__ const char* bbase(const Unit& u) const { return Bt + (size_t)u.e * estride + (size_t)(pn0 + u.pn) * BM * KB; }
    __device__ __forceinline__ void aoffs(int ui, const Unit& u, int tid, unsigned (&ao)[2][2]) const {
        asm volatile("" : "+v"(tid));
#pragma unroll
        for (int i = 0; i < 2; ++i) { int R, C; stage_rc(tid * 16 + i * 8192, R, C);
#pragma unroll
            for (int h = 0; h < 2; ++h) { if (MODE == 1) ao[h][i] = rt[ui * 256 + h * HALF + R] + (unsigned)C * 2u; else ao[h][i] = (unsigned)(u.pm * BM + h * HALF + R) * (unsigned)KB + (unsigned)C * 2u; } }
    }
    __device__ __forceinline__ const char* abase(const char* A, const Unit& u) const { return A; }
};

__device__ __forceinline__ unsigned cvt_pk_bf16(float lo, float hi) { unsigned r; asm volatile("v_cvt_pk_bf16_f32 %0, %1, %2" : "=v"(r) : "v"(lo), "v"(hi)); return r; }

typedef int v8i __attribute__((ext_vector_type(8)));
typedef int v4i __attribute__((ext_vector_type(4)));
union Frag { v8i v; struct { v4i lo, hi; }; };
template <bool F8, int LAY, class Epi, class Sched>
__device__ __forceinline__ void gemm_phase(const int tid, LAS unsigned char* lds, const char* Abase, const int KB, const Sched& S, const Epi& E, const int sw = 0x7f7f7f7f, const int sa = 0x7f7f7f7f) {
    LAS unsigned char* const ept = lds + (EPT_OFF - RING_OFF);
    const int wid = __builtin_amdgcn_readfirstlane(tid >> 6), lane = tid & 63, wr = wid >> 2, wc = wid & 3, fr = lane & 15, fq = lane >> 4;
    const int nt = KB / 128;
    constexpr bool GA = Sched::GATHER;
    unsigned voffB[2], voffA[2];
#pragma unroll
    for (int i = 0; i < 2; ++i) { int R, C; stage_rc(tid * 16 + i * 8192, R, C); const int Rb = LAY ? brow1(R) : brow(R); voffB[i] = (unsigned)Rb * (unsigned)KB + (unsigned)C * 2u; voffA[i] = (unsigned)R * (unsigned)KB + (unsigned)C * 2u; }
    const size_t kstep = (size_t)(BK * 2);
    const size_t hstep = (size_t)HALF * KB;
    const size_t hstepB = (size_t)(LAY ? 32 : 8) * KB;
    const unsigned ldsw = (unsigned)wid * 1024u;
    const int aoff = lds_byte(wr * 64 + fr, fq * 8), boff = lds_byte(wc * 32 + fr, fq * 8);
#define PG8_SA(b, h) (((b) * 2 + (h)) * HTB)
#define PG8_SB(b, h) ((4 + (b) * 2 + (h)) * HTB)
#define PG8_STAGE(bufoff, gbase, voff) do { _Pragma("unroll") for (int _i = 0; _i < 2; ++_i) \
        __builtin_amdgcn_global_load_lds((const unsigned*)((const char*)(gbase) + (voff)[_i]), (LAS unsigned*)(lds + (bufoff) + ldsw + _i * 8192), 16, 0, 0); } while (0)
#define PG8_STAGEA(bufoff, gbase, half) do { if constexpr (GA) { PG8_STAGE(bufoff, gbase, ca[half]); } else { PG8_STAGE(bufoff, (gbase) + (half) * hstep, voffA); } } while (0)
#define PG8_LD1(dst, off) do { const v4i _lo = *(const LAS v4i*)(lds + (off)), _hi = *(const LAS v4i*)(lds + (off) + 1024); dst.lo = _lo; dst.hi = _hi; } while (0)
#define PG8_LDA(dst, b, h) do { _Pragma("unroll") for (int m = 0; m < 4; ++m) PG8_LD1(dst[m], PG8_SA(b, h) + aoff + m * 2048); } while (0)
#define PG8_LDB(dst, b, h) do { _Pragma("unroll") for (int n = 0; n < 2; ++n) PG8_LD1(dst[n], PG8_SB(b, h) + boff + n * 2048); } while (0)
#define PG8_MMA(ai, bj, At, Bt) do { __builtin_amdgcn_s_setprio(1); _Pragma("unroll") for (int m = 0; m < 4; ++m) _Pragma("unroll") for (int n = 0; n < 2; ++n) { \
        if constexpr (F8) { acc[ai][bj][m][n] = __builtin_amdgcn_mfma_scale_f32_16x16x128_f8f6f4(Bt[n].v, At[m].v, acc[ai][bj][m][n], 0, 0, 0, sw, 0, sa); } \
        else { acc[ai][bj][m][n] = __builtin_amdgcn_mfma_f32_16x16x32_bf16(__builtin_bit_cast(bf16x8, Bt[n].lo), __builtin_bit_cast(bf16x8, At[m].lo), acc[ai][bj][m][n], 0, 0, 0); \
               acc[ai][bj][m][n] = __builtin_amdgcn_mfma_f32_16x16x32_bf16(__builtin_bit_cast(bf16x8, Bt[n].hi), __builtin_bit_cast(bf16x8, At[m].hi), acc[ai][bj][m][n], 0, 0, 0); } } \
        __builtin_amdgcn_s_setprio(0); } while (0)
#define PG8_WAIT_V(n) asm volatile("s_waitcnt vmcnt(" #n ")" ::: "memory")
#define PG8_WAIT_L(n) asm volatile("s_waitcnt lgkmcnt(" #n ")" ::: "memory")
#define PG8_BAR __builtin_amdgcn_s_barrier()
#define PG8_SCHED __builtin_amdgcn_sched_barrier(0)
    Unit cur, nxt; int ui = 0;
    if (!S.next(0, cur)) return;
    f32x4 acc[2][2][4][2];
#pragma unroll
    for (int a = 0; a < 2; ++a)
#pragma unroll
        for (int b = 0; b < 2; ++b)
#pragma unroll
            for (int m = 0; m < 4; ++m)
#pragma unroll
                for (int n = 0; n < 2; ++n) acc[a][b][m][n] = (f32x4){0.f, 0.f, 0.f, 0.f};
    Frag At[4], B0[2], B1[2];
    unsigned ca[2][2], na[2][2];
    if constexpr (GA) S.aoffs(0, cur, tid, ca);
    const char* cB = S.bbase(cur); const char* cA = S.abase(Abase, cur);
    PG8_STAGE(PG8_SB(0, 0), cB, voffB); PG8_STAGEA(PG8_SA(0, 0), cA, 0); PG8_STAGE(PG8_SB(0, 1), cB + hstepB, voffB); PG8_STAGEA(PG8_SA(0, 1), cA, 1);
    if (wr == 1) PG8_BAR;
    PG8_WAIT_V(4); PG8_BAR;
    PG8_STAGE(PG8_SB(1, 0), cB + kstep, voffB); PG8_STAGEA(PG8_SA(1, 0), cA + kstep, 0); PG8_STAGE(PG8_SB(1, 1), cB + hstepB + kstep, voffB);
    PG8_WAIT_V(6); PG8_BAR;
    for (;;) {
        const bool has_next = S.next(ui + 1, nxt);
        const char* nB = has_next ? S.bbase(nxt) : cB; const char* nA = has_next ? S.abase(Abase, nxt) : cA;
        if constexpr (GA) {
            if (has_next) S.aoffs(ui + 1, nxt, tid, na);
            else {
#pragma unroll
                for (int h = 0; h < 2; ++h)
#pragma unroll
                    for (int i = 0; i < 2; ++i) na[h][i] = ca[h][i];
            }
        }
#pragma nounroll
        for (int t = 0; t < nt; t += 2) {
            const bool last = (t == nt - 2);
            const char* a1 = cA + (size_t)(t + 1) * kstep;
            const char* a2 = last ? nA : cA + (size_t)(t + 2) * kstep; const char* b2 = last ? nB : cB + (size_t)(t + 2) * kstep;
            const char* a3 = a2 + kstep; const char* b3 = b2 + kstep;
            if (t == 0 && wid == 0) { int tz = tid; asm volatile("" : "+v"(tz)); E.prefetch(cur, ept + (ui & 1) * 2048, tz & 63); }
            PG8_LDB(B0, 0, 0); PG8_SCHED; PG8_LDA(At, 0, 0); PG8_STAGEA(PG8_SA(1, 1), a1, 1);
            PG8_WAIT_L(8); PG8_BAR; PG8_WAIT_L(0); PG8_MMA(0, 0, At, B0); PG8_BAR; PG8_SCHED;
            if constexpr (GA) { if (last) {
#pragma unroll
                for (int h = 0; h < 2; ++h)
#pragma unroll
                    for (int i = 0; i < 2; ++i) ca[h][i] = na[h][i];
            } }
            PG8_LDB(B1, 0, 1); PG8_STAGE(PG8_SB(0, 0), b2, voffB);
            PG8_BAR; PG8_WAIT_L(0); PG8_MMA(0, 1, At, B1); PG8_BAR;
            PG8_LDA(At, 0, 1); PG8_STAGEA(PG8_SA(0, 0), a2, 0);
            PG8_BAR; PG8_WAIT_L(0); PG8_MMA(1, 0, At, B0); PG8_BAR; PG8_SCHED;
            PG8_STAGE(PG8_SB(0, 1), b2 + hstepB, voffB);
            PG8_WAIT_V(6); PG8_BAR; PG8_MMA(1, 1, At, B1); PG8_BAR;
            PG8_LDB(B0, 1, 0); PG8_SCHED; PG8_LDA(At, 1, 0); PG8_STAGEA(PG8_SA(0, 1), a2, 1);
            PG8_WAIT_L(8); PG8_BAR; PG8_WAIT_L(0); PG8_MMA(0, 0, At, B0); PG8_BAR; PG8_SCHED;
            PG8_LDB(B1, 1, 1); PG8_STAGE(PG8_SB(1, 0), b3, voffB);
            PG8_BAR; PG8_WAIT_L(0); PG8_MMA(0, 1, At, B1); PG8_BAR;
            PG8_LDA(At, 1, 1); PG8_STAGEA(PG8_SA(1, 0), a3, 0);
            PG8_BAR; PG8_WAIT_L(0); PG8_MMA(1, 0, At, B0); PG8_BAR; PG8_SCHED;
            PG8_STAGE(PG8_SB(1, 1), b3 + hstepB, voffB);
            PG8_WAIT_V(6); PG8_BAR; PG8_MMA(1, 1, At, B1); PG8_BAR;
        }
        { int tz = tid; asm volatile("" : "+v"(tz)); const int l2 = tz & 63; E(acc, cur, wr, wc, l2 & 15, l2 >> 4, ept + (ui & 1) * 2048); }
        if (!has_next) break;
#pragma unroll
        for (int a = 0; a < 2; ++a)
#pragma unroll
            for (int b = 0; b < 2; ++b)
#pragma unroll
                for (int m = 0; m < 4; ++m)
#pragma unroll
                    for (int n = 0; n < 2; ++n) acc[a][b][m][n] = (f32x4){0.f, 0.f, 0.f, 0.f};
        cur = nxt; cB = nB; cA = nA; ++ui;
    }
    PG8_WAIT_V(0);
    if (wr == 0) PG8_BAR;
    PG8_BAR;
#undef PG8_SA
#undef PG8_SB
#undef PG8_STAGE
#undef PG8_STAGEA
#undef PG8_LD1
#undef PG8_LDA
#undef PG8_LDB
#undef PG8_MMA
#undef PG8_WAIT_V
#undef PG8_WAIT_L
#undef PG8_BAR
#undef PG8_SCHED
}

__device__ __forceinline__ unsigned cvt4_fp8(float a, float b, float c, float d) { int w = 0; w = __builtin_amdgcn_cvt_pk_fp8_f32(a, b, w, false); w = __builtin_amdgcn_cvt_pk_fp8_f32(c, d, w, true); return (unsigned)w; }
__device__ __forceinline__ v4u pack8_bf16(const f32x4 a, const f32x4 b) { v4u w; w.x = cvt_pk_bf16(a[0], a[1]); w.y = cvt_pk_bf16(a[2], a[3]); w.z = cvt_pk_bf16(b[0], b[1]); w.w = cvt_pk_bf16(b[2], b[3]); return w; }
__device__ __forceinline__ void unpack8(const v4u w, f32x4& a, f32x4& b) { a = (f32x4){bflo(w[0]), bfhi(w[0]), bflo(w[1]), bfhi(w[1])}; b = (f32x4){bflo(w[2]), bfhi(w[2]), bflo(w[3]), bfhi(w[3])}; }
struct EpiBf16Scale {
    bf16* O; int ldc; const float* rs;
    __device__ __forceinline__ void prefetch(const Unit& u, LAS unsigned char* tab, int lane) const {
        if (rs) __builtin_amdgcn_global_load_lds((const unsigned*)(rs + u.pm * BM + 4 * lane), (LAS unsigned*)tab, 16, 0, 0);
    }
    __device__ __forceinline__ void operator()(const f32x4 (&acc)[2][2][4][2], const Unit& u, int wr, int wc, int fr, int fq, const LAS unsigned char* tab) const {
        const int row0 = u.pm * BM + wr * 64 + fr, col0 = u.pn * BM + wc * 64 + 8 * fq;
        float sc[8];
#pragma unroll
        for (int q = 0; q < 8; ++q) sc[q] = rs ? ((const LAS float*)tab)[wr * 64 + fr + (q >> 2) * HALF + (q & 3) * 16] : 1.f;
#pragma unroll
        for (int ai = 0; ai < 2; ++ai)
#pragma unroll
            for (int m = 0; m < 4; ++m) { const int row = row0 + ai * HALF + m * 16; const float s = sc[ai * 4 + m]; bf16* rowp = O + (size_t)row * ldc + col0;
#pragma unroll
                for (int bj = 0; bj < 2; ++bj) *(v4u*)(rowp + 32 * bj) = pack8_bf16(acc[ai][bj][m][0] * s, acc[ai][bj][m][1] * s); }
    }
};
struct EpiResF32 {
    bf16* O; const bf16* X; int ldc; unsigned char* O8;
    __device__ __forceinline__ void prefetch(const Unit&, LAS unsigned char*, int) const {}
    __device__ __forceinline__ void operator()(const f32x4 (&acc)[2][2][4][2], const Unit& u, int wr, int wc, int fr, int fq, const LAS unsigned char*) const {
        const int row0 = u.pm * BM + wr * 64 + fr, col0 = u.pn * BM + wc * 64 + 8 * fq;
#pragma unroll
        for (int ai = 0; ai < 2; ++ai) {
            v4u xw[4][2];
#pragma unroll
            for (int m = 0; m < 4; ++m)
#pragma unroll
                for (int bj = 0; bj < 2; ++bj) xw[m][bj] = *(const v4u*)(X + (size_t)(row0 + ai * HALF + m * 16) * ldc + col0 + 32 * bj);
#pragma unroll
            for (int m = 0; m < 4; ++m) { const size_t ro = (size_t)(row0 + ai * HALF + m * 16) * ldc + col0;
#pragma unroll
                for (int bj = 0; bj < 2; ++bj) { f32x4 x0, x1; unpack8(xw[m][bj], x0, x1);
                    const f32x4 v0 = acc[ai][bj][m][0] + x0, v1 = acc[ai][bj][m][1] + x1;
                    *(v4u*)(O + ro + 32 * bj) = pack8_bf16(v0, v1);
                    v2u w8; w8.x = cvt4_fp8(v0[0], v0[1], v0[2], v0[3]); w8.y = cvt4_fp8(v1[0], v1[1], v1[2], v1[3]);
                    *(v2u*)(O8 + ro + 32 * bj) = w8; } }
        }
    }
};
struct EpiGateUp {
    unsigned char* Hp; const float* rr;
    __device__ __forceinline__ void prefetch(const Unit& u, LAS unsigned char* tab, int lane) const {
        __builtin_amdgcn_global_load_lds((const unsigned*)(rr + u.pm * BM + 4 * lane), (LAS unsigned*)tab, 16, 0, 0);
    }
    __device__ __forceinline__ void operator()(const f32x4 (&acc)[2][2][4][2], const Unit& u, int wr, int wc, int fr, int fq, const LAS unsigned char* tab) const {
        const int row0 = u.pm * BM + wr * 64 + fr, col0 = u.pn * HALF + wc * 32 + 8 * fq;
        float sc[8];
#pragma unroll
        for (int q = 0; q < 8; ++q) sc[q] = ((const LAS float*)tab)[wr * 64 + fr + (q >> 2) * HALF + (q & 3) * 16];
#pragma unroll
        for (int ai = 0; ai < 2; ++ai)
#pragma unroll
            for (int m = 0; m < 4; ++m) { const int row = row0 + ai * HALF + m * 16; const float s = sc[ai * 4 + m];
                float h[8];
#pragma unroll
                for (int n = 0; n < 2; ++n)
#pragma unroll
                    for (int j = 0; j < 4; ++j) { const float g = acc[ai][0][m][n][j] * s, up = acc[ai][1][m][n][j] * s; h[n * 4 + j] = g * fsigmoid(g) * up; }
                v2u w; w.x = cvt4_fp8(h[0], h[1], h[2], h[3]); w.y = cvt4_fp8(h[4], h[5], h[6], h[7]);
                *(v2u*)(Hp + (size_t)row * ED + col0) = w; }
    }
};
struct EpiDown {
    unsigned char* S0; unsigned char* S1; unsigned char* S8; const float* rw; const int* rdst;
    __device__ __forceinline__ void prefetch(const Unit& u, LAS unsigned char* tab, int lane) const {
        __builtin_amdgcn_global_load_lds((const unsigned*)(rw + u.pm * BM + 4 * lane), (LAS unsigned*)tab, 16, 0, 0);
        __builtin_amdgcn_global_load_lds((const unsigned*)(rdst + u.pm * BM + 4 * lane), (LAS unsigned*)(tab + 1024), 16, 0, 0);
    }
    __device__ __forceinline__ void operator()(const f32x4 (&acc)[2][2][4][2], const Unit& u, int wr, int wc, int fr, int fq, const LAS unsigned char* tab) const {
        const int row0 = u.pm * BM + wr * 64 + fr, col0 = u.pn * BM + wc * 64 + 16 * fq;
        float sc[8]; int ds[8];
#pragma unroll
        for (int q = 0; q < 8; ++q) { const int lr = wr * 64 + fr + (q >> 2) * HALF + (q & 3) * 16; sc[q] = ((const LAS float*)tab)[lr]; ds[q] = ((const LAS int*)(tab + 1024))[lr]; }
#pragma unroll
        for (int ai = 0; ai < 2; ++ai)
#pragma unroll
            for (int m = 0; m < 4; ++m) { const float s = sc[ai * 4 + m] * SLOT_SCALE; const int dst = ds[ai * 4 + m];
                if (dst >= 0) { unsigned char* rowp = (dst < 4 * T ? S0 + (size_t)dst * D : dst < 8 * T ? S1 + (size_t)(dst - 4 * T) * D : S8 + (size_t)(dst - 8 * T) * D) + col0;
                    v4u w;
#pragma unroll
                    for (int bj = 0; bj < 2; ++bj) { const f32x4 v0 = acc[ai][bj][m][0] * s, v1 = acc[ai][bj][m][1] * s;
                        w[2 * bj] = cvt4_fp8(v0[0], v0[1], v0[2], v0[3]); w[2 * bj + 1] = cvt4_fp8(v1[0], v1[1], v1[2], v1[3]); }
                    *(v4u*)rowp = w; } }
    }
};
struct EpiPle {
    bf16* H3; const bf16* H2; const bf16* PP; const float* ssq2; float* ssq3;
    __device__ __forceinline__ void prefetch(const Unit&, LAS unsigned char*, int) const {}
    __device__ __forceinline__ void operator()(const f32x4 (&acc)[2][2][4][2], const Unit& u, int wr, int wc, int fr, int fq, const LAS unsigned char*) const {
        const int row0 = u.pm * BM + wr * 64 + fr, col0 = u.pn * BM + wc * 64 + 8 * fq;
        float sq[8];
#pragma unroll
        for (int q = 0; q < 8; ++q) sq[q] = ssq2[row0 + (q >> 2) * HALF + (q & 3) * 16];
#pragma unroll
        for (int ai = 0; ai < 2; ++ai)
#pragma unroll
            for (int mp = 0; mp < 2; ++mp) {
                v4u hw[2][2], pw[2][2];
#pragma unroll
                for (int mm = 0; mm < 2; ++mm)
#pragma unroll
                    for (int bj = 0; bj < 2; ++bj) { const size_t o = (size_t)(row0 + ai * HALF + (2 * mp + mm) * 16) * D + col0 + 32 * bj; hw[mm][bj] = *(const v4u*)(H2 + o); pw[mm][bj] = *(const v4u*)(PP + o); }
#pragma unroll
                for (int mm = 0; mm < 2; ++mm) { const int m = 2 * mp + mm, row = row0 + ai * HALF + m * 16;
                    const float r = __builtin_amdgcn_rsqf(sq[ai * 4 + m] * (1.f / D) + EPS);
                    const size_t ro = (size_t)row * D + col0; float ss = 0.f;
#pragma unroll
                    for (int bj = 0; bj < 2; ++bj) { f32x4 h0, h1, p0, p1; unpack8(hw[mm][bj], h0, h1); unpack8(pw[mm][bj], p0, p1);
                        f32x4 o0, o1;
#pragma unroll
                        for (int j = 0; j < 4; ++j) { o0[j] = h0[j] + fsigmoid(acc[ai][bj][m][0][j] * r) * p0[j]; o1[j] = h1[j] + fsigmoid(acc[ai][bj][m][1][j] * r) * p1[j]; ss += o0[j] * o0[j] + o1[j] * o1[j]; }
                        *(v4u*)(H3 + ro + 32 * bj) = pack8_bf16(o0, o1); }
                    ss += __shfl_xor(ss, 16); ss += __shfl_xor(ss, 32);
                    if (fq == 0) ssq3[(size_t)(u.pn * 4 + wc) * T + row] = ss; }
            }
    }
};
}

struct Frame {
    LAS unsigned char* lds;
    int tid, lane, wave, G, bx;
    unsigned char* ws;
    const float* in[21];
    float* out;
};
enum { I_X = 0, I_P, I_NMIX, I_WIN, I_CONVW, I_GCONV, I_GSB, I_WOUT, I_NFFN, I_WR, I_RB, I_WEG, I_WEU, I_WED, I_WSG, I_WSU, I_WSD, I_NPLE, I_WPG, I_WPP, I_NFIN };

__device__ __forceinline__ void p0_transpose_item(const float* W, int N, bf16* WT, int ldk, int k0, int n0, int row_off, const float* g64, LAS float* scr, int lane) {
    const int n4 = lane & 15, kr = lane >> 4;
    f32x4 v[16];
    const float* src = W + (size_t)(k0 + kr) * N + n0 + 4 * n4;
#pragma unroll
    for (int i = 0; i < 16; ++i) v[i] = *(const GAS f32x4*)(src + (size_t)(4 * i) * N);
    const int c = lane >> 3, nn = lane & 7;
    f32x4 ga = (f32x4){1.f, 1.f, 1.f, 1.f}, gb = ga;
    if (g64) { ga = *(const GAS f32x4*)(g64 + 8 * c); gb = *(const GAS f32x4*)(g64 + 8 * c + 4); }
#pragma unroll
    for (int i = 0; i < 16; ++i) { LAS float* d = scr + (4 * i + kr) * 65 + 4 * n4; d[0] = v[i].x; d[1] = v[i].y; d[2] = v[i].z; d[3] = v[i].w; }
    LDS_WAIT(); asm volatile("" ::: "memory");
#pragma unroll
    for (int j = 0; j < 8; ++j) { const int n = nn + 8 * j; const LAS float* s = scr + (8 * c) * 65 + n;
        v4u o; o.x = pg8::cvt_pk_bf16(s[0] * ga.x, s[65] * ga.y); o.y = pg8::cvt_pk_bf16(s[130] * ga.z, s[195] * ga.w); o.z = pg8::cvt_pk_bf16(s[260] * gb.x, s[325] * gb.y); o.w = pg8::cvt_pk_bf16(s[390] * gb.z, s[455] * gb.w);
        *(GAS v4u*)(WT + (size_t)(row_off + n) * ldk + k0 + 8 * c) = o; }
    LDS_WAIT(); asm volatile("" ::: "memory");
}
__device__ __forceinline__ void p0_transpose_item_f8(const float* W, int N, unsigned char* WT, int ldk, int k0, int n0, int row_off, int mode, const float* g64, LAS float* scr, int lane) {
    const int n4 = lane & 15, kr = lane >> 4;
    f32x4 v[16];
    const float* src = W + (size_t)(k0 + kr) * N + n0 + 4 * n4;
#pragma unroll
    for (int i = 0; i < 16; ++i) v[i] = *(const GAS f32x4*)(src + (size_t)(4 * i) * N);
    const int c = lane >> 4, nn = lane & 15;
    float g[16];
#pragma unroll
    for (int q = 0; q < 4; ++q) { f32x4 t = (f32x4){1.f, 1.f, 1.f, 1.f}; if (g64) t = *(const GAS f32x4*)(g64 + 16 * c + 4 * q); g[4 * q] = 64.f * t.x; g[4 * q + 1] = 64.f * t.y; g[4 * q + 2] = 64.f * t.z; g[4 * q + 3] = 64.f * t.w; }
#pragma unroll
    for (int i = 0; i < 16; ++i) { LAS float* d = scr + (4 * i + kr) * 65 + 4 * n4; d[0] = v[i].x; d[1] = v[i].y; d[2] = v[i].z; d[3] = v[i].w; }
    LDS_WAIT(); asm volatile("" ::: "memory");
#pragma unroll
    for (int j = 0; j < 4; ++j) { const int n = nn + 16 * j; const LAS float* s = scr + (16 * c) * 65 + n;
        v4u o;
        o.x = pg8::cvt4_fp8(s[0] * g[0], s[65] * g[1], s[130] * g[2], s[195] * g[3]); o.y = pg8::cvt4_fp8(s[260] * g[4], s[325] * g[5], s[390] * g[6], s[455] * g[7]);
        o.z = pg8::cvt4_fp8(s[520] * g[8], s[585] * g[9], s[650] * g[10], s[715] * g[11]); o.w = pg8::cvt4_fp8(s[780] * g[12], s[845] * g[13], s[910] * g[14], s[975] * g[15]);
        const int hid = n0 + n, drow = mode == 0 ? row_off + n : 16 * (hid >> 3) + 8 * (mode - 1) + (hid & 7);
        *(GAS v4u*)(WT + (size_t)drow * ldk + k0 + 16 * c) = o; }
    LDS_WAIT(); asm volatile("" ::: "memory");
}
constexpr int P0_I_WIN = (D / 64) * (NPROJ / 64), P0_I_WOUT = (D / 64) * (D / 64), P0_I_WR = (D / 64) * (NE / 64), P0_I_WPG = (D / 64) * (D / 64), P0_I_WPP = (PLE / 64) * (D / 64);
constexpr int P0_NONEXP = P0_I_WIN + P0_I_WOUT + P0_I_WR + P0_I_WPG + P0_I_WPP;
constexpr int P0_I_EXP = 768, P0_NITEMS = P0_I_WIN + P0_I_WOUT + P0_I_WR + P0_I_WPG + P0_I_WPP + 65 * P0_I_EXP;
__device__ __forceinline__ void p0_item(Frame& F, int it, LAS float* scr) {
    unsigned char* ws = F.ws; const int lane = F.lane;
    if (it < P0_I_WIN) { const int kb = it / (NPROJ / 64), nb = it % (NPROJ / 64); p0_transpose_item(F.in[I_WIN], NPROJ, (bf16*)(ws + WS_WIN), D, 64 * kb, 64 * nb, 64 * nb, F.in[I_NMIX] + 64 * kb, scr, lane); return; } it -= P0_I_WIN;
    if (it < P0_I_WOUT) { const int kb = it / (D / 64), nb = it % (D / 64), k0 = 64 * kb; const float* g = k0 < CW ? F.in[I_GCONV] + k0 : F.in[I_GSB] + (k0 - CW);
        p0_transpose_item(F.in[I_WOUT], D, (bf16*)(ws + WS_WOUT), D, k0, 64 * nb, 64 * nb, g, scr, lane); return; } it -= P0_I_WOUT;
    if (it < P0_I_WR) { const int kb = it; p0_transpose_item(F.in[I_WR], NE, (bf16*)(ws + WS_WR), D, 64 * kb, 0, 0, F.in[I_NFFN] + 64 * kb, scr, lane); return; } it -= P0_I_WR;
    if (it < P0_I_WPG) { const int kb = it / (D / 64), nb = it % (D / 64); p0_transpose_item_f8(F.in[I_WPG], D, ws + WS_WPG, D, 64 * kb, 64 * nb, 64 * nb, 0, F.in[I_NPLE] + 64 * kb, scr, lane); return; } it -= P0_I_WPG;
    if (it < P0_I_WPP) { const int kb = it / (D / 64), nb = it % (D / 64); p0_transpose_item(F.in[I_WPP], D, (bf16*)(ws + WS_WPP), PLE, 64 * kb, 64 * nb, 64 * nb, nullptr, scr, lane); return; } it -= P0_I_WPP;
    const int e = it / P0_I_EXP, r = it % P0_I_EXP, sub = r / 256, q = r % 256;
    if (sub < 2) {
        const float* src = e < NE ? (sub == 0 ? F.in[I_WEG] : F.in[I_WEU]) + (size_t)e * D * ED : (sub == 0 ? F.in[I_WSG] : F.in[I_WSU]);
        const int kb = q / (ED / 64), nb = q % (ED / 64), n0 = 64 * nb;
        p0_transpose_item_f8(src, ED, ws + WS_WGU + (size_t)e * 1024 * D, D, 64 * kb, n0, 0, 1 + sub, F.in[I_NFFN] + 64 * kb, scr, lane);
    } else {
        const float* src = e < NE ? F.in[I_WED] + (size_t)e * ED * D : F.in[I_WSD];
        const int kb = q / (D / 64), nb = q % (D / 64);
        p0_transpose_item_f8(src, D, ws + WS_WDN + (size_t)e * D * ED, ED, 64 * kb, 64 * nb, 64 * nb, 0, nullptr, scr, lane);
    }
}
__device__ __forceinline__ void p0_prologue(Frame& F) {
    LAS float* scr = (LAS float*)(F.lds + RING_OFF + F.wave * 16896);
    const int gw = F.bx * NWAVES + F.wave, NGW = F.G * NWAVES;
    {
        bf16* XB = (bf16*)F.out; float* rmix = (float*)(F.ws + WS_RMIX); const float* x = F.in[I_X];
        for (int m = gw; m < T; m += NGW) {
            const GAS f32x4* xr = (const GAS f32x4*)(x + (size_t)m * D) + F.lane;
            f32x4 v[8]; float s = 0.f;
#pragma unroll
            for (int j = 0; j < 8; ++j) { v[j] = xr[64 * j]; s += (v[j].x * v[j].x + v[j].y * v[j].y) + (v[j].z * v[j].z + v[j].w * v[j].w); }
            s = wave_sum(s);
            if (F.lane == 0) rmix[m] = __builtin_amdgcn_rsqf(s * (1.f / D) + EPS);
            GAS v2u* o8 = (GAS v2u*)(XB + (size_t)m * D) + F.lane;
#pragma unroll
            for (int j = 0; j < 8; ++j) { v2u w; w.x = pk2(v[j].x, v[j].y); w.y = pk2(v[j].z, v[j].w); o8[64 * j] = w; }
        }
    }
    {
        const float* p = F.in[I_P]; bf16* PB = (bf16*)(F.ws + WS_PB);
        const int nchunk = T * PLE / 8, gt = F.bx * NTHR + F.tid, NGT = F.G * NTHR;
        for (int c = gt; c < nchunk; c += NGT) { const f32x4 a = *(const GAS f32x4*)(p + (size_t)c * 8), b = *(const GAS f32x4*)(p + (size_t)c * 8 + 4);
            v4u w; w.x = pk2(a.x, a.y); w.y = pk2(a.z, a.w); w.z = pk2(b.x, b.y); w.w = pk2(b.z, b.w); *(GAS v4u*)(PB + (size_t)c * 8) = w; }
    }
    for (int it = gw; it < P0_NONEXP; it += NGW) p0_item(F, it, scr);
}

__device__ __forceinline__ unsigned off_b(unsigned row, unsigned ch) { return 256u * row + 16u * (ch ^ (((row & 3) << 2) | ((row >> 2) & 3))); }
#define MFMA32(a, b, c) __builtin_amdgcn_mfma_f32_32x32x16_bf16((a), (b), (c), 0, 0, 0)

__device__ __forceinline__ void conv_item(Frame& F, int it) {
    const bf16* proj = (const bf16*)(F.ws + WS_PROJ); bf16* ymix = (bf16*)F.out + (size_t)T * D;
    const float* cw = F.in[I_CONVW]; const int lane = F.lane;
    float w0[16], w1[16], w2[16], u1[16], u2[16];
#pragma unroll
    for (int j = 0; j < 2; ++j)
#pragma unroll
        for (int i = 0; i < 8; ++i) { const int c = 512 * j + 8 * lane + i; w0[8 * j + i] = cw[c]; w1[8 * j + i] = cw[CW + c]; w2[8 * j + i] = cw[2 * CW + c]; u1[8 * j + i] = 0.f; u2[8 * j + i] = 0.f; }
    const int t0 = 16 * it; const bool seq_start = (t0 & (SEQ - 1)) == 0;
    for (int g = 0; g < 6; ++g) {
        v4u hw[3][2], cwv[3][2], bw[3][2];
#pragma unroll
        for (int q = 0; q < 3; ++q) { const long t = (long)t0 - 2 + 3 * g + q; const bf16* pr = proj + t * NPROJ + 8 * lane;
#pragma unroll
            for (int j = 0; j < 2; ++j) { hw[q][j] = *(const GAS v4u*)(pr + 512 * j); cwv[q][j] = *(const GAS v4u*)(pr + 2 * CW + 512 * j); bw[q][j] = *(const GAS v4u*)(pr + CW + 512 * j); } }
#pragma unroll
        for (int q = 0; q < 3; ++q) { const int tt = -2 + 3 * g + q; const long t = (long)t0 + tt;
            float u[16];
#pragma unroll
            for (int j = 0; j < 2; ++j)
#pragma unroll
                for (int k = 0; k < 4; ++k) { u[8 * j + 2 * k] = bflo(hw[q][j][k]) * bflo(cwv[q][j][k]); u[8 * j + 2 * k + 1] = bfhi(hw[q][j][k]) * bfhi(cwv[q][j][k]); }
            if (tt < 0 && seq_start) {
#pragma unroll
                for (int i = 0; i < 16; ++i) u[i] = 0.f;
            }
            if (tt >= 0) {
                float y[16], ss = 0.f;
#pragma unroll
                for (int j = 0; j < 2; ++j)
#pragma unroll
                    for (int k = 0; k < 4; ++k) { const int i = 8 * j + 2 * k;
                        y[i] = bflo(bw[q][j][k]) * (w0[i] * u2[i] + w1[i] * u1[i] + w2[i] * u[i]); y[i + 1] = bfhi(bw[q][j][k]) * (w0[i + 1] * u2[i + 1] + w1[i + 1] * u1[i + 1] + w2[i + 1] * u[i + 1]);
                        ss += y[i] * y[i] + y[i + 1] * y[i + 1]; }
                const float r = __builtin_amdgcn_rsqf(wave_sum(ss) * (1.f / CW) + EPS);
                bf16* yo = ymix + t * D + 8 * lane;
#pragma unroll
                for (int j = 0; j < 2; ++j) { v4u w; w.x = pg8::cvt_pk_bf16(y[8 * j] * r, y[8 * j + 1] * r); w.y = pg8::cvt_pk_bf16(y[8 * j + 2] * r, y[8 * j + 3] * r); w.z = pg8::cvt_pk_bf16(y[8 * j + 4] * r, y[8 * j + 5] * r); w.w = pg8::cvt_pk_bf16(y[8 * j + 6] * r, y[8 * j + 7] * r);
                    *(GAS v4u*)(yo + 512 * j) = w; }
            }
#pragma unroll
            for (int i = 0; i < 16; ++i) { u2[i] = u1[i]; u1[i] = u[i]; }
        }
    }
}

__device__ __forceinline__ bf16x8 pack8(float a0, float a1, float a2, float a3, float a4, float a5, float a6, float a7) {
    v4u p; p.x = pg8::cvt_pk_bf16(a0, a1); p.y = pg8::cvt_pk_bf16(a2, a3); p.z = pg8::cvt_pk_bf16(a4, a5); p.w = pg8::cvt_pk_bf16(a6, a7); return __builtin_bit_cast(bf16x8, p);
}
__device__ __forceinline__ void tr_read4(unsigned a_t0, unsigned a_t1, s16x4& r00, s16x4& r01, s16x4& r10, s16x4& r11) {
    asm volatile("ds_read_b64_tr_b16 %0, %4\n\tds_read_b64_tr_b16 %1, %5\n\tds_read_b64_tr_b16 %2, %4 offset:4096\n\tds_read_b64_tr_b16 %3, %5 offset:4096\n\ts_waitcnt lgkmcnt(0)"
                 : "=&v"(r00), "=&v"(r01), "=&v"(r10), "=&v"(r11) : "v"(a_t0), "v"(a_t1) : "memory");
}
constexpr float ATT_C = 0.08838834764831845f * 1.4426950408889634f;
constexpr float ATT_EXIT = -152.f;

__device__ __forceinline__ float attn_head(Frame& F, int lw, int h, int b, int qblk, f32x16 (&oacc)[4]) {
    const int lane = F.lane, r = lane & 31, hh = lane >> 5;
    const bf16* proj = (const bf16*)(F.ws + WS_PROJ);
    const size_t rowbase = (size_t)b * SEQ; const int t0 = qblk * 32;
    LAS unsigned char* kt = F.lds + lw * 16384; LAS unsigned char* vt = kt + 8192;
    bf16x8 qf[8];
    { const bf16* qp = proj + (rowbase + t0 + r) * NPROJ + 3 * CW + h * HD + 8 * hh;
#pragma unroll
      for (int kk = 0; kk < 8; ++kk) qf[kk] = *(const GAS bf16x8*)(qp + 16 * kk); }
#pragma unroll
    for (int c = 0; c < 4; ++c)
#pragma unroll
        for (int i = 0; i < 16; ++i) oacc[c][i] = 0.f;
    float L = 0.f;
    const unsigned pr = (unsigned)((r & 19) | ((r & 4) << 1) | ((r & 8) >> 1));
    const unsigned ktb = (unsigned)(size_t)kt, vtb = (unsigned)(size_t)vt;
    unsigned va[2][4];
    { const unsigned blk = (lane >> 4) & 1, q = (lane & 15) >> 2, p = lane & 3;
#pragma unroll
      for (int t = 0; t < 2; ++t)
#pragma unroll
          for (int c = 0; c < 4; ++c) va[t][c] = vtb + off_b(8 * hh + 4 * t + q, 4 * c + 2 * blk + (p >> 1)) + 8 * (p & 1); }
    unsigned loff[8];
#pragma unroll
    for (int i = 0; i < 8; ++i) { const unsigned row = 4 * i + (lane >> 4), ch = (lane & 15) ^ (((row & 3) << 2) | ((row >> 2) & 3)); loff[i] = (row * NPROJ + ch * 8) * 2; }
    const char* kvb = (const char*)(proj + rowbase * NPROJ + 4 * CW + h * HD);
#define ATT_DMA(ldsb, gp) do { _Pragma("unroll") for (int _i = 0; _i < 8; ++_i) \
        __builtin_amdgcn_global_load_lds((const unsigned*)((gp) + loff[_i]), (LAS unsigned*)((ldsb) + _i * 1024), 16, 0, 0); } while (0)
    { const char* g0 = kvb + (size_t)(qblk * 32) * NPROJ * 2; ATT_DMA(kt, g0); ATT_DMA(vt, g0 + CW * 2); }
    for (int kti = qblk; kti >= 0; --kti) {
        const int s0 = kti * 32;
        const char* gn = kvb + (size_t)((kti > 0 ? kti - 1 : 0) * 32) * NPROJ * 2;
        asm volatile("s_waitcnt vmcnt(8)" ::: "memory");
        f32x16 x;
#pragma unroll
        for (int i = 0; i < 16; ++i) x[i] = 0.f;
        bf16x8 kf[8];
#pragma unroll
        for (int kk = 0; kk < 8; ++kk) kf[kk] = *(const LAS bf16x8*)(kt + off_b(pr, 2 * kk + hh));
        LDS_WAIT();
        ATT_DMA(kt, gn);
#pragma unroll
        for (int kk = 0; kk < 8; ++kk) x = MFMA32(kf[kk], qf[kk], x);
        const bool diag = (kti == qblk);
        float zz[16], suf[16];
#pragma unroll
        for (int i = 0; i < 16; ++i) {
            zz[i] = x[i] * ATT_C;
            const float e = __builtin_amdgcn_exp2f(fminf(zz[i], 126.f));
            float l = -__builtin_amdgcn_logf(1.f + e);
            const int kap = 16 * (i >> 3) + 8 * hh + (i & 7);
            if (diag && !(kap < r)) l = 0.f;
            suf[i] = l;
        }
#pragma unroll
        for (int j = 6; j >= 0; --j) { suf[j] += suf[j + 1]; suf[8 + j] += suf[8 + j + 1]; }
        const float T0 = suf[0], T1 = suf[8];
        const float T0p = __shfl_xor(T0, 32), T1p = __shfl_xor(T1, 32);
        const float base0 = L + T1 + T1p + (hh == 0 ? T0p : 0.f), base1 = L + (hh == 0 ? T1p : 0.f);
        float a[16];
#pragma unroll
        for (int i = 0; i < 16; ++i) {
            float v = __builtin_amdgcn_exp2f(zz[i] + (i < 8 ? base0 : base1) + suf[i]);
            const int kap = 16 * (i >> 3) + 8 * hh + (i & 7);
            if (diag && !(kap < r)) v = 0.f;
            a[i] = v;
        }
        L += (T0 + T1) + (T0p + T1p);
        const bf16x8 pf0 = pack8(a[0], a[1], a[2], a[3], a[4], a[5], a[6], a[7]);
        const bf16x8 pf1 = pack8(a[8], a[9], a[10], a[11], a[12], a[13], a[14], a[15]);
        asm volatile("s_waitcnt vmcnt(8)" ::: "memory");
#pragma unroll
        for (int c = 0; c < 4; ++c) {
            s16x4 r00, r01, r10, r11; tr_read4(va[0][c], va[1][c], r00, r01, r10, r11);
            const bf16x8 vf0 = __builtin_shufflevector(r00, r01, 0, 1, 2, 3, 4, 5, 6, 7), vf1 = __builtin_shufflevector(r10, r11, 0, 1, 2, 3, 4, 5, 6, 7);
            oacc[c] = MFMA32(vf0, pf0, oacc[c]); oacc[c] = MFMA32(vf1, pf1, oacc[c]);
        }
        ATT_DMA(vt, gn + CW * 2);
        if (__all(L < ATT_EXIT)) break;
    }
    VM_WAIT();
#undef ATT_DMA
    float ss = 0.f;
#pragma unroll
    for (int c = 0; c < 4; ++c)
#pragma unroll
        for (int i = 0; i < 16; ++i) ss += oacc[c][i] * oacc[c][i];
    ss += __shfl_xor(ss, 32);
    return ss;
}
constexpr int P2_BSCR_OFF = 65536, P2_XS_OFF = P2_BSCR_OFF + 4 * 16896;
static_assert(P2_XS_OFF + 2048 <= LDS_BYTES, "P2 LDS map");
__device__ __forceinline__ void p2_mixer(Frame& F) {
    const int lane = F.lane, w = F.wave, r = lane & 31, hh = lane >> 5;
    const int nunits = (NB * (SEQ / 32) - F.bx + F.G - 1) / F.G;
    if (w < 4) {
        bf16* ymix = (bf16*)F.out + (size_t)T * D;
        for (int j = 0; j < nunits; ++j) {
            const int u = F.bx + j * F.G, b = u / (SEQ / 32), qblk = u % (SEQ / 32);
            LAS float* XS = (LAS float*)(F.lds + P2_XS_OFF) + (j & 1) * 256;
            v2u st0[16];
            f32x16 oacc[4];
            const float ss0 = attn_head(F, w, w, b, qblk, oacc);
#pragma unroll
            for (int c = 0; c < 4; ++c)
#pragma unroll
                for (int g = 0; g < 4; ++g) { st0[c * 4 + g].x = pg8::cvt_pk_bf16(oacc[c][4 * g], oacc[c][4 * g + 1]); st0[c * 4 + g].y = pg8::cvt_pk_bf16(oacc[c][4 * g + 2], oacc[c][4 * g + 3]); }
            if (hh == 0) XS[w * 32 + r] = ss0;
            const float ss1 = attn_head(F, w, w + 4, b, qblk, oacc);
            if (hh == 0) XS[(w + 4) * 32 + r] = ss1;
            __syncthreads();
            float tot = 0.f;
#pragma unroll
            for (int k = 0; k < 8; ++k) tot += XS[k * 32 + r];
            const float rs = __builtin_amdgcn_rsqf(tot * (1.f / CW) + EPS);
            bf16* yo = ymix + ((size_t)b * SEQ + qblk * 32 + r) * D + CW + 4 * hh;
#pragma unroll
            for (int c = 0; c < 4; ++c)
#pragma unroll
                for (int g = 0; g < 4; ++g) {
                    v2u o0; o0.x = pg8::cvt_pk_bf16(bflo(st0[c * 4 + g].x) * rs, bfhi(st0[c * 4 + g].x) * rs); o0.y = pg8::cvt_pk_bf16(bflo(st0[c * 4 + g].y) * rs, bfhi(st0[c * 4 + g].y) * rs);
                    *(GAS v2u*)(yo + w * HD + 32 * c + 8 * g) = o0;
                    v2u o1; o1.x = pg8::cvt_pk_bf16(oacc[c][4 * g] * rs, oacc[c][4 * g + 1] * rs); o1.y = pg8::cvt_pk_bf16(oacc[c][4 * g + 2] * rs, oacc[c][4 * g + 3] * rs);
                    *(GAS v2u*)(yo + (w + 4) * HD + 32 * c + 8 * g) = o1; }
        }
    } else {
        LAS float* scr = (LAS float*)(F.lds + P2_BSCR_OFF + (w - 4) * 16896);
        const int gb = F.bx * 4 + (w - 4), NBW = F.G * 4;
        const int cnt = (P0_NITEMS - P0_NONEXP - gb + NBW - 1) / NBW;
        for (int j = 0; j < nunits; ++j) {
            const int k0 = (int)((long)cnt * j / nunits), k1 = (int)((long)cnt * (j + 1) / nunits);
            for (int k = k0; k < k1; ++k) p0_item(F, P0_NONEXP + gb + k * NBW, scr);
            __syncthreads();
        }
    }
    const int gw = F.bx * NWAVES + F.wave, NGW = F.G * NWAVES;
    for (int it = gw; it < T / 16; it += NGW) conv_item(F, it);
}

__device__ __forceinline__ void router_unit(Frame& F, int unit, LAS int* hist) {
    const int lane = F.lane, r16 = lane & 15, g = lane >> 4;
    const bf16* H = (const bf16*)(F.ws + WS_H1B); const bf16* WR = (const bf16*)(F.ws + WS_WR);
    const int t0 = unit * 16;
    LAS float* LG = (LAS float*)(F.lds + F.wave * 16384); LAS float* BI = LG + 16 * 65 + 16;
    f32x4 acc[4];
#pragma unroll
    for (int nb = 0; nb < 4; ++nb) acc[nb] = (f32x4){0.f, 0.f, 0.f, 0.f};
    float ss = 0.f;
    const bf16* ap = H + (size_t)(t0 + r16) * D + 8 * g; const bf16* bp = WR + (size_t)r16 * D + 8 * g;
#pragma unroll 8
    for (int ks = 0; ks < D / 32; ++ks) {
        const v4u aw = *(const GAS v4u*)(ap + 32 * ks);
#pragma unroll
        for (int q = 0; q < 4; ++q) { const float lo = bflo(aw[q]), hi = bfhi(aw[q]); ss += lo * lo + hi * hi; }
        const bf16x8 af = __builtin_bit_cast(bf16x8, aw);
#pragma unroll
        for (int nb = 0; nb < 4; ++nb) { const bf16x8 bf = *(const GAS bf16x8*)(bp + (size_t)(16 * nb) * D + 32 * ks); acc[nb] = __builtin_amdgcn_mfma_f32_16x16x32_bf16(af, bf, acc[nb], 0, 0, 0); }
    }
    ss += __shfl_xor(ss, 16); ss += __shfl_xor(ss, 32);
#pragma unroll
    for (int nb = 0; nb < 4; ++nb)
#pragma unroll
        for (int j = 0; j < 4; ++j) LG[(4 * g + j) * 65 + 16 * nb + r16] = acc[nb][j];
    LDS_WAIT();
    if (lane < 16) {
        const int t = t0 + lane; const float rs = __builtin_amdgcn_rsqf(ss * (1.f / D) + EPS);
        ((float*)(F.ws + WS_RFFN))[t] = rs;
        const LAS float* lg = LG + lane * 65; const float* rb = F.in[I_RB];
        float sc[NE], bi[NE];
#pragma unroll
        for (int e = 0; e < NE; ++e) { const float s = fsigmoid(lg[e] * rs); sc[e] = s; bi[e] = s + rb[e]; }
        float gs[8];
#pragma unroll
        for (int gg = 0; gg < 8; ++gg) { float m1 = -__builtin_inff(), m2 = -__builtin_inff();
#pragma unroll
            for (int j = 0; j < 8; ++j) { const float v = bi[8 * gg + j]; const float lo = fminf(m1, v); m1 = fmaxf(m1, v); m2 = fmaxf(m2, lo); }
            gs[gg] = m1 + m2; }
        bool okg[8];
#pragma unroll
        for (int gg = 0; gg < 8; ++gg) { int cnt = 0;
#pragma unroll
            for (int g2 = 0; g2 < 8; ++g2) cnt += (gs[g2] > gs[gg] || (gs[g2] == gs[gg] && g2 < gg)) ? 1 : 0;
            okg[gg] = cnt < 4; }
#pragma unroll
        for (int e = 0; e < NE; ++e) bi[e] = okg[e >> 3] ? bi[e] : -__builtin_inff();
        int se[8]; float sv[8]; float wsum = 0.f;
#pragma unroll
        for (int k = 0; k < 8; ++k) { float best = -__builtin_inff(); int be = 0;
#pragma unroll
            for (int e = 0; e < NE; ++e) { const bool tk = bi[e] > best; best = tk ? bi[e] : best; be = tk ? e : be; }
            float svk = 0.f;
#pragma unroll
            for (int e = 0; e < NE; ++e) { const bool hit = (e == be); svk = hit ? sc[e] : svk; bi[e] = hit ? -__builtin_inff() : bi[e]; }
            se[k] = be; sv[k] = svk; wsum += svk; }
        const float inv = 2.5f / wsum;
        int* te = (int*)(F.ws + WS_TOPE) + (size_t)t * 8; float* tw = (float*)(F.ws + WS_TOPW) + (size_t)t * 8;
#pragma unroll
        for (int k = 0; k < 8; ++k) { te[k] = se[k]; tw[k] = sv[k] * inv; (void)__hip_atomic_fetch_add(hist + se[k], 1, __ATOMIC_RELAXED, __HIP_MEMORY_SCOPE_WORKGROUP); }
    }
}
__device__ __forceinline__ void p4_router(Frame& F) {
    LAS int* hist = (LAS int*)(F.lds + RT_OFF);
    for (int v = F.bx; v < 256; v += F.G) {
        if (F.tid < 64) hist[F.tid] = 0;
        __syncthreads();
        router_unit(F, v * 8 + F.wave, hist);
        __syncthreads();
        if (F.tid < 64) ((int*)(F.ws + WS_CNT))[v * 64 + F.tid] = hist[F.tid];
        __syncthreads();
    }
}

__device__ __forceinline__ void p4b_tables(Frame& F) {
    LAS int* L = (LAS int*)(F.lds + RING_OFF);
    LAS int* part_t = L;
    LAS int* part_b = L + 512;
    LAS int* totals = L + 1024;
    LAS int* below = L + 1088;
    LAS int* segst = L + 1152;
    LAS int* wcount = L + 1280;
    LAS int* pe = L + 2048;
    LAS int* rank = L + 3072;
    const int* CNT = (const int*)(F.ws + WS_CNT); const int* TOPE = (const int*)(F.ws + WS_TOPE); const float* TOPW = (const float*)(F.ws + WS_TOPW);
    const float* RFFN = (const float*)(F.ws + WS_RFFN);
    int* RTOK = (int*)(F.ws + WS_RTOK); float* RW = (float*)(F.ws + WS_RW); int* RDST = (int*)(F.ws + WS_RDST); float* RR = (float*)(F.ws + WS_RR); int* TILEE = (int*)(F.ws + WS_TILEE);
    const int tid = F.tid, lane = F.lane, wave = F.wave;
    for (int v = F.bx; v < 256; v += F.G) {
        { const int e = tid & 63, part = tid >> 6; int tot = 0, bel = 0;
          for (int vv = 32 * part; vv < 32 * part + 32; ++vv) { const int c = CNT[vv * 64 + e]; tot += c; bel += (vv < v) ? c : 0; }
          part_t[part * 64 + e] = tot; part_b[part * 64 + e] = bel; }
        for (int i = tid; i < 1024; i += NTHR) pe[i] = TOPE[(size_t)v * 1024 + i];
        __syncthreads();
        if (wave == 0) {
            int tot = 0, bel = 0;
#pragma unroll
            for (int p = 0; p < 8; ++p) { tot += part_t[p * 64 + lane]; bel += part_b[p * 64 + lane]; }
            totals[lane] = tot; below[lane] = bel;
            const int ru = (tot + 255) & ~255; int sc = ru;
#pragma unroll
            for (int o = 1; o < 64; o <<= 1) { const int n = __shfl_up(sc, o); if (lane >= o) sc += n; }
            segst[lane] = sc - ru; if (lane == 63) segst[64] = sc;
        }
        { int cnt = 0;
          for (int j = 0; j < 128; ++j) { const int p = 128 * wave + j; if (pe[p] == lane) { rank[p] = cnt; ++cnt; } }
          wcount[wave * 64 + lane] = cnt; }
        __syncthreads();
        const int SS = segst[64];
        for (int p = tid; p < 1024; p += NTHR) { const int e = pe[p], w = p >> 7; int off = 0;
            for (int w2 = 0; w2 < w; ++w2) off += wcount[w2 * 64 + e];
            const int row = segst[e] + below[e] + off + rank[p]; const int t = 128 * v + (p >> 3), k = p & 7;
            RTOK[row] = t; RW[row] = TOPW[(size_t)t * 8 + k]; RDST[row] = k * T + t; RR[row] = RFFN[t]; }
        if (tid < 128) { const int t = 128 * v + tid, row = SS + t; RTOK[row] = t; RW[row] = 1.f; RDST[row] = 8 * T + t; RR[row] = RFFN[t]; }
        if (v < NE) { const int e = v, tot = totals[e], ru = (tot + 255) & ~255, st = segst[e];
            if (tid < ru - tot) { const int row = st + tot + tid; RTOK[row] = 0; RW[row] = 0.f; RDST[row] = -1; RR[row] = 0.f; }
            if (tid < ru / 256) TILEE[st / 256 + tid] = e; }
        if (v == NE) { if (tid < T / 256) TILEE[SS / 256 + tid] = NE; if (tid == 0) TILEE[MAXTILES] = SS / 256 + T / 256; }
        __syncthreads();
    }
}

template <int MODE> __device__ __forceinline__ int group_setup(Frame& F, int nN) {
    const int* TILEE = (const int*)(F.ws + WS_TILEE);
    const int NT = __builtin_amdgcn_readfirstlane((int)__hip_atomic_load((unsigned*)TILEE + MAXTILES, RLX_AGENT));
    LAS int* te = (LAS int*)(F.lds + TE_OFF); LAS unsigned* rt = (LAS unsigned*)(F.lds + RT_OFF);
    for (int i = F.tid; i < NT && i < MAXTILES; i += NTHR) te[i] = TILEE[i];
    if (MODE == 1) {
        const int* RTOK = (const int*)(F.ws + WS_RTOK);
        for (int ui = F.tid >> 8; ui < RT_UNITS; ui += 2) { int pm, pn; if (!pg8::order_next(ui, F.G, F.bx, NT, nN, pm, pn)) break;
            rt[ui * 256 + (F.tid & 255)] = (unsigned)RTOK[pm * 256 + (F.tid & 255)] * (unsigned)D; }
    }
    __syncthreads();
    return NT;
}

__device__ __forceinline__ void acc_fp8x16(const v4u w, float (&o)[16]) {
#pragma unroll
    for (int q = 0; q < 4; ++q) { const f32x2 lo = __builtin_amdgcn_cvt_pk_f32_fp8((int)w[q], false), hi = __builtin_amdgcn_cvt_pk_f32_fp8((int)w[q], true);
        o[4 * q] += lo.x; o[4 * q + 1] += lo.y; o[4 * q + 2] += hi.x; o[4 * q + 3] += hi.y; }
}
__device__ __forceinline__ void p7_combine(Frame& F, int n) {
    const int gw = F.bx * NWAVES + F.wave, NGW = F.G * NWAVES, lane = F.lane;
    bf16* H = (bf16*)(F.ws + WS_H1B); const unsigned char* S0 = (const unsigned char*)F.out; const unsigned char* S1 = F.ws + WS_SLOT47; const unsigned char* S8 = F.ws + WS_SLOT8;
    float* ssq2 = (float*)(F.ws + WS_SSQ2);
    for (int t = gw; t < T; t += NGW) {
        float ss = 0.f;
#pragma unroll
        for (int ch = 0; ch < 2; ++ch) {
            const int co = 1024 * ch + 16 * lane;
            bf16* hp = H + (size_t)t * D + co;
            const v4u h0 = *(const GAS v4u*)hp, h1 = *(const GAS v4u*)(hp + 8);
            v4u w[9];
#pragma unroll
            for (int k = 0; k < 4; ++k) { w[k] = *(const GAS v4u*)(S0 + ((size_t)k * T + t) * D + co); w[4 + k] = *(const GAS v4u*)(S1 + ((size_t)k * T + t) * D + co); }
            w[8] = *(const GAS v4u*)(S8 + (size_t)t * D + co);
            float o[16];
#pragma unroll
            for (int i = 0; i < 16; ++i) o[i] = 0.f;
#pragma unroll
            for (int k = 0; k < 9; ++k) acc_fp8x16(w[k], o);
            f32x4 a0, a1, a2, a3; pg8::unpack8(h0, a0, a1); pg8::unpack8(h1, a2, a3);
#pragma unroll
            for (int j = 0; j < 4; ++j) { a0[j] += o[j] * (1.f / SLOT_SCALE); a1[j] += o[4 + j] * (1.f / SLOT_SCALE); a2[j] += o[8 + j] * (1.f / SLOT_SCALE); a3[j] += o[12 + j] * (1.f / SLOT_SCALE);
                ss += (a0[j] * a0[j] + a1[j] * a1[j]) + (a2[j] * a2[j] + a3[j] * a3[j]); }
            *(GAS v4u*)hp = pg8::pack8_bf16(a0, a1); *(GAS v4u*)(hp + 8) = pg8::pack8_bf16(a2, a3);
            { v4u w8; w8.x = pg8::cvt4_fp8(a0[0], a0[1], a0[2], a0[3]); w8.y = pg8::cvt4_fp8(a1[0], a1[1], a1[2], a1[3]); w8.z = pg8::cvt4_fp8(a2[0], a2[1], a2[2], a2[3]); w8.w = pg8::cvt4_fp8(a3[0], a3[1], a3[2], a3[3]);
              *(GAS v4u*)(F.ws + WS_H1F8 + (size_t)t * D + co) = w8; }
        }
        ss = wave_sum(ss);
        if (lane == 0) ssq2[t] = ss;
    }
}

__device__ __forceinline__ void p9_final(Frame& F, const bf16* H, const float* ssq, int nparts) {
    const int gw = F.bx * NWAVES + F.wave, NGW = F.G * NWAVES, lane = F.lane; const float* g = F.in[I_NFIN];
    for (int t = gw; t < T; t += NGW) {
        v4u w[4];
#pragma unroll
        for (int j = 0; j < 4; ++j) w[j] = *(const GAS v4u*)(H + (size_t)t * D + 512 * j + 8 * lane);
        float ss = 0.f;
        if (nparts > 0) { if (lane < nparts) ss = ssq[(size_t)lane * T + t]; }
        else {
#pragma unroll
            for (int j = 0; j < 4; ++j)
#pragma unroll
                for (int q = 0; q < 4; ++q) { const float lo = bflo(w[j][q]), hi = bfhi(w[j][q]); ss += lo * lo + hi * hi; }
        }
        const float r = __builtin_amdgcn_rsqf(wave_sum(ss) * (1.f / D) + EPS);
        float* o = F.out + (size_t)t * D;
#pragma unroll
        for (int j = 0; j < 4; ++j) { const int c = 512 * j + 8 * lane; const f32x4 g0 = *(const GAS f32x4*)(g + c), g1 = *(const GAS f32x4*)(g + c + 4);
            f32x4 a, b; a.x = bflo(w[j][0]) * r * g0.x; a.y = bfhi(w[j][0]) * r * g0.y; a.z = bflo(w[j][1]) * r * g0.z; a.w = bfhi(w[j][1]) * r * g0.w;
            b.x = bflo(w[j][2]) * r * g1.x; b.y = bfhi(w[j][2]) * r * g1.y; b.z = bflo(w[j][3]) * r * g1.z; b.w = bfhi(w[j][3]) * r * g1.w;
            *(GAS f32x4*)(o + c) = a; *(GAS f32x4*)(o + c + 4) = b; }
    }
}

struct Args { const float* in[21]; float* out; unsigned char* ws; int ph_lo, ph_hi, fin_mode, li; };
__global__ void __launch_bounds__(NTHR, 2) mk_fwd(Args args) {
    extern __shared__ __attribute__((aligned(16))) unsigned char lds[];
    Frame F;
    F.lds = (LAS unsigned char*)lds;
    F.tid = threadIdx.x; F.lane = F.tid & 63; F.wave = __builtin_amdgcn_readfirstlane(F.tid >> 6);
    F.G = gridDim.x; F.bx = blockIdx.x; F.ws = args.ws; F.out = args.out;
#pragma unroll
    for (int i = 0; i < 21; ++i) F.in[i] = args.in[i];
    volatile LAS unsigned* MISC = (volatile LAS unsigned*)(F.lds + MISC_OFF);
    if (F.tid < 32) MISC[F.tid] = 0u;
    __syncthreads();
    XcdBarrier bar = xcd_barrier_post((unsigned*)(F.ws + WS_CTL) + CW_BAR + args.li * XCD_BAR_WORDS, MISC + 8);
    unsigned char* ws = F.ws;
    const int lo = args.ph_lo, hi = args.ph_hi;
    LAS unsigned char* ring = F.lds + RING_OFF;
#define PHASE(k) if (lo <= (k) && (k) < hi)
#define PH(k) PHASE(k) { RELANE();
#define GRID_BAR() xcd_barrier(bar)
#define RELANE() do { int _t = threadIdx.x; asm volatile("" : "+v"(_t)); F.tid = _t; F.lane = _t & 63; F.wave = __builtin_amdgcn_readfirstlane(_t >> 6); } while (0)

    PHASE(0) { RELANE(); p0_prologue(F); GRID_BAR(); }
    PHASE(1) { RELANE();
        pg8::DenseSched S{T / 256, NPROJ / 256, F.G, F.bx, D * 2, (const char*)(ws + WS_WIN)};
        pg8::EpiBf16Scale E{(bf16*)(ws + WS_PROJ), NPROJ, (const float*)(ws + WS_RMIX)};
        pg8::gemm_phase<false, 1>(F.tid, ring, (const char*)F.out, D * 2, S, E);
        GRID_BAR();
    }
    PHASE(2) { RELANE(); p2_mixer(F); GRID_BAR(); }
    PHASE(3) { RELANE();
        pg8::DenseSched S{T / 256, D / 256, F.G, F.bx, D * 2, (const char*)(ws + WS_WOUT)};
        pg8::EpiResF32 E{(bf16*)(ws + WS_H1B), (const bf16*)F.out, D, ws + WS_H1F8};
        pg8::gemm_phase<false, 1>(F.tid, ring, (const char*)((bf16*)F.out + (size_t)T * D), D * 2, S, E);
        GRID_BAR();
    }
    PHASE(4) { RELANE(); p4_router(F); GRID_BAR(); }
    PHASE(5) { RELANE(); p4b_tables(F); GRID_BAR(); }
    PHASE(6) { RELANE();
        const int NT = group_setup<1>(F, 4);
        pg8::GroupSched<1> S{NT, 4, F.G, F.bx, D, 0, (const char*)(ws + WS_WGU), (size_t)1024 * D, (const LAS int*)(F.lds + TE_OFF), (const LAS unsigned*)(F.lds + RT_OFF)};
        pg8::EpiGateUp E{ws + WS_HPERM, (const float*)(ws + WS_RR)};
        pg8::gemm_phase<true, 0>(F.tid, ring, (const char*)(ws + WS_H1F8), D, S, E, 0x79797979, 0x7f7f7f7f);
        GRID_BAR();
    }
    {
        for (int n = 0; n < NSLICE; ++n) {
            PHASE(7 + 2 * n) { RELANE();
            const int NT = group_setup<2>(F, SLW / 256);
            pg8::GroupSched<2> S{NT, SLW / 256, F.G, F.bx, ED, (SLW / 256) * n, (const char*)(ws + WS_WDN), (size_t)D * ED, (const LAS int*)(F.lds + TE_OFF), (const LAS unsigned*)(F.lds + RT_OFF)};
            pg8::EpiDown E{(unsigned char*)F.out, ws + WS_SLOT47, ws + WS_SLOT8, (const float*)(ws + WS_RW), (const int*)(ws + WS_RDST)};
            pg8::gemm_phase<true, 0>(F.tid, ring, (const char*)(ws + WS_HPERM), ED, S, E, 0x79797979, 0x7f7f7f7f);
            GRID_BAR();
            }
            PHASE(8 + 2 * n) { RELANE();
            p7_combine(F, n);
            GRID_BAR();
            }
        }
    }
    PHASE(15) { RELANE();
        pg8::DenseSched S{T / 256, D / 256, F.G, F.bx, PLE * 2, (const char*)(ws + WS_WPP)};
        pg8::EpiBf16Scale E{(bf16*)(ws + WS_PP), D, nullptr};
        pg8::gemm_phase<false, 1>(F.tid, ring, (const char*)(ws + WS_PB), PLE * 2, S, E);
        GRID_BAR();
    }
    PHASE(16) { RELANE();
        pg8::DenseSchedG S{T / 256, D / 256, F.G, F.bx, D, (const char*)(ws + WS_WPG)};
        pg8::EpiPle E{(bf16*)(ws + WS_H3), (const bf16*)(ws + WS_H1B), (const bf16*)(ws + WS_PP), (const float*)(ws + WS_SSQ2), (float*)(ws + WS_SSQ3)};
        pg8::gemm_phase<true, 1>(F.tid, ring, (const char*)(ws + WS_H1F8), D, S, E, 0x79797979, 0x7f7f7f7f);
        GRID_BAR();
    }
    PHASE(17) { RELANE();
    if (args.fin_mode == 0) p9_final(F, (const bf16*)(ws + WS_H3), (const float*)(ws + WS_SSQ3), 32);
    else p9_final(F, (const bf16*)(ws + WS_H1B), nullptr, 0);
    }
}

extern "C" void kernel_launch(void* const* d_in, const int* in_sizes, int n_in, void* d_out, int out_size, void* d_ws, size_t ws_size, hipStream_t stream) {
    static int grid = 0;
    if (grid == 0) {
        int dev = 0, cus = 0;
        if (n_in != 21 || ws_size < WS_END) { fprintf(stderr, "kernel_launch: n_in %d ws %zu (need %zu)\n", n_in, ws_size, (size_t)WS_END); grid = -1; return; }
        if (hipGetDevice(&dev) != hipSuccess || hipDeviceGetAttribute(&cus, hipDeviceAttributeMultiprocessorCount, dev) != hipSuccess) { grid = -1; return; }
        if (hipFuncSetAttribute((const void*)mk_fwd, hipFuncAttributeMaxDynamicSharedMemorySize, LDS_BYTES) != hipSuccess) { fprintf(stderr, "hipFuncSetAttribute failed\n"); grid = -1; return; }
        int per_cu = 0;
        (void)hipOccupancyMaxActiveBlocksPerMultiprocessor(&per_cu, (const void*)mk_fwd, NTHR, LDS_BYTES);
        (void)hipGetLastError();
        grid = cus > 256 ? 256 : cus;
    }
    if (grid < 0) return;
    (void)hipMemsetAsync((char*)d_ws + WS_CTL, 0, CTL_ZERO_BYTES, stream);
    Args a{};
    for (int i = 0; i < 21; ++i) a.in[i] = (const float*)d_in[i];
    a.out = (float*)d_out; a.ws = (unsigned char*)d_ws; a.fin_mode = FIN_MODE;
#if PROBE_K >= 0
    a.ph_lo = 0; a.ph_hi = PROBE_K + 1; a.li = 0;
    hipLaunchKernelGGL(mk_fwd, dim3(grid), dim3(NTHR), LDS_BYTES, stream, a);
    a.ph_lo = PROBE_K; a.ph_hi = PH_HI; a.li = 1;
    hipLaunchKernelGGL(mk_fwd, dim3(grid), dim3(NTHR), LDS_BYTES, stream, a);
#else
    a.ph_lo = 0; a.ph_hi = PH_HI; a.li = 0;
    hipLaunchKernelGGL(mk_fwd, dim3(grid), dim3(NTHR), LDS_BYTES, stream, a);
#endif
}
```

```cpp
#include <hip/hip_runtime.h>
#include <cstdio>
#ifndef PROBE_K
#define PROBE_K -1
#endif
#ifndef PH_HI
#define PH_HI 100
#endif
#ifndef FIN_MODE
#define FIN_MODE 0
#endif

#define GAS __attribute__((address_space(1)))
#define LAS __attribute__((address_space(3)))
typedef unsigned short bf16;
typedef unsigned v4u __attribute__((ext_vector_type(4)));
typedef unsigned v2u __attribute__((ext_vector_type(2)));
typedef float f32x4 __attribute__((ext_vector_type(4)));
typedef float f32x2 __attribute__((ext_vector_type(2)));
typedef float f32x16 __attribute__((ext_vector_type(16)));
typedef short bf16x8 __attribute__((ext_vector_type(8)));
typedef short s16x4 __attribute__((ext_vector_type(4)));
typedef GAS unsigned gu32;
#define RLX_AGENT __ATOMIC_RELAXED, __HIP_MEMORY_SCOPE_AGENT
#define LDS_WAIT() asm volatile("s_waitcnt lgkmcnt(0)" ::: "memory")
#define VM_WAIT() asm volatile("s_waitcnt vmcnt(0)" ::: "memory")

constexpr int NB = 8, SEQ = 4096, T = NB * SEQ, D = 2048, NPROJ = 6144, CW = 1024, HD = 128, NH = 8;
constexpr int PCW = 3 * CW;
constexpr int PLE = 256, NE = 64, ED = 512, TOPK = 8, NSLOT = 9;
constexpr float EPS = 1e-6f;
constexpr int NWAVES = 8, NTHR = 512;
constexpr int MAXTILES = 1216;
constexpr int MAXROWS = MAXTILES * 256;
constexpr int NSLICE = 1, SLW = D / NSLICE;
constexpr float SLOT_SCALE = 16.f;

constexpr size_t MiB = 1u << 20;
constexpr size_t WS_CTL = 0, CTL_ZERO_BYTES = 1 * MiB;
constexpr size_t WS_RMIX = 1 * MiB;
constexpr size_t WS_RFFN = WS_RMIX + 128 * 1024;
constexpr size_t WS_SSQ2 = WS_RFFN + 128 * 1024;
constexpr size_t WS_SSQ3 = WS_SSQ2 + 512 * 1024;
constexpr size_t WS_TOPE = WS_SSQ3 + 4 * MiB;
constexpr size_t WS_TOPW = WS_TOPE + 1 * MiB;
constexpr size_t WS_CNT  = WS_TOPW + 1 * MiB;
constexpr size_t WS_RTOK = WS_CNT + 64 * 1024;
constexpr size_t WS_RW   = WS_RTOK + 1280 * 1024;
constexpr size_t WS_RDST = WS_RW + 1280 * 1024;
constexpr size_t WS_RR   = WS_RDST + 1280 * 1024;
constexpr size_t WS_TILEE = WS_RR + 1280 * 1024;
constexpr size_t WS_WR   = 16 * MiB;
constexpr size_t WS_WIN  = 17 * MiB;
constexpr size_t WS_WOUT = WS_WIN + 24 * MiB;
constexpr size_t WS_WGU  = WS_WOUT + 8 * MiB;
constexpr size_t WS_WDN  = WS_WGU + 130 * MiB;
constexpr size_t WS_WPG  = WS_WDN + 65 * MiB;
constexpr size_t WS_WPP  = WS_WPG + 8 * MiB;
constexpr size_t WS_PB   = WS_WPP + 1 * MiB;
constexpr size_t WS_H1B  = WS_PB + 16 * MiB;
constexpr size_t WS_H1F8 = WS_H1B + 128 * MiB;
constexpr size_t WS_OVL  = WS_H1F8 + 64 * MiB;
constexpr size_t WS_PROJ = WS_OVL;
constexpr size_t WS_QKV  = WS_OVL + 192 * MiB;
constexpr size_t WS_HPERM = WS_OVL;
constexpr size_t WS_SLOT8 = WS_OVL + 304 * MiB;
constexpr size_t WS_PP   = WS_OVL;
constexpr size_t WS_H3   = WS_OVL + 128 * MiB;
constexpr size_t WS_SLOT47 = WS_OVL + 384 * MiB;
constexpr size_t WS_END  = WS_SLOT47 + 256 * MiB;
constexpr int CW_BAR = 4096;

constexpr int RING_OFF = 0, RING_BYTES = 131072;
constexpr int RT_OFF = 131072, RT_UNITS = 20, RT_BYTES = RT_UNITS * 1024;
constexpr int TE_OFF = RT_OFF + RT_BYTES, TE_BYTES = 4864 + 128;
constexpr int EPT_OFF = TE_OFF + TE_BYTES, EPT_BYTES = 4096;
constexpr int MISC_OFF = EPT_OFF + EPT_BYTES;
constexpr int LDS_BYTES = MISC_OFF + 128;
static_assert(LDS_BYTES <= 163840, "LDS");

__device__ __forceinline__ unsigned f2bf(float f) { unsigned u = __builtin_bit_cast(unsigned, f); return (u + 0x7fffu + ((u >> 16) & 1u)) >> 16; }
__device__ __forceinline__ unsigned pk2(float lo, float hi) { return f2bf(lo) | (f2bf(hi) << 16); }
__device__ __forceinline__ float bflo(unsigned w) { return __builtin_bit_cast(float, w << 16); }
__device__ __forceinline__ float bfhi(unsigned w) { return __builtin_bit_cast(float, w & 0xffff0000u); }
__device__ __forceinline__ float wave_sum(float v) {
#pragma unroll
    for (int o = 1; o < 64; o <<= 1) v += __shfl_xor(v, o);
    return v;
}
__device__ __forceinline__ float fsigmoid(float v) { return __builtin_amdgcn_rcpf(1.f + __builtin_amdgcn_exp2f(-1.4426950409f * v)); }

#define XB_TMO      128
#define XB_XCNT(j)  (256  + 64 * (j))
#define XB_XSUB(j)  (1280 + 64 * (j))
#define XB_XGEN(j)  (2304 + 64 * (j))
#define XB_TOP      3328
#define XB_TOPGEN   3392
#define XCD_BAR_WORDS 3456
#define XB_SPIN_CAP (1u << 18)
__device__ __forceinline__ unsigned xb_ld(unsigned* p)              { return __hip_atomic_load(p, __ATOMIC_RELAXED, __HIP_MEMORY_SCOPE_AGENT); }
__device__ __forceinline__ unsigned xb_add(unsigned* p, unsigned v) { return __hip_atomic_fetch_add(p, v, __ATOMIC_RELAXED, __HIP_MEMORY_SCOPE_AGENT); }
__device__ __forceinline__ unsigned xb_xcc_id() { return (unsigned)__builtin_amdgcn_s_getreg((3 << 11) | 20) & 0xFu; }
#define XB_SPIN(cond, bar) do { unsigned _sp = 0; while (cond) { __builtin_amdgcn_s_sleep(1); \
    if ((++_sp & 255u) == 0u) { if (xb_ld(&(bar)[XB_TMO])) break; if (_sp > XB_SPIN_CAP) { atomicAdd(&(bar)[XB_TMO], 1u); break; } } } } while (0)
struct XcdBarrier { unsigned* bar; unsigned x; volatile LAS unsigned* st; };
__device__ __forceinline__ XcdBarrier xcd_barrier_post(unsigned* bar, volatile LAS unsigned* st) {
    XcdBarrier b; b.bar = bar; b.x = xb_xcc_id(); b.st = st;
    if (threadIdx.x == 0) (void)xb_add(&bar[XB_XCNT(b.x)], 1u);
    return b;
}
__device__ __forceinline__ void xcd_barrier_complete(unsigned* bar, unsigned x, unsigned& nloc, unsigned& nx) {
    const unsigned G = gridDim.x * gridDim.y * gridDim.z;
    unsigned sum, cnt, mine, sp = 0u;
    for (;;) {
        sum = 0u; cnt = 0u; mine = 0u;
#pragma unroll
        for (unsigned j = 0; j < 16; ++j) { const unsigned c = xb_ld(&bar[XB_XCNT(j)]); sum += c; cnt += (c > 0u) ? 1u : 0u; mine = (j == x) ? c : mine; }
        if (sum == G) break;
        __builtin_amdgcn_s_sleep(1);
        if ((++sp & 255u) == 0u) { if (xb_ld(&bar[XB_TMO])) break; if (sp > XB_SPIN_CAP) { atomicAdd(&bar[XB_TMO], 1u); break; } }
    }
    nloc = mine > 0u ? mine : 1u; nx = cnt > 0u ? cnt : 1u;
}
__device__ __forceinline__ void xcd_barrier(const XcdBarrier& b) {
    asm volatile("s_waitcnt vmcnt(0)" ::: "memory");
    __syncthreads();
    if (threadIdx.x == 0) {
        unsigned* bar = b.bar;
        __builtin_amdgcn_s_waitcnt(0);
        unsigned nloc = b.st[0], nx = b.st[1];
        if (nloc == 0u) { xcd_barrier_complete(bar, b.x, nloc, nx); b.st[0] = nloc; b.st[1] = nx; }
        const unsigned old = xb_add(&bar[XB_XSUB(b.x)], 1u);
        const unsigned gen = old / nloc;
        if (old + 1u == (gen + 1u) * nloc) {
            __builtin_amdgcn_fence(__ATOMIC_RELEASE, "agent");
            asm volatile("s_waitcnt vmcnt(0)" ::: "memory");
            const unsigned og = xb_add(&bar[XB_TOP], 1u);
            const unsigned tg = og / nx;
            if (og + 1u == (tg + 1u) * nx) xb_add(&bar[XB_TOPGEN], 1u);
            else XB_SPIN(xb_ld(&bar[XB_TOPGEN]) == tg, bar);
            __builtin_amdgcn_fence(__ATOMIC_ACQUIRE, "agent");
            xb_add(&bar[XB_XGEN(b.x)], 1u);
            asm volatile("s_waitcnt vmcnt(0)" ::: "memory");
        } else {
            XB_SPIN(xb_ld(&bar[XB_XGEN(b.x)]) == gen, bar);
            __builtin_amdgcn_fence(__ATOMIC_ACQUIRE, "agent");
            asm volatile("s_waitcnt vmcnt(0)" ::: "memory");
        }
    }
    __syncthreads();
}

namespace pg8 {
constexpr int BM = 256, BK = 64, HALF = 128, HTB = HALF * BK * 2, STAGE_BYTES = 8 * HTB, NXCD = 8, WGM = 8;
__device__ __forceinline__ int lds_byte(int r, int c) { const int st = (r >> 4) * 2 + (c >> 5), rr = r & 15, cc = c & 31, ob = rr * 64 + cc * 2; return st * 1024 + (ob ^ (((ob >> 9) & 1) << 5)); }
__device__ __forceinline__ void stage_rc(int b, int& R, int& C) { const int st = b / 1024, sb = b % 1024, swz = sb ^ (((sb >> 9) & 1) << 5); R = (st >> 1) * 16 + swz / 64; C = (st & 1) * 32 + (swz % 64) / 2; }
__device__ __forceinline__ int brow(int R) { return 64 * (R >> 5) + 16 * ((R & 15) >> 2) + 4 * ((R >> 4) & 1) + (R & 3); }
__device__ __forceinline__ int brow1(int R) { return 64 * (R >> 5) + 8 * ((R & 15) >> 2) + 4 * ((R >> 4) & 1) + (R & 3); }

struct Unit { int pm, pn, e; };

__device__ __forceinline__ bool order_next(int i, int G, int c, int nM, int nN, int& pm, int& pn) {
    const int nwg = nM * nN; const long L = (long)i * G + c; if (L >= nwg) return false;
    int wgid = (int)L; { const int q = nwg / NXCD, r = nwg % NXCD, xcd = wgid % NXCD, off = wgid / NXCD; wgid = (xcd < r ? xcd * (q + 1) : r * (q + 1) + (xcd - r) * q) + off; }
    const int nig = WGM * nN, gid = wgid / nig, fm = gid * WGM, gsz = (nM - fm) < WGM ? (nM - fm) : WGM;
    pm = fm + ((wgid % nig) % gsz); pn = (wgid % nig) / gsz; return true;
}

struct DenseSched {
    static constexpr bool GATHER = false;
    int nM, nN, G, c, KB; const char* Bt;
    __device__ __forceinline__ bool next(int i, Unit& u) const { u.e = 0; return order_next(i, G, c, nM, nN, u.pm, u.pn); }
    __device__ __forceinline__ const char* bbase(const Unit& u) const { return Bt + (size_t)u.pn * BM * KB; }
    __device__ __forceinline__ const char* abase(const char* A, const Unit& u) const { return A + (size_t)u.pm * BM * KB; }
    __device__ __forceinline__ void aoffs(int ui, const Unit& u, int tid, unsigned (&ao)[2][2]) const {}
};
struct DenseSchedG {
    static constexpr bool GATHER = true;
    int nM, nN, G, c, KB; const char* Bt;
    __device__ __forceinline__ bool next(int i, Unit& u) const { u.e = 0; return order_next(i, G, c, nM, nN, u.pm, u.pn); }
    __device__ __forceinline__ const char* bbase(const Unit& u) const { return Bt + (size_t)u.pn * BM * KB; }
    __device__ __forceinline__ const char* abase(const char* A, const Unit& u) const { return A; }
    __device__ __forceinline__ void aoffs(int ui, const Unit& u, int tid, unsigned (&ao)[2][2]) const {
        asm volatile("" : "+v"(tid));
#pragma unroll
        for (int i = 0; i < 2; ++i) { int R, C; stage_rc(tid * 16 + i * 8192, R, C);
#pragma unroll
            for (int h = 0; h < 2; ++h) ao[h][i] = (unsigned)(u.pm * BM + h * HALF + R) * (unsigned)KB + (unsigned)C * 2u; }
    }
};
template <int MODE> struct GroupSched {
    static constexpr bool GATHER = true;
    int nM, nN, G, c, KB, pn0; const char* Bt; size_t estride; const LAS int* te; const LAS unsigned* rt;
    __device__ __forceinline__ bool next(int i, Unit& u) const { if (!order_next(i, G, c, nM, nN, u.pm, u.pn)) return false; u.e = __builtin_amdgcn_readfirstlane(te[u.pm]); return true; }
    __device__ __forceinline__ const char* bbase(const Unit& u) const { return Bt + (size_t)u.e * estride + (size_t)(pn0 + u.pn) * BM * KB; }
    __device__ __forceinline__ void aoffs(int ui, const Unit& u, int tid, unsigned (&ao)[2][2]) const {
        asm volatile("" : "+v"(tid));
#pragma unroll
        for (int i = 0; i < 2; ++i) { int R, C; stage_rc(tid * 16 + i * 8192, R, C);
#pragma unroll
            for (int h = 0; h < 2; ++h) { if (MODE == 1) ao[h][i] = rt[ui * 256 + h * HALF + R] + (unsigned)C * 2u; else ao[h][i] = (unsigned)(u.pm * BM + h * HALF + R) * (unsigned)KB + (unsigned)C * 2u; } }
    }
    __device__ __forceinline__ const char* abase(const char* A, const Unit& u) const { return A; }
};

__device__ __forceinline__ unsigned cvt_pk_bf16(float lo, float hi) { unsigned r; asm volatile("v_cvt_pk_bf16_f32 %0, %1, %2" : "=v"(r) : "v"(lo), "v"(hi)); return r; }

typedef int v8i __attribute__((ext_vector_type(8)));
typedef int v4i __attribute__((ext_vector_type(4)));
union Frag { v8i v; struct { v4i lo, hi; }; };
template <bool F8, int LAY, class Epi, class Sched>
__device__ __forceinline__ void gemm_phase(const int tid, LAS unsigned char* lds, const char* Abase, const int KB, const Sched& S, const Epi& E, const int sw = 0x7f7f7f7f, const int sa = 0x7f7f7f7f) {
    LAS unsigned char* const ept = lds + (EPT_OFF - RING_OFF);
    const int wid = __builtin_amdgcn_readfirstlane(tid >> 6), lane = tid & 63, wr = wid >> 2, wc = wid & 3, fr = lane & 15, fq = lane >> 4;
    const int nt = KB / 128;
    constexpr bool GA = Sched::GATHER;
    unsigned voffB[2], voffA[2];
#pragma unroll
    for (int i = 0; i < 2; ++i) { int R, C; stage_rc(tid * 16 + i * 8192, R, C); const int Rb = LAY ? brow1(R) : brow(R); voffB[i] = (unsigned)Rb * (unsigned)KB + (unsigned)C * 2u; voffA[i] = (unsigned)R * (unsigned)KB + (unsigned)C * 2u; }
    const size_t kstep = (size_t)(BK * 2);
    const size_t hstep = (size_t)HALF * KB;
    const size_t hstepB = (size_t)(LAY ? 32 : 8) * KB;
    const unsigned ldsw = (unsigned)wid * 1024u;
    const int aoff = lds_byte(wr * 64 + fr, fq * 8), boff = lds_byte(wc * 32 + fr, fq * 8);
#define PG8_SA(b, h) (((b) * 2 + (h)) * HTB)
#define PG8_SB(b, h) ((4 + (b) * 2 + (h)) * HTB)
#define PG8_STAGE(bufoff, gbase, voff) do { _Pragma("unroll") for (int _i = 0; _i < 2; ++_i) \
        __builtin_amdgcn_global_load_lds((const unsigned*)((const char*)(gbase) + (voff)[_i]), (LAS unsigned*)(lds + (bufoff) + ldsw + _i * 8192), 16, 0, 0); } while (0)
#define PG8_STAGEA(bufoff, gbase, half) do { if constexpr (GA) { PG8_STAGE(bufoff, gbase, ca[half]); } else { PG8_STAGE(bufoff, (gbase) + (half) * hstep, voffA); } } while (0)
#define PG8_LD1(dst, off) do { const v4i _lo = *(const LAS v4i*)(lds + (off)), _hi = *(const LAS v4i*)(lds + (off) + 1024); dst.lo = _lo; dst.hi = _hi; } while (0)
#define PG8_LDA(dst, b, h) do { _Pragma("unroll") for (int m = 0; m < 4; ++m) PG8_LD1(dst[m], PG8_SA(b, h) + aoff + m * 2048); } while (0)
#define PG8_LDB(dst, b, h) do { _Pragma("unroll") for (int n = 0; n < 2; ++n) PG8_LD1(dst[n], PG8_SB(b, h) + boff + n * 2048); } while (0)
#define PG8_MMA(ai, bj, At, Bt) do { __builtin_amdgcn_s_setprio(1); _Pragma("unroll") for (int m = 0; m < 4; ++m) _Pragma("unroll") for (int n = 0; n < 2; ++n) { \
        if constexpr (F8) { acc[ai][bj][m][n] = __builtin_amdgcn_mfma_scale_f32_16x16x128_f8f6f4(Bt[n].v, At[m].v, acc[ai][bj][m][n], 0, 0, 0, sw, 0, sa); } \
        else { acc[ai][bj][m][n] = __builtin_amdgcn_mfma_f32_16x16x32_bf16(__builtin_bit_cast(bf16x8, Bt[n].lo), __builtin_bit_cast(bf16x8, At[m].lo), acc[ai][bj][m][n], 0, 0, 0); \
               acc[ai][bj][m][n] = __builtin_amdgcn_mfma_f32_16x16x32_bf16(__builtin_bit_cast(bf16x8, Bt[n].hi), __builtin_bit_cast(bf16x8, At[m].hi), acc[ai][bj][m][n], 0, 0, 0); } } \
        __builtin_amdgcn_s_setprio(0); } while (0)
#define PG8_WAIT_V(n) asm volatile("s_waitcnt vmcnt(" #n ")" ::: "memory")
#define PG8_WAIT_L(n) asm volatile("s_waitcnt lgkmcnt(" #n ")" ::: "memory")
#define PG8_BAR __builtin_amdgcn_s_barrier()
#define PG8_SCHED __builtin_amdgcn_sched_barrier(0)
    Unit cur, nxt; int ui = 0;
    if (!S.next(0, cur)) return;
    f32x4 acc[2][2][4][2];
#pragma unroll
    for (int a = 0; a < 2; ++a)
#pragma unroll
        for (int b = 0; b < 2; ++b)
#pragma unroll
            for (int m = 0; m < 4; ++m)
#pragma unroll
                for (int n = 0; n < 2; ++n) acc[a][b][m][n] = (f32x4){0.f, 0.f, 0.f, 0.f};
    Frag At[4], B0[2], B1[2];
    unsigned ca[2][2], na[2][2];
    if constexpr (GA) S.aoffs(0, cur, tid, ca);
    const char* cB = S.bbase(cur); const char* cA = S.abase(Abase, cur);
    PG8_STAGE(PG8_SB(0, 0), cB, voffB); PG8_STAGEA(PG8_SA(0, 0), cA, 0); PG8_STAGE(PG8_SB(0, 1), cB + hstepB, voffB); PG8_STAGEA(PG8_SA(0, 1), cA, 1);
    if (wr == 1) PG8_BAR;
    PG8_WAIT_V(4); PG8_BAR;
    PG8_STAGE(PG8_SB(1, 0), cB + kstep, voffB); PG8_STAGEA(PG8_SA(1, 0), cA + kstep, 0); PG8_STAGE(PG8_SB(1, 1), cB + hstepB + kstep, voffB);
    PG8_WAIT_V(6); PG8_BAR;
    for (;;) {
        const bool has_next = S.next(ui + 1, nxt);
        const char* nB = has_next ? S.bbase(nxt) : cB; const char* nA = has_next ? S.abase(Abase, nxt) : cA;
        if constexpr (GA) {
            if (has_next) S.aoffs(ui + 1, nxt, tid, na);
            else {
#pragma unroll
                for (int h = 0; h < 2; ++h)
#pragma unroll
                    for (int i = 0; i < 2; ++i) na[h][i] = ca[h][i];
            }
        }
#pragma nounroll
        for (int t = 0; t < nt; t += 2) {
            const bool last = (t == nt - 2);
            const char* a1 = cA + (size_t)(t + 1) * kstep;
            const char* a2 = last ? nA : cA + (size_t)(t + 2) * kstep; const char* b2 = last ? nB : cB + (size_t)(t + 2) * kstep;
            const char* a3 = a2 + kstep; const char* b3 = b2 + kstep;
            if (t == 0 && wid == 0) { int tz = tid; asm volatile("" : "+v"(tz)); E.prefetch(cur, ept + (ui & 1) * 2048, tz & 63); }
            PG8_LDB(B0, 0, 0); PG8_SCHED; PG8_LDA(At, 0, 0); PG8_STAGEA(PG8_SA(1, 1), a1, 1);
            PG8_WAIT_L(8); PG8_BAR; PG8_WAIT_L(0); PG8_MMA(0, 0, At, B0); PG8_BAR; PG8_SCHED;
            if constexpr (GA) { if (last) {
#pragma unroll
                for (int h = 0; h < 2; ++h)
#pragma unroll
                    for (int i = 0; i < 2; ++i) ca[h][i] = na[h][i];
            } }
            PG8_LDB(B1, 0, 1); PG8_STAGE(PG8_SB(0, 0), b2, voffB);
            PG8_BAR; PG8_WAIT_L(0); PG8_MMA(0, 1, At, B1); PG8_BAR;
            PG8_LDA(At, 0, 1); PG8_STAGEA(PG8_SA(0, 0), a2, 0);
            PG8_BAR; PG8_WAIT_L(0); PG8_MMA(1, 0, At, B0); PG8_BAR; PG8_SCHED;
            PG8_STAGE(PG8_SB(0, 1), b2 + hstepB, voffB);
            PG8_WAIT_V(6); PG8_BAR; PG8_MMA(1, 1, At, B1); PG8_BAR;
            PG8_LDB(B0, 1, 0); PG8_SCHED; PG8_LDA(At, 1, 0); PG8_STAGEA(PG8_SA(0, 1), a2, 1);
            PG8_WAIT_L(8); PG8_BAR; PG8_WAIT_L(0); PG8_MMA(0, 0, At, B0); PG8_BAR; PG8_SCHED;
            PG8_LDB(B1, 1, 1); PG8_STAGE(PG8_SB(1, 0), b3, voffB);
            PG8_BAR; PG8_WAIT_L(0); PG8_MMA(0, 1, At, B1); PG8_BAR;
            PG8_LDA(At, 1, 1); PG8_STAGEA(PG8_SA(1, 0), a3, 0);
            PG8_BAR; PG8_WAIT_L(0); PG8_MMA(1, 0, At, B0); PG8_BAR; PG8_SCHED;
            PG8_STAGE(PG8_SB(1, 1), b3 + hstepB, voffB);
            PG8_WAIT_V(6); PG8_BAR; PG8_MMA(1, 1, At, B1); PG8_BAR;
        }
        { int tz = tid; asm volatile("" : "+v"(tz)); const int l2 = tz & 63; E(acc, cur, wr, wc, l2 & 15, l2 >> 4, ept + (ui & 1) * 2048); }
        if (!has_next) break;
#pragma unroll
        for (int a = 0; a < 2; ++a)
#pragma unroll
            for (int b = 0; b < 2; ++b)
#pragma unroll
                for (int m = 0; m < 4; ++m)
#pragma unroll
                    for (int n = 0; n < 2; ++n) acc[a][b][m][n] = (f32x4){0.f, 0.f, 0.f, 0.f};
        cur = nxt; cB = nB; cA = nA; ++ui;
    }
    PG8_WAIT_V(0);
    if (wr == 0) PG8_BAR;
    PG8_BAR;
#undef PG8_SA
#undef PG8_SB
#undef PG8_STAGE
#undef PG8_STAGEA
#undef PG8_LD1
#undef PG8_LDA
#undef PG8_LDB
#undef PG8_MMA
#undef PG8_WAIT_V
#undef PG8_WAIT_L
#undef PG8_BAR
#undef PG8_SCHED
}

__device__ __forceinline__ unsigned cvt4_fp8(float a, float b, float c, float d) { int w = 0; w = __builtin_amdgcn_cvt_pk_fp8_f32(a, b, w, false); w = __builtin_amdgcn_cvt_pk_fp8_f32(c, d, w, true); return (unsigned)w; }
__device__ __forceinline__ v4u pack8_bf16(const f32x4 a, const f32x4 b) { v4u w; w.x = cvt_pk_bf16(a[0], a[1]); w.y = cvt_pk_bf16(a[2], a[3]); w.z = cvt_pk_bf16(b[0], b[1]); w.w = cvt_pk_bf16(b[2], b[3]); return w; }
__device__ __forceinline__ void unpack8(const v4u w, f32x4& a, f32x4& b) { a = (f32x4){bflo(w[0]), bfhi(w[0]), bflo(w[1]), bfhi(w[1])}; b = (f32x4){bflo(w[2]), bfhi(w[2]), bflo(w[3]), bfhi(w[3])}; }
struct EpiBf16Scale {
    bf16* O; int ldc; const float* rs;
    __device__ __forceinline__ void prefetch(const Unit& u, LAS unsigned char* tab, int lane) const {
        if (rs) __builtin_amdgcn_global_load_lds((const unsigned*)(rs + u.pm * BM + 4 * lane), (LAS unsigned*)tab, 16, 0, 0);
    }
    __device__ __forceinline__ void operator()(const f32x4 (&acc)[2][2][4][2], const Unit& u, int wr, int wc, int fr, int fq, const LAS unsigned char* tab) const {
        const int row0 = u.pm * BM + wr * 64 + fr, col0 = u.pn * BM + wc * 64 + 8 * fq;
        float sc[8];
#pragma unroll
        for (int q = 0; q < 8; ++q) sc[q] = rs ? ((const LAS float*)tab)[wr * 64 + fr + (q >> 2) * HALF + (q & 3) * 16] : 1.f;
#pragma unroll
        for (int ai = 0; ai < 2; ++ai)
#pragma unroll
            for (int m = 0; m < 4; ++m) { const int row = row0 + ai * HALF + m * 16; const float s = sc[ai * 4 + m]; bf16* rowp = O + (size_t)row * ldc + col0;
#pragma unroll
                for (int bj = 0; bj < 2; ++bj) *(v4u*)(rowp + 32 * bj) = pack8_bf16(acc[ai][bj][m][0] * s, acc[ai][bj][m][1] * s); }
    }
};
struct EpiProj {
    bf16* O; bf16* QKV; const float* rs;
    __device__ __forceinline__ void prefetch(const Unit& u, LAS unsigned char* tab, int lane) const {
        __builtin_amdgcn_global_load_lds((const unsigned*)(rs + u.pm * BM + 4 * lane), (LAS unsigned*)tab, 16, 0, 0);
    }
    __device__ __forceinline__ void operator()(const f32x4 (&acc)[2][2][4][2], const Unit& u, int wr, int wc, int fr, int fq, const LAS unsigned char* tab) const {
        const int row0 = u.pm * BM + wr * 64 + fr;
        float sc[8];
#pragma unroll
        for (int q = 0; q < 8; ++q) sc[q] = ((const LAS float*)tab)[wr * 64 + fr + (q >> 2) * HALF + (q & 3) * 16];
        const bool conv = u.pn < PCW / BM;
        const int cp = (conv ? u.pn : (u.pn - PCW / BM) & 3) * BM + wc * 64 + 8 * fq;
        const int part = (u.pn - PCW / BM) >> 2, h = cp >> 7, d = cp & 127;
#pragma unroll
        for (int ai = 0; ai < 2; ++ai)
#pragma unroll
            for (int m = 0; m < 4; ++m) { const int row = row0 + ai * HALF + m * 16; const float s = sc[ai * 4 + m];
                bf16* rowp = conv ? O + (size_t)row * PCW + cp : QKV + ((((size_t)part * NB + (row >> 12)) * NH + h) * SEQ + (row & (SEQ - 1))) * HD + d;
#pragma unroll
                for (int bj = 0; bj < 2; ++bj) *(v4u*)(rowp + 32 * bj) = pack8_bf16(acc[ai][bj][m][0] * s, acc[ai][bj][m][1] * s); }
    }
};
struct EpiResF32 {
    bf16* O; const bf16* X; int ldc; unsigned char* O8;
    __device__ __forceinline__ void prefetch(const Unit&, LAS unsigned char*, int) const {}
    __device__ __forceinline__ void operator()(const f32x4 (&acc)[2][2][4][2], const Unit& u, int wr, int wc, int fr, int fq, const LAS unsigned char*) const {
        const int row0 = u.pm * BM + wr * 64 + fr, col0 = u.pn * BM + wc * 64 + 8 * fq;
#pragma unroll
        for (int ai = 0; ai < 2; ++ai) {
            v4u xw[4][2];
#pragma unroll
            for (int m = 0; m < 4; ++m)
#pragma unroll
                for (int bj = 0; bj < 2; ++bj) xw[m][bj] = *(const v4u*)(X + (size_t)(row0 + ai * HALF + m * 16) * ldc + col0 + 32 * bj);
#pragma unroll
            for (int m = 0; m < 4; ++m) { const size_t ro = (size_t)(row0 + ai * HALF + m * 16) * ldc + col0;
#pragma unroll
                for (int bj = 0; bj < 2; ++bj) { f32x4 x0, x1; unpack8(xw[m][bj], x0, x1);
                    const f32x4 v0 = acc[ai][bj][m][0] + x0, v1 = acc[ai][bj][m][1] + x1;
                    *(v4u*)(O + ro + 32 * bj) = pack8_bf16(v0, v1);
                    v2u w8; w8.x = cvt4_fp8(v0[0], v0[1], v0[2], v0[3]); w8.y = cvt4_fp8(v1[0], v1[1], v1[2], v1[3]);
                    *(v2u*)(O8 + ro + 32 * bj) = w8; } }
        }
    }
};
struct EpiGateUp {
    unsigned char* Hp; const float* rr;
    __device__ __forceinline__ void prefetch(const Unit& u, LAS unsigned char* tab, int lane) const {
        __builtin_amdgcn_global_load_lds((const unsigned*)(rr + u.pm * BM + 4 * lane), (LAS unsigned*)tab, 16, 0, 0);
    }
    __device__ __forceinline__ void operator()(const f32x4 (&acc)[2][2][4][2], const Unit& u, int wr, int wc, int fr, int fq, const LAS unsigned char* tab) const {
        const int row0 = u.pm * BM + wr * 64 + fr, col0 = u.pn * HALF + wc * 32 + 8 * fq;
        float sc[8];
#pragma unroll
        for (int q = 0; q < 8; ++q) sc[q] = ((const LAS float*)tab)[wr * 64 + fr + (q >> 2) * HALF + (q & 3) * 16];
#pragma unroll
        for (int ai = 0; ai < 2; ++ai)
#pragma unroll
            for (int m = 0; m < 4; ++m) { const int row = row0 + ai * HALF + m * 16; const float s = sc[ai * 4 + m];
                float h[8];
#pragma unroll
                for (int n = 0; n < 2; ++n)
#pragma unroll
                    for (int j = 0; j < 4; ++j) { const float g = acc[ai][0][m][n][j] * s, up = acc[ai][1][m][n][j] * s; h[n * 4 + j] = g * fsigmoid(g) * up; }
                v2u w; w.x = cvt4_fp8(h[0], h[1], h[2], h[3]); w.y = cvt4_fp8(h[4], h[5], h[6], h[7]);
                *(v2u*)(Hp + (size_t)row * ED + col0) = w; }
    }
};
struct EpiDown {
    unsigned char* S0; unsigned char* S1; unsigned char* S8; const float* rw; const int* rdst;
    __device__ __forceinline__ void prefetch(const Unit& u, LAS unsigned char* tab, int lane) const {
        __builtin_amdgcn_global_load_lds((const unsigned*)(rw + u.pm * BM + 4 * lane), (LAS unsigned*)tab, 16, 0, 0);
        __builtin_amdgcn_global_load_lds((const unsigned*)(rdst + u.pm * BM + 4 * lane), (LAS unsigned*)(tab + 1024), 16, 0, 0);
    }
    __device__ __forceinline__ void operator()(const f32x4 (&acc)[2][2][4][2], const Unit& u, int wr, int wc, int fr, int fq, const LAS unsigned char* tab) const {
        const int row0 = u.pm * BM + wr * 64 + fr, col0 = u.pn * BM + wc * 64 + 16 * fq;
        float sc[8]; int ds[8];
#pragma unroll
        for (int q = 0; q < 8; ++q) { const int lr = wr * 64 + fr + (q >> 2) * HALF + (q & 3) * 16; sc[q] = ((const LAS float*)tab)[lr]; ds[q] = ((const LAS int*)(tab + 1024))[lr]; }
#pragma unroll
        for (int ai = 0; ai < 2; ++ai)
#pragma unroll
            for (int m = 0; m < 4; ++m) { const float s = sc[ai * 4 + m] * SLOT_SCALE; const int dst = ds[ai * 4 + m];
                if (dst >= 0) { unsigned char* rowp = (dst < 4 * T ? S0 + (size_t)dst * D : dst < 8 * T ? S1 + (size_t)(dst - 4 * T) * D : S8 + (size_t)(dst - 8 * T) * D) + col0;
                    v4u w;
#pragma unroll
                    for (int bj = 0; bj < 2; ++bj) { const f32x4 v0 = acc[ai][bj][m][0] * s, v1 = acc[ai][bj][m][1] * s;
                        w[2 * bj] = cvt4_fp8(v0[0], v0[1], v0[2], v0[3]); w[2 * bj + 1] = cvt4_fp8(v1[0], v1[1], v1[2], v1[3]); }
                    *(v4u*)rowp = w; } }
    }
};
struct EpiPle {
    bf16* H3; const bf16* H2; const bf16* PP; const float* ssq2; float* ssq3;
    __device__ __forceinline__ void prefetch(const Unit&, LAS unsigned char*, int) const {}
    __device__ __forceinline__ void operator()(const f32x4 (&acc)[2][2][4][2], const Unit& u, int wr, int wc, int fr, int fq, const LAS unsigned char*) const {
        const int row0 = u.pm * BM + wr * 64 + fr, col0 = u.pn * BM + wc * 64 + 8 * fq;
        float sq[8];
#pragma unroll
        for (int q = 0; q < 8; ++q) sq[q] = ssq2[row0 + (q >> 2) * HALF + (q & 3) * 16];
#pragma unroll
        for (int ai = 0; ai < 2; ++ai)
#pragma unroll
            for (int mp = 0; mp < 2; ++mp) {
                v4u hw[2][2], pw[2][2];
#pragma unroll
                for (int mm = 0; mm < 2; ++mm)
#pragma unroll
                    for (int bj = 0; bj < 2; ++bj) { const size_t o = (size_t)(row0 + ai * HALF + (2 * mp + mm) * 16) * D + col0 + 32 * bj; hw[mm][bj] = *(const v4u*)(H2 + o); pw[mm][bj] = *(const v4u*)(PP + o); }
#pragma unroll
                for (int mm = 0; mm < 2; ++mm) { const int m = 2 * mp + mm, row = row0 + ai * HALF + m * 16;
                    const float r = __builtin_amdgcn_rsqf(sq[ai * 4 + m] * (1.f / D) + EPS);
                    const size_t ro = (size_t)row * D + col0; float ss = 0.f;
#pragma unroll
                    for (int bj = 0; bj < 2; ++bj) { f32x4 h0, h1, p0, p1; unpack8(hw[mm][bj], h0, h1); unpack8(pw[mm][bj], p0, p1);
                        f32x4 o0, o1;
#pragma unroll
                        for (int j = 0; j < 4; ++j) { o0[j] = h0[j] + fsigmoid(acc[ai][bj][m][0][j] * r) * p0[j]; o1[j] = h1[j] + fsigmoid(acc[ai][bj][m][1][j] * r) * p1[j]; ss += o0[j] * o0[j] + o1[j] * o1[j]; }
                        *(v4u*)(H3 + ro + 32 * bj) = pack8_bf16(o0, o1); }
                    ss += __shfl_xor(ss, 16); ss += __shfl_xor(ss, 32);
                    if (fq == 0) ssq3[(size_t)(u.pn * 4 + wc) * T + row] = ss; }
            }
    }
};
}

struct Frame {
    LAS unsigned char* lds;
    int tid, lane, wave, G, bx;
    unsigned char* ws;
    const float* in[21];
    float* out;
};
enum { I_X = 0, I_P, I_NMIX, I_WIN, I_CONVW, I_GCONV, I_GSB, I_WOUT, I_NFFN, I_WR, I_RB, I_WEG, I_WEU, I_WED, I_WSG, I_WSU, I_WSD, I_NPLE, I_WPG, I_WPP, I_NFIN };

__device__ __forceinline__ void p0_transpose_item(const float* W, int N, bf16* WT, int ldk, int k0, int n0, int row_off, const float* g64, LAS float* scr, int lane) {
    const int n4 = lane & 15, kr = lane >> 4;
    f32x4 v[16];
    const float* src = W + (size_t)(k0 + kr) * N + n0 + 4 * n4;
#pragma unroll
    for (int i = 0; i < 16; ++i) v[i] = *(const GAS f32x4*)(src + (size_t)(4 * i) * N);
    const int c = lane >> 3, nn = lane & 7;
    f32x4 ga = (f32x4){1.f, 1.f, 1.f, 1.f}, gb = ga;
    if (g64) { ga = *(const GAS f32x4*)(g64 + 8 * c); gb = *(const GAS f32x4*)(g64 + 8 * c + 4); }
#pragma unroll
    for (int i = 0; i < 16; ++i) { LAS float* d = scr + (4 * i + kr) * 65 + 4 * n4; d[0] = v[i].x; d[1] = v[i].y; d[2] = v[i].z; d[3] = v[i].w; }
    LDS_WAIT(); asm volatile("" ::: "memory");
#pragma unroll
    for (int j = 0; j < 8; ++j) { const int n = nn + 8 * j; const LAS float* s = scr + (8 * c) * 65 + n;
        v4u o; o.x = pg8::cvt_pk_bf16(s[0] * ga.x, s[65] * ga.y); o.y = pg8::cvt_pk_bf16(s[130] * ga.z, s[195] * ga.w); o.z = pg8::cvt_pk_bf16(s[260] * gb.x, s[325] * gb.y); o.w = pg8::cvt_pk_bf16(s[390] * gb.z, s[455] * gb.w);
        *(GAS v4u*)(WT + (size_t)(row_off + n) * ldk + k0 + 8 * c) = o; }
    LDS_WAIT(); asm volatile("" ::: "memory");
}
__device__ __forceinline__ void p0_transpose_item_f8(const float* W, int N, unsigned char* WT, int ldk, int k0, int n0, int row_off, int mode, const float* g64, LAS float* scr, int lane) {
    const int n4 = lane & 15, kr = lane >> 4;
    f32x4 v[16];
    const float* src = W + (size_t)(k0 + kr) * N + n0 + 4 * n4;
#pragma unroll
    for (int i = 0; i < 16; ++i) v[i] = *(const GAS f32x4*)(src + (size_t)(4 * i) * N);
    const int c = lane >> 4, nn = lane & 15;
    float g[16];
#pragma unroll
    for (int q = 0; q < 4; ++q) { f32x4 t = (f32x4){1.f, 1.f, 1.f, 1.f}; if (g64) t = *(const GAS f32x4*)(g64 + 16 * c + 4 * q); g[4 * q] = 64.f * t.x; g[4 * q + 1] = 64.f * t.y; g[4 * q + 2] = 64.f * t.z; g[4 * q + 3] = 64.f * t.w; }
#pragma unroll
    for (int i = 0; i < 16; ++i) { LAS float* d = scr + (4 * i + kr) * 65 + 4 * n4; d[0] = v[i].x; d[1] = v[i].y; d[2] = v[i].z; d[3] = v[i].w; }
    LDS_WAIT(); asm volatile("" ::: "memory");
#pragma unroll
    for (int j = 0; j < 4; ++j) { const int n = nn + 16 * j; const LAS float* s = scr + (16 * c) * 65 + n;
        v4u o;
        o.x = pg8::cvt4_fp8(s[0] * g[0], s[65] * g[1], s[130] * g[2], s[195] * g[3]); o.y = pg8::cvt4_fp8(s[260] * g[4], s[325] * g[5], s[390] * g[6], s[455] * g[7]);
        o.z = pg8::cvt4_fp8(s[520] * g[8], s[585] * g[9], s[650] * g[10], s[715] * g[11]); o.w = pg8::cvt4_fp8(s[780] * g[12], s[845] * g[13], s[910] * g[14], s[975] * g[15]);
        const int hid = n0 + n, drow = mode == 0 ? row_off + n : 16 * (hid >> 3) + 8 * (mode - 1) + (hid & 7);
        *(GAS v4u*)(WT + (size_t)drow * ldk + k0 + 16 * c) = o; }
    LDS_WAIT(); asm volatile("" ::: "memory");
}
constexpr int P0_I_WIN = (D / 64) * (NPROJ / 64), P0_I_WOUT = (D / 64) * (D / 64), P0_I_WR = (D / 64) * (NE / 64), P0_I_WPG = (D / 64) * (D / 64), P0_I_WPP = (PLE / 64) * (D / 64);
struct ExpItem { const float* src; const float* g128; unsigned char* dst; int N, ldk, k0, n0, mode; };
__device__ __forceinline__ void exp_issue(const ExpItem& I, int lane, f32x4 (&v)[32], f32x4 (&gq)[8]) {
    const int n4 = lane & 15, kr = lane >> 4;
#pragma unroll
    for (int q = 0; q < 8; ++q) { gq[q] = (f32x4){1.f, 1.f, 1.f, 1.f}; if (I.g128) gq[q] = *(const GAS f32x4*)(I.g128 + 64 * (q >> 2) + 16 * (lane >> 4) + 4 * (q & 3)); }
    const float* src = I.src + (size_t)(I.k0 + kr) * I.N + I.n0 + 4 * n4;
#pragma unroll
    for (int i = 0; i < 32; ++i) v[i] = *(const GAS f32x4*)(src + (size_t)(4 * i) * I.N);
}
template <int H> __device__ __forceinline__ void exp_finish_half(const ExpItem& I, int lane, const f32x4 (&v)[32], const f32x4 (&gq)[8], LAS float* scr) {
    const int n4 = lane & 15, kr = lane >> 4, c = lane >> 4, nn = lane & 15;
    float g[16];
#pragma unroll
    for (int q = 0; q < 4; ++q) { g[4 * q] = 64.f * gq[4 * H + q].x; g[4 * q + 1] = 64.f * gq[4 * H + q].y; g[4 * q + 2] = 64.f * gq[4 * H + q].z; g[4 * q + 3] = 64.f * gq[4 * H + q].w; }
#pragma unroll
    for (int i = 0; i < 16; ++i) { LAS float* d = scr + (4 * i + kr) * 65 + 4 * n4; d[0] = v[16 * H + i].x; d[1] = v[16 * H + i].y; d[2] = v[16 * H + i].z; d[3] = v[16 * H + i].w; }
    LDS_WAIT(); asm volatile("" ::: "memory");
#pragma unroll
    for (int j = 0; j < 4; ++j) { const int n = nn + 16 * j; const LAS float* s = scr + (16 * c) * 65 + n;
        v4u o;
        o.x = pg8::cvt4_fp8(s[0] * g[0], s[65] * g[1], s[130] * g[2], s[195] * g[3]); o.y = pg8::cvt4_fp8(s[260] * g[4], s[325] * g[5], s[390] * g[6], s[455] * g[7]);
        o.z = pg8::cvt4_fp8(s[520] * g[8], s[585] * g[9], s[650] * g[10], s[715] * g[11]); o.w = pg8::cvt4_fp8(s[780] * g[12], s[845] * g[13], s[910] * g[14], s[975] * g[15]);
        const int hid = I.n0 + n, drow = I.mode == 0 ? hid : 16 * (hid >> 3) + 8 * (I.mode - 1) + (hid & 7);
        *(GAS v4u*)(I.dst + (size_t)drow * I.ldk + I.k0 + 64 * H + 16 * c) = o; }
    LDS_WAIT(); asm volatile("" ::: "memory");
}
constexpr int P0_NONEXP = P0_I_WIN + P0_I_WOUT + P0_I_WR + P0_I_WPG + P0_I_WPP;
constexpr int P0_I_EXP = 768, P0_NITEMS = P0_I_WIN + P0_I_WOUT + P0_I_WR + P0_I_WPG + P0_I_WPP + 65 * P0_I_EXP;
__device__ __forceinline__ void p0_item(Frame& F, int it, LAS float* scr) {
    unsigned char* ws = F.ws; const int lane = F.lane;
    if (it < P0_I_WIN) { const int kb = it / (NPROJ / 64), nb = it % (NPROJ / 64); p0_transpose_item(F.in[I_WIN], NPROJ, (bf16*)(ws + WS_WIN), D, 64 * kb, 64 * nb, 64 * nb, F.in[I_NMIX] + 64 * kb, scr, lane); return; } it -= P0_I_WIN;
    if (it < P0_I_WOUT) { const int kb = it / (D / 64), nb = it % (D / 64), k0 = 64 * kb; const float* g = k0 < CW ? F.in[I_GCONV] + k0 : F.in[I_GSB] + (k0 - CW);
        p0_transpose_item(F.in[I_WOUT], D, (bf16*)(ws + WS_WOUT), D, k0, 64 * nb, 64 * nb, g, scr, lane); return; } it -= P0_I_WOUT;
    if (it < P0_I_WR) { const int kb = it; p0_transpose_item(F.in[I_WR], NE, (bf16*)(ws + WS_WR), D, 64 * kb, 0, 0, F.in[I_NFFN] + 64 * kb, scr, lane); return; } it -= P0_I_WR;
    if (it < P0_I_WPG) { const int kb = it / (D / 64), nb = it % (D / 64); p0_transpose_item_f8(F.in[I_WPG], D, ws + WS_WPG, D, 64 * kb, 64 * nb, 64 * nb, 0, F.in[I_NPLE] + 64 * kb, scr, lane); return; } it -= P0_I_WPG;
    if (it < P0_I_WPP) { const int kb = it / (D / 64), nb = it % (D / 64); p0_transpose_item(F.in[I_WPP], D, (bf16*)(ws + WS_WPP), PLE, 64 * kb, 64 * nb, 64 * nb, nullptr, scr, lane); return; } it -= P0_I_WPP;
    const int e = it / P0_I_EXP, r = it % P0_I_EXP, sub = r / 256, q = r % 256;
    if (sub < 2) {
        const float* src = e < NE ? (sub == 0 ? F.in[I_WEG] : F.in[I_WEU]) + (size_t)e * D * ED : (sub == 0 ? F.in[I_WSG] : F.in[I_WSU]);
        const int kb = q / (ED / 64), nb = q % (ED / 64), n0 = 64 * nb;
        p0_transpose_item_f8(src, ED, ws + WS_WGU + (size_t)e * 1024 * D, D, 64 * kb, n0, 0, 1 + sub, F.in[I_NFFN] + 64 * kb, scr, lane);
    } else {
        const float* src = e < NE ? F.in[I_WED] + (size_t)e * ED * D : F.in[I_WSD];
        const int kb = q / (D / 64), nb = q % (D / 64);
        p0_transpose_item_f8(src, D, ws + WS_WDN + (size_t)e * D * ED, ED, 64 * kb, 64 * nb, 64 * nb, 0, nullptr, scr, lane);
    }
}
constexpr int EXP_ITEMS_PER = 384, EXP_ITEMS = 65 * EXP_ITEMS_PER;
__device__ __forceinline__ ExpItem exp_decode(Frame& F, int it) {
    unsigned char* ws = F.ws; ExpItem I;
    const int e = it / EXP_ITEMS_PER, r = it % EXP_ITEMS_PER, sub = r / 128, q = r % 128;
    if (sub < 2) { I.src = e < NE ? (sub == 0 ? F.in[I_WEG] : F.in[I_WEU]) + (size_t)e * D * ED : (sub == 0 ? F.in[I_WSG] : F.in[I_WSU]);
        const int kb = q / (ED / 64), nb = q % (ED / 64); I.N = ED; I.dst = ws + WS_WGU + (size_t)e * 1024 * D; I.ldk = D; I.k0 = 128 * kb; I.n0 = 64 * nb; I.mode = 1 + sub; I.g128 = F.in[I_NFFN] + 128 * kb; }
    else { I.src = e < NE ? F.in[I_WED] + (size_t)e * ED * D : F.in[I_WSD];
        const int kb = q / (D / 64), nb = q % (D / 64); I.N = D; I.dst = ws + WS_WDN + (size_t)e * D * ED; I.ldk = ED; I.k0 = 128 * kb; I.n0 = 64 * nb; I.mode = 0; I.g128 = nullptr; }
    return I;
}
__device__ __forceinline__ void p0_prologue(Frame& F) {
    LAS float* scr = (LAS float*)(F.lds + RING_OFF + F.wave * 16896);
    const int gw = F.bx * NWAVES + F.wave, NGW = F.G * NWAVES;
    {
        bf16* XB = (bf16*)F.out; float* rmix = (float*)(F.ws + WS_RMIX); const float* x = F.in[I_X];
        for (int m = gw; m < T; m += NGW) {
            const GAS f32x4* xr = (const GAS f32x4*)(x + (size_t)m * D) + F.lane;
            f32x4 v[8]; float s = 0.f;
#pragma unroll
            for (int j = 0; j < 8; ++j) { v[j] = xr[64 * j]; s += (v[j].x * v[j].x + v[j].y * v[j].y) + (v[j].z * v[j].z + v[j].w * v[j].w); }
            s = wave_sum(s);
            if (F.lane == 0) rmix[m] = __builtin_amdgcn_rsqf(s * (1.f / D) + EPS);
            GAS v2u* o8 = (GAS v2u*)(XB + (size_t)m * D) + F.lane;
#pragma unroll
            for (int j = 0; j < 8; ++j) { v2u w; w.x = pk2(v[j].x, v[j].y); w.y = pk2(v[j].z, v[j].w); o8[64 * j] = w; }
        }
    }
    {
        const float* p = F.in[I_P]; bf16* PB = (bf16*)(F.ws + WS_PB);
        const int nchunk = T * PLE / 8, gt = F.bx * NTHR + F.tid, NGT = F.G * NTHR;
        for (int c = gt; c < nchunk; c += NGT) { const f32x4 a = *(const GAS f32x4*)(p + (size_t)c * 8), b = *(const GAS f32x4*)(p + (size_t)c * 8 + 4);
            v4u w; w.x = pk2(a.x, a.y); w.y = pk2(a.z, a.w); w.z = pk2(b.x, b.y); w.w = pk2(b.z, b.w); *(GAS v4u*)(PB + (size_t)c * 8) = w; }
    }
    for (int it = gw; it < P0_NONEXP; it += NGW) p0_item(F, it, scr);
}

__device__ __forceinline__ unsigned off_b(unsigned row, unsigned ch) { return 256u * row + 16u * (ch ^ (((row & 3) << 2) | ((row >> 2) & 3))); }
#define MFMA32(a, b, c) __builtin_amdgcn_mfma_f32_32x32x16_bf16((a), (b), (c), 0, 0, 0)

__device__ __forceinline__ void conv_item(Frame& F, int it) {
    const bf16* proj = (const bf16*)(F.ws + WS_PROJ); bf16* ymix = (bf16*)F.out + (size_t)T * D;
    const float* cw = F.in[I_CONVW]; const int lane = F.lane;
    float w0[16], w1[16], w2[16], u1[16], u2[16];
#pragma unroll
    for (int j = 0; j < 2; ++j)
#pragma unroll
        for (int i = 0; i < 8; ++i) { const int c = 512 * j + 8 * lane + i; w0[8 * j + i] = cw[c]; w1[8 * j + i] = cw[CW + c]; w2[8 * j + i] = cw[2 * CW + c]; u1[8 * j + i] = 0.f; u2[8 * j + i] = 0.f; }
    const int t0 = 16 * it; const bool seq_start = (t0 & (SEQ - 1)) == 0;
    for (int g = 0; g < 6; ++g) {
        v4u hw[3][2], cwv[3][2], bw[3][2];
#pragma unroll
        for (int q = 0; q < 3; ++q) { const long t = (long)t0 - 2 + 3 * g + q; const bf16* pr = proj + t * PCW + 8 * lane;
#pragma unroll
            for (int j = 0; j < 2; ++j) { hw[q][j] = *(const GAS v4u*)(pr + 512 * j); cwv[q][j] = *(const GAS v4u*)(pr + 2 * CW + 512 * j); bw[q][j] = *(const GAS v4u*)(pr + CW + 512 * j); } }
#pragma unroll
        for (int q = 0; q < 3; ++q) { const int tt = -2 + 3 * g + q; const long t = (long)t0 + tt;
            float u[16];
#pragma unroll
            for (int j = 0; j < 2; ++j)
#pragma unroll
                for (int k = 0; k < 4; ++k) { u[8 * j + 2 * k] = bflo(hw[q][j][k]) * bflo(cwv[q][j][k]); u[8 * j + 2 * k + 1] = bfhi(hw[q][j][k]) * bfhi(cwv[q][j][k]); }
            if (tt < 0 && seq_start) {
#pragma unroll
                for (int i = 0; i < 16; ++i) u[i] = 0.f;
            }
            if (tt >= 0) {
                float y[16], ss = 0.f;
#pragma unroll
                for (int j = 0; j < 2; ++j)
#pragma unroll
                    for (int k = 0; k < 4; ++k) { const int i = 8 * j + 2 * k;
                        y[i] = bflo(bw[q][j][k]) * (w0[i] * u2[i] + w1[i] * u1[i] + w2[i] * u[i]); y[i + 1] = bfhi(bw[q][j][k]) * (w0[i + 1] * u2[i + 1] + w1[i + 1] * u1[i + 1] + w2[i + 1] * u[i + 1]);
                        ss += y[i] * y[i] + y[i + 1] * y[i + 1]; }
                const float r = __builtin_amdgcn_rsqf(wave_sum(ss) * (1.f / CW) + EPS);
                bf16* yo = ymix + t * D + 8 * lane;
#pragma unroll
                for (int j = 0; j < 2; ++j) { v4u w; w.x = pg8::cvt_pk_bf16(y[8 * j] * r, y[8 * j + 1] * r); w.y = pg8::cvt_pk_bf16(y[8 * j + 2] * r, y[8 * j + 3] * r); w.z = pg8::cvt_pk_bf16(y[8 * j + 4] * r, y[8 * j + 5] * r); w.w = pg8::cvt_pk_bf16(y[8 * j + 6] * r, y[8 * j + 7] * r);
                    *(GAS v4u*)(yo + 512 * j) = w; }
            }
#pragma unroll
            for (int i = 0; i < 16; ++i) { u2[i] = u1[i]; u1[i] = u[i]; }
        }
    }
}

__device__ __forceinline__ bf16x8 pack8(float a0, float a1, float a2, float a3, float a4, float a5, float a6, float a7) {
    v4u p; p.x = pg8::cvt_pk_bf16(a0, a1); p.y = pg8::cvt_pk_bf16(a2, a3); p.z = pg8::cvt_pk_bf16(a4, a5); p.w = pg8::cvt_pk_bf16(a6, a7); return __builtin_bit_cast(bf16x8, p);
}
__device__ __forceinline__ void tr_read4(unsigned a_t0, unsigned a_t1, s16x4& r00, s16x4& r01, s16x4& r10, s16x4& r11) {
    asm volatile("ds_read_b64_tr_b16 %0, %4\n\tds_read_b64_tr_b16 %1, %5\n\tds_read_b64_tr_b16 %2, %4 offset:4096\n\tds_read_b64_tr_b16 %3, %5 offset:4096\n\ts_waitcnt lgkmcnt(0)"
                 : "=&v"(r00), "=&v"(r01), "=&v"(r10), "=&v"(r11) : "v"(a_t0), "v"(a_t1) : "memory");
}
constexpr float ATT_C = 0.08838834764831845f * 1.4426950408889634f;
constexpr float ATT_EXIT = -152.f;

__device__ __forceinline__ float attn_head(Frame& F, int lw, int h, int b, int qblk, f32x16 (&oacc)[4]) {
    const int lane = F.lane, r = lane & 31, hh = lane >> 5;
    const bf16* qkv = (const bf16*)(F.ws + WS_QKV);
    const size_t hb = ((size_t)b * NH + h) * SEQ;
    const int t0 = qblk * 32;
    LAS unsigned char* kt = F.lds + lw * 16384; LAS unsigned char* vt = kt + 8192;
    bf16x8 qf[8];
    { const bf16* qp = qkv + (hb + t0 + r) * HD + 8 * hh;
#pragma unroll
      for (int kk = 0; kk < 8; ++kk) qf[kk] = *(const GAS bf16x8*)(qp + 16 * kk); }
#pragma unroll
    for (int c = 0; c < 4; ++c)
#pragma unroll
        for (int i = 0; i < 16; ++i) oacc[c][i] = 0.f;
    float L = 0.f;
    const unsigned pr = (unsigned)((r & 19) | ((r & 4) << 1) | ((r & 8) >> 1));
    const unsigned ktb = (unsigned)(size_t)kt, vtb = (unsigned)(size_t)vt;
    unsigned va[2][4];
    { const unsigned blk = (lane >> 4) & 1, q = (lane & 15) >> 2, p = lane & 3;
#pragma unroll
      for (int t = 0; t < 2; ++t)
#pragma unroll
          for (int c = 0; c < 4; ++c) va[t][c] = vtb + off_b(8 * hh + 4 * t + q, 4 * c + 2 * blk + (p >> 1)) + 8 * (p & 1); }
    unsigned loff[8];
#pragma unroll
    for (int i = 0; i < 8; ++i) { const unsigned row = 4 * i + (lane >> 4), ch = (lane & 15) ^ (((row & 3) << 2) | ((row >> 2) & 3)); loff[i] = (row * HD + ch * 8) * 2; }
    const char* kvb = (const char*)(qkv + ((size_t)NB * NH * SEQ + hb) * HD);
    constexpr size_t VOFF = (size_t)NB * NH * SEQ * HD * 2;
#define ATT_DMA(ldsb, gp) do { _Pragma("unroll") for (int _i = 0; _i < 8; ++_i) \
        __builtin_amdgcn_global_load_lds((const unsigned*)((gp) + loff[_i]), (LAS unsigned*)((ldsb) + _i * 1024), 16, 0, 0); } while (0)
    { const char* g0 = kvb + (size_t)(qblk * 32) * HD * 2; ATT_DMA(kt, g0); ATT_DMA(vt, g0 + VOFF); }
    for (int kti = qblk; kti >= 0; --kti) {
        const int s0 = kti * 32;
        const char* gn = kvb + (size_t)((kti > 0 ? kti - 1 : 0) * 32) * HD * 2;
        asm volatile("s_waitcnt vmcnt(8)" ::: "memory");
        f32x16 x;
#pragma unroll
        for (int i = 0; i < 16; ++i) x[i] = 0.f;
        bf16x8 kf[8];
#pragma unroll
        for (int kk = 0; kk < 8; ++kk) kf[kk] = *(const LAS bf16x8*)(kt + off_b(pr, 2 * kk + hh));
        LDS_WAIT();
        ATT_DMA(kt, gn);
#pragma unroll
        for (int kk = 0; kk < 8; ++kk) x = MFMA32(kf[kk], qf[kk], x);
        const bool diag = (kti == qblk);
        float zz[16], suf[16];
#pragma unroll
        for (int i = 0; i < 16; ++i) {
            zz[i] = x[i] * ATT_C;
            const float e = __builtin_amdgcn_exp2f(fminf(zz[i], 126.f));
            float l = -__builtin_amdgcn_logf(1.f + e);
            const int kap = 16 * (i >> 3) + 8 * hh + (i & 7);
            if (diag && !(kap < r)) l = 0.f;
            suf[i] = l;
        }
#pragma unroll
        for (int j = 6; j >= 0; --j) { suf[j] += suf[j + 1]; suf[8 + j] += suf[8 + j + 1]; }
        const float T0 = suf[0], T1 = suf[8];
        const float T0p = __shfl_xor(T0, 32), T1p = __shfl_xor(T1, 32);
        const float base0 = L + T1 + T1p + (hh == 0 ? T0p : 0.f), base1 = L + (hh == 0 ? T1p : 0.f);
        float a[16];
#pragma unroll
        for (int i = 0; i < 16; ++i) {
            float v = __builtin_amdgcn_exp2f(zz[i] + (i < 8 ? base0 : base1) + suf[i]);
            const int kap = 16 * (i >> 3) + 8 * hh + (i & 7);
            if (diag && !(kap < r)) v = 0.f;
            a[i] = v;
        }
        L += (T0 + T1) + (T0p + T1p);
        const bf16x8 pf0 = pack8(a[0], a[1], a[2], a[3], a[4], a[5], a[6], a[7]);
        const bf16x8 pf1 = pack8(a[8], a[9], a[10], a[11], a[12], a[13], a[14], a[15]);
        asm volatile("s_waitcnt vmcnt(8)" ::: "memory");
#pragma unroll
        for (int c = 0; c < 4; ++c) {
            s16x4 r00, r01, r10, r11; tr_read4(va[0][c], va[1][c], r00, r01, r10, r11);
            const bf16x8 vf0 = __builtin_shufflevector(r00, r01, 0, 1, 2, 3, 4, 5, 6, 7), vf1 = __builtin_shufflevector(r10, r11, 0, 1, 2, 3, 4, 5, 6, 7);
            oacc[c] = MFMA32(vf0, pf0, oacc[c]); oacc[c] = MFMA32(vf1, pf1, oacc[c]);
        }
        ATT_DMA(vt, gn + VOFF);
        if (__all(L < ATT_EXIT)) break;
    }
    VM_WAIT();
#undef ATT_DMA
    float ss = 0.f;
#pragma unroll
    for (int c = 0; c < 4; ++c)
#pragma unroll
        for (int i = 0; i < 16; ++i) ss += oacc[c][i] * oacc[c][i];
    ss += __shfl_xor(ss, 32);
    return ss;
}
constexpr int P2_BSCR_OFF = 65536, P2_XS_OFF = P2_BSCR_OFF + 4 * 16896;
static_assert(P2_XS_OFF + 2048 + 64 <= LDS_BYTES, "P2 LDS map");
__device__ __forceinline__ void p2_mixer(Frame& F) {
    const int lane = F.lane, w = F.wave, r = lane & 31, hh = lane >> 5;
    const int nunits = (NB * (SEQ / 32) - F.bx + F.G - 1) / F.G;
    if (F.tid < 8) ((volatile LAS unsigned*)(F.lds + P2_XS_OFF + 2048))[F.tid] = 0u;
    __syncthreads();
    if (w < 4) {
        bf16* ymix = (bf16*)F.out + (size_t)T * D;
        for (int j = 0; j < nunits; ++j) {
            const int u = F.bx + j * F.G, b = u % NB, qblk = u / NB;
            LAS float* XS = (LAS float*)(F.lds + P2_XS_OFF) + (j & 1) * 256;
            v2u st0[16];
            f32x16 oacc[4];
            const float ss0 = attn_head(F, w, w, b, qblk, oacc);
#pragma unroll
            for (int c = 0; c < 4; ++c)
#pragma unroll
                for (int g = 0; g < 4; ++g) { st0[c * 4 + g].x = pg8::cvt_pk_bf16(oacc[c][4 * g], oacc[c][4 * g + 1]); st0[c * 4 + g].y = pg8::cvt_pk_bf16(oacc[c][4 * g + 2], oacc[c][4 * g + 3]); }
            if (hh == 0) XS[w * 32 + r] = ss0;
            const float ss1 = attn_head(F, w, w + 4, b, qblk, oacc);
            if (hh == 0) XS[(w + 4) * 32 + r] = ss1;
            { volatile LAS unsigned* FL = (volatile LAS unsigned*)(F.lds + P2_XS_OFF + 2048) + (j & 1) * 4;
              LDS_WAIT(); if (lane == 0) FL[w] = (unsigned)(j + 1);
              for (unsigned sp = 0; sp < (1u << 22); ++sp) { const unsigned f0 = FL[0], f1 = FL[1], f2 = FL[2], f3 = FL[3]; if (f0 == (unsigned)(j + 1) && f1 == f0 && f2 == f0 && f3 == f0) break; __builtin_amdgcn_s_sleep(1); }
              asm volatile("" ::: "memory"); }
            float tot = 0.f;
#pragma unroll
            for (int k = 0; k < 8; ++k) tot += XS[k * 32 + r];
            const float rs = __builtin_amdgcn_rsqf(tot * (1.f / CW) + EPS);
            bf16* yo = ymix + ((size_t)b * SEQ + qblk * 32 + r) * D + CW + 4 * hh;
#pragma unroll
            for (int c = 0; c < 4; ++c)
#pragma unroll
                for (int g = 0; g < 4; ++g) {
                    v2u o0; o0.x = pg8::cvt_pk_bf16(bflo(st0[c * 4 + g].x) * rs, bfhi(st0[c * 4 + g].x) * rs); o0.y = pg8::cvt_pk_bf16(bflo(st0[c * 4 + g].y) * rs, bfhi(st0[c * 4 + g].y) * rs);
                    *(GAS v2u*)(yo + w * HD + 32 * c + 8 * g) = o0;
                    v2u o1; o1.x = pg8::cvt_pk_bf16(oacc[c][4 * g] * rs, oacc[c][4 * g + 1] * rs); o1.y = pg8::cvt_pk_bf16(oacc[c][4 * g + 2] * rs, oacc[c][4 * g + 3] * rs);
                    *(GAS v2u*)(yo + (w + 4) * HD + 32 * c + 8 * g) = o1; }
        }
        { const int ga = F.bx * 4 + w, NAW = F.G * 4;
          for (int it = ga; it < T / 16; it += NAW) conv_item(F, it); }
    } else {
        LAS float* scr = (LAS float*)(F.lds + P2_BSCR_OFF + (w - 4) * 16896);
        const int gb = F.bx * 4 + (w - 4), NBW = F.G * 4;
        const int cnt = (EXP_ITEMS - gb + NBW - 1) / NBW;
        for (int j = 0; j < nunits; ++j) {
            const int k0 = (int)((long)cnt * j / nunits), k1 = (int)((long)cnt * (j + 1) / nunits);
            for (int k = k0; k < k1; ++k) {
                f32x4 v[32], gq[8];
                const ExpItem I = exp_decode(F, gb + k * NBW);
                exp_issue(I, lane, v, gq);
                exp_finish_half<0>(I, lane, v, gq, scr);
                exp_finish_half<1>(I, lane, v, gq, scr);
            }
        }
    }
}

__device__ __forceinline__ void router_unit(Frame& F, int unit, LAS int* hist) {
    const int lane = F.lane, r16 = lane & 15, g = lane >> 4;
    const bf16* H = (const bf16*)(F.ws + WS_H1B); const bf16* WR = (const bf16*)(F.ws + WS_WR);
    const int t0 = unit * 16;
    LAS float* LG = (LAS float*)(F.lds + F.wave * 16384); LAS float* BI = LG + 16 * 65 + 16;
    f32x4 acc[4];
#pragma unroll
    for (int nb = 0; nb < 4; ++nb) acc[nb] = (f32x4){0.f, 0.f, 0.f, 0.f};
    float ss = 0.f;
    const bf16* ap = H + (size_t)(t0 + r16) * D + 8 * g; const bf16* bp = WR + (size_t)r16 * D + 8 * g;
#pragma unroll 8
    for (int ks = 0; ks < D / 32; ++ks) {
        const v4u aw = *(const GAS v4u*)(ap + 32 * ks);
#pragma unroll
        for (int q = 0; q < 4; ++q) { const float lo = bflo(aw[q]), hi = bfhi(aw[q]); ss += lo * lo + hi * hi; }
        const bf16x8 af = __builtin_bit_cast(bf16x8, aw);
#pragma unroll
        for (int nb = 0; nb < 4; ++nb) { const bf16x8 bf = *(const GAS bf16x8*)(bp + (size_t)(16 * nb) * D + 32 * ks); acc[nb] = __builtin_amdgcn_mfma_f32_16x16x32_bf16(af, bf, acc[nb], 0, 0, 0); }
    }
    ss += __shfl_xor(ss, 16); ss += __shfl_xor(ss, 32);
#pragma unroll
    for (int nb = 0; nb < 4; ++nb)
#pragma unroll
        for (int j = 0; j < 4; ++j) LG[(4 * g + j) * 65 + 16 * nb + r16] = acc[nb][j];
    LDS_WAIT();
    if (lane < 16) {
        const int t = t0 + lane; const float rs = __builtin_amdgcn_rsqf(ss * (1.f / D) + EPS);
        ((float*)(F.ws + WS_RFFN))[t] = rs;
        const LAS float* lg = LG + lane * 65; const float* rb = F.in[I_RB];
        float sc[NE], bi[NE];
#pragma unroll
        for (int e = 0; e < NE; ++e) { const float s = fsigmoid(lg[e] * rs); sc[e] = s; bi[e] = s + rb[e]; }
        float gs[8];
#pragma unroll
        for (int gg = 0; gg < 8; ++gg) { float m1 = -__builtin_inff(), m2 = -__builtin_inff();
#pragma unroll
            for (int j = 0; j < 8; ++j) { const float v = bi[8 * gg + j]; const float lo = fminf(m1, v); m1 = fmaxf(m1, v); m2 = fmaxf(m2, lo); }
            gs[gg] = m1 + m2; }
        bool okg[8];
#pragma unroll
        for (int gg = 0; gg < 8; ++gg) { int cnt = 0;
#pragma unroll
            for (int g2 = 0; g2 < 8; ++g2) cnt += (gs[g2] > gs[gg] || (gs[g2] == gs[gg] && g2 < gg)) ? 1 : 0;
            okg[gg] = cnt < 4; }
#pragma unroll
        for (int e = 0; e < NE; ++e) bi[e] = okg[e >> 3] ? bi[e] : -__builtin_inff();
        int se[8]; float sv[8]; float wsum = 0.f;
#pragma unroll
        for (int k = 0; k < 8; ++k) { float best = -__builtin_inff(); int be = 0;
#pragma unroll
            for (int e = 0; e < NE; ++e) { const bool tk = bi[e] > best; best = tk ? bi[e] : best; be = tk ? e : be; }
            float svk = 0.f;
#pragma unroll
            for (int e = 0; e < NE; ++e) { const bool hit = (e == be); svk = hit ? sc[e] : svk; bi[e] = hit ? -__builtin_inff() : bi[e]; }
            se[k] = be; sv[k] = svk; wsum += svk; }
        const float inv = 2.5f / wsum;
        int* te = (int*)(F.ws + WS_TOPE) + (size_t)t * 8; float* tw = (float*)(F.ws + WS_TOPW) + (size_t)t * 8;
#pragma unroll
        for (int k = 0; k < 8; ++k) { te[k] = se[k]; tw[k] = sv[k] * inv; (void)__hip_atomic_fetch_add(hist + se[k], 1, __ATOMIC_RELAXED, __HIP_MEMORY_SCOPE_WORKGROUP); }
    }
}
__device__ __forceinline__ void p4_router(Frame& F) {
    LAS int* hist = (LAS int*)(F.lds + RT_OFF);
    for (int v = F.bx; v < 256; v += F.G) {
        if (F.tid < 64) hist[F.tid] = 0;
        __syncthreads();
        router_unit(F, v * 8 + F.wave, hist);
        __syncthreads();
        if (F.tid < 64) ((int*)(F.ws + WS_CNT))[v * 64 + F.tid] = hist[F.tid];
        __syncthreads();
    }
}

__device__ __forceinline__ void p4b_tables(Frame& F) {
    LAS int* L = (LAS int*)(F.lds + RING_OFF);
    LAS int* part_t = L;
    LAS int* part_b = L + 512;
    LAS int* totals = L + 1024;
    LAS int* below = L + 1088;
    LAS int* segst = L + 1152;
    LAS int* wcount = L + 1280;
    LAS int* pe = L + 2048;
    LAS int* rank = L + 3072;
    const int* CNT = (const int*)(F.ws + WS_CNT); const int* TOPE = (const int*)(F.ws + WS_TOPE); const float* TOPW = (const float*)(F.ws + WS_TOPW);
    const float* RFFN = (const float*)(F.ws + WS_RFFN);
    int* RTOK = (int*)(F.ws + WS_RTOK); float* RW = (float*)(F.ws + WS_RW); int* RDST = (int*)(F.ws + WS_RDST); float* RR = (float*)(F.ws + WS_RR); int* TILEE = (int*)(F.ws + WS_TILEE);
    const int tid = F.tid, lane = F.lane, wave = F.wave;
    for (int v = F.bx; v < 256; v += F.G) {
        { const int e = tid & 63, part = tid >> 6; int tot = 0, bel = 0;
          for (int vv = 32 * part; vv < 32 * part + 32; ++vv) { const int c = CNT[vv * 64 + e]; tot += c; bel += (vv < v) ? c : 0; }
          part_t[part * 64 + e] = tot; part_b[part * 64 + e] = bel; }
        for (int i = tid; i < 1024; i += NTHR) pe[i] = TOPE[(size_t)v * 1024 + i];
        __syncthreads();
        if (wave == 0) {
            int tot = 0, bel = 0;
#pragma unroll
            for (int p = 0; p < 8; ++p) { tot += part_t[p * 64 + lane]; bel += part_b[p * 64 + lane]; }
            totals[lane] = tot; below[lane] = bel;
            const int ru = (tot + 255) & ~255; int sc = ru;
#pragma unroll
            for (int o = 1; o < 64; o <<= 1) { const int n = __shfl_up(sc, o); if (lane >= o) sc += n; }
            segst[lane] = sc - ru; if (lane == 63) segst[64] = sc;
        }
        { int cnt = 0;
          for (int j = 0; j < 128; ++j) { const int p = 128 * wave + j; if (pe[p] == lane) { rank[p] = cnt; ++cnt; } }
          wcount[wave * 64 + lane] = cnt; }
        __syncthreads();
        const int SS = segst[64];
        for (int p = tid; p < 1024; p += NTHR) { const int e = pe[p], w = p >> 7; int off = 0;
            for (int w2 = 0; w2 < w; ++w2) off += wcount[w2 * 64 + e];
            const int row = segst[e] + below[e] + off + rank[p]; const int t = 128 * v + (p >> 3), k = p & 7;
            RTOK[row] = t; RW[row] = TOPW[(size_t)t * 8 + k]; RDST[row] = k * T + t; RR[row] = RFFN[t]; }
        if (tid < 128) { const int t = 128 * v + tid, row = SS + t; RTOK[row] = t; RW[row] = 1.f; RDST[row] = 8 * T + t; RR[row] = RFFN[t]; }
        if (v < NE) { const int e = v, tot = totals[e], ru = (tot + 255) & ~255, st = segst[e];
            if (tid < ru - tot) { const int row = st + tot + tid; RTOK[row] = 0; RW[row] = 0.f; RDST[row] = -1; RR[row] = 0.f; }
            if (tid < ru / 256) TILEE[st / 256 + tid] = e; }
        if (v == NE) { if (tid < T / 256) TILEE[SS / 256 + tid] = NE; if (tid == 0) TILEE[MAXTILES] = SS / 256 + T / 256; }
        __syncthreads();
    }
}

template <int MODE> __device__ __forceinline__ int group_setup(Frame& F, int nN) {
    const int* TILEE = (const int*)(F.ws + WS_TILEE);
    const int NT = __builtin_amdgcn_readfirstlane((int)__hip_atomic_load((unsigned*)TILEE + MAXTILES, RLX_AGENT));
    LAS int* te = (LAS int*)(F.lds + TE_OFF); LAS unsigned* rt = (LAS unsigned*)(F.lds + RT_OFF);
    for (int i = F.tid; i < NT && i < MAXTILES; i += NTHR) te[i] = TILEE[i];
    if (MODE == 1) {
        const int* RTOK = (const int*)(F.ws + WS_RTOK);
        for (int ui = F.tid >> 8; ui < RT_UNITS; ui += 2) { int pm, pn; if (!pg8::order_next(ui, F.G, F.bx, NT, nN, pm, pn)) break;
            rt[ui * 256 + (F.tid & 255)] = (unsigned)RTOK[pm * 256 + (F.tid & 255)] * (unsigned)D; }
    }
    __syncthreads();
    return NT;
}

__device__ __forceinline__ void acc_fp8x16(const v4u w, float (&o)[16]) {
#pragma unroll
    for (int q = 0; q < 4; ++q) { const f32x2 lo = __builtin_amdgcn_cvt_pk_f32_fp8((int)w[q], false), hi = __builtin_amdgcn_cvt_pk_f32_fp8((int)w[q], true);
        o[4 * q] += lo.x; o[4 * q + 1] += lo.y; o[4 * q + 2] += hi.x; o[4 * q + 3] += hi.y; }
}
__device__ __forceinline__ void p7_combine(Frame& F, int n) {
    const int gw = F.bx * NWAVES + F.wave, NGW = F.G * NWAVES, lane = F.lane;
    bf16* H = (bf16*)(F.ws + WS_H1B); const unsigned char* S0 = (const unsigned char*)F.out; const unsigned char* S1 = F.ws + WS_SLOT47; const unsigned char* S8 = F.ws + WS_SLOT8;
    float* ssq2 = (float*)(F.ws + WS_SSQ2);
    for (int t = gw; t < T; t += NGW) {
        float ss = 0.f;
#pragma unroll
        for (int ch = 0; ch < 2; ++ch) {
            const int co = 1024 * ch + 16 * lane;
            bf16* hp = H + (size_t)t * D + co;
            const v4u h0 = *(const GAS v4u*)hp, h1 = *(const GAS v4u*)(hp + 8);
            v4u w[9];
#pragma unroll
            for (int k = 0; k < 4; ++k) { w[k] = *(const GAS v4u*)(S0 + ((size_t)k * T + t) * D + co); w[4 + k] = *(const GAS v4u*)(S1 + ((size_t)k * T + t) * D + co); }
            w[8] = *(const GAS v4u*)(S8 + (size_t)t * D + co);
            float o[16];
#pragma unroll
            for (int i = 0; i < 16; ++i) o[i] = 0.f;
#pragma unroll
            for (int k = 0; k < 9; ++k) acc_fp8x16(w[k], o);
            f32x4 a0, a1, a2, a3; pg8::unpack8(h0, a0, a1); pg8::unpack8(h1, a2, a3);
#pragma unroll
            for (int j = 0; j < 4; ++j) { a0[j] += o[j] * (1.f / SLOT_SCALE); a1[j] += o[4 + j] * (1.f / SLOT_SCALE); a2[j] += o[8 + j] * (1.f / SLOT_SCALE); a3[j] += o[12 + j] * (1.f / SLOT_SCALE);
                ss += (a0[j] * a0[j] + a1[j] * a1[j]) + (a2[j] * a2[j] + a3[j] * a3[j]); }
            *(GAS v4u*)hp = pg8::pack8_bf16(a0, a1); *(GAS v4u*)(hp + 8) = pg8::pack8_bf16(a2, a3);
            { v4u w8; w8.x = pg8::cvt4_fp8(a0[0], a0[1], a0[2], a0[3]); w8.y = pg8::cvt4_fp8(a1[0], a1[1], a1[2], a1[3]); w8.z = pg8::cvt4_fp8(a2[0], a2[1], a2[2], a2[3]); w8.w = pg8::cvt4_fp8(a3[0], a3[1], a3[2], a3[3]);
              *(GAS v4u*)(F.ws + WS_H1F8 + (size_t)t * D + co) = w8; }
        }
        ss = wave_sum(ss);
        if (lane == 0) ssq2[t] = ss;
    }
}

__device__ __forceinline__ void p9_final(Frame& F, const bf16* H, const float* ssq, int nparts) {
    const int gw = F.bx * NWAVES + F.wave, NGW = F.G * NWAVES, lane = F.lane; const float* g = F.in[I_NFIN];
    for (int t = gw; t < T; t += NGW) {
        v4u w[4];
#pragma unroll
        for (int j = 0; j < 4; ++j) w[j] = *(const GAS v4u*)(H + (size_t)t * D + 512 * j + 8 * lane);
        float ss = 0.f;
        if (nparts > 0) { if (lane < nparts) ss = ssq[(size_t)lane * T + t]; }
        else {
#pragma unroll
            for (int j = 0; j < 4; ++j)
#pragma unroll
                for (int q = 0; q < 4; ++q) { const float lo = bflo(w[j][q]), hi = bfhi(w[j][q]); ss += lo * lo + hi * hi; }
        }
        const float r = __builtin_amdgcn_rsqf(wave_sum(ss) * (1.f / D) + EPS);
        float* o = F.out + (size_t)t * D;
#pragma unroll
        for (int j = 0; j < 4; ++j) { const int c = 512 * j + 8 * lane; const f32x4 g0 = *(const GAS f32x4*)(g + c), g1 = *(const GAS f32x4*)(g + c + 4);
            f32x4 a, b; a.x = bflo(w[j][0]) * r * g0.x; a.y = bfhi(w[j][0]) * r * g0.y; a.z = bflo(w[j][1]) * r * g0.z; a.w = bfhi(w[j][1]) * r * g0.w;
            b.x = bflo(w[j][2]) * r * g1.x; b.y = bfhi(w[j][2]) * r * g1.y; b.z = bflo(w[j][3]) * r * g1.z; b.w = bfhi(w[j][3]) * r * g1.w;
            *(GAS f32x4*)(o + c) = a; *(GAS f32x4*)(o + c + 4) = b; }
    }
}

struct Args { const float* in[21]; float* out; unsigned char* ws; int ph_lo, ph_hi, fin_mode, li; };
__global__ void __launch_bounds__(NTHR, 2) mk_fwd(Args args) {
    extern __shared__ __attribute__((aligned(16))) unsigned char lds[];
    Frame F;
    F.lds = (LAS unsigned char*)lds;
    F.tid = threadIdx.x; F.lane = F.tid & 63; F.wave = __builtin_amdgcn_readfirstlane(F.tid >> 6);
    F.G = gridDim.x; F.bx = blockIdx.x; F.ws = args.ws; F.out = args.out;
#pragma unroll
    for (int i = 0; i < 21; ++i) F.in[i] = args.in[i];
    volatile LAS unsigned* MISC = (volatile LAS unsigned*)(F.lds + MISC_OFF);
    if (F.tid < 32) MISC[F.tid] = 0u;
    __syncthreads();
    XcdBarrier bar = xcd_barrier_post((unsigned*)(F.ws + WS_CTL) + CW_BAR + args.li * XCD_BAR_WORDS, MISC + 8);
    unsigned char* ws = F.ws;
    const int lo = args.ph_lo, hi = args.ph_hi;
    LAS unsigned char* ring = F.lds + RING_OFF;
#define PHASE(k) if (lo <= (k) && (k) < hi)
#define PH(k) PHASE(k) { RELANE();
#define GRID_BAR() xcd_barrier(bar)
#define RELANE() do { int _t = threadIdx.x; asm volatile("" : "+v"(_t)); F.tid = _t; F.lane = _t & 63; F.wave = __builtin_amdgcn_readfirstlane(_t >> 6); } while (0)

    PHASE(0) { RELANE(); p0_prologue(F); GRID_BAR(); }
    PHASE(1) { RELANE();
        pg8::DenseSched S{T / 256, NPROJ / 256, F.G, F.bx, D * 2, (const char*)(ws + WS_WIN)};
        pg8::EpiProj E{(bf16*)(ws + WS_PROJ), (bf16*)(ws + WS_QKV), (const float*)(ws + WS_RMIX)};
        pg8::gemm_phase<false, 1>(F.tid, ring, (const char*)F.out, D * 2, S, E);
        GRID_BAR();
    }
    PHASE(2) { RELANE(); p2_mixer(F); GRID_BAR(); }
    PHASE(3) { RELANE();
        pg8::DenseSched S{T / 256, D / 256, F.G, F.bx, D * 2, (const char*)(ws + WS_WOUT)};
        pg8::EpiResF32 E{(bf16*)(ws + WS_H1B), (const bf16*)F.out, D, ws + WS_H1F8};
        pg8::gemm_phase<false, 1>(F.tid, ring, (const char*)((bf16*)F.out + (size_t)T * D), D * 2, S, E);
        GRID_BAR();
    }
    PHASE(4) { RELANE(); p4_router(F); GRID_BAR(); }
    PHASE(5) { RELANE(); p4b_tables(F); GRID_BAR(); }
    PHASE(6) { RELANE();
        const int NT = group_setup<1>(F, 4);
        pg8::GroupSched<1> S{NT, 4, F.G, F.bx, D, 0, (const char*)(ws + WS_WGU), (size_t)1024 * D, (const LAS int*)(F.lds + TE_OFF), (const LAS unsigned*)(F.lds + RT_OFF)};
        pg8::EpiGateUp E{ws + WS_HPERM, (const float*)(ws + WS_RR)};
        pg8::gemm_phase<true, 0>(F.tid, ring, (const char*)(ws + WS_H1F8), D, S, E, 0x79797979, 0x7f7f7f7f);
        GRID_BAR();
    }
    {
        for (int n = 0; n < NSLICE; ++n) {
            PHASE(7 + 2 * n) { RELANE();
            const int NT = group_setup<2>(F, SLW / 256);
            pg8::GroupSched<2> S{NT, SLW / 256, F.G, F.bx, ED, (SLW / 256) * n, (const char*)(ws + WS_WDN), (size_t)D * ED, (const LAS int*)(F.lds + TE_OFF), (const LAS unsigned*)(F.lds + RT_OFF)};
            pg8::EpiDown E{(unsigned char*)F.out, ws + WS_SLOT47, ws + WS_SLOT8, (const float*)(ws + WS_RW), (const int*)(ws + WS_RDST)};
            pg8::gemm_phase<true, 0>(F.tid, ring, (const char*)(ws + WS_HPERM), ED, S, E, 0x79797979, 0x7f7f7f7f);
            GRID_BAR();
            }
            PHASE(8 + 2 * n) { RELANE();
            p7_combine(F, n);
            GRID_BAR();
            }
        }
    }
    PHASE(15) { RELANE();
        pg8::DenseSched S{T / 256, D / 256, F.G, F.bx, PLE * 2, (const char*)(ws + WS_WPP)};
        pg8::EpiBf16Scale E{(bf16*)(ws + WS_PP), D, nullptr};
        pg8::gemm_phase<false, 1>(F.tid, ring, (const char*)(ws + WS_PB), PLE * 2, S, E);
        GRID_BAR();
    }
    PHASE(16) { RELANE();
        pg8::DenseSchedG S{T / 256, D / 256, F.G, F.bx, D, (const char*)(ws + WS_WPG)};
        pg8::EpiPle E{(bf16*)(ws + WS_H3), (const bf16*)(ws + WS_H1B), (const bf16*)(ws + WS_PP), (const float*)(ws + WS_SSQ2), (float*)(ws + WS_SSQ3)};
        pg8::gemm_phase<true, 1>(F.tid, ring, (const char*)(ws + WS_H1F8), D, S, E, 0x79797979, 0x7f7f7f7f);
        GRID_BAR();
    }
    PHASE(17) { RELANE();
    if (args.fin_mode == 0) p9_final(F, (const bf16*)(ws + WS_H3), (const float*)(ws + WS_SSQ3), 32);
    else p9_final(F, (const bf16*)(ws + WS_H1B), nullptr, 0);
    }
}

extern "C" void kernel_launch(void* const* d_in, const int* in_sizes, int n_in, void* d_out, int out_size, void* d_ws, size_t ws_size, hipStream_t stream) {
    static int grid = 0;
    if (grid == 0) {
        int dev = 0, cus = 0;
        if (n_in != 21 || ws_size < WS_END) { fprintf(stderr, "kernel_launch: n_in %d ws %zu (need %zu)\n", n_in, ws_size, (size_t)WS_END); grid = -1; return; }
        if (hipGetDevice(&dev) != hipSuccess || hipDeviceGetAttribute(&cus, hipDeviceAttributeMultiprocessorCount, dev) != hipSuccess) { grid = -1; return; }
        if (hipFuncSetAttribute((const void*)mk_fwd, hipFuncAttributeMaxDynamicSharedMemorySize, LDS_BYTES) != hipSuccess) { fprintf(stderr, "hipFuncSetAttribute failed\n"); grid = -1; return; }
        int per_cu = 0;
        (void)hipOccupancyMaxActiveBlocksPerMultiprocessor(&per_cu, (const void*)mk_fwd, NTHR, LDS_BYTES);
        (void)hipGetLastError();
        grid = cus > 256 ? 256 : cus;
    }
    if (grid < 0) return;
    (void)hipMemsetAsync((char*)d_ws + WS_CTL, 0, CTL_ZERO_BYTES, stream);
    Args a{};
    for (int i = 0; i < 21; ++i) a.in[i] = (const float*)d_in[i];
    a.out = (float*)d_out; a.ws = (unsigned char*)d_ws; a.fin_mode = FIN_MODE;
#if PROBE_K >= 0
    a.ph_lo = 0; a.ph_hi = PROBE_K + 1; a.li = 0;
    hipLaunchKernelGGL(mk_fwd, dim3(grid), dim3(NTHR), LDS_BYTES, stream, a);
    a.ph_lo = PROBE_K; a.ph_hi = PH_HI; a.li = 1;
    hipLaunchKernelGGL(mk_fwd, dim3(grid), dim3(NTHR), LDS_BYTES, stream, a);
#else
    a.ph_lo = 0; a.ph_hi = PH_HI; a.li = 0;
    hipLaunchKernelGGL(mk_fwd, dim3(grid), dim3(NTHR), LDS_BYTES, stream, a);
#endif
}
```

```cpp
#include <hip/hip_runtime.h>
#include <cstdio>
#ifndef PROBE_K
#define PROBE_K -1
#endif
#ifndef PH_HI
#define PH_HI 100
#endif
#ifndef FIN_MODE
#define FIN_MODE 0
#endif

#define GAS __attribute__((address_space(1)))
#define LAS __attribute__((address_space(3)))
typedef unsigned short bf16;
typedef unsigned v4u __attribute__((ext_vector_type(4)));
typedef unsigned v2u __attribute__((ext_vector_type(2)));
typedef float f32x4 __attribute__((ext_vector_type(4)));
typedef float f32x2 __attribute__((ext_vector_type(2)));
typedef float f32x16 __attribute__((ext_vector_type(16)));
typedef short bf16x8 __attribute__((ext_vector_type(8)));
typedef short s16x4 __attribute__((ext_vector_type(4)));
typedef GAS unsigned gu32;
#define RLX_AGENT __ATOMIC_RELAXED, __HIP_MEMORY_SCOPE_AGENT
#define LDS_WAIT() asm volatile("s_waitcnt lgkmcnt(0)" ::: "memory")
#define VM_WAIT() asm volatile("s_waitcnt vmcnt(0)" ::: "memory")

constexpr int NB = 8, SEQ = 4096, T = NB * SEQ, D = 2048, NPROJ = 6144, CW = 1024, HD = 128, NH = 8;
constexpr int PCW = 3 * CW;
constexpr int PLE = 256, NE = 64, ED = 512, TOPK = 8, NSLOT = 9;
constexpr float EPS = 1e-6f;
constexpr int NWAVES = 8, NTHR = 512;
constexpr int MAXTILES = 1216;
constexpr int MAXROWS = MAXTILES * 256;
constexpr int P8_TSPLIT = 8192;
constexpr int P8_NPLE = 128;
constexpr int NSLICE = 1, SLW = D / NSLICE;
constexpr float SLOT_SCALE = 16.f;

constexpr size_t MiB = 1u << 20;
constexpr size_t WS_CTL = 0, CTL_ZERO_BYTES = 1 * MiB;
constexpr size_t WS_RMIX = 1 * MiB;
constexpr size_t WS_RFFN = WS_RMIX + 128 * 1024;
constexpr size_t WS_SSQ2 = WS_RFFN + 128 * 1024;
constexpr size_t WS_SSQ3 = WS_SSQ2 + 512 * 1024;
constexpr size_t WS_TOPE = WS_SSQ3 + 4 * MiB;
constexpr size_t WS_TOPW = WS_TOPE + 1 * MiB;
constexpr size_t WS_CNT  = WS_TOPW + 1 * MiB;
constexpr size_t WS_RTOK = WS_CNT + 64 * 1024;
constexpr size_t WS_RW   = WS_RTOK + 1280 * 1024;
constexpr size_t WS_RDST = WS_RW + 1280 * 1024;
constexpr size_t WS_RR   = WS_RDST + 1280 * 1024;
constexpr size_t WS_TILEE = WS_RR + 1280 * 1024;
constexpr size_t WS_WR   = 16 * MiB;
constexpr size_t WS_WOR  = WS_WR + 512 * 1024;
constexpr size_t WS_WIN  = 17 * MiB;
constexpr size_t WS_WOUT = WS_WIN + 24 * MiB;
constexpr size_t WS_WGU  = WS_WOUT + 8 * MiB;
constexpr size_t WS_WDN  = WS_WGU + 130 * MiB;
constexpr size_t WS_WPG  = WS_WDN + 65 * MiB;
constexpr size_t WS_WPP  = WS_WPG + 8 * MiB;
constexpr size_t WS_PB   = WS_WPP + 1 * MiB;
constexpr size_t WS_H1B  = WS_PB + 16 * MiB;
constexpr size_t WS_H1F8 = WS_H1B + 128 * MiB;
constexpr size_t WS_OVL  = WS_H1F8 + 64 * MiB;
constexpr size_t WS_PROJ = WS_OVL;
constexpr size_t WS_QKV  = WS_OVL + 192 * MiB;
constexpr size_t WS_HPERM = WS_OVL;
constexpr size_t WS_SLOT8 = WS_OVL + 304 * MiB;
constexpr size_t WS_PP   = WS_OVL;
constexpr size_t WS_H3   = WS_OVL + 128 * MiB;
constexpr size_t WS_SLOT47 = WS_OVL + 384 * MiB;
constexpr size_t WS_YMIX8 = WS_SLOT47;
constexpr size_t WS_LOGX = WS_SLOT47 + 64 * MiB;
constexpr size_t WS_SSQ1 = WS_SSQ3;
constexpr size_t WS_END  = WS_SLOT47 + 256 * MiB;
constexpr int CW_BAR = 4096, CW_CONVQ = 1024;

constexpr int RING_OFF = 0, RING_BYTES = 131072;
constexpr int RT_OFF = 131072, RT_UNITS = 20, RT_BYTES = RT_UNITS * 1024;
constexpr int TE_OFF = RT_OFF + RT_BYTES, TE_BYTES = 4864 + 128;
constexpr int EPT_OFF = TE_OFF + TE_BYTES, EPT_BYTES = 4096;
constexpr int MISC_OFF = EPT_OFF + EPT_BYTES;
constexpr int LDS_BYTES = MISC_OFF + 128;
static_assert(LDS_BYTES <= 163840, "LDS");

__device__ __forceinline__ unsigned f2bf(float f) { unsigned u = __builtin_bit_cast(unsigned, f); return (u + 0x7fffu + ((u >> 16) & 1u)) >> 16; }
__device__ __forceinline__ unsigned pk2(float lo, float hi) { return f2bf(lo) | (f2bf(hi) << 16); }
__device__ __forceinline__ float bflo(unsigned w) { return __builtin_bit_cast(float, w << 16); }
__device__ __forceinline__ float bfhi(unsigned w) { return __builtin_bit_cast(float, w & 0xffff0000u); }
__device__ __forceinline__ float wave_sum(float v) {
#pragma unroll
    for (int o = 1; o < 64; o <<= 1) v += __shfl_xor(v, o);
    return v;
}
__device__ __forceinline__ float fsigmoid(float v) { return __builtin_amdgcn_rcpf(1.f + __builtin_amdgcn_exp2f(-1.4426950409f * v)); }

#define XB_TMO      128
#define XB_XCNT(j)  (256  + 64 * (j))
#define XB_XSUB(j)  (1280 + 64 * (j))
#define XB_XGEN(j)  (2304 + 64 * (j))
#define XB_TOP      3328
#define XB_TOPGEN   3392
#define XCD_BAR_WORDS 3456
#define XB_SPIN_CAP (1u << 18)
__device__ __forceinline__ unsigned xb_ld(unsigned* p)              { return __hip_atomic_load(p, __ATOMIC_RELAXED, __HIP_MEMORY_SCOPE_AGENT); }
__device__ __forceinline__ unsigned xb_add(unsigned* p, unsigned v) { return __hip_atomic_fetch_add(p, v, __ATOMIC_RELAXED, __HIP_MEMORY_SCOPE_AGENT); }
__device__ __forceinline__ unsigned xb_xcc_id() { return (unsigned)__builtin_amdgcn_s_getreg((3 << 11) | 20) & 0xFu; }
#define XB_SPIN(cond, bar) do { unsigned _sp = 0; while (cond) { __builtin_amdgcn_s_sleep(1); \
    if ((++_sp & 255u) == 0u) { if (xb_ld(&(bar)[XB_TMO])) break; if (_sp > XB_SPIN_CAP) { atomicAdd(&(bar)[XB_TMO], 1u); break; } } } } while (0)
struct XcdBarrier { unsigned* bar; unsigned x; volatile LAS unsigned* st; };
__device__ __forceinline__ XcdBarrier xcd_barrier_post(unsigned* bar, volatile LAS unsigned* st) {
    XcdBarrier b; b.bar = bar; b.x = xb_xcc_id(); b.st = st;
    if (threadIdx.x == 0) (void)xb_add(&bar[XB_XCNT(b.x)], 1u);
    return b;
}
__device__ __forceinline__ void xcd_barrier_complete(unsigned* bar, unsigned x, unsigned& nloc, unsigned& nx) {
    const unsigned G = gridDim.x * gridDim.y * gridDim.z;
    unsigned sum, cnt, mine, sp = 0u;
    for (;;) {
        sum = 0u; cnt = 0u; mine = 0u;
#pragma unroll
        for (unsigned j = 0; j < 16; ++j) { const unsigned c = xb_ld(&bar[XB_XCNT(j)]); sum += c; cnt += (c > 0u) ? 1u : 0u; mine = (j == x) ? c : mine; }
        if (sum == G) break;
        __builtin_amdgcn_s_sleep(1);
        if ((++sp & 255u) == 0u) { if (xb_ld(&bar[XB_TMO])) break; if (sp > XB_SPIN_CAP) { atomicAdd(&bar[XB_TMO], 1u); break; } }
    }
    nloc = mine > 0u ? mine : 1u; nx = cnt > 0u ? cnt : 1u;
}
__device__ __forceinline__ void xcd_barrier(const XcdBarrier& b) {
    asm volatile("s_waitcnt vmcnt(0)" ::: "memory");
    __syncthreads();
    if (threadIdx.x == 0) {
        unsigned* bar = b.bar;
        __builtin_amdgcn_s_waitcnt(0);
        unsigned nloc = b.st[0], nx = b.st[1];
        if (nloc == 0u) { xcd_barrier_complete(bar, b.x, nloc, nx); b.st[0] = nloc; b.st[1] = nx; }
        const unsigned old = xb_add(&bar[XB_XSUB(b.x)], 1u);
        const unsigned gen = old / nloc;
        if (old + 1u == (gen + 1u) * nloc) {
            __builtin_amdgcn_fence(__ATOMIC_RELEASE, "agent");
            asm volatile("s_waitcnt vmcnt(0)" ::: "memory");
            const unsigned og = xb_add(&bar[XB_TOP], 1u);
            const unsigned tg = og / nx;
            if (og + 1u == (tg + 1u) * nx) xb_add(&bar[XB_TOPGEN], 1u);
            else XB_SPIN(xb_ld(&bar[XB_TOPGEN]) == tg, bar);
            __builtin_amdgcn_fence(__ATOMIC_ACQUIRE, "agent");
            xb_add(&bar[XB_XGEN(b.x)], 1u);
            asm volatile("s_waitcnt vmcnt(0)" ::: "memory");
        } else {
            XB_SPIN(xb_ld(&bar[XB_XGEN(b.x)]) == gen, bar);
            __builtin_amdgcn_fence(__ATOMIC_ACQUIRE, "agent");
            asm volatile("s_waitcnt vmcnt(0)" ::: "memory");
        }
    }
    __syncthreads();
}

namespace pg8 {
constexpr int BM = 256, BK = 64, HALF = 128, HTB = HALF * BK * 2, STAGE_BYTES = 8 * HTB, NXCD = 8, WGM = 8;
__device__ __forceinline__ int lds_byte(int r, int c) { const int st = (r >> 4) * 2 + (c >> 5), rr = r & 15, cc = c & 31, ob = rr * 64 + cc * 2; return st * 1024 + (ob ^ (((ob >> 9) & 1) << 5)); }
__device__ __forceinline__ void stage_rc(int b, int& R, int& C) { const int st = b / 1024, sb = b % 1024, swz = sb ^ (((sb >> 9) & 1) << 5); R = (st >> 1) * 16 + swz / 64; C = (st & 1) * 32 + (swz % 64) / 2; }
__device__ __forceinline__ int brow(int R) { return 64 * (R >> 5) + 16 * ((R & 15) >> 2) + 4 * ((R >> 4) & 1) + (R & 3); }
__device__ __forceinline__ int brow1(int R) { return 64 * (R >> 5) + 8 * ((R & 15) >> 2) + 4 * ((R >> 4) & 1) + (R & 3); }

struct Unit { int pm, pn, e; };

__device__ __forceinline__ bool order_next(int i, int G, int c, int nM, int nN, int& pm, int& pn) {
    const int nwg = nM * nN; const long L = (long)i * G + c; if (L >= nwg) return false;
    int wgid = (int)L; { const int q = nwg / NXCD, r = nwg % NXCD, xcd = wgid % NXCD, off = wgid / NXCD; wgid = (xcd < r ? xcd * (q + 1) : r * (q + 1) + (xcd - r) * q) + off; }
    const int nig = WGM * nN, gid = wgid / nig, fm = gid * WGM, gsz = (nM - fm) < WGM ? (nM - fm) : WGM;
    pm = fm + ((wgid % nig) % gsz); pn = (wgid % nig) / gsz; return true;
}

struct DenseSched {
    static constexpr bool GATHER = false;
    int nM, nN, G, c, KB; const char* Bt;
    __device__ __forceinline__ bool next(int i, Unit& u) const { u.e = 0; return order_next(i, G, c, nM, nN, u.pm, u.pn); }
    __device__ __forceinline__ const char* bbase(const Unit& u) const { return Bt + (size_t)u.pn * BM * KB; }
    __device__ __forceinline__ const char* abase(const char* A, const Unit& u) const { return A + (size_t)u.pm * BM * KB; }
    __device__ __forceinline__ void aoffs(int ui, const Unit& u, int tid, unsigned (&ao)[2][2]) const {}
};
struct DenseSchedG {
    static constexpr bool GATHER = true;
    int nM, nN, G, c, KB; const char* Bt;
    __device__ __forceinline__ bool next(int i, Unit& u) const { u.e = 0; return order_next(i, G, c, nM, nN, u.pm, u.pn); }
    __device__ __forceinline__ const char* bbase(const Unit& u) const { return Bt + (size_t)u.pn * BM * KB; }
    __device__ __forceinline__ const char* abase(const char* A, const Unit& u) const { return A; }
    __device__ __forceinline__ void aoffs(int ui, const Unit& u, int tid, unsigned (&ao)[2][2]) const {
        asm volatile("" : "+v"(tid));
#pragma unroll
        for (int i = 0; i < 2; ++i) { int R, C; stage_rc(tid * 16 + i * 8192, R, C);
#pragma unroll
            for (int h = 0; h < 2; ++h) ao[h][i] = (unsigned)(u.pm * BM + h * HALF + R) * (unsigned)KB + (unsigned)C * 2u; }
    }
};
template <int MODE> struct GroupSched {
    static constexpr bool GATHER = true;
    int nM, nN, G, c, KB, pn0; const char* Bt; size_t estride; const LAS int* te; const LAS unsigned* rt;
    __device__ __forceinline__ bool next(int i, Unit& u) const { if (!order_next(i, G, c, nM, nN, u.pm, u.pn)) return false; u.e = __builtin_amdgcn_readfirstlane(te[u.pm]); return true; }
    __device__ __forceinline__ const char* bbase(const Unit& u) const { return Bt + (size_t)u.e * estride + (size_t)(pn0 + u.pn) * BM * KB; }
    __device__ __forceinline__ void aoffs(int ui, const Unit& u, int tid, unsigned (&ao)[2][2]) const {
        asm volatile("" : "+v"(tid));
#pragma unroll
        for (int i = 0; i < 2; ++i) { int R, C; stage_rc(tid * 16 + i * 8192, R, C);
#pragma unroll
            for (int h = 0; h < 2; ++h) { if (MODE == 1) ao[h][i] = rt[ui * 256 + h * HALF + R] + (unsigned)C * 2u; else ao[h][i] = (unsigned)(u.pm * BM + h * HALF + R) * (unsigned)KB + (unsigned)C * 2u; } }
    }
    __device__ __forceinline__ const char* abase(const char* A, const Unit& u) const { return A; }
};

__device__ __forceinline__ unsigned cvt_pk_bf16(float lo, float hi) { unsigned r; asm volatile("v_cvt_pk_bf16_f32 %0, %1, %2" : "=v"(r) : "v"(lo), "v"(hi)); return r; }

typedef int v8i __attribute__((ext_vector_type(8)));
typedef int v4i __attribute__((ext_vector_type(4)));
union Frag { v8i v; struct { v4i lo, hi; }; };
template <bool F8, int LAY, class Epi, class Sched>
__device__ __forceinline__ void gemm_phase(const int tid, LAS unsigned char* lds, const char* Abase, const int KB, const Sched& S, const Epi& E, const int sw = 0x7f7f7f7f, const int sa = 0x7f7f7f7f) {
    LAS unsigned char* const ept = lds + (EPT_OFF - RING_OFF);
    const int wid = __builtin_amdgcn_readfirstlane(tid >> 6), lane = tid & 63, wr = wid >> 2, wc = wid & 3, fr = lane & 15, fq = lane >> 4;
    const int nt = KB / 128;
    constexpr bool GA = Sched::GATHER;
    unsigned voffB[2], voffA[2];
#pragma unroll
    for (int i = 0; i < 2; ++i) { int R, C; stage_rc(tid * 16 + i * 8192, R, C); const int Rb = LAY ? brow1(R) : brow(R); voffB[i] = (unsigned)Rb * (unsigned)KB + (unsigned)C * 2u; voffA[i] = (unsigned)R * (unsigned)KB + (unsigned)C * 2u; }
    const size_t kstep = (size_t)(BK * 2);
    const size_t hstep = (size_t)HALF * KB;
    const size_t hstepB = (size_t)(LAY ? 32 : 8) * KB;
    const unsigned ldsw = (unsigned)wid * 1024u;
    const int aoff = lds_byte(wr * 64 + fr, fq * 8), boff = lds_byte(wc * 32 + fr, fq * 8);
#define PG8_SA(b, h) (((b) * 2 + (h)) * HTB)
#define PG8_SB(b, h) ((4 + (b) * 2 + (h)) * HTB)
#define PG8_STAGE(bufoff, gbase, voff) do { _Pragma("unroll") for (int _i = 0; _i < 2; ++_i) \
        __builtin_amdgcn_global_load_lds((const unsigned*)((const char*)(gbase) + (voff)[_i]), (LAS unsigned*)(lds + (bufoff) + ldsw + _i * 8192), 16, 0, 0); } while (0)
#define PG8_STAGEA(bufoff, gbase, half) do { if constexpr (GA) { PG8_STAGE(bufoff, gbase, ca[half]); } else { PG8_STAGE(bufoff, (gbase) + (half) * hstep, voffA); } } while (0)
#define PG8_LD1(dst, off) do { const v4i _lo = *(const LAS v4i*)(lds + (off)), _hi = *(const LAS v4i*)(lds + (off) + 1024); dst.lo = _lo; dst.hi = _hi; } while (0)
#define PG8_LDA(dst, b, h) do { _Pragma("unroll") for (int m = 0; m < 4; ++m) PG8_LD1(dst[m], PG8_SA(b, h) + aoff + m * 2048); } while (0)
#define PG8_LDB(dst, b, h) do { _Pragma("unroll") for (int n = 0; n < 2; ++n) PG8_LD1(dst[n], PG8_SB(b, h) + boff + n * 2048); } while (0)
#define PG8_MMA(ai, bj, At, Bt) do { __builtin_amdgcn_s_setprio(1); _Pragma("unroll") for (int m = 0; m < 4; ++m) _Pragma("unroll") for (int n = 0; n < 2; ++n) { \
        if constexpr (F8) { acc[ai][bj][m][n] = __builtin_amdgcn_mfma_scale_f32_16x16x128_f8f6f4(Bt[n].v, At[m].v, acc[ai][bj][m][n], 0, 0, 0, sw, 0, sa); } \
        else { acc[ai][bj][m][n] = __builtin_amdgcn_mfma_f32_16x16x32_bf16(__builtin_bit_cast(bf16x8, Bt[n].lo), __builtin_bit_cast(bf16x8, At[m].lo), acc[ai][bj][m][n], 0, 0, 0); \
               acc[ai][bj][m][n] = __builtin_amdgcn_mfma_f32_16x16x32_bf16(__builtin_bit_cast(bf16x8, Bt[n].hi), __builtin_bit_cast(bf16x8, At[m].hi), acc[ai][bj][m][n], 0, 0, 0); } } \
        __builtin_amdgcn_s_setprio(0); } while (0)
#define PG8_WAIT_V(n) asm volatile("s_waitcnt vmcnt(" #n ")" ::: "memory")
#define PG8_WAIT_L(n) asm volatile("s_waitcnt lgkmcnt(" #n ")" ::: "memory")
#define PG8_BAR __builtin_amdgcn_s_barrier()
#define PG8_SCHED __builtin_amdgcn_sched_barrier(0)
    Unit cur, nxt; int ui = 0;
    if (!S.next(0, cur)) return;
    f32x4 acc[2][2][4][2];
#pragma unroll
    for (int a = 0; a < 2; ++a)
#pragma unroll
        for (int b = 0; b < 2; ++b)
#pragma unroll
            for (int m = 0; m < 4; ++m)
#pragma unroll
                for (int n = 0; n < 2; ++n) acc[a][b][m][n] = (f32x4){0.f, 0.f, 0.f, 0.f};
    Frag At[4], B0[2], B1[2];
    unsigned ca[2][2], na[2][2];
    if constexpr (GA) S.aoffs(0, cur, tid, ca);
    const char* cB = S.bbase(cur); const char* cA = S.abase(Abase, cur);
    PG8_STAGE(PG8_SB(0, 0), cB, voffB); PG8_STAGEA(PG8_SA(0, 0), cA, 0); PG8_STAGE(PG8_SB(0, 1), cB + hstepB, voffB); PG8_STAGEA(PG8_SA(0, 1), cA, 1);
    if (wr == 1) PG8_BAR;
    PG8_WAIT_V(4); PG8_BAR;
    PG8_STAGE(PG8_SB(1, 0), cB + kstep, voffB); PG8_STAGEA(PG8_SA(1, 0), cA + kstep, 0); PG8_STAGE(PG8_SB(1, 1), cB + hstepB + kstep, voffB);
    PG8_WAIT_V(6); PG8_BAR;
    for (;;) {
        const bool has_next = S.next(ui + 1, nxt);
        const char* nB = has_next ? S.bbase(nxt) : cB; const char* nA = has_next ? S.abase(Abase, nxt) : cA;
        if constexpr (GA) {
            if (has_next) S.aoffs(ui + 1, nxt, tid, na);
            else {
#pragma unroll
                for (int h = 0; h < 2; ++h)
#pragma unroll
                    for (int i = 0; i < 2; ++i) na[h][i] = ca[h][i];
            }
        }
#pragma nounroll
        for (int t = 0; t < nt; t += 2) {
            const bool last = (t == nt - 2);
            const char* a1 = cA + (size_t)(t + 1) * kstep;
            const char* a2 = last ? nA : cA + (size_t)(t + 2) * kstep; const char* b2 = last ? nB : cB + (size_t)(t + 2) * kstep;
            const char* a3 = a2 + kstep; const char* b3 = b2 + kstep;
            if (t == 0 && wid == 0) { int tz = tid; asm volatile("" : "+v"(tz)); E.prefetch(cur, ept + (ui & 1) * 2048, tz & 63); }
            PG8_LDB(B0, 0, 0); PG8_SCHED; PG8_LDA(At, 0, 0); PG8_STAGEA(PG8_SA(1, 1), a1, 1);
            PG8_WAIT_L(8); PG8_BAR; PG8_WAIT_L(0); PG8_MMA(0, 0, At, B0); PG8_BAR; PG8_SCHED;
            if constexpr (GA) { if (last) {
#pragma unroll
                for (int h = 0; h < 2; ++h)
#pragma unroll
                    for (int i = 0; i < 2; ++i) ca[h][i] = na[h][i];
            } }
            PG8_LDB(B1, 0, 1); PG8_STAGE(PG8_SB(0, 0), b2, voffB);
            PG8_BAR; PG8_WAIT_L(0); PG8_MMA(0, 1, At, B1); PG8_BAR;
            PG8_LDA(At, 0, 1); PG8_STAGEA(PG8_SA(0, 0), a2, 0);
            PG8_BAR; PG8_WAIT_L(0); PG8_MMA(1, 0, At, B0); PG8_BAR; PG8_SCHED;
            PG8_STAGE(PG8_SB(0, 1), b2 + hstepB, voffB);
            PG8_WAIT_V(6); PG8_BAR; PG8_MMA(1, 1, At, B1); PG8_BAR;
            PG8_LDB(B0, 1, 0); PG8_SCHED; PG8_LDA(At, 1, 0); PG8_STAGEA(PG8_SA(0, 1), a2, 1);
            PG8_WAIT_L(8); PG8_BAR; PG8_WAIT_L(0); PG8_MMA(0, 0, At, B0); PG8_BAR; PG8_SCHED;
            PG8_LDB(B1, 1, 1); PG8_STAGE(PG8_SB(1, 0), b3, voffB);
            PG8_BAR; PG8_WAIT_L(0); PG8_MMA(0, 1, At, B1); PG8_BAR;
            PG8_LDA(At, 1, 1); PG8_STAGEA(PG8_SA(1, 0), a3, 0);
            PG8_BAR; PG8_WAIT_L(0); PG8_MMA(1, 0, At, B0); PG8_BAR; PG8_SCHED;
            PG8_STAGE(PG8_SB(1, 1), b3 + hstepB, voffB);
            PG8_WAIT_V(6); PG8_BAR; PG8_MMA(1, 1, At, B1); PG8_BAR;
        }
        { int tz = tid; asm volatile("" : "+v"(tz)); const int l2 = tz & 63; E(acc, cur, wr, wc, l2 & 15, l2 >> 4, ept + (ui & 1) * 2048); }
        if (!has_next) break;
#pragma unroll
        for (int a = 0; a < 2; ++a)
#pragma unroll
            for (int b = 0; b < 2; ++b)
#pragma unroll
                for (int m = 0; m < 4; ++m)
#pragma unroll
                    for (int n = 0; n < 2; ++n) acc[a][b][m][n] = (f32x4){0.f, 0.f, 0.f, 0.f};
        cur = nxt; cB = nB; cA = nA; ++ui;
    }
    PG8_WAIT_V(0);
    if (wr == 0) PG8_BAR;
    PG8_BAR;
#undef PG8_SA
#undef PG8_SB
#undef PG8_STAGE
#undef PG8_STAGEA
#undef PG8_LD1
#undef PG8_LDA
#undef PG8_LDB
#undef PG8_MMA
#undef PG8_WAIT_V
#undef PG8_WAIT_L
#undef PG8_BAR
#undef PG8_SCHED
}

__device__ __forceinline__ unsigned cvt4_fp8(float a, float b, float c, float d) { int w = 0; w = __builtin_amdgcn_cvt_pk_fp8_f32(a, b, w, false); w = __builtin_amdgcn_cvt_pk_fp8_f32(c, d, w, true); return (unsigned)w; }
__device__ __forceinline__ v4u pack8_bf16(const f32x4 a, const f32x4 b) { v4u w; w.x = cvt_pk_bf16(a[0], a[1]); w.y = cvt_pk_bf16(a[2], a[3]); w.z = cvt_pk_bf16(b[0], b[1]); w.w = cvt_pk_bf16(b[2], b[3]); return w; }
__device__ __forceinline__ void unpack8(const v4u w, f32x4& a, f32x4& b) { a = (f32x4){bflo(w[0]), bfhi(w[0]), bflo(w[1]), bfhi(w[1])}; b = (f32x4){bflo(w[2]), bfhi(w[2]), bflo(w[3]), bfhi(w[3])}; }
struct EpiBf16Scale {
    bf16* O; int ldc; const float* rs;
    __device__ __forceinline__ void prefetch(const Unit& u, LAS unsigned char* tab, int lane) const {
        if (rs) __builtin_amdgcn_global_load_lds((const unsigned*)(rs + u.pm * BM + 4 * lane), (LAS unsigned*)tab, 16, 0, 0);
    }
    __device__ __forceinline__ void operator()(const f32x4 (&acc)[2][2][4][2], const Unit& u, int wr, int wc, int fr, int fq, const LAS unsigned char* tab) const {
        const int row0 = u.pm * BM + wr * 64 + fr, col0 = u.pn * BM + wc * 64 + 8 * fq;
        float sc[8];
#pragma unroll
        for (int q = 0; q < 8; ++q) sc[q] = rs ? ((const LAS float*)tab)[wr * 64 + fr + (q >> 2) * HALF + (q & 3) * 16] : 1.f;
#pragma unroll
        for (int ai = 0; ai < 2; ++ai)
#pragma unroll
            for (int m = 0; m < 4; ++m) { const int row = row0 + ai * HALF + m * 16; const float s = sc[ai * 4 + m]; bf16* rowp = O + (size_t)row * ldc + col0;
#pragma unroll
                for (int bj = 0; bj < 2; ++bj) *(v4u*)(rowp + 32 * bj) = pack8_bf16(acc[ai][bj][m][0] * s, acc[ai][bj][m][1] * s); }
    }
};
struct EpiF8x16 {
    unsigned char* O8; int ldc;
    __device__ __forceinline__ void prefetch(const Unit&, LAS unsigned char*, int) const {}
    __device__ __forceinline__ void operator()(const f32x4 (&acc)[2][2][4][2], const Unit& u, int wr, int wc, int fr, int fq, const LAS unsigned char*) const {
        const int row0 = u.pm * BM + wr * 64 + fr, col0 = u.pn * BM + wc * 64 + 8 * fq;
#pragma unroll
        for (int ai = 0; ai < 2; ++ai)
#pragma unroll
            for (int m = 0; m < 4; ++m) { unsigned char* rowp = O8 + (size_t)(row0 + ai * HALF + m * 16) * ldc + col0;
#pragma unroll
                for (int bj = 0; bj < 2; ++bj) { const f32x4 v0 = acc[ai][bj][m][0] * 16.f, v1 = acc[ai][bj][m][1] * 16.f;
                    v2u w; w.x = cvt4_fp8(v0[0], v0[1], v0[2], v0[3]); w.y = cvt4_fp8(v1[0], v1[1], v1[2], v1[3]);
                    *(v2u*)(rowp + 32 * bj) = w; } }
    }
};
struct EpiProj {
    bf16* O; bf16* QKV; const float* rs;
    __device__ __forceinline__ void prefetch(const Unit& u, LAS unsigned char* tab, int lane) const {
        __builtin_amdgcn_global_load_lds((const unsigned*)(rs + u.pm * BM + 4 * lane), (LAS unsigned*)tab, 16, 0, 0);
    }
    __device__ __forceinline__ void operator()(const f32x4 (&acc)[2][2][4][2], const Unit& u, int wr, int wc, int fr, int fq, const LAS unsigned char* tab) const {
        const int row0 = u.pm * BM + wr * 64 + fr;
        float sc[8];
#pragma unroll
        for (int q = 0; q < 8; ++q) sc[q] = ((const LAS float*)tab)[wr * 64 + fr + (q >> 2) * HALF + (q & 3) * 16];
        const bool conv = u.pn < PCW / BM;
        const int cp = (conv ? u.pn : (u.pn - PCW / BM) & 3) * BM + wc * 64 + 8 * fq;
        const int part = (u.pn - PCW / BM) >> 2, h = cp >> 7, d = cp & 127;
#pragma unroll
        for (int ai = 0; ai < 2; ++ai)
#pragma unroll
            for (int m = 0; m < 4; ++m) { const int row = row0 + ai * HALF + m * 16; const float s = sc[ai * 4 + m];
                bf16* rowp = conv ? O + (size_t)row * PCW + cp : QKV + ((((size_t)part * NB + (row >> 12)) * NH + h) * SEQ + (row & (SEQ - 1))) * HD + d;
#pragma unroll
                for (int bj = 0; bj < 2; ++bj) *(v4u*)(rowp + 32 * bj) = pack8_bf16(acc[ai][bj][m][0] * s, acc[ai][bj][m][1] * s); }
    }
};
struct EpiResF32 {
    bf16* O; const bf16* X; int ldc; unsigned char* O8; float* ssq1;
    __device__ __forceinline__ void prefetch(const Unit&, LAS unsigned char*, int) const {}
    __device__ __forceinline__ void operator()(const f32x4 (&acc)[2][2][4][2], const Unit& u, int wr, int wc, int fr, int fq, const LAS unsigned char*) const {
        const int row0 = u.pm * BM + wr * 64 + fr, col0 = u.pn * BM + wc * 64 + 8 * fq;
#pragma unroll
        for (int ai = 0; ai < 2; ++ai) {
            v4u xw[4][2];
#pragma unroll
            for (int m = 0; m < 4; ++m)
#pragma unroll
                for (int bj = 0; bj < 2; ++bj) xw[m][bj] = *(const v4u*)(X + (size_t)(row0 + ai * HALF + m * 16) * ldc + col0 + 32 * bj);
#pragma unroll
            for (int m = 0; m < 4; ++m) { const int row = row0 + ai * HALF + m * 16; const size_t ro = (size_t)row * ldc + col0; float ss = 0.f;
#pragma unroll
                for (int bj = 0; bj < 2; ++bj) { f32x4 x0, x1; unpack8(xw[m][bj], x0, x1);
                    const f32x4 v0 = acc[ai][bj][m][0] + x0, v1 = acc[ai][bj][m][1] + x1;
#pragma unroll
                    for (int j = 0; j < 4; ++j) ss += v0[j] * v0[j] + v1[j] * v1[j];
                    v2u w8; w8.x = cvt4_fp8(v0[0], v0[1], v0[2], v0[3]); w8.y = cvt4_fp8(v1[0], v1[1], v1[2], v1[3]);
                    *(v2u*)(O8 + ro + 32 * bj) = w8; }
                ss += __shfl_xor(ss, 16); ss += __shfl_xor(ss, 32);
                if (fq == 0) ssq1[(size_t)(u.pn * 4 + wc) * T + row] = ss; }
        }
    }
};
struct EpiGateUp {
    unsigned char* Hp; const float* rr;
    __device__ __forceinline__ void prefetch(const Unit& u, LAS unsigned char* tab, int lane) const {
        __builtin_amdgcn_global_load_lds((const unsigned*)(rr + u.pm * BM + 4 * lane), (LAS unsigned*)tab, 16, 0, 0);
    }
    __device__ __forceinline__ void operator()(const f32x4 (&acc)[2][2][4][2], const Unit& u, int wr, int wc, int fr, int fq, const LAS unsigned char* tab) const {
        const int row0 = u.pm * BM + wr * 64 + fr, col0 = u.pn * HALF + wc * 32 + 8 * fq;
        float sc[8];
#pragma unroll
        for (int q = 0; q < 8; ++q) sc[q] = ((const LAS float*)tab)[wr * 64 + fr + (q >> 2) * HALF + (q & 3) * 16];
#pragma unroll
        for (int ai = 0; ai < 2; ++ai)
#pragma unroll
            for (int m = 0; m < 4; ++m) { const int row = row0 + ai * HALF + m * 16; const float s = sc[ai * 4 + m];
                const float sn = s * -1.4426950409f, is2 = __builtin_amdgcn_rcpf(s * s);
                float h[8];
#pragma unroll
                for (int n = 0; n < 2; ++n)
#pragma unroll
                    for (int j = 0; j < 4; ++j) { const float ag = acc[ai][0][m][n][j], au = acc[ai][1][m][n][j];
                        h[n * 4 + j] = (ag * au) * __builtin_amdgcn_rcpf(__builtin_fmaf(__builtin_amdgcn_exp2f(ag * sn), is2, is2)); }
                v2u w; w.x = cvt4_fp8(h[0], h[1], h[2], h[3]); w.y = cvt4_fp8(h[4], h[5], h[6], h[7]);
                *(v2u*)(Hp + (size_t)row * ED + col0) = w; }
    }
};
struct EpiDown {
    unsigned char* S0; unsigned char* S1; unsigned char* S8; const float* rw; const int* rdst;
    __device__ __forceinline__ void prefetch(const Unit& u, LAS unsigned char* tab, int lane) const {
        __builtin_amdgcn_global_load_lds((const unsigned*)(rw + u.pm * BM + 4 * lane), (LAS unsigned*)tab, 16, 0, 0);
        __builtin_amdgcn_global_load_lds((const unsigned*)(rdst + u.pm * BM + 4 * lane), (LAS unsigned*)(tab + 1024), 16, 0, 0);
    }
    __device__ __forceinline__ void operator()(const f32x4 (&acc)[2][2][4][2], const Unit& u, int wr, int wc, int fr, int fq, const LAS unsigned char* tab) const {
        const int row0 = u.pm * BM + wr * 64 + fr, col0 = u.pn * BM + wc * 64 + 16 * fq;
        float sc[8]; int ds[8];
#pragma unroll
        for (int q = 0; q < 8; ++q) { const int lr = wr * 64 + fr + (q >> 2) * HALF + (q & 3) * 16; sc[q] = ((const LAS float*)tab)[lr]; ds[q] = ((const LAS int*)(tab + 1024))[lr]; }
#pragma unroll
        for (int ai = 0; ai < 2; ++ai)
#pragma unroll
            for (int m = 0; m < 4; ++m) { const float s = sc[ai * 4 + m] * SLOT_SCALE; const int dst = ds[ai * 4 + m];
                if (dst >= 0) { unsigned char* rowp = (dst < 4 * T ? S0 + (size_t)dst * D : dst < 8 * T ? S1 + (size_t)(dst - 4 * T) * D : S8 + (size_t)(dst - 8 * T) * D) + col0;
                    v4u w;
#pragma unroll
                    for (int bj = 0; bj < 2; ++bj) { const f32x4 v0 = acc[ai][bj][m][0] * s, v1 = acc[ai][bj][m][1] * s;
                        w[2 * bj] = cvt4_fp8(v0[0], v0[1], v0[2], v0[3]); w[2 * bj + 1] = cvt4_fp8(v1[0], v1[1], v1[2], v1[3]); }
                    *(v4u*)rowp = w; } }
    }
};
struct EpiPle {
    unsigned char* H3; const unsigned char* H2; const unsigned char* PP; const float* ssq2; float* ssq3;
    __device__ __forceinline__ void prefetch(const Unit&, LAS unsigned char*, int) const {}
    __device__ __forceinline__ void operator()(const f32x4 (&acc)[2][2][4][2], const Unit& u, int wr, int wc, int fr, int fq, const LAS unsigned char*) const {
        const int row0 = u.pm * BM + wr * 64 + fr, col0 = u.pn * BM + wc * 64 + 8 * fq;
        float sq[8];
#pragma unroll
        for (int q = 0; q < 8; ++q) sq[q] = ssq2[row0 + (q >> 2) * HALF + (q & 3) * 16];
#pragma unroll
        for (int ai = 0; ai < 2; ++ai)
#pragma unroll
            for (int mp = 0; mp < 2; ++mp) {
                v2u hw[2][2]; v2u pw[2][2];
#pragma unroll
                for (int mm = 0; mm < 2; ++mm)
#pragma unroll
                    for (int bj = 0; bj < 2; ++bj) { const size_t o = (size_t)(row0 + ai * HALF + (2 * mp + mm) * 16) * D + col0 + 32 * bj; hw[mm][bj] = *(const v2u*)(H2 + o); pw[mm][bj] = *(const v2u*)(PP + o); }
#pragma unroll
                for (int mm = 0; mm < 2; ++mm) { const int m = 2 * mp + mm, row = row0 + ai * HALF + m * 16;
                    const float rn = __builtin_amdgcn_rsqf(sq[ai * 4 + m] * (1.f / D) + EPS) * -1.4426950409f;
                    const size_t ro = (size_t)row * D + col0; float ss = 0.f;
#pragma unroll
                    for (int bj = 0; bj < 2; ++bj) { f32x4 h0, h1, p0, p1;
                        { const f32x2 a = __builtin_amdgcn_cvt_pk_f32_fp8((int)hw[mm][bj].x, false), b = __builtin_amdgcn_cvt_pk_f32_fp8((int)hw[mm][bj].x, true),
                                      c = __builtin_amdgcn_cvt_pk_f32_fp8((int)hw[mm][bj].y, false), d = __builtin_amdgcn_cvt_pk_f32_fp8((int)hw[mm][bj].y, true);
                          h0 = (f32x4){a.x, a.y, b.x, b.y}; h1 = (f32x4){c.x, c.y, d.x, d.y}; }
                        { const f32x2 a = __builtin_amdgcn_cvt_pk_f32_fp8((int)pw[mm][bj].x, false), b = __builtin_amdgcn_cvt_pk_f32_fp8((int)pw[mm][bj].x, true),
                                      c = __builtin_amdgcn_cvt_pk_f32_fp8((int)pw[mm][bj].y, false), d = __builtin_amdgcn_cvt_pk_f32_fp8((int)pw[mm][bj].y, true);
                          p0 = (f32x4){a.x, a.y, b.x, b.y}; p1 = (f32x4){c.x, c.y, d.x, d.y}; }
                        f32x4 o0, o1;
#pragma unroll
                        for (int j = 0; j < 4; ++j) {
                            o0[j] = h0[j] + p0[j] * __builtin_amdgcn_rcpf(__builtin_fmaf(__builtin_amdgcn_exp2f(acc[ai][bj][m][0][j] * rn), 16.f, 16.f));
                            o1[j] = h1[j] + p1[j] * __builtin_amdgcn_rcpf(__builtin_fmaf(__builtin_amdgcn_exp2f(acc[ai][bj][m][1][j] * rn), 16.f, 16.f));
                            ss += o0[j] * o0[j] + o1[j] * o1[j]; }
                        v2u w8; w8.x = cvt4_fp8(o0[0], o0[1], o0[2], o0[3]); w8.y = cvt4_fp8(o1[0], o1[1], o1[2], o1[3]);
                        *(v2u*)(H3 + ro + 32 * bj) = w8; }
                    ss += __shfl_xor(ss, 16); ss += __shfl_xor(ss, 32);
                    if (fq == 0) ssq3[(size_t)(u.pn * 4 + wc) * T + row] = ss; }
            }
    }
};
}

struct Frame {
    LAS unsigned char* lds;
    int tid, lane, wave, G, bx;
    unsigned char* ws;
    const float* in[21];
    float* out;
};
enum { I_X = 0, I_P, I_NMIX, I_WIN, I_CONVW, I_GCONV, I_GSB, I_WOUT, I_NFFN, I_WR, I_RB, I_WEG, I_WEU, I_WED, I_WSG, I_WSU, I_WSD, I_NPLE, I_WPG, I_WPP, I_NFIN };

__device__ __forceinline__ void p0_transpose_item(const float* W, int N, bf16* WT, int ldk, int k0, int n0, int row_off, const float* g64, LAS float* scr, int lane) {
    const int n4 = lane & 15, kr = lane >> 4;
    f32x4 v[16];
    const float* src = W + (size_t)(k0 + kr) * N + n0 + 4 * n4;
#pragma unroll
    for (int i = 0; i < 16; ++i) v[i] = *(const GAS f32x4*)(src + (size_t)(4 * i) * N);
    const int c = lane >> 3, nn = lane & 7;
    f32x4 ga = (f32x4){1.f, 1.f, 1.f, 1.f}, gb = ga;
    if (g64) { ga = *(const GAS f32x4*)(g64 + 8 * c); gb = *(const GAS f32x4*)(g64 + 8 * c + 4); }
#pragma unroll
    for (int i = 0; i < 16; ++i) { LAS float* d = scr + (4 * i + kr) * 65 + 4 * n4; d[0] = v[i].x; d[1] = v[i].y; d[2] = v[i].z; d[3] = v[i].w; }
    LDS_WAIT(); asm volatile("" ::: "memory");
#pragma unroll
    for (int j = 0; j < 8; ++j) { const int n = nn + 8 * j; const LAS float* s = scr + (8 * c) * 65 + n;
        v4u o; o.x = pg8::cvt_pk_bf16(s[0] * ga.x, s[65] * ga.y); o.y = pg8::cvt_pk_bf16(s[130] * ga.z, s[195] * ga.w); o.z = pg8::cvt_pk_bf16(s[260] * gb.x, s[325] * gb.y); o.w = pg8::cvt_pk_bf16(s[390] * gb.z, s[455] * gb.w);
        *(GAS v4u*)(WT + (size_t)(row_off + n) * ldk + k0 + 8 * c) = o; }
    LDS_WAIT(); asm volatile("" ::: "memory");
}
__device__ __forceinline__ void p0_transpose_item_f8(const float* W, int N, unsigned char* WT, int ldk, int k0, int n0, int row_off, int mode, const float* g64, LAS float* scr, int lane) {
    const int n4 = lane & 15, kr = lane >> 4;
    f32x4 v[16];
    const float* src = W + (size_t)(k0 + kr) * N + n0 + 4 * n4;
#pragma unroll
    for (int i = 0; i < 16; ++i) v[i] = *(const GAS f32x4*)(src + (size_t)(4 * i) * N);
    const int c = lane >> 4, nn = lane & 15;
    float g[16];
#pragma unroll
    for (int q = 0; q < 4; ++q) { f32x4 t = (f32x4){1.f, 1.f, 1.f, 1.f}; if (g64) t = *(const GAS f32x4*)(g64 + 16 * c + 4 * q); g[4 * q] = 64.f * t.x; g[4 * q + 1] = 64.f * t.y; g[4 * q + 2] = 64.f * t.z; g[4 * q + 3] = 64.f * t.w; }
#pragma unroll
    for (int i = 0; i < 16; ++i) { LAS float* d = scr + (4 * i + kr) * 65 + 4 * n4; d[0] = v[i].x; d[1] = v[i].y; d[2] = v[i].z; d[3] = v[i].w; }
    LDS_WAIT(); asm volatile("" ::: "memory");
#pragma unroll
    for (int j = 0; j < 4; ++j) { const int n = nn + 16 * j; const LAS float* s = scr + (16 * c) * 65 + n;
        v4u o;
        o.x = pg8::cvt4_fp8(s[0] * g[0], s[65] * g[1], s[130] * g[2], s[195] * g[3]); o.y = pg8::cvt4_fp8(s[260] * g[4], s[325] * g[5], s[390] * g[6], s[455] * g[7]);
        o.z = pg8::cvt4_fp8(s[520] * g[8], s[585] * g[9], s[650] * g[10], s[715] * g[11]); o.w = pg8::cvt4_fp8(s[780] * g[12], s[845] * g[13], s[910] * g[14], s[975] * g[15]);
        const int hid = n0 + n, drow = mode == 0 ? row_off + n : 16 * (hid >> 3) + 8 * (mode - 1) + (hid & 7);
        *(GAS v4u*)(WT + (size_t)drow * ldk + k0 + 16 * c) = o; }
    LDS_WAIT(); asm volatile("" ::: "memory");
}
constexpr int P0_I_WIN = (D / 64) * (NPROJ / 64), P0_I_WOUT = (D / 64) * (D / 64), P0_I_WR = (D / 64) * (NE / 64), P0_I_WPG = (D / 64) * (D / 64), P0_I_WPP = (PLE / 64) * (D / 64);
struct ExpItem { const float* src; const float* g128; unsigned char* dst; int N, ldk, k0, n0, mode; };
__device__ __forceinline__ void exp_issue(const ExpItem& I, int lane, f32x4 (&v)[32], f32x4 (&gq)[8]) {
    const int n4 = lane & 15, kr = lane >> 4;
#pragma unroll
    for (int q = 0; q < 8; ++q) { gq[q] = (f32x4){1.f, 1.f, 1.f, 1.f}; if (I.g128) gq[q] = *(const GAS f32x4*)(I.g128 + 64 * (q >> 2) + 16 * (lane >> 4) + 4 * (q & 3)); }
    const float* src = I.src + (size_t)(I.k0 + kr) * I.N + I.n0 + 4 * n4;
#pragma unroll
    for (int i = 0; i < 32; ++i) v[i] = *(const GAS f32x4*)(src + (size_t)(4 * i) * I.N);
}
template <int H> __device__ __forceinline__ void exp_finish_half(const ExpItem& I, int lane, const f32x4 (&v)[32], const f32x4 (&gq)[8], LAS float* scr) {
    const int n4 = lane & 15, kr = lane >> 4, c = lane >> 4, nn = lane & 15;
    float g[16];
#pragma unroll
    for (int q = 0; q < 4; ++q) { g[4 * q] = 64.f * gq[4 * H + q].x; g[4 * q + 1] = 64.f * gq[4 * H + q].y; g[4 * q + 2] = 64.f * gq[4 * H + q].z; g[4 * q + 3] = 64.f * gq[4 * H + q].w; }
#pragma unroll
    for (int i = 0; i < 16; ++i) { LAS float* d = scr + (4 * i + kr) * 65 + 4 * n4; d[0] = v[16 * H + i].x; d[1] = v[16 * H + i].y; d[2] = v[16 * H + i].z; d[3] = v[16 * H + i].w; }
    LDS_WAIT(); asm volatile("" ::: "memory");
#pragma unroll
    for (int j = 0; j < 4; ++j) { const int n = nn + 16 * j; const LAS float* s = scr + (16 * c) * 65 + n;
        v4u o;
        o.x = pg8::cvt4_fp8(s[0] * g[0], s[65] * g[1], s[130] * g[2], s[195] * g[3]); o.y = pg8::cvt4_fp8(s[260] * g[4], s[325] * g[5], s[390] * g[6], s[455] * g[7]);
        o.z = pg8::cvt4_fp8(s[520] * g[8], s[585] * g[9], s[650] * g[10], s[715] * g[11]); o.w = pg8::cvt4_fp8(s[780] * g[12], s[845] * g[13], s[910] * g[14], s[975] * g[15]);
        const int hid = I.n0 + n, drow = I.mode == 0 ? hid : 16 * (hid >> 3) + 8 * (I.mode - 1) + (hid & 7);
        *(GAS v4u*)(I.dst + (size_t)drow * I.ldk + I.k0 + 64 * H + 16 * c) = o; }
    LDS_WAIT(); asm volatile("" ::: "memory");
}
constexpr int P0_NONEXP = P0_I_WIN + P0_I_WOUT + P0_I_WR + P0_I_WPG + P0_I_WPP;
constexpr int P0_I_EXP = 768, P0_NITEMS = P0_I_WIN + P0_I_WOUT + P0_I_WR + P0_I_WPG + P0_I_WPP + 65 * P0_I_EXP;
__device__ __forceinline__ void p0_item(Frame& F, int it, LAS float* scr) {
    unsigned char* ws = F.ws; const int lane = F.lane;
    if (it < P0_I_WIN) { const int kb = it / (NPROJ / 64), nb = it % (NPROJ / 64); p0_transpose_item(F.in[I_WIN], NPROJ, (bf16*)(ws + WS_WIN), D, 64 * kb, 64 * nb, 64 * nb, F.in[I_NMIX] + 64 * kb, scr, lane); return; } it -= P0_I_WIN;
    if (it < P0_I_WOUT) { const int kb = it / (D / 64), nb = it % (D / 64), k0 = 64 * kb; const float* g = k0 < CW ? F.in[I_GCONV] + k0 : F.in[I_GSB] + (k0 - CW);
        p0_transpose_item_f8(F.in[I_WOUT], D, ws + WS_WOUT, D, k0, 64 * nb, 64 * nb, 0, g, scr, lane); return; } it -= P0_I_WOUT;
    if (it < P0_I_WR) return; it -= P0_I_WR;
    if (it < P0_I_WPG) { const int kb = it / (D / 64), nb = it % (D / 64); p0_transpose_item_f8(F.in[I_WPG], D, ws + WS_WPG, D, 64 * kb, 64 * nb, 64 * nb, 0, F.in[I_NPLE] + 64 * kb, scr, lane); return; } it -= P0_I_WPG;
    if (it < P0_I_WPP) { const int kb = it / (D / 64), nb = it % (D / 64); p0_transpose_item(F.in[I_WPP], D, (bf16*)(ws + WS_WPP), PLE, 64 * kb, 64 * nb, 64 * nb, nullptr, scr, lane); return; } it -= P0_I_WPP;
    const int e = it / P0_I_EXP, r = it % P0_I_EXP, sub = r / 256, q = r % 256;
    if (sub < 2) {
        const float* src = e < NE ? (sub == 0 ? F.in[I_WEG] : F.in[I_WEU]) + (size_t)e * D * ED : (sub == 0 ? F.in[I_WSG] : F.in[I_WSU]);
        const int kb = q / (ED / 64), nb = q % (ED / 64), n0 = 64 * nb;
        p0_transpose_item_f8(src, ED, ws + WS_WGU + (size_t)e * 1024 * D, D, 64 * kb, n0, 0, 1 + sub, F.in[I_NFFN] + 64 * kb, scr, lane);
    } else {
        const float* src = e < NE ? F.in[I_WED] + (size_t)e * ED * D : F.in[I_WSD];
        const int kb = q / (D / 64), nb = q % (D / 64);
        p0_transpose_item_f8(src, D, ws + WS_WDN + (size_t)e * D * ED, ED, 64 * kb, 64 * nb, 64 * nb, 0, nullptr, scr, lane);
    }
}
constexpr int EXP_ITEMS_PER = 384, EXP_ITEMS = 65 * EXP_ITEMS_PER;
__device__ __forceinline__ ExpItem exp_decode(Frame& F, int it) {
    unsigned char* ws = F.ws; ExpItem I;
    const int e = it / EXP_ITEMS_PER, r = it % EXP_ITEMS_PER, sub = r / 128, q = r % 128;
    if (sub < 2) { I.src = e < NE ? (sub == 0 ? F.in[I_WEG] : F.in[I_WEU]) + (size_t)e * D * ED : (sub == 0 ? F.in[I_WSG] : F.in[I_WSU]);
        const int kb = q / (ED / 64), nb = q % (ED / 64); I.N = ED; I.dst = ws + WS_WGU + (size_t)e * 1024 * D; I.ldk = D; I.k0 = 128 * kb; I.n0 = 64 * nb; I.mode = 1 + sub; I.g128 = F.in[I_NFFN] + 128 * kb; }
    else { I.src = e < NE ? F.in[I_WED] + (size_t)e * ED * D : F.in[I_WSD];
        const int kb = q / (D / 64), nb = q % (D / 64); I.N = D; I.dst = ws + WS_WDN + (size_t)e * D * ED; I.ldk = ED; I.k0 = 128 * kb; I.n0 = 64 * nb; I.mode = 0; I.g128 = nullptr; }
    return I;
}
__device__ __forceinline__ void p0_xpass(Frame& F) {
    const int lane = F.lane, r16 = lane & 15, g = lane >> 4, tid = F.tid;
    const float* x = F.in[I_X]; const float* wr = F.in[I_WR]; const float* gf = F.in[I_NFFN]; const float* wo = F.in[I_WOUT];
    bf16* XB = (bf16*)F.out; float* rmix = (float*)(F.ws + WS_RMIX); float* logx = (float*)(F.ws + WS_LOGX); bf16* wor = (bf16*)(F.ws + WS_WOR);
    LAS unsigned char* WL = F.lds;
    const int NGW = F.G * NWAVES;
    for (int u0 = F.bx * NWAVES; u0 < T / 16; u0 += NGW) {
        const int unit = u0 + F.wave; const bool act = unit < T / 16; const int t0 = unit * 16;
        const bool wact = act && (unit & 15) == 0; const int k0w = unit;
        f32x4 acc[4], acw[4];
#pragma unroll
        for (int nb = 0; nb < 4; ++nb) { acc[nb] = (f32x4){0.f, 0.f, 0.f, 0.f}; acw[nb] = (f32x4){0.f, 0.f, 0.f, 0.f}; }
        float ss = 0.f;
        for (int kc = 0; kc < 4; ++kc) {
            __syncthreads();
            { const int k = 512 * kc + tid; const float gk = gf[k]; const float* wp = wr + (size_t)k * NE;
#pragma unroll
              for (int q = 0; q < 16; ++q) { const f32x4 v = *(const GAS f32x4*)(wp + 4 * q);
                  *(LAS unsigned short*)(WL + (4 * q + 0) * 1040 + 2 * tid) = (unsigned short)f2bf(v.x * gk); *(LAS unsigned short*)(WL + (4 * q + 1) * 1040 + 2 * tid) = (unsigned short)f2bf(v.y * gk);
                  *(LAS unsigned short*)(WL + (4 * q + 2) * 1040 + 2 * tid) = (unsigned short)f2bf(v.z * gk); *(LAS unsigned short*)(WL + (4 * q + 3) * 1040 + 2 * tid) = (unsigned short)f2bf(v.w * gk); } }
            __syncthreads();
            if (act) {
                f32x4 xv[16][2];
                const float* xp = x + (size_t)(t0 + r16) * D + 512 * kc + 8 * g;
#pragma unroll
                for (int ks = 0; ks < 16; ++ks) { xv[ks][0] = *(const GAS f32x4*)(xp + 32 * ks); xv[ks][1] = *(const GAS f32x4*)(xp + 32 * ks + 4); }
#pragma unroll
                for (int ks = 0; ks < 16; ++ks) { const f32x4 a0 = xv[ks][0], a1 = xv[ks][1];
                    ss += (a0.x * a0.x + a0.y * a0.y) + (a0.z * a0.z + a0.w * a0.w) + (a1.x * a1.x + a1.y * a1.y) + (a1.z * a1.z + a1.w * a1.w);
                    v4u w; w.x = pg8::cvt_pk_bf16(a0.x, a0.y); w.y = pg8::cvt_pk_bf16(a0.z, a0.w); w.z = pg8::cvt_pk_bf16(a1.x, a1.y); w.w = pg8::cvt_pk_bf16(a1.z, a1.w);
                    *(GAS v4u*)(XB + (size_t)(t0 + r16) * D + 512 * kc + 32 * ks + 8 * g) = w;
                    const bf16x8 af = __builtin_bit_cast(bf16x8, w);
#pragma unroll
                    for (int nb = 0; nb < 4; ++nb) { const bf16x8 bf = *(const LAS bf16x8*)(WL + (16 * nb + r16) * 1040 + 64 * ks + 16 * g); acc[nb] = __builtin_amdgcn_mfma_f32_16x16x32_bf16(af, bf, acc[nb], 0, 0, 0); } }
            }
            if (wact) {
                const float* wp = wo + (size_t)(k0w + r16) * D + 512 * kc + 8 * g;
                f32x4 wv[16][2];
#pragma unroll
                for (int ks = 0; ks < 16; ++ks) { wv[ks][0] = *(const GAS f32x4*)(wp + 32 * ks); wv[ks][1] = *(const GAS f32x4*)(wp + 32 * ks + 4); }
#pragma unroll
                for (int ks = 0; ks < 16; ++ks) { const f32x4 a0 = wv[ks][0], a1 = wv[ks][1];
                    v4u w; w.x = pg8::cvt_pk_bf16(a0.x, a0.y); w.y = pg8::cvt_pk_bf16(a0.z, a0.w); w.z = pg8::cvt_pk_bf16(a1.x, a1.y); w.w = pg8::cvt_pk_bf16(a1.z, a1.w);
                    const bf16x8 af = __builtin_bit_cast(bf16x8, w);
#pragma unroll
                    for (int nb = 0; nb < 4; ++nb) { const bf16x8 bf = *(const LAS bf16x8*)(WL + (16 * nb + r16) * 1040 + 64 * ks + 16 * g); acw[nb] = __builtin_amdgcn_mfma_f32_16x16x32_bf16(af, bf, acw[nb], 0, 0, 0); } }
            }
        }
        if (act) {
            ss += __shfl_xor(ss, 16); ss += __shfl_xor(ss, 32);
            if (g == 0) rmix[t0 + r16] = __builtin_amdgcn_rsqf(ss * (1.f / D) + EPS);
#pragma unroll
            for (int nb = 0; nb < 4; ++nb)
#pragma unroll
                for (int j = 0; j < 4; ++j) logx[(size_t)(t0 + 4 * g + j) * NE + 16 * nb + r16] = acc[nb][j];
        }
        if (wact) {
#pragma unroll
            for (int j = 0; j < 4; ++j) { const int k = k0w + 4 * g + j; const float gk = k < CW ? F.in[I_GCONV][k] : F.in[I_GSB][k - CW];
#pragma unroll
                for (int nb = 0; nb < 4; ++nb) wor[(size_t)(16 * nb + r16) * D + k] = (bf16)f2bf(acw[nb][j] * gk); }
        }
    }
    __syncthreads();
}
__device__ __forceinline__ void p0_prologue(Frame& F) {
    LAS float* scr = (LAS float*)(F.lds + RING_OFF + F.wave * 16896);
    const int gw = F.bx * NWAVES + F.wave, NGW = F.G * NWAVES;
    p0_xpass(F);
    {
        const float* p = F.in[I_P]; bf16* PB = (bf16*)(F.ws + WS_PB);
        const int nchunk = T * PLE / 8, gt = F.bx * NTHR + F.tid, NGT = F.G * NTHR;
        for (int c0 = gt; c0 < nchunk; c0 += 8 * NGT) {
            f32x4 a[8], b[8];
#pragma unroll
            for (int i = 0; i < 8; ++i) { const int c = c0 + i * NGT, cc = c < nchunk ? c : gt; a[i] = *(const GAS f32x4*)(p + (size_t)cc * 8); b[i] = *(const GAS f32x4*)(p + (size_t)cc * 8 + 4); }
#pragma unroll
            for (int i = 0; i < 8; ++i) { const int c = c0 + i * NGT;
                if (c < nchunk) { v4u w; w.x = pk2(a[i].x, a[i].y); w.y = pk2(a[i].z, a[i].w); w.z = pk2(b[i].x, b[i].y); w.w = pk2(b[i].z, b[i].w); *(GAS v4u*)(PB + (size_t)c * 8) = w; } }
        }
    }
    for (int it = gw; it < P0_NONEXP; it += NGW) p0_item(F, it, scr);
}

__device__ __forceinline__ unsigned off_b(unsigned row, unsigned ch) { return 256u * row + 16u * (ch ^ (((row & 3) << 2) | ((row >> 2) & 3))); }
#define MFMA32(a, b, c) __builtin_amdgcn_mfma_f32_32x32x16_bf16((a), (b), (c), 0, 0, 0)

__device__ __forceinline__ void conv_item(Frame& F, int it) {
    const bf16* proj = (const bf16*)(F.ws + WS_PROJ); bf16* ymix = (bf16*)F.out + (size_t)T * D;
    const float* cw = F.in[I_CONVW]; const int lane = F.lane;
    float w0[16], w1[16], w2[16], u1[16], u2[16];
#pragma unroll
    for (int j = 0; j < 2; ++j)
#pragma unroll
        for (int i = 0; i < 8; ++i) { const int c = 512 * j + 8 * lane + i; w0[8 * j + i] = cw[c]; w1[8 * j + i] = cw[CW + c]; w2[8 * j + i] = cw[2 * CW + c]; u1[8 * j + i] = 0.f; u2[8 * j + i] = 0.f; }
    const int t0 = 16 * it; const bool seq_start = (t0 & (SEQ - 1)) == 0;
    for (int g = 0; g < 6; ++g) {
        v4u hw[3][2], cwv[3][2], bw[3][2];
#pragma unroll
        for (int q = 0; q < 3; ++q) { const long t = (long)t0 - 2 + 3 * g + q; const bf16* pr = proj + t * PCW + 8 * lane;
#pragma unroll
            for (int j = 0; j < 2; ++j) { hw[q][j] = *(const GAS v4u*)(pr + 512 * j); cwv[q][j] = *(const GAS v4u*)(pr + 2 * CW + 512 * j); bw[q][j] = *(const GAS v4u*)(pr + CW + 512 * j); } }
#pragma unroll
        for (int q = 0; q < 3; ++q) { const int tt = -2 + 3 * g + q; const long t = (long)t0 + tt;
            float u[16];
#pragma unroll
            for (int j = 0; j < 2; ++j)
#pragma unroll
                for (int k = 0; k < 4; ++k) { u[8 * j + 2 * k] = bflo(hw[q][j][k]) * bflo(cwv[q][j][k]); u[8 * j + 2 * k + 1] = bfhi(hw[q][j][k]) * bfhi(cwv[q][j][k]); }
            if (tt < 0 && seq_start) {
#pragma unroll
                for (int i = 0; i < 16; ++i) u[i] = 0.f;
            }
            if (tt >= 0) {
                float y[16], ss = 0.f;
#pragma unroll
                for (int j = 0; j < 2; ++j)
#pragma unroll
                    for (int k = 0; k < 4; ++k) { const int i = 8 * j + 2 * k;
                        y[i] = bflo(bw[q][j][k]) * (w0[i] * u2[i] + w1[i] * u1[i] + w2[i] * u[i]); y[i + 1] = bfhi(bw[q][j][k]) * (w0[i + 1] * u2[i + 1] + w1[i + 1] * u1[i + 1] + w2[i + 1] * u[i + 1]);
                        ss += y[i] * y[i] + y[i + 1] * y[i + 1]; }
                const float r = __builtin_amdgcn_rsqf(wave_sum(ss) * (1.f / CW) + EPS);
                bf16* yo = ymix + t * D + 8 * lane;
#pragma unroll
                for (int j = 0; j < 2; ++j) { v4u w; w.x = pg8::cvt_pk_bf16(y[8 * j] * r, y[8 * j + 1] * r); w.y = pg8::cvt_pk_bf16(y[8 * j + 2] * r, y[8 * j + 3] * r); w.z = pg8::cvt_pk_bf16(y[8 * j + 4] * r, y[8 * j + 5] * r); w.w = pg8::cvt_pk_bf16(y[8 * j + 6] * r, y[8 * j + 7] * r);
                    *(GAS v4u*)(yo + 512 * j) = w;
                    v2u w8; w8.x = pg8::cvt4_fp8(y[8 * j] * r, y[8 * j + 1] * r, y[8 * j + 2] * r, y[8 * j + 3] * r); w8.y = pg8::cvt4_fp8(y[8 * j + 4] * r, y[8 * j + 5] * r, y[8 * j + 6] * r, y[8 * j + 7] * r);
                    *(GAS v2u*)(F.ws + WS_YMIX8 + (size_t)t * D + 8 * lane + 512 * j) = w8; }
            }
#pragma unroll
            for (int i = 0; i < 16; ++i) { u2[i] = u1[i]; u1[i] = u[i]; }
        }
    }
}

__device__ __forceinline__ bf16x8 pack8(float a0, float a1, float a2, float a3, float a4, float a5, float a6, float a7) {
    v4u p; p.x = pg8::cvt_pk_bf16(a0, a1); p.y = pg8::cvt_pk_bf16(a2, a3); p.z = pg8::cvt_pk_bf16(a4, a5); p.w = pg8::cvt_pk_bf16(a6, a7); return __builtin_bit_cast(bf16x8, p);
}
__device__ __forceinline__ void tr_read4(unsigned a_t0, unsigned a_t1, s16x4& r00, s16x4& r01, s16x4& r10, s16x4& r11) {
    asm volatile("ds_read_b64_tr_b16 %0, %4\n\tds_read_b64_tr_b16 %1, %5\n\tds_read_b64_tr_b16 %2, %4 offset:4096\n\tds_read_b64_tr_b16 %3, %5 offset:4096\n\ts_waitcnt lgkmcnt(0)"
                 : "=&v"(r00), "=&v"(r01), "=&v"(r10), "=&v"(r11) : "v"(a_t0), "v"(a_t1) : "memory");
}
constexpr float ATT_C = 0.08838834764831845f * 1.4426950408889634f;
constexpr float ATT_EXIT = -152.f;

__device__ __forceinline__ float attn_head(Frame& F, int lw, int h, int b, int qblk, f32x16 (&oacc)[4]) {
    const int lane = F.lane, r = lane & 31, hh = lane >> 5;
    const bf16* qkv = (const bf16*)(F.ws + WS_QKV);
    const size_t hb = ((size_t)b * NH + h) * SEQ;
    const int t0 = qblk * 32;
    LAS unsigned char* kt = F.lds + lw * 16384; LAS unsigned char* vt = kt + 8192;
    bf16x8 qf[8];
    { const bf16* qp = qkv + (hb + t0 + r) * HD + 8 * hh;
#pragma unroll
      for (int kk = 0; kk < 8; ++kk) qf[kk] = *(const GAS bf16x8*)(qp + 16 * kk); }
#pragma unroll
    for (int c = 0; c < 4; ++c)
#pragma unroll
        for (int i = 0; i < 16; ++i) oacc[c][i] = 0.f;
    float L = 0.f;
    const unsigned pr = (unsigned)((r & 19) | ((r & 4) << 1) | ((r & 8) >> 1));
    const unsigned ktb = (unsigned)(size_t)kt, vtb = (unsigned)(size_t)vt;
    unsigned va[2][4];
    { const unsigned blk = (lane >> 4) & 1, q = (lane & 15) >> 2, p = lane & 3;
#pragma unroll
      for (int t = 0; t < 2; ++t)
#pragma unroll
          for (int c = 0; c < 4; ++c) va[t][c] = vtb + off_b(8 * hh + 4 * t + q, 4 * c + 2 * blk + (p >> 1)) + 8 * (p & 1); }
    unsigned loff[8];
#pragma unroll
    for (int i = 0; i < 8; ++i) { const unsigned row = 4 * i + (lane >> 4), ch = (lane & 15) ^ (((row & 3) << 2) | ((row >> 2) & 3)); loff[i] = (row * HD + ch * 8) * 2; }
    const char* kvb = (const char*)(qkv + ((size_t)NB * NH * SEQ + hb) * HD);
    constexpr size_t VOFF = (size_t)NB * NH * SEQ * HD * 2;
#define ATT_DMA(ldsb, gp) do { _Pragma("unroll") for (int _i = 0; _i < 8; ++_i) \
        __builtin_amdgcn_global_load_lds((const unsigned*)((gp) + loff[_i]), (LAS unsigned*)((ldsb) + _i * 1024), 16, 0, 0); } while (0)
    { const char* g0 = kvb + (size_t)(qblk * 32) * HD * 2; ATT_DMA(kt, g0); ATT_DMA(vt, g0 + VOFF); }
    for (int kti = qblk; kti >= 0; --kti) {
        const int s0 = kti * 32;
        const char* gn = kvb + (size_t)((kti > 0 ? kti - 1 : 0) * 32) * HD * 2;
        asm volatile("s_waitcnt vmcnt(8)" ::: "memory");
        f32x16 x;
#pragma unroll
        for (int i = 0; i < 16; ++i) x[i] = 0.f;
        bf16x8 kf[8];
#pragma unroll
        for (int kk = 0; kk < 8; ++kk) kf[kk] = *(const LAS bf16x8*)(kt + off_b(pr, 2 * kk + hh));
        LDS_WAIT();
        ATT_DMA(kt, gn);
#pragma unroll
        for (int kk = 0; kk < 8; ++kk) x = MFMA32(kf[kk], qf[kk], x);
        const bool diag = (kti == qblk);
        float zz[16], suf[16];
#pragma unroll
        for (int i = 0; i < 16; ++i) {
            zz[i] = x[i] * ATT_C;
            const float e = __builtin_amdgcn_exp2f(fminf(zz[i], 126.f));
            float l = -__builtin_amdgcn_logf(1.f + e);
            const int kap = 16 * (i >> 3) + 8 * hh + (i & 7);
            if (diag && !(kap < r)) l = 0.f;
            suf[i] = l;
        }
#pragma unroll
        for (int j = 6; j >= 0; --j) { suf[j] += suf[j + 1]; suf[8 + j] += suf[8 + j + 1]; }
        const float T0 = suf[0], T1 = suf[8];
        const float T0p = __shfl_xor(T0, 32), T1p = __shfl_xor(T1, 32);
        const float base0 = L + T1 + T1p + (hh == 0 ? T0p : 0.f), base1 = L + (hh == 0 ? T1p : 0.f);
        float a[16];
#pragma unroll
        for (int i = 0; i < 16; ++i) {
            float v = __builtin_amdgcn_exp2f(zz[i] + (i < 8 ? base0 : base1) + suf[i]);
            const int kap = 16 * (i >> 3) + 8 * hh + (i & 7);
            if (diag && !(kap < r)) v = 0.f;
            a[i] = v;
        }
        L += (T0 + T1) + (T0p + T1p);
        const bf16x8 pf0 = pack8(a[0], a[1], a[2], a[3], a[4], a[5], a[6], a[7]);
        const bf16x8 pf1 = pack8(a[8], a[9], a[10], a[11], a[12], a[13], a[14], a[15]);
        asm volatile("s_waitcnt vmcnt(8)" ::: "memory");
#pragma unroll
        for (int c = 0; c < 4; ++c) {
            s16x4 r00, r01, r10, r11; tr_read4(va[0][c], va[1][c], r00, r01, r10, r11);
            const bf16x8 vf0 = __builtin_shufflevector(r00, r01, 0, 1, 2, 3, 4, 5, 6, 7), vf1 = __builtin_shufflevector(r10, r11, 0, 1, 2, 3, 4, 5, 6, 7);
            oacc[c] = MFMA32(vf0, pf0, oacc[c]); oacc[c] = MFMA32(vf1, pf1, oacc[c]);
        }
        ATT_DMA(vt, gn + VOFF);
        if (__all(L < ATT_EXIT)) break;
    }
    VM_WAIT();
#undef ATT_DMA
    float ss = 0.f;
#pragma unroll
    for (int c = 0; c < 4; ++c)
#pragma unroll
        for (int i = 0; i < 16; ++i) ss += oacc[c][i] * oacc[c][i];
    ss += __shfl_xor(ss, 32);
    return ss;
}
constexpr int P2_BSCR_OFF = 65536, P2_XS_OFF = P2_BSCR_OFF + 4 * 16896;
static_assert(P2_XS_OFF + 2048 + 64 <= LDS_BYTES, "P2 LDS map");
__device__ __forceinline__ void p2_mixer(Frame& F) {
    const int lane = F.lane, w = F.wave, r = lane & 31, hh = lane >> 5;
    const int nunits = (NB * (SEQ / 32) - F.bx + F.G - 1) / F.G;
    if (F.tid < 8) ((volatile LAS unsigned*)(F.lds + P2_XS_OFF + 2048))[F.tid] = 0u;
    __syncthreads();
    if (w < 4) {
        bf16* ymix = (bf16*)F.out + (size_t)T * D;
        for (int j = 0; j < nunits; ++j) {
            const int u = F.bx + j * F.G, b = u % NB, qblk = u / NB;
            LAS float* XS = (LAS float*)(F.lds + P2_XS_OFF) + (j & 1) * 256;
            v2u st0[16];
            f32x16 oacc[4];
            const float ss0 = attn_head(F, w, w, b, qblk, oacc);
#pragma unroll
            for (int c = 0; c < 4; ++c)
#pragma unroll
                for (int g = 0; g < 4; ++g) { st0[c * 4 + g].x = pg8::cvt_pk_bf16(oacc[c][4 * g], oacc[c][4 * g + 1]); st0[c * 4 + g].y = pg8::cvt_pk_bf16(oacc[c][4 * g + 2], oacc[c][4 * g + 3]); }
            if (hh == 0) XS[w * 32 + r] = ss0;
            const float ss1 = attn_head(F, w, w + 4, b, qblk, oacc);
            if (hh == 0) XS[(w + 4) * 32 + r] = ss1;
            { volatile LAS unsigned* FL = (volatile LAS unsigned*)(F.lds + P2_XS_OFF + 2048) + (j & 1) * 4;
              LDS_WAIT(); if (lane == 0) FL[w] = (unsigned)(j + 1);
              for (unsigned sp = 0; sp < (1u << 22); ++sp) { const unsigned f0 = FL[0], f1 = FL[1], f2 = FL[2], f3 = FL[3]; if (f0 == (unsigned)(j + 1) && f1 == f0 && f2 == f0 && f3 == f0) break; __builtin_amdgcn_s_sleep(1); }
              asm volatile("" ::: "memory"); }
            float tot = 0.f;
#pragma unroll
            for (int k = 0; k < 8; ++k) tot += XS[k * 32 + r];
            const float rs = __builtin_amdgcn_rsqf(tot * (1.f / CW) + EPS);
            bf16* yo = ymix + ((size_t)b * SEQ + qblk * 32 + r) * D + CW + 4 * hh;
#pragma unroll
            for (int c = 0; c < 4; ++c)
#pragma unroll
                for (int g = 0; g < 4; ++g) {
                    v2u o0; o0.x = pg8::cvt_pk_bf16(bflo(st0[c * 4 + g].x) * rs, bfhi(st0[c * 4 + g].x) * rs); o0.y = pg8::cvt_pk_bf16(bflo(st0[c * 4 + g].y) * rs, bfhi(st0[c * 4 + g].y) * rs);
                    *(GAS v2u*)(yo + w * HD + 32 * c + 8 * g) = o0;
                    v2u o1; o1.x = pg8::cvt_pk_bf16(oacc[c][4 * g] * rs, oacc[c][4 * g + 1] * rs); o1.y = pg8::cvt_pk_bf16(oacc[c][4 * g + 2] * rs, oacc[c][4 * g + 3] * rs);
                    *(GAS v2u*)(yo + (w + 4) * HD + 32 * c + 8 * g) = o1; }
            {
                LAS unsigned char* img = F.lds + w * 16384;
#pragma unroll
                for (int c = 0; c < 4; ++c)
#pragma unroll
                    for (int g = 0; g < 4; ++g) {
                        *(LAS unsigned*)(img + r * 136 + 32 * c + 8 * g + 4 * hh) = pg8::cvt4_fp8(bflo(st0[c * 4 + g].x) * rs, bfhi(st0[c * 4 + g].x) * rs, bflo(st0[c * 4 + g].y) * rs, bfhi(st0[c * 4 + g].y) * rs);
                        *(LAS unsigned*)(img + 4352 + r * 136 + 32 * c + 8 * g + 4 * hh) = pg8::cvt4_fp8(oacc[c][4 * g] * rs, oacc[c][4 * g + 1] * rs, oacc[c][4 * g + 2] * rs, oacc[c][4 * g + 3] * rs); }
                LDS_WAIT();
                unsigned char* y8 = F.ws + WS_YMIX8 + ((size_t)b * SEQ + qblk * 32) * D + CW + 16 * (lane & 7);
#pragma unroll
                for (int hsel = 0; hsel < 2; ++hsel)
#pragma unroll
                    for (int i = 0; i < 4; ++i) { const int row = (lane >> 3) + 8 * i; const LAS unsigned char* p = img + hsel * 4352 + row * 136 + 16 * (lane & 7);
                        const v2u lo = *(const LAS v2u*)p, hi = *(const LAS v2u*)(p + 8); v4u o; o.x = lo.x; o.y = lo.y; o.z = hi.x; o.w = hi.y;
                        *(GAS v4u*)(y8 + (size_t)row * D + (w + 4 * hsel) * HD) = o; }
                LDS_WAIT();
            }
        }
    } else {
        LAS float* scr = (LAS float*)(F.lds + P2_BSCR_OFF + (w - 4) * 16896);
        const int gb = F.bx * 4 + (w - 4), NBW = F.G * 4;
        const int cnt = (EXP_ITEMS - gb + NBW - 1) / NBW;
        for (int j = 0; j < nunits; ++j) {
            const int k0 = (int)((long)cnt * j / nunits), k1 = (int)((long)cnt * (j + 1) / nunits);
            for (int k = k0; k < k1; ++k) {
                f32x4 v[32], gq[8];
                const ExpItem I = exp_decode(F, gb + k * NBW);
                exp_issue(I, lane, v, gq);
                exp_finish_half<0>(I, lane, v, gq, scr);
                exp_finish_half<1>(I, lane, v, gq, scr);
            }
        }
    }
    { unsigned* q = (unsigned*)(F.ws + WS_CTL) + CW_CONVQ;
      for (;;) { int it = 0; if (F.lane == 0) it = (int)__hip_atomic_fetch_add(q, 1u, __ATOMIC_RELAXED, __HIP_MEMORY_SCOPE_AGENT);
          it = __builtin_amdgcn_readfirstlane(it); if (it >= T / 16) break; conv_item(F, it); } }
}

constexpr int ROUTER_LG_OFF = 69632;
static_assert(64 * 1040 <= ROUTER_LG_OFF && ROUTER_LG_OFF + 8 * 6144 <= RT_OFF && 16 * 65 * 4 <= 6144, "router LDS map");
__device__ __forceinline__ void router_unit(Frame& F, int unit, LAS int* hist) {
    const int lane = F.lane, r16 = lane & 15, g = lane >> 4;
    const bf16* YM = (const bf16*)F.out + (size_t)T * D; const bf16* WOR = (const bf16*)(F.ws + WS_WOR);
    const int t0 = unit * 16;
    LAS float* LG = (LAS float*)(F.lds + ROUTER_LG_OFF + F.wave * 6144);
    LAS unsigned char* WL = F.lds;
    f32x4 acc[4];
#pragma unroll
    for (int nb = 0; nb < 4; ++nb) acc[nb] = (f32x4){0.f, 0.f, 0.f, 0.f};
    {
        const bf16* ap = YM + (size_t)(t0 + r16) * D + 8 * g;
        float lxv[4][4];
        { const float* lx = (const float*)(F.ws + WS_LOGX) + (size_t)(t0 + 4 * g) * NE + r16;
#pragma unroll
          for (int nb = 0; nb < 4; ++nb)
#pragma unroll
              for (int j = 0; j < 4; ++j) lxv[nb][j] = lx[(size_t)j * NE + 16 * nb]; }
        const int srow = F.tid >> 3, sseg = F.tid & 7;
        for (int kc = 0; kc < 4; ++kc) {
            v4u wst[8]; bf16x8 av[16];
#pragma unroll
            for (int i = 0; i < 8; ++i) wst[i] = *(const GAS v4u*)((const char*)WOR + (size_t)srow * (D * 2) + 1024 * kc + 128 * sseg + 16 * i);
#pragma unroll
            for (int ks = 0; ks < 16; ++ks) av[ks] = *(const GAS bf16x8*)(ap + 512 * kc + 32 * ks);
            __syncthreads();
#pragma unroll
            for (int i = 0; i < 8; ++i) *(LAS v4u*)(WL + srow * 1040 + 128 * sseg + 16 * i) = wst[i];
            __syncthreads();
#pragma unroll
            for (int ks = 0; ks < 16; ++ks)
#pragma unroll
                for (int nb = 0; nb < 4; ++nb) { const bf16x8 bf = *(const LAS bf16x8*)(WL + (16 * nb + r16) * 1040 + 64 * ks + 16 * g); acc[nb] = __builtin_amdgcn_mfma_f32_16x16x32_bf16(av[ks], bf, acc[nb], 0, 0, 0); }
        }
#pragma unroll
        for (int nb = 0; nb < 4; ++nb)
#pragma unroll
            for (int j = 0; j < 4; ++j) acc[nb][j] += lxv[nb][j];
    }
    float ss = 0.f;
    { const float* s1 = (const float*)(F.ws + WS_SSQ1) + (size_t)(8 * g) * T + t0 + r16;
#pragma unroll
      for (int p = 0; p < 8; ++p) ss += s1[(size_t)p * T]; }
    ss += __shfl_xor(ss, 16); ss += __shfl_xor(ss, 32);
#pragma unroll
    for (int nb = 0; nb < 4; ++nb)
#pragma unroll
        for (int j = 0; j < 4; ++j) LG[(4 * g + j) * 65 + 16 * nb + r16] = acc[nb][j];
    LDS_WAIT();
    if (lane < 16) {
        const int t = t0 + lane; const float rs = __builtin_amdgcn_rsqf(ss * (1.f / D) + EPS);
        ((float*)(F.ws + WS_RFFN))[t] = rs;
        const LAS float* lg = LG + lane * 65; const float* rb = F.in[I_RB];
        float sc[NE], bi[NE];
#pragma unroll
        for (int e = 0; e < NE; ++e) { const float s = fsigmoid(lg[e] * rs); sc[e] = s; bi[e] = s + rb[e]; }
        float gs[8];
#pragma unroll
        for (int gg = 0; gg < 8; ++gg) { float m1 = -__builtin_inff(), m2 = -__builtin_inff();
#pragma unroll
            for (int j = 0; j < 8; ++j) { const float v = bi[8 * gg + j]; const float lo = fminf(m1, v); m1 = fmaxf(m1, v); m2 = fmaxf(m2, lo); }
            gs[gg] = m1 + m2; }
        bool okg[8];
#pragma unroll
        for (int gg = 0; gg < 8; ++gg) { int cnt = 0;
#pragma unroll
            for (int g2 = 0; g2 < 8; ++g2) cnt += (gs[g2] > gs[gg] || (gs[g2] == gs[gg] && g2 < gg)) ? 1 : 0;
            okg[gg] = cnt < 4; }
#pragma unroll
        for (int e = 0; e < NE; ++e) bi[e] = okg[e >> 3] ? bi[e] : -__builtin_inff();
        int se[8]; float sv[8]; float wsum = 0.f;
#pragma unroll
        for (int k = 0; k < 8; ++k) { float best = -__builtin_inff(); int be = 0;
#pragma unroll
            for (int e = 0; e < NE; ++e) { const bool tk = bi[e] > best; best = tk ? bi[e] : best; be = tk ? e : be; }
            float svk = 0.f;
#pragma unroll
            for (int e = 0; e < NE; ++e) { const bool hit = (e == be); svk = hit ? sc[e] : svk; bi[e] = hit ? -__builtin_inff() : bi[e]; }
            se[k] = be; sv[k] = svk; wsum += svk; }
        const float inv = 2.5f / wsum;
        int* te = (int*)(F.ws + WS_TOPE) + (size_t)t * 8; float* tw = (float*)(F.ws + WS_TOPW) + (size_t)t * 8;
#pragma unroll
        for (int k = 0; k < 8; ++k) { te[k] = se[k]; tw[k] = sv[k] * inv; (void)__hip_atomic_fetch_add(hist + se[k], 1, __ATOMIC_RELAXED, __HIP_MEMORY_SCOPE_WORKGROUP); }
    }
}
__device__ __forceinline__ void p4_router(Frame& F) {
    LAS int* hist = (LAS int*)(F.lds + RT_OFF);
    for (int v = F.bx; v < 256; v += F.G) {
        if (F.tid < 64) hist[F.tid] = 0;
        __syncthreads();
        router_unit(F, v * 8 + F.wave, hist);
        __syncthreads();
        if (F.tid < 64) ((int*)(F.ws + WS_CNT))[v * 64 + F.tid] = hist[F.tid];
        __syncthreads();
    }
}

__device__ __forceinline__ void p4b_tables(Frame& F) {
    LAS int* L = (LAS int*)(F.lds + RING_OFF);
    LAS int* part_t = L;
    LAS int* part_b = L + 512;
    LAS int* totals = L + 1024;
    LAS int* below = L + 1088;
    LAS int* segst = L + 1152;
    LAS int* wcount = L + 1280;
    LAS int* pe = L + 2048;
    LAS int* rank = L + 3072;
    const int* CNT = (const int*)(F.ws + WS_CNT); const int* TOPE = (const int*)(F.ws + WS_TOPE); const float* TOPW = (const float*)(F.ws + WS_TOPW);
    const float* RFFN = (const float*)(F.ws + WS_RFFN);
    int* RTOK = (int*)(F.ws + WS_RTOK); float* RW = (float*)(F.ws + WS_RW); int* RDST = (int*)(F.ws + WS_RDST); float* RR = (float*)(F.ws + WS_RR); int* TILEE = (int*)(F.ws + WS_TILEE);
    const int tid = F.tid, lane = F.lane, wave = F.wave;
    for (int v = F.bx; v < 256; v += F.G) {
        { const int e = tid & 63, part = tid >> 6; int tot = 0, bel = 0;
          for (int vv = 32 * part; vv < 32 * part + 32; ++vv) { const int c = CNT[vv * 64 + e]; tot += c; bel += (vv < v) ? c : 0; }
          part_t[part * 64 + e] = tot; part_b[part * 64 + e] = bel; }
        for (int i = tid; i < 1024; i += NTHR) pe[i] = TOPE[(size_t)v * 1024 + i];
        __syncthreads();
        if (wave == 0) {
            int tot = 0, bel = 0;
#pragma unroll
            for (int p = 0; p < 8; ++p) { tot += part_t[p * 64 + lane]; bel += part_b[p * 64 + lane]; }
            totals[lane] = tot; below[lane] = bel;
            const int ru = (tot + 255) & ~255; int sc = ru;
#pragma unroll
            for (int o = 1; o < 64; o <<= 1) { const int n = __shfl_up(sc, o); if (lane >= o) sc += n; }
            segst[lane] = sc - ru; if (lane == 63) segst[64] = sc;
        }
        { int cnt = 0;
          for (int j = 0; j < 128; ++j) { const int p = 128 * wave + j; if (pe[p] == lane) { rank[p] = cnt; ++cnt; } }
          wcount[wave * 64 + lane] = cnt; }
        __syncthreads();
        const int SS = segst[64];
        for (int p = tid; p < 1024; p += NTHR) { const int e = pe[p], w = p >> 7; int off = 0;
            for (int w2 = 0; w2 < w; ++w2) off += wcount[w2 * 64 + e];
            const int row = segst[e] + below[e] + off + rank[p]; const int t = 128 * v + (p >> 3), k = p & 7;
            RTOK[row] = t; RW[row] = TOPW[(size_t)t * 8 + k]; RDST[row] = k * T + t; RR[row] = RFFN[t]; }
        if (tid < 128) { const int t = 128 * v + tid, row = SS + t; RTOK[row] = t; RW[row] = 1.f; RDST[row] = 8 * T + t; RR[row] = RFFN[t]; }
        if (v < NE) { const int e = v, tot = totals[e], ru = (tot + 255) & ~255, st = segst[e];
            if (tid < ru - tot) { const int row = st + tot + tid; RTOK[row] = 0; RW[row] = 0.f; RDST[row] = -1; RR[row] = 0.f; }
            if (tid < ru / 256) TILEE[st / 256 + tid] = e; }
        if (v == NE) { if (tid < T / 256) TILEE[SS / 256 + tid] = NE; if (tid == 0) TILEE[MAXTILES] = SS / 256 + T / 256; }
        __syncthreads();
    }
}

template <int MODE> __device__ __forceinline__ int group_setup(Frame& F, int nN) {
    const int* TILEE = (const int*)(F.ws + WS_TILEE);
    const int NT = __builtin_amdgcn_readfirstlane((int)__hip_atomic_load((unsigned*)TILEE + MAXTILES, RLX_AGENT));
    LAS int* te = (LAS int*)(F.lds + TE_OFF); LAS unsigned* rt = (LAS unsigned*)(F.lds + RT_OFF);
    for (int i = F.tid; i < NT && i < MAXTILES; i += NTHR) te[i] = TILEE[i];
    if (MODE == 1) {
        const int* RTOK = (const int*)(F.ws + WS_RTOK);
        for (int ui = F.tid >> 8; ui < RT_UNITS; ui += 2) { int pm, pn; if (!pg8::order_next(ui, F.G, F.bx, NT, nN, pm, pn)) break;
            rt[ui * 256 + (F.tid & 255)] = (unsigned)RTOK[pm * 256 + (F.tid & 255)] * (unsigned)D; }
    }
    __syncthreads();
    return NT;
}

__device__ __forceinline__ void acc_fp8x16(const v4u w, float (&o)[16]) {
#pragma unroll
    for (int q = 0; q < 4; ++q) { const f32x2 lo = __builtin_amdgcn_cvt_pk_f32_fp8((int)w[q], false), hi = __builtin_amdgcn_cvt_pk_f32_fp8((int)w[q], true);
        o[4 * q] += lo.x; o[4 * q + 1] += lo.y; o[4 * q + 2] += hi.x; o[4 * q + 3] += hi.y; }
}
__device__ __forceinline__ void comb_load(const unsigned char* S0, const unsigned char* S1, const unsigned char* S8, const unsigned char* H8, int t, int co, v4u& h8, v4u (&w)[9]) {
    h8 = *(const GAS v4u*)(H8 + (size_t)t * D + co);
#pragma unroll
    for (int k = 0; k < 4; ++k) { w[k] = *(const GAS v4u*)(S0 + ((size_t)k * T + t) * D + co); w[4 + k] = *(const GAS v4u*)(S1 + ((size_t)k * T + t) * D + co); }
    w[8] = *(const GAS v4u*)(S8 + (size_t)t * D + co);
}
__device__ __forceinline__ float comb_proc(unsigned char* hp8, const v4u h8, const v4u (&w)[9]) {
    float o[16];
#pragma unroll
    for (int i = 0; i < 16; ++i) o[i] = 0.f;
#pragma unroll
    for (int k = 0; k < 9; ++k) acc_fp8x16(w[k], o);
    float hf[16];
#pragma unroll
    for (int i = 0; i < 16; ++i) hf[i] = 0.f;
    acc_fp8x16(h8, hf);
    float ss = 0.f;
#pragma unroll
    for (int i = 0; i < 16; ++i) { hf[i] += o[i] * (1.f / SLOT_SCALE); ss += hf[i] * hf[i]; }
    v4u w8;
#pragma unroll
    for (int q = 0; q < 4; ++q) w8[q] = pg8::cvt4_fp8(hf[4 * q], hf[4 * q + 1], hf[4 * q + 2], hf[4 * q + 3]);
    *(GAS v4u*)hp8 = w8;
    return ss;
}
__device__ __forceinline__ void p7_combine(Frame& F, int n, int wg0, int nwg, int t_lo, int t_hi) {
    const int gw = t_lo + (F.bx - wg0) * NWAVES + F.wave, NGW = nwg * NWAVES, lane = F.lane; const int T = t_hi;
    const unsigned char* S0 = (const unsigned char*)F.out; const unsigned char* S1 = F.ws + WS_SLOT47; const unsigned char* S8 = F.ws + WS_SLOT8;
    unsigned char* H8 = F.ws + WS_H1F8; float* ssq2 = (float*)(F.ws + WS_SSQ2);
    const int coA = 16 * lane, coB = 1024 + 16 * lane;
    v4u hA, wA[9], hB, wB[9];
    if (gw < T) comb_load(S0, S1, S8, H8, gw, coA, hA, wA);
    for (int t = gw; t < T; t += NGW) {
        comb_load(S0, S1, S8, H8, t, coB, hB, wB);
        float ss = comb_proc(H8 + (size_t)t * D + coA, hA, wA);
        const int tn = t + NGW < T ? t + NGW : t;
        comb_load(S0, S1, S8, H8, tn, coA, hA, wA);
        ss += comb_proc(H8 + (size_t)t * D + coB, hB, wB);
        ss = wave_sum(ss);
        if (lane == 0) ssq2[t] = ss;
    }
}

__device__ __forceinline__ void p9_final(Frame& F, const bf16* H, const float* ssq, int nparts) {
    const int gw = F.bx * NWAVES + F.wave, NGW = F.G * NWAVES, lane = F.lane; const float* g = F.in[I_NFIN];
    for (int t = gw; t < T; t += NGW) {
        v4u w[4];
#pragma unroll
        for (int j = 0; j < 4; ++j) w[j] = *(const GAS v4u*)(H + (size_t)t * D + 512 * j + 8 * lane);
        float ss = 0.f;
        if (nparts > 0) { if (lane < nparts) ss = ssq[(size_t)lane * T + t]; }
        else {
#pragma unroll
            for (int j = 0; j < 4; ++j)
#pragma unroll
                for (int q = 0; q < 4; ++q) { const float lo = bflo(w[j][q]), hi = bfhi(w[j][q]); ss += lo * lo + hi * hi; }
        }
        const float r = __builtin_amdgcn_rsqf(wave_sum(ss) * (1.f / D) + EPS);
        float* o = F.out + (size_t)t * D;
#pragma unroll
        for (int j = 0; j < 4; ++j) { const int c = 512 * j + 8 * lane; const f32x4 g0 = *(const GAS f32x4*)(g + c), g1 = *(const GAS f32x4*)(g + c + 4);
            f32x4 a, b; a.x = bflo(w[j][0]) * r * g0.x; a.y = bfhi(w[j][0]) * r * g0.y; a.z = bflo(w[j][1]) * r * g0.z; a.w = bfhi(w[j][1]) * r * g0.w;
            b.x = bflo(w[j][2]) * r * g1.x; b.y = bfhi(w[j][2]) * r * g1.y; b.z = bflo(w[j][3]) * r * g1.z; b.w = bfhi(w[j][3]) * r * g1.w;
            *(GAS f32x4*)(o + c) = a; *(GAS f32x4*)(o + c + 4) = b; }
    }
}

__device__ __forceinline__ void p9_final8(Frame& F, const unsigned char* H8, const float* ssq) {
    const int gw = F.bx * NWAVES + F.wave, NGW = F.G * NWAVES, lane = F.lane; const float* g = F.in[I_NFIN];
    f32x4 gv[2][4];
#pragma unroll
    for (int j = 0; j < 2; ++j)
#pragma unroll
        for (int q = 0; q < 4; ++q) gv[j][q] = *(const GAS f32x4*)(g + 1024 * j + 16 * lane + 4 * q);
    for (int t0 = gw; t0 < T; t0 += 16 * NGW) {
        v4u w[16][2]; float ss[16];
#pragma unroll
        for (int i = 0; i < 16; ++i) { const int t = t0 + i * NGW, tc = t < T ? t : T - 1;
#pragma unroll
            for (int j = 0; j < 2; ++j) w[i][j] = *(const GAS v4u*)(H8 + (size_t)tc * D + 1024 * j + 16 * lane);
            ss[i] = lane < 32 ? ssq[(size_t)lane * T + tc] : 0.f; }
#pragma unroll
        for (int i = 0; i < 16; ++i) { const int t = t0 + i * NGW;
            const float r = __builtin_amdgcn_rsqf(wave_sum(ss[i]) * (1.f / D) + EPS);
            if (t < T) { float* o = F.out + (size_t)t * D;
#pragma unroll
                for (int j = 0; j < 2; ++j)
#pragma unroll
                    for (int q = 0; q < 4; ++q) { const f32x2 a = __builtin_amdgcn_cvt_pk_f32_fp8((int)w[i][j][q], false), b = __builtin_amdgcn_cvt_pk_f32_fp8((int)w[i][j][q], true);
                        f32x4 v; v.x = a.x * r * gv[j][q].x; v.y = a.y * r * gv[j][q].y; v.z = b.x * r * gv[j][q].z; v.w = b.y * r * gv[j][q].w;
                        *(GAS f32x4*)(o + 1024 * j + 16 * lane + 4 * q) = v; } }
        }
    }
}

struct Args { const float* in[21]; float* out; unsigned char* ws; int ph_lo, ph_hi, fin_mode, li; };
__global__ void __launch_bounds__(NTHR, 2) mk_fwd(Args args) {
    extern __shared__ __attribute__((aligned(16))) unsigned char lds[];
    Frame F;
    F.lds = (LAS unsigned char*)lds;
    F.tid = threadIdx.x; F.lane = F.tid & 63; F.wave = __builtin_amdgcn_readfirstlane(F.tid >> 6);
    F.G = gridDim.x; F.bx = blockIdx.x; F.ws = args.ws; F.out = args.out;
#pragma unroll
    for (int i = 0; i < 21; ++i) F.in[i] = args.in[i];
    volatile LAS unsigned* MISC = (volatile LAS unsigned*)(F.lds + MISC_OFF);
    if (F.tid < 32) MISC[F.tid] = 0u;
    __syncthreads();
    XcdBarrier bar = xcd_barrier_post((unsigned*)(F.ws + WS_CTL) + CW_BAR + args.li * XCD_BAR_WORDS, MISC + 8);
    unsigned char* ws = F.ws;
    const int lo = args.ph_lo, hi = args.ph_hi;
    LAS unsigned char* ring = F.lds + RING_OFF;
#define PHASE(k) if (lo <= (k) && (k) < hi)
#define PH(k) PHASE(k) { RELANE();
#define GRID_BAR() xcd_barrier(bar)
#define RELANE() do { int _t = threadIdx.x; asm volatile("" : "+v"(_t)); F.tid = _t; F.lane = _t & 63; F.wave = __builtin_amdgcn_readfirstlane(_t >> 6); } while (0)

    PHASE(0) { RELANE(); p0_prologue(F); GRID_BAR(); }
    PHASE(1) { RELANE();
        pg8::DenseSched S{T / 256, NPROJ / 256, F.G, F.bx, D * 2, (const char*)(ws + WS_WIN)};
        pg8::EpiProj E{(bf16*)(ws + WS_PROJ), (bf16*)(ws + WS_QKV), (const float*)(ws + WS_RMIX)};
        pg8::gemm_phase<false, 1>(F.tid, ring, (const char*)F.out, D * 2, S, E);
        GRID_BAR();
    }
    PHASE(2) { RELANE(); p2_mixer(F); GRID_BAR(); }
    PHASE(3) { RELANE();
        pg8::DenseSchedG S{T / 256, D / 256, F.G, F.bx, D, (const char*)(ws + WS_WOUT)};
        pg8::EpiResF32 E{(bf16*)(ws + WS_H1B), (const bf16*)F.out, D, ws + WS_H1F8, (float*)(ws + WS_SSQ1)};
        pg8::gemm_phase<true, 1>(F.tid, ring, (const char*)(ws + WS_YMIX8), D, S, E, 0x79797979, 0x7f7f7f7f);
        GRID_BAR();
    }
    PHASE(4) { RELANE(); p4_router(F); GRID_BAR(); }
    PHASE(5) { RELANE(); p4b_tables(F); GRID_BAR(); }
    PHASE(6) { RELANE();
        const int NT = group_setup<1>(F, 4);
        pg8::GroupSched<1> S{NT, 4, F.G, F.bx, D, 0, (const char*)(ws + WS_WGU), (size_t)1024 * D, (const LAS int*)(F.lds + TE_OFF), (const LAS unsigned*)(F.lds + RT_OFF)};
        pg8::EpiGateUp E{ws + WS_HPERM, (const float*)(ws + WS_RR)};
        pg8::gemm_phase<true, 0>(F.tid, ring, (const char*)(ws + WS_H1F8), D, S, E, 0x79797979, 0x7f7f7f7f);
        GRID_BAR();
    }
    {
        for (int n = 0; n < NSLICE; ++n) {
            PHASE(7 + 2 * n) { RELANE();
            const int NT = group_setup<2>(F, SLW / 256);
            pg8::GroupSched<2> S{NT, SLW / 256, F.G, F.bx, ED, (SLW / 256) * n, (const char*)(ws + WS_WDN), (size_t)D * ED, (const LAS int*)(F.lds + TE_OFF), (const LAS unsigned*)(F.lds + RT_OFF)};
            pg8::EpiDown E{(unsigned char*)F.out, ws + WS_SLOT47, ws + WS_SLOT8, (const float*)(ws + WS_RW), (const int*)(ws + WS_RDST)};
            pg8::gemm_phase<true, 0>(F.tid, ring, (const char*)(ws + WS_HPERM), ED, S, E, 0x79797979, 0x7f7f7f7f);
            GRID_BAR();
            }
            PHASE(8 + 2 * n) { RELANE();
            const int npl = F.G >= 2 * P8_NPLE ? P8_NPLE : 0;
            if (F.bx < npl) {
                pg8::DenseSched S{T / 256, D / 256, npl, F.bx, PLE * 2, (const char*)(ws + WS_WPP)};
                pg8::EpiF8x16 E{ws + WS_PP, D};
                pg8::gemm_phase<false, 1>(F.tid, ring, (const char*)(ws + WS_PB), PLE * 2, S, E);
                RELANE();
                p7_combine(F, n, 0, npl, 0, P8_TSPLIT);
            } else p7_combine(F, n, npl, F.G - npl, npl ? P8_TSPLIT : 0, ::T);
            GRID_BAR();
            }
        }
    }
    PHASE(15) { RELANE();
        if (F.G < 2 * P8_NPLE) {
        pg8::DenseSched S{T / 256, D / 256, F.G, F.bx, PLE * 2, (const char*)(ws + WS_WPP)};
        pg8::EpiF8x16 E{ws + WS_PP, D};
        pg8::gemm_phase<false, 1>(F.tid, ring, (const char*)(ws + WS_PB), PLE * 2, S, E);
        GRID_BAR();
        }
    }
    PHASE(16) { RELANE();
        pg8::DenseSchedG S{T / 256, D / 256, F.G, F.bx, D, (const char*)(ws + WS_WPG)};
        pg8::EpiPle E{ws + WS_H3, ws + WS_H1F8, ws + WS_PP, (const float*)(ws + WS_SSQ2), (float*)(ws + WS_SSQ3)};
        pg8::gemm_phase<true, 1>(F.tid, ring, (const char*)(ws + WS_H1F8), D, S, E, 0x79797979, 0x7f7f7f7f);
        GRID_BAR();
    }
    PHASE(17) { RELANE();
    if (args.fin_mode == 0) p9_final8(F, ws + WS_H3, (const float*)(ws + WS_SSQ3));
    else p9_final(F, (const bf16*)(ws + WS_H1B), nullptr, 0);
    }
}

extern "C" void kernel_launch(void* const* d_in, const int* in_sizes, int n_in, void* d_out, int out_size, void* d_ws, size_t ws_size, hipStream_t stream) {
    static int grid = 0;
    if (grid == 0) {
        int dev = 0, cus = 0;
        if (n_in != 21 || ws_size < WS_END) { fprintf(stderr, "kernel_launch: n_in %d ws %zu (need %zu)\n", n_in, ws_size, (size_t)WS_END); grid = -1; return; }
        if (hipGetDevice(&dev) != hipSuccess || hipDeviceGetAttribute(&cus, hipDeviceAttributeMultiprocessorCount, dev) != hipSuccess) { grid = -1; return; }
        if (hipFuncSetAttribute((const void*)mk_fwd, hipFuncAttributeMaxDynamicSharedMemorySize, LDS_BYTES) != hipSuccess) { fprintf(stderr, "hipFuncSetAttribute failed\n"); grid = -1; return; }
        int per_cu = 0;
        (void)hipOccupancyMaxActiveBlocksPerMultiprocessor(&per_cu, (const void*)mk_fwd, NTHR, LDS_BYTES);
        (void)hipGetLastError();
        grid = cus > 256 ? 256 : cus;
    }
    if (grid < 0) return;
    (void)hipMemsetAsync((char*)d_ws + WS_CTL, 0, CTL_ZERO_BYTES, stream);
    Args a{};
    for (int i = 0; i < 21; ++i) a.in[i] = (const float*)d_in[i];
    a.out = (float*)d_out; a.ws = (unsigned char*)d_ws; a.fin_mode = FIN_MODE;
#if PROBE_K >= 0
    a.ph_lo = 0; a.ph_hi = PROBE_K + 1; a.li = 0;
    hipLaunchKernelGGL(mk_fwd, dim3(grid), dim3(NTHR), LDS_BYTES, stream, a);
    a.ph_lo = PROBE_K; a.ph_hi = PH_HI; a.li = 1;
    hipLaunchKernelGGL(mk_fwd, dim3(grid), dim3(NTHR), LDS_BYTES, stream, a);
#else
    a.ph_lo = 0; a.ph_hi = PH_HI; a.li = 0;
    hipLaunchKernelGGL(mk_fwd, dim3(grid), dim3(NTHR), LDS_BYTES, stream, a);
#endif
}
```

```cpp
#include <hip/hip_runtime.h>
#include <cstdio>
#ifndef PROBE_K
#define PROBE_K -1
#endif
#ifndef PH_HI
#define PH_HI 100
#endif
#ifndef FIN_MODE
#define FIN_MODE 0
#endif

#define GAS __attribute__((address_space(1)))
#define LAS __attribute__((address_space(3)))
typedef unsigned short bf16;
typedef unsigned v4u __attribute__((ext_vector_type(4)));
typedef unsigned v2u __attribute__((ext_vector_type(2)));
typedef float f32x4 __attribute__((ext_vector_type(4)));
typedef float f32x2 __attribute__((ext_vector_type(2)));
typedef float f32x16 __attribute__((ext_vector_type(16)));
typedef short bf16x8 __attribute__((ext_vector_type(8)));
typedef short s16x4 __attribute__((ext_vector_type(4)));
typedef GAS unsigned gu32;
#define RLX_AGENT __ATOMIC_RELAXED, __HIP_MEMORY_SCOPE_AGENT
#define LDS_WAIT() asm volatile("s_waitcnt lgkmcnt(0)" ::: "memory")
#define VM_WAIT() asm volatile("s_waitcnt vmcnt(0)" ::: "memory")

constexpr int NB = 8, SEQ = 4096, T = NB * SEQ, D = 2048, NPROJ = 6144, CW = 1024, HD = 128, NH = 8;
constexpr int PCW = 3 * CW;
constexpr int PLE = 256, NE = 64, ED = 512, TOPK = 8, NSLOT = 9;
constexpr float EPS = 1e-6f;
constexpr int NWAVES = 8, NTHR = 512;
constexpr int MAXTILES = 1216;
constexpr int MAXROWS = MAXTILES * 256;
constexpr int P8_TSPLIT = 8192;
constexpr int P8_NPLE = 128;
constexpr int NSLICE = 1, SLW = D / NSLICE;
constexpr float SLOT_SCALE = 16.f;

constexpr size_t MiB = 1u << 20;
constexpr size_t WS_CTL = 0, CTL_ZERO_BYTES = 1 * MiB;
constexpr size_t WS_RMIX = 1 * MiB;
constexpr size_t WS_RFFN = WS_RMIX + 128 * 1024;
constexpr size_t WS_SSQ2 = WS_RFFN + 128 * 1024;
constexpr size_t WS_SSQ3 = WS_SSQ2 + 512 * 1024;
constexpr size_t WS_TOPE = WS_SSQ3 + 4 * MiB;
constexpr size_t WS_TOPW = WS_TOPE + 1 * MiB;
constexpr size_t WS_CNT  = WS_TOPW + 1 * MiB;
constexpr size_t WS_RTOK = WS_CNT + 64 * 1024;
constexpr size_t WS_RW   = WS_RTOK + 1280 * 1024;
constexpr size_t WS_RDST = WS_RW + 1280 * 1024;
constexpr size_t WS_RR   = WS_RDST + 1280 * 1024;
constexpr size_t WS_TILEE = WS_RR + 1280 * 1024;
constexpr size_t WS_WR   = 16 * MiB;
constexpr size_t WS_WOR  = WS_WR + 512 * 1024;
constexpr size_t WS_WIN  = 17 * MiB;
constexpr size_t WS_WOUT = WS_WIN + 24 * MiB;
constexpr size_t WS_WGU  = WS_WOUT + 8 * MiB;
constexpr size_t WS_WDN  = WS_WGU + 130 * MiB;
constexpr size_t WS_WPG  = WS_WDN + 65 * MiB;
constexpr size_t WS_WPP  = WS_WPG + 8 * MiB;
constexpr size_t WS_PB   = WS_WPP + 1 * MiB;
constexpr size_t WS_H1B  = WS_PB + 16 * MiB;
constexpr size_t WS_H1F8 = WS_H1B + 128 * MiB;
constexpr size_t WS_OVL  = WS_H1F8 + 64 * MiB;
constexpr size_t WS_PROJ = WS_OVL;
constexpr size_t WS_QKV  = WS_OVL + 192 * MiB;
constexpr size_t WS_HPERM = WS_OVL;
constexpr size_t WS_SLOT8 = WS_OVL + 304 * MiB;
constexpr size_t WS_PP   = WS_OVL;
constexpr size_t WS_H3   = WS_OVL + 128 * MiB;
constexpr size_t WS_SLOT47 = WS_OVL + 384 * MiB;
constexpr size_t WS_YMIX8 = WS_SLOT47;
constexpr size_t WS_LOGX = WS_SLOT47 + 64 * MiB;
constexpr size_t WS_SSQ1 = WS_SSQ3;
constexpr size_t WS_END  = WS_SLOT47 + 256 * MiB;
constexpr int CW_BAR = 4096, CW_CONVQ = 1024;

constexpr int RING_OFF = 0, RING_BYTES = 131072;
constexpr int RT_OFF = 131072, RT_UNITS = 20, RT_BYTES = RT_UNITS * 1024;
constexpr int TE_OFF = RT_OFF + RT_BYTES, TE_BYTES = 4864 + 128;
constexpr int EPT_OFF = TE_OFF + TE_BYTES, EPT_BYTES = 4096;
constexpr int MISC_OFF = EPT_OFF + EPT_BYTES;
constexpr int LDS_BYTES = MISC_OFF + 128;
static_assert(LDS_BYTES <= 163840, "LDS");

__device__ __forceinline__ unsigned f2bf(float f) { unsigned u = __builtin_bit_cast(unsigned, f); return (u + 0x7fffu + ((u >> 16) & 1u)) >> 16; }
__device__ __forceinline__ unsigned pk2(float lo, float hi) { return f2bf(lo) | (f2bf(hi) << 16); }
__device__ __forceinline__ float bflo(unsigned w) { return __builtin_bit_cast(float, w << 16); }
__device__ __forceinline__ float bfhi(unsigned w) { return __builtin_bit_cast(float, w & 0xffff0000u); }
__device__ __forceinline__ float wave_sum(float v) {
#pragma unroll
    for (int o = 1; o < 64; o <<= 1) v += __shfl_xor(v, o);
    return v;
}
__device__ __forceinline__ float fsigmoid(float v) { return __builtin_amdgcn_rcpf(1.f + __builtin_amdgcn_exp2f(-1.4426950409f * v)); }

#define XB_TMO      128
#define XB_XCNT(j)  (256  + 64 * (j))
#define XB_XSUB(j)  (1280 + 64 * (j))
#define XB_XGEN(j)  (2304 + 64 * (j))
#define XB_TOP      3328
#define XB_TOPGEN   3392
#define XCD_BAR_WORDS 3456
#define XB_SPIN_CAP (1u << 18)
__device__ __forceinline__ unsigned xb_ld(unsigned* p)              { return __hip_atomic_load(p, __ATOMIC_RELAXED, __HIP_MEMORY_SCOPE_AGENT); }
__device__ __forceinline__ unsigned xb_add(unsigned* p, unsigned v) { return __hip_atomic_fetch_add(p, v, __ATOMIC_RELAXED, __HIP_MEMORY_SCOPE_AGENT); }
__device__ __forceinline__ unsigned xb_xcc_id() { return (unsigned)__builtin_amdgcn_s_getreg((3 << 11) | 20) & 0xFu; }
#define XB_SPIN(cond, bar) do { unsigned _sp = 0; while (cond) { __builtin_amdgcn_s_sleep(1); \
    if ((++_sp & 255u) == 0u) { if (xb_ld(&(bar)[XB_TMO])) break; if (_sp > XB_SPIN_CAP) { atomicAdd(&(bar)[XB_TMO], 1u); break; } } } } while (0)
struct XcdBarrier { unsigned* bar; unsigned x; volatile LAS unsigned* st; };
__device__ __forceinline__ XcdBarrier xcd_barrier_post(unsigned* bar, volatile LAS unsigned* st) {
    XcdBarrier b; b.bar = bar; b.x = xb_xcc_id(); b.st = st;
    if (threadIdx.x == 0) (void)xb_add(&bar[XB_XCNT(b.x)], 1u);
    return b;
}
__device__ __forceinline__ void xcd_barrier_complete(unsigned* bar, unsigned x, unsigned& nloc, unsigned& nx) {
    const unsigned G = gridDim.x * gridDim.y * gridDim.z;
    unsigned sum, cnt, mine, sp = 0u;
    for (;;) {
        sum = 0u; cnt = 0u; mine = 0u;
#pragma unroll
        for (unsigned j = 0; j < 16; ++j) { const unsigned c = xb_ld(&bar[XB_XCNT(j)]); sum += c; cnt += (c > 0u) ? 1u : 0u; mine = (j == x) ? c : mine; }
        if (sum == G) break;
        __builtin_amdgcn_s_sleep(1);
        if ((++sp & 255u) == 0u) { if (xb_ld(&bar[XB_TMO])) break; if (sp > XB_SPIN_CAP) { atomicAdd(&bar[XB_TMO], 1u); break; } }
    }
    nloc = mine > 0u ? mine : 1u; nx = cnt > 0u ? cnt : 1u;
}
__device__ __forceinline__ void xcd_barrier(const XcdBarrier& b) {
    asm volatile("s_waitcnt vmcnt(0)" ::: "memory");
    __syncthreads();
    if (threadIdx.x == 0) {
        unsigned* bar = b.bar;
        __builtin_amdgcn_s_waitcnt(0);
        unsigned nloc = b.st[0], nx = b.st[1];
        if (nloc == 0u) { xcd_barrier_complete(bar, b.x, nloc, nx); b.st[0] = nloc; b.st[1] = nx; }
        const unsigned old = xb_add(&bar[XB_XSUB(b.x)], 1u);
        const unsigned gen = old / nloc;
        if (old + 1u == (gen + 1u) * nloc) {
            __builtin_amdgcn_fence(__ATOMIC_RELEASE, "agent");
            asm volatile("s_waitcnt vmcnt(0)" ::: "memory");
            const unsigned og = xb_add(&bar[XB_TOP], 1u);
            const unsigned tg = og / nx;
            if (og + 1u == (tg + 1u) * nx) xb_add(&bar[XB_TOPGEN], 1u);
            else XB_SPIN(xb_ld(&bar[XB_TOPGEN]) == tg, bar);
            __builtin_amdgcn_fence(__ATOMIC_ACQUIRE, "agent");
            xb_add(&bar[XB_XGEN(b.x)], 1u);
            asm volatile("s_waitcnt vmcnt(0)" ::: "memory");
        } else {
            XB_SPIN(xb_ld(&bar[XB_XGEN(b.x)]) == gen, bar);
            __builtin_amdgcn_fence(__ATOMIC_ACQUIRE, "agent");
            asm volatile("s_waitcnt vmcnt(0)" ::: "memory");
        }
    }
    __syncthreads();
}

namespace pg8 {
constexpr int BM = 256, BK = 64, HALF = 128, HTB = HALF * BK * 2, STAGE_BYTES = 8 * HTB, NXCD = 8, WGM = 8;
__device__ __forceinline__ int lds_byte(int r, int c) { const int st = (r >> 4) * 2 + (c >> 5), rr = r & 15, cc = c & 31, ob = rr * 64 + cc * 2; return st * 1024 + (ob ^ (((ob >> 9) & 1) << 5)); }
__device__ __forceinline__ void stage_rc(int b, int& R, int& C) { const int st = b / 1024, sb = b % 1024, swz = sb ^ (((sb >> 9) & 1) << 5); R = (st >> 1) * 16 + swz / 64; C = (st & 1) * 32 + (swz % 64) / 2; }
__device__ __forceinline__ int brow(int R) { return 64 * (R >> 5) + 16 * ((R & 15) >> 2) + 4 * ((R >> 4) & 1) + (R & 3); }
__device__ __forceinline__ int brow1(int R) { return 64 * (R >> 5) + 8 * ((R & 15) >> 2) + 4 * ((R >> 4) & 1) + (R & 3); }

struct Unit { int pm, pn, e; };

__device__ __forceinline__ bool order_next(int i, int G, int c, int nM, int nN, int& pm, int& pn) {
    const int nwg = nM * nN; const long L = (long)i * G + c; if (L >= nwg) return false;
    int wgid = (int)L; { const int q = nwg / NXCD, r = nwg % NXCD, xcd = wgid % NXCD, off = wgid / NXCD; wgid = (xcd < r ? xcd * (q + 1) : r * (q + 1) + (xcd - r) * q) + off; }
    const int nig = WGM * nN, gid = wgid / nig, fm = gid * WGM, gsz = (nM - fm) < WGM ? (nM - fm) : WGM;
    pm = fm + ((wgid % nig) % gsz); pn = (wgid % nig) / gsz; return true;
}

struct DenseSched {
    static constexpr bool GATHER = false;
    int nM, nN, G, c, KB; const char* Bt;
    __device__ __forceinline__ bool next(int i, Unit& u) const { u.e = 0; return order_next(i, G, c, nM, nN, u.pm, u.pn); }
    __device__ __forceinline__ const char* bbase(const Unit& u) const { return Bt + (size_t)u.pn * BM * KB; }
    __device__ __forceinline__ const char* abase(const char* A, const Unit& u) const { return A + (size_t)u.pm * BM * KB; }
    __device__ __forceinline__ void aoffs(int ui, const Unit& u, int tid, unsigned (&ao)[2][2]) const {}
};
struct DenseSchedG {
    static constexpr bool GATHER = true;
    int nM, nN, G, c, KB; const char* Bt;
    __device__ __forceinline__ bool next(int i, Unit& u) const { u.e = 0; return order_next(i, G, c, nM, nN, u.pm, u.pn); }
    __device__ __forceinline__ const char* bbase(const Unit& u) const { return Bt + (size_t)u.pn * BM * KB; }
    __device__ __forceinline__ const char* abase(const char* A, const Unit& u) const { return A; }
    __device__ __forceinline__ void aoffs(int ui, const Unit& u, int tid, unsigned (&ao)[2][2]) const {
        asm volatile("" : "+v"(tid));
#pragma unroll
        for (int i = 0; i < 2; ++i) { int R, C; stage_rc(tid * 16 + i * 8192, R, C);
#pragma unroll
            for (int h = 0; h < 2; ++h) ao[h][i] = (unsigned)(u.pm * BM + h * HALF + R) * (unsigned)KB + (unsigned)C * 2u; }
    }
};
template <int MODE> struct GroupSched {
    static constexpr bool GATHER = true;
    int nM, nN, G, c, KB, pn0; const char* Bt; size_t estride; const LAS int* te; const LAS unsigned* rt;
    __device__ __forceinline__ bool next(int i, Unit& u) const { if (!order_next(i, G, c, nM, nN, u.pm, u.pn)) return false; u.e = __builtin_amdgcn_readfirstlane(te[u.pm]); return true; }
    __device__ __forceinline__ const char* bbase(const Unit& u) const { return Bt + (size_t)u.e * estride + (size_t)(pn0 + u.pn) * BM * KB; }
    __device__ __forceinline__ void aoffs(int ui, const Unit& u, int tid, unsigned (&ao)[2][2]) const {
        asm volatile("" : "+v"(tid));
#pragma unroll
        for (int i = 0; i < 2; ++i) { int R, C; stage_rc(tid * 16 + i * 8192, R, C);
#pragma unroll
            for (int h = 0; h < 2; ++h) { if (MODE == 1) ao[h][i] = rt[ui * 256 + h * HALF + R] + (unsigned)C * 2u; else ao[h][i] = (unsigned)(u.pm * BM + h * HALF + R) * (unsigned)KB + (unsigned)C * 2u; } }
    }
    __device__ __forceinline__ const char* abase(const char* A, const Unit& u) const { return A; }
};

__device__ __forceinline__ unsigned cvt_pk_bf16(float lo, float hi) { unsigned r; asm volatile("v_cvt_pk_bf16_f32 %0, %1, %2" : "=v"(r) : "v"(lo), "v"(hi)); return r; }

typedef int v8i __attribute__((ext_vector_type(8)));
typedef int v4i __attribute__((ext_vector_type(4)));
union Frag { v8i v; struct { v4i lo, hi; }; };
template <bool F8, int LAY, class Epi, class Sched>
__device__ __forceinline__ void gemm_phase(const int tid, LAS unsigned char* lds, const char* Abase, const int KB, const Sched& S, const Epi& E, const int sw = 0x7f7f7f7f, const int sa = 0x7f7f7f7f) {
    LAS unsigned char* const ept = lds + (EPT_OFF - RING_OFF);
    const int wid = __builtin_amdgcn_readfirstlane(tid >> 6), lane = tid & 63, wr = wid >> 2, wc = wid & 3, fr = lane & 15, fq = lane >> 4;
    const int nt = KB / 128;
    constexpr bool GA = Sched::GATHER;
    unsigned voffB[2], voffA[2];
#pragma unroll
    for (int i = 0; i < 2; ++i) { int R, C; stage_rc(tid * 16 + i * 8192, R, C); const int Rb = LAY ? brow1(R) : brow(R); voffB[i] = (unsigned)Rb * (unsigned)KB + (unsigned)C * 2u; voffA[i] = (unsigned)R * (unsigned)KB + (unsigned)C * 2u; }
    const size_t kstep = (size_t)(BK * 2);
    const size_t hstep = (size_t)HALF * KB;
    const size_t hstepB = (size_t)(LAY ? 32 : 8) * KB;
    const unsigned ldsw = (unsigned)wid * 1024u;
    const int aoff = lds_byte(wr * 64 + fr, fq * 8), boff = lds_byte(wc * 32 + fr, fq * 8);
#define PG8_SA(b, h) (((b) * 2 + (h)) * HTB)
#define PG8_SB(b, h) ((4 + (b) * 2 + (h)) * HTB)
#define PG8_STAGE(bufoff, gbase, voff) do { _Pragma("unroll") for (int _i = 0; _i < 2; ++_i) \
        __builtin_amdgcn_global_load_lds((const unsigned*)((const char*)(gbase) + (voff)[_i]), (LAS unsigned*)(lds + (bufoff) + ldsw + _i * 8192), 16, 0, 0); } while (0)
#define PG8_STAGEA(bufoff, gbase, half) do { if constexpr (GA) { PG8_STAGE(bufoff, gbase, ca[half]); } else { PG8_STAGE(bufoff, (gbase) + (half) * hstep, voffA); } } while (0)
#define PG8_LD1(dst, off) do { const v4i _lo = *(const LAS v4i*)(lds + (off)), _hi = *(const LAS v4i*)(lds + (off) + 1024); dst.lo = _lo; dst.hi = _hi; } while (0)
#define PG8_LDA(dst, b, h) do { _Pragma("unroll") for (int m = 0; m < 4; ++m) PG8_LD1(dst[m], PG8_SA(b, h) + aoff + m * 2048); } while (0)
#define PG8_LDB(dst, b, h) do { _Pragma("unroll") for (int n = 0; n < 2; ++n) PG8_LD1(dst[n], PG8_SB(b, h) + boff + n * 2048); } while (0)
#define PG8_MMA(ai, bj, At, Bt) do { __builtin_amdgcn_s_setprio(1); _Pragma("unroll") for (int m = 0; m < 4; ++m) _Pragma("unroll") for (int n = 0; n < 2; ++n) { \
        if constexpr (F8) { acc[ai][bj][m][n] = __builtin_amdgcn_mfma_scale_f32_16x16x128_f8f6f4(Bt[n].v, At[m].v, acc[ai][bj][m][n], 0, 0, 0, sw, 0, sa); } \
        else { acc[ai][bj][m][n] = __builtin_amdgcn_mfma_f32_16x16x32_bf16(__builtin_bit_cast(bf16x8, Bt[n].lo), __builtin_bit_cast(bf16x8, At[m].lo), acc[ai][bj][m][n], 0, 0, 0); \
               acc[ai][bj][m][n] = __builtin_amdgcn_mfma_f32_16x16x32_bf16(__builtin_bit_cast(bf16x8, Bt[n].hi), __builtin_bit_cast(bf16x8, At[m].hi), acc[ai][bj][m][n], 0, 0, 0); } } \
        __builtin_amdgcn_s_setprio(0); } while (0)
#define PG8_WAIT_V(n) asm volatile("s_waitcnt vmcnt(" #n ")" ::: "memory")
#define PG8_WAIT_L(n) asm volatile("s_waitcnt lgkmcnt(" #n ")" ::: "memory")
#define PG8_BAR __builtin_amdgcn_s_barrier()
#define PG8_SCHED __builtin_amdgcn_sched_barrier(0)
    Unit cur, nxt; int ui = 0;
    if (!S.next(0, cur)) return;
    f32x4 acc[2][2][4][2];
#pragma unroll
    for (int a = 0; a < 2; ++a)
#pragma unroll
        for (int b = 0; b < 2; ++b)
#pragma unroll
            for (int m = 0; m < 4; ++m)
#pragma unroll
                for (int n = 0; n < 2; ++n) acc[a][b][m][n] = (f32x4){0.f, 0.f, 0.f, 0.f};
    Frag At[4], B0[2], B1[2];
    unsigned ca[2][2], na[2][2];
    if constexpr (GA) S.aoffs(0, cur, tid, ca);
    const char* cB = S.bbase(cur); const char* cA = S.abase(Abase, cur);
    PG8_STAGE(PG8_SB(0, 0), cB, voffB); PG8_STAGEA(PG8_SA(0, 0), cA, 0); PG8_STAGE(PG8_SB(0, 1), cB + hstepB, voffB); PG8_STAGEA(PG8_SA(0, 1), cA, 1);
    if (wr == 1) PG8_BAR;
    PG8_WAIT_V(4); PG8_BAR;
    PG8_STAGE(PG8_SB(1, 0), cB + kstep, voffB); PG8_STAGEA(PG8_SA(1, 0), cA + kstep, 0); PG8_STAGE(PG8_SB(1, 1), cB + hstepB + kstep, voffB);
    PG8_WAIT_V(6); PG8_BAR;
    for (;;) {
        const bool has_next = S.next(ui + 1, nxt);
        const char* nB = has_next ? S.bbase(nxt) : cB; const char* nA = has_next ? S.abase(Abase, nxt) : cA;
        if constexpr (GA) {
            if (has_next) S.aoffs(ui + 1, nxt, tid, na);
            else {
#pragma unroll
                for (int h = 0; h < 2; ++h)
#pragma unroll
                    for (int i = 0; i < 2; ++i) na[h][i] = ca[h][i];
            }
        }
#pragma nounroll
        for (int t = 0; t < nt; t += 2) {
            const bool last = (t == nt - 2);
            const char* a1 = cA + (size_t)(t + 1) * kstep;
            const char* a2 = last ? nA : cA + (size_t)(t + 2) * kstep; const char* b2 = last ? nB : cB + (size_t)(t + 2) * kstep;
            const char* a3 = a2 + kstep; const char* b3 = b2 + kstep;
            if (t == 0 && wid == 0) { int tz = tid; asm volatile("" : "+v"(tz)); E.prefetch(cur, ept + (ui & 1) * 2048, tz & 63); }
            PG8_LDB(B0, 0, 0); PG8_SCHED; PG8_LDA(At, 0, 0); PG8_STAGEA(PG8_SA(1, 1), a1, 1);
            PG8_WAIT_L(8); PG8_BAR; PG8_WAIT_L(0); PG8_MMA(0, 0, At, B0); PG8_BAR; PG8_SCHED;
            if constexpr (GA) { if (last) {
#pragma unroll
                for (int h = 0; h < 2; ++h)
#pragma unroll
                    for (int i = 0; i < 2; ++i) ca[h][i] = na[h][i];
            } }
            PG8_LDB(B1, 0, 1); PG8_STAGE(PG8_SB(0, 0), b2, voffB);
            PG8_BAR; PG8_WAIT_L(0); PG8_MMA(0, 1, At, B1); PG8_BAR;
            PG8_LDA(At, 0, 1); PG8_STAGEA(PG8_SA(0, 0), a2, 0);
            PG8_BAR; PG8_WAIT_L(0); PG8_MMA(1, 0, At, B0); PG8_BAR; PG8_SCHED;
            PG8_STAGE(PG8_SB(0, 1), b2 + hstepB, voffB);
            PG8_WAIT_V(6); PG8_BAR; PG8_MMA(1, 1, At, B1); PG8_BAR;
            PG8_LDB(B0, 1, 0); PG8_SCHED; PG8_LDA(At, 1, 0); PG8_STAGEA(PG8_SA(0, 1), a2, 1);
            PG8_WAIT_L(8); PG8_BAR; PG8_WAIT_L(0); PG8_MMA(0, 0, At, B0); PG8_BAR; PG8_SCHED;
            PG8_LDB(B1, 1, 1); PG8_STAGE(PG8_SB(1, 0), b3, voffB);
            PG8_BAR; PG8_WAIT_L(0); PG8_MMA(0, 1, At, B1); PG8_BAR;
            PG8_LDA(At, 1, 1); PG8_STAGEA(PG8_SA(1, 0), a3, 0);
            PG8_BAR; PG8_WAIT_L(0); PG8_MMA(1, 0, At, B0); PG8_BAR; PG8_SCHED;
            PG8_STAGE(PG8_SB(1, 1), b3 + hstepB, voffB);
            PG8_WAIT_V(6); PG8_BAR; PG8_MMA(1, 1, At, B1); PG8_BAR;
        }
        { int tz = tid; asm volatile("" : "+v"(tz)); const int l2 = tz & 63; E(acc, cur, wr, wc, l2 & 15, l2 >> 4, ept + (ui & 1) * 2048); }
        if (!has_next) break;
#pragma unroll
        for (int a = 0; a < 2; ++a)
#pragma unroll
            for (int b = 0; b < 2; ++b)
#pragma unroll
                for (int m = 0; m < 4; ++m)
#pragma unroll
                    for (int n = 0; n < 2; ++n) acc[a][b][m][n] = (f32x4){0.f, 0.f, 0.f, 0.f};
        cur = nxt; cB = nB; cA = nA; ++ui;
    }
    PG8_WAIT_V(0);
    if (wr == 0) PG8_BAR;
    PG8_BAR;
#undef PG8_SA
#undef PG8_SB
#undef PG8_STAGE
#undef PG8_STAGEA
#undef PG8_LD1
#undef PG8_LDA
#undef PG8_LDB
#undef PG8_MMA
#undef PG8_WAIT_V
#undef PG8_WAIT_L
#undef PG8_BAR
#undef PG8_SCHED
}

__device__ __forceinline__ unsigned cvt4_fp8(float a, float b, float c, float d) { int w = 0; w = __builtin_amdgcn_cvt_pk_fp8_f32(a, b, w, false); w = __builtin_amdgcn_cvt_pk_fp8_f32(c, d, w, true); return (unsigned)w; }
__device__ __forceinline__ v4u pack8_bf16(const f32x4 a, const f32x4 b) { v4u w; w.x = cvt_pk_bf16(a[0], a[1]); w.y = cvt_pk_bf16(a[2], a[3]); w.z = cvt_pk_bf16(b[0], b[1]); w.w = cvt_pk_bf16(b[2], b[3]); return w; }
__device__ __forceinline__ void unpack8(const v4u w, f32x4& a, f32x4& b) { a = (f32x4){bflo(w[0]), bfhi(w[0]), bflo(w[1]), bfhi(w[1])}; b = (f32x4){bflo(w[2]), bfhi(w[2]), bflo(w[3]), bfhi(w[3])}; }
struct EpiBf16Scale {
    bf16* O; int ldc; const float* rs;
    __device__ __forceinline__ void prefetch(const Unit& u, LAS unsigned char* tab, int lane) const {
        if (rs) __builtin_amdgcn_global_load_lds((const unsigned*)(rs + u.pm * BM + 4 * lane), (LAS unsigned*)tab, 16, 0, 0);
    }
    __device__ __forceinline__ void operator()(const f32x4 (&acc)[2][2][4][2], const Unit& u, int wr, int wc, int fr, int fq, const LAS unsigned char* tab) const {
        const int row0 = u.pm * BM + wr * 64 + fr, col0 = u.pn * BM + wc * 64 + 8 * fq;
        float sc[8];
#pragma unroll
        for (int q = 0; q < 8; ++q) sc[q] = rs ? ((const LAS float*)tab)[wr * 64 + fr + (q >> 2) * HALF + (q & 3) * 16] : 1.f;
#pragma unroll
        for (int ai = 0; ai < 2; ++ai)
#pragma unroll
            for (int m = 0; m < 4; ++m) { const int row = row0 + ai * HALF + m * 16; const float s = sc[ai * 4 + m]; bf16* rowp = O + (size_t)row * ldc + col0;
#pragma unroll
                for (int bj = 0; bj < 2; ++bj) *(v4u*)(rowp + 32 * bj) = pack8_bf16(acc[ai][bj][m][0] * s, acc[ai][bj][m][1] * s); }
    }
};
struct EpiF8x16 {
    unsigned char* O8; int ldc;
    __device__ __forceinline__ void prefetch(const Unit&, LAS unsigned char*, int) const {}
    __device__ __forceinline__ void operator()(const f32x4 (&acc)[2][2][4][2], const Unit& u, int wr, int wc, int fr, int fq, const LAS unsigned char*) const {
        const int row0 = u.pm * BM + wr * 64 + fr, col0 = u.pn * BM + wc * 64 + 8 * fq;
#pragma unroll
        for (int ai = 0; ai < 2; ++ai)
#pragma unroll
            for (int m = 0; m < 4; ++m) { unsigned char* rowp = O8 + (size_t)(row0 + ai * HALF + m * 16) * ldc + col0;
#pragma unroll
                for (int bj = 0; bj < 2; ++bj) { const f32x4 v0 = acc[ai][bj][m][0] * 16.f, v1 = acc[ai][bj][m][1] * 16.f;
                    v2u w; w.x = cvt4_fp8(v0[0], v0[1], v0[2], v0[3]); w.y = cvt4_fp8(v1[0], v1[1], v1[2], v1[3]);
                    *(v2u*)(rowp + 32 * bj) = w; } }
    }
};
struct EpiProj {
    bf16* O; bf16* QKV; const float* rs;
    __device__ __forceinline__ void prefetch(const Unit& u, LAS unsigned char* tab, int lane) const {
        __builtin_amdgcn_global_load_lds((const unsigned*)(rs + u.pm * BM + 4 * lane), (LAS unsigned*)tab, 16, 0, 0);
    }
    __device__ __forceinline__ void operator()(const f32x4 (&acc)[2][2][4][2], const Unit& u, int wr, int wc, int fr, int fq, const LAS unsigned char* tab) const {
        const int row0 = u.pm * BM + wr * 64 + fr;
        float sc[8];
#pragma unroll
        for (int q = 0; q < 8; ++q) sc[q] = ((const LAS float*)tab)[wr * 64 + fr + (q >> 2) * HALF + (q & 3) * 16];
        const bool conv = u.pn < PCW / BM;
        const int cp = (conv ? u.pn : (u.pn - PCW / BM) & 3) * BM + wc * 64 + 8 * fq;
        const int part = (u.pn - PCW / BM) >> 2, h = cp >> 7, d = cp & 127;
#pragma unroll
        for (int ai = 0; ai < 2; ++ai)
#pragma unroll
            for (int m = 0; m < 4; ++m) { const int row = row0 + ai * HALF + m * 16; const float s = sc[ai * 4 + m];
                bf16* rowp = conv ? O + (size_t)row * PCW + cp : QKV + ((((size_t)part * NB + (row >> 12)) * NH + h) * SEQ + (row & (SEQ - 1))) * HD + d;
#pragma unroll
                for (int bj = 0; bj < 2; ++bj) *(v4u*)(rowp + 32 * bj) = pack8_bf16(acc[ai][bj][m][0] * s, acc[ai][bj][m][1] * s); }
    }
};
struct EpiResF32 {
    bf16* O; const bf16* X; int ldc; unsigned char* O8; float* ssq1;
    __device__ __forceinline__ void prefetch(const Unit&, LAS unsigned char*, int) const {}
    __device__ __forceinline__ void operator()(const f32x4 (&acc)[2][2][4][2], const Unit& u, int wr, int wc, int fr, int fq, const LAS unsigned char*) const {
        const int row0 = u.pm * BM + wr * 64 + fr, col0 = u.pn * BM + wc * 64 + 8 * fq;
#pragma unroll
        for (int ai = 0; ai < 2; ++ai) {
            v4u xw[4][2];
#pragma unroll
            for (int m = 0; m < 4; ++m)
#pragma unroll
                for (int bj = 0; bj < 2; ++bj) xw[m][bj] = *(const v4u*)(X + (size_t)(row0 + ai * HALF + m * 16) * ldc + col0 + 32 * bj);
#pragma unroll
            for (int m = 0; m < 4; ++m) { const int row = row0 + ai * HALF + m * 16; const size_t ro = (size_t)row * ldc + col0; float ss = 0.f;
#pragma unroll
                for (int bj = 0; bj < 2; ++bj) { f32x4 x0, x1; unpack8(xw[m][bj], x0, x1);
                    const f32x4 v0 = acc[ai][bj][m][0] + x0, v1 = acc[ai][bj][m][1] + x1;
#pragma unroll
                    for (int j = 0; j < 4; ++j) ss += v0[j] * v0[j] + v1[j] * v1[j];
                    v2u w8; w8.x = cvt4_fp8(v0[0], v0[1], v0[2], v0[3]); w8.y = cvt4_fp8(v1[0], v1[1], v1[2], v1[3]);
                    *(v2u*)(O8 + ro + 32 * bj) = w8; }
                ss += __shfl_xor(ss, 16); ss += __shfl_xor(ss, 32);
                if (fq == 0) ssq1[(size_t)(u.pn * 4 + wc) * T + row] = ss; }
        }
    }
};
struct EpiGateUp {
    unsigned char* Hp; const float* rr;
    __device__ __forceinline__ void prefetch(const Unit& u, LAS unsigned char* tab, int lane) const {
        __builtin_amdgcn_global_load_lds((const unsigned*)(rr + u.pm * BM + 4 * lane), (LAS unsigned*)tab, 16, 0, 0);
    }
    __device__ __forceinline__ void operator()(const f32x4 (&acc)[2][2][4][2], const Unit& u, int wr, int wc, int fr, int fq, const LAS unsigned char* tab) const {
        const int row0 = u.pm * BM + wr * 64 + fr, col0 = u.pn * HALF + wc * 32 + 8 * fq;
        float sc[8];
#pragma unroll
        for (int q = 0; q < 8; ++q) sc[q] = ((const LAS float*)tab)[wr * 64 + fr + (q >> 2) * HALF + (q & 3) * 16];
#pragma unroll
        for (int ai = 0; ai < 2; ++ai)
#pragma unroll
            for (int m = 0; m < 4; ++m) { const int row = row0 + ai * HALF + m * 16; const float s = sc[ai * 4 + m];
                const float sn = s * -1.4426950409f, is2 = __builtin_amdgcn_rcpf(s * s);
                float h[8];
#pragma unroll
                for (int n = 0; n < 2; ++n)
#pragma unroll
                    for (int j = 0; j < 4; ++j) { const float ag = acc[ai][0][m][n][j], au = acc[ai][1][m][n][j];
                        h[n * 4 + j] = (ag * au) * __builtin_amdgcn_rcpf(__builtin_fmaf(__builtin_amdgcn_exp2f(ag * sn), is2, is2)); }
                v2u w; w.x = cvt4_fp8(h[0], h[1], h[2], h[3]); w.y = cvt4_fp8(h[4], h[5], h[6], h[7]);
                *(v2u*)(Hp + (size_t)row * ED + col0) = w; }
    }
};
struct EpiDown {
    unsigned char* S0; unsigned char* S1; unsigned char* S8; const float* rw; const int* rdst;
    __device__ __forceinline__ void prefetch(const Unit& u, LAS unsigned char* tab, int lane) const {
        __builtin_amdgcn_global_load_lds((const unsigned*)(rw + u.pm * BM + 4 * lane), (LAS unsigned*)tab, 16, 0, 0);
        __builtin_amdgcn_global_load_lds((const unsigned*)(rdst + u.pm * BM + 4 * lane), (LAS unsigned*)(tab + 1024), 16, 0, 0);
    }
    __device__ __forceinline__ void operator()(const f32x4 (&acc)[2][2][4][2], const Unit& u, int wr, int wc, int fr, int fq, const LAS unsigned char* tab) const {
        const int row0 = u.pm * BM + wr * 64 + fr, col0 = u.pn * BM + wc * 64 + 16 * fq;
        float sc[8]; int ds[8];
#pragma unroll
        for (int q = 0; q < 8; ++q) { const int lr = wr * 64 + fr + (q >> 2) * HALF + (q & 3) * 16; sc[q] = ((const LAS float*)tab)[lr]; ds[q] = ((const LAS int*)(tab + 1024))[lr]; }
#pragma unroll
        for (int ai = 0; ai < 2; ++ai)
#pragma unroll
            for (int m = 0; m < 4; ++m) { const float s = sc[ai * 4 + m] * SLOT_SCALE; const int dst = ds[ai * 4 + m];
                if (dst >= 0) { unsigned char* rowp = (dst < 4 * T ? S0 + (size_t)dst * D : dst < 8 * T ? S1 + (size_t)(dst - 4 * T) * D : S8 + (size_t)(dst - 8 * T) * D) + col0;
                    v4u w;
#pragma unroll
                    for (int bj = 0; bj < 2; ++bj) { const f32x4 v0 = acc[ai][bj][m][0] * s, v1 = acc[ai][bj][m][1] * s;
                        w[2 * bj] = cvt4_fp8(v0[0], v0[1], v0[2], v0[3]); w[2 * bj + 1] = cvt4_fp8(v1[0], v1[1], v1[2], v1[3]); }
                    *(v4u*)rowp = w; } }
    }
};
struct EpiPle {
    unsigned char* H3; const unsigned char* H2; const unsigned char* PP; const float* ssq2; float* ssq3;
    __device__ __forceinline__ void prefetch(const Unit&, LAS unsigned char*, int) const {}
    __device__ __forceinline__ void operator()(const f32x4 (&acc)[2][2][4][2], const Unit& u, int wr, int wc, int fr, int fq, const LAS unsigned char*) const {
        const int row0 = u.pm * BM + wr * 64 + fr, col0 = u.pn * BM + wc * 64 + 8 * fq;
        float sq[8];
#pragma unroll
        for (int q = 0; q < 8; ++q) sq[q] = ssq2[row0 + (q >> 2) * HALF + (q & 3) * 16];
#pragma unroll
        for (int ai = 0; ai < 2; ++ai)
#pragma unroll
            for (int mp = 0; mp < 2; ++mp) {
                v2u hw[2][2]; v2u pw[2][2];
#pragma unroll
                for (int mm = 0; mm < 2; ++mm)
#pragma unroll
                    for (int bj = 0; bj < 2; ++bj) { const size_t o = (size_t)(row0 + ai * HALF + (2 * mp + mm) * 16) * D + col0 + 32 * bj; hw[mm][bj] = *(const v2u*)(H2 + o); pw[mm][bj] = *(const v2u*)(PP + o); }
#pragma unroll
                for (int mm = 0; mm < 2; ++mm) { const int m = 2 * mp + mm, row = row0 + ai * HALF + m * 16;
                    const float rn = __builtin_amdgcn_rsqf(sq[ai * 4 + m] * (1.f / D) + EPS) * -1.4426950409f;
                    const size_t ro = (size_t)row * D + col0; float ss = 0.f;
#pragma unroll
                    for (int bj = 0; bj < 2; ++bj) { f32x4 h0, h1, p0, p1;
                        { const f32x2 a = __builtin_amdgcn_cvt_pk_f32_fp8((int)hw[mm][bj].x, false), b = __builtin_amdgcn_cvt_pk_f32_fp8((int)hw[mm][bj].x, true),
                                      c = __builtin_amdgcn_cvt_pk_f32_fp8((int)hw[mm][bj].y, false), d = __builtin_amdgcn_cvt_pk_f32_fp8((int)hw[mm][bj].y, true);
                          h0 = (f32x4){a.x, a.y, b.x, b.y}; h1 = (f32x4){c.x, c.y, d.x, d.y}; }
                        { const f32x2 a = __builtin_amdgcn_cvt_pk_f32_fp8((int)pw[mm][bj].x, false), b = __builtin_amdgcn_cvt_pk_f32_fp8((int)pw[mm][bj].x, true),
                                      c = __builtin_amdgcn_cvt_pk_f32_fp8((int)pw[mm][bj].y, false), d = __builtin_amdgcn_cvt_pk_f32_fp8((int)pw[mm][bj].y, true);
                          p0 = (f32x4){a.x, a.y, b.x, b.y}; p1 = (f32x4){c.x, c.y, d.x, d.y}; }
                        f32x4 o0, o1;
#pragma unroll
                        for (int j = 0; j < 4; ++j) {
                            o0[j] = h0[j] + p0[j] * __builtin_amdgcn_rcpf(__builtin_fmaf(__builtin_amdgcn_exp2f(acc[ai][bj][m][0][j] * rn), 16.f, 16.f));
                            o1[j] = h1[j] + p1[j] * __builtin_amdgcn_rcpf(__builtin_fmaf(__builtin_amdgcn_exp2f(acc[ai][bj][m][1][j] * rn), 16.f, 16.f));
                            ss += o0[j] * o0[j] + o1[j] * o1[j]; }
                        v2u w8; w8.x = cvt4_fp8(o0[0], o0[1], o0[2], o0[3]); w8.y = cvt4_fp8(o1[0], o1[1], o1[2], o1[3]);
                        *(v2u*)(H3 + ro + 32 * bj) = w8; }
                    ss += __shfl_xor(ss, 16); ss += __shfl_xor(ss, 32);
                    if (fq == 0) ssq3[(size_t)(u.pn * 4 + wc) * T + row] = ss; }
            }
    }
};
}

struct Frame {
    LAS unsigned char* lds;
    int tid, lane, wave, G, bx;
    unsigned char* ws;
    const float* in[21];
    float* out;
};
enum { I_X = 0, I_P, I_NMIX, I_WIN, I_CONVW, I_GCONV, I_GSB, I_WOUT, I_NFFN, I_WR, I_RB, I_WEG, I_WEU, I_WED, I_WSG, I_WSU, I_WSD, I_NPLE, I_WPG, I_WPP, I_NFIN };

__device__ __forceinline__ void p0_transpose_item(const float* W, int N, bf16* WT, int ldk, int k0, int n0, int row_off, const float* g64, LAS float* scr, int lane) {
    const int n4 = lane & 15, kr = lane >> 4;
    f32x4 v[16];
    const float* src = W + (size_t)(k0 + kr) * N + n0 + 4 * n4;
#pragma unroll
    for (int i = 0; i < 16; ++i) v[i] = *(const GAS f32x4*)(src + (size_t)(4 * i) * N);
    const int c = lane >> 3, nn = lane & 7;
    f32x4 ga = (f32x4){1.f, 1.f, 1.f, 1.f}, gb = ga;
    if (g64) { ga = *(const GAS f32x4*)(g64 + 8 * c); gb = *(const GAS f32x4*)(g64 + 8 * c + 4); }
#pragma unroll
    for (int i = 0; i < 16; ++i) { LAS float* d = scr + (4 * i + kr) * 65 + 4 * n4; d[0] = v[i].x; d[1] = v[i].y; d[2] = v[i].z; d[3] = v[i].w; }
    LDS_WAIT(); asm volatile("" ::: "memory");
#pragma unroll
    for (int j = 0; j < 8; ++j) { const int n = nn + 8 * j; const LAS float* s = scr + (8 * c) * 65 + n;
        v4u o; o.x = pg8::cvt_pk_bf16(s[0] * ga.x, s[65] * ga.y); o.y = pg8::cvt_pk_bf16(s[130] * ga.z, s[195] * ga.w); o.z = pg8::cvt_pk_bf16(s[260] * gb.x, s[325] * gb.y); o.w = pg8::cvt_pk_bf16(s[390] * gb.z, s[455] * gb.w);
        *(GAS v4u*)(WT + (size_t)(row_off + n) * ldk + k0 + 8 * c) = o; }
    LDS_WAIT(); asm volatile("" ::: "memory");
}
__device__ __forceinline__ void p0_transpose_item_f8(const float* W, int N, unsigned char* WT, int ldk, int k0, int n0, int row_off, int mode, const float* g64, LAS float* scr, int lane) {
    const int n4 = lane & 15, kr = lane >> 4;
    f32x4 v[16];
    const float* src = W + (size_t)(k0 + kr) * N + n0 + 4 * n4;
#pragma unroll
    for (int i = 0; i < 16; ++i) v[i] = *(const GAS f32x4*)(src + (size_t)(4 * i) * N);
    const int c = lane >> 4, nn = lane & 15;
    float g[16];
#pragma unroll
    for (int q = 0; q < 4; ++q) { f32x4 t = (f32x4){1.f, 1.f, 1.f, 1.f}; if (g64) t = *(const GAS f32x4*)(g64 + 16 * c + 4 * q); g[4 * q] = 64.f * t.x; g[4 * q + 1] = 64.f * t.y; g[4 * q + 2] = 64.f * t.z; g[4 * q + 3] = 64.f * t.w; }
#pragma unroll
    for (int i = 0; i < 16; ++i) { LAS float* d = scr + (4 * i + kr) * 65 + 4 * n4; d[0] = v[i].x; d[1] = v[i].y; d[2] = v[i].z; d[3] = v[i].w; }
    LDS_WAIT(); asm volatile("" ::: "memory");
#pragma unroll
    for (int j = 0; j < 4; ++j) { const int n = nn + 16 * j; const LAS float* s = scr + (16 * c) * 65 + n;
        v4u o;
        o.x = pg8::cvt4_fp8(s[0] * g[0], s[65] * g[1], s[130] * g[2], s[195] * g[3]); o.y = pg8::cvt4_fp8(s[260] * g[4], s[325] * g[5], s[390] * g[6], s[455] * g[7]);
        o.z = pg8::cvt4_fp8(s[520] * g[8], s[585] * g[9], s[650] * g[10], s[715] * g[11]); o.w = pg8::cvt4_fp8(s[780] * g[12], s[845] * g[13], s[910] * g[14], s[975] * g[15]);
        const int hid = n0 + n, drow = mode == 0 ? row_off + n : 16 * (hid >> 3) + 8 * (mode - 1) + (hid & 7);
        *(GAS v4u*)(WT + (size_t)drow * ldk + k0 + 16 * c) = o; }
    LDS_WAIT(); asm volatile("" ::: "memory");
}
constexpr int P0_I_WIN = (D / 64) * (NPROJ / 64), P0_I_WOUT = (D / 64) * (D / 64), P0_I_WR = (D / 64) * (NE / 64), P0_I_WPG = (D / 64) * (D / 64), P0_I_WPP = (PLE / 64) * (D / 64);
struct ExpItem { const float* src; const float* g128; unsigned char* dst; int N, ldk, k0, n0, mode; };
__device__ __forceinline__ void exp_issue(const ExpItem& I, int lane, f32x4 (&v)[32], f32x4 (&gq)[8]) {
    const int n4 = lane & 15, kr = lane >> 4;
#pragma unroll
    for (int q = 0; q < 8; ++q) { gq[q] = (f32x4){1.f, 1.f, 1.f, 1.f}; if (I.g128) gq[q] = *(const GAS f32x4*)(I.g128 + 64 * (q >> 2) + 16 * (lane >> 4) + 4 * (q & 3)); }
    const float* src = I.src + (size_t)(I.k0 + kr) * I.N + I.n0 + 4 * n4;
#pragma unroll
    for (int i = 0; i < 32; ++i) v[i] = *(const GAS f32x4*)(src + (size_t)(4 * i) * I.N);
}
template <int H> __device__ __forceinline__ void exp_finish_half(const ExpItem& I, int lane, const f32x4 (&v)[32], const f32x4 (&gq)[8], LAS float* scr) {
    const int n4 = lane & 15, kr = lane >> 4, c = lane >> 4, nn = lane & 15;
    float g[16];
#pragma unroll
    for (int q = 0; q < 4; ++q) { g[4 * q] = 64.f * gq[4 * H + q].x; g[4 * q + 1] = 64.f * gq[4 * H + q].y; g[4 * q + 2] = 64.f * gq[4 * H + q].z; g[4 * q + 3] = 64.f * gq[4 * H + q].w; }
#pragma unroll
    for (int i = 0; i < 16; ++i) { LAS float* d = scr + (4 * i + kr) * 65 + 4 * n4; d[0] = v[16 * H + i].x; d[1] = v[16 * H + i].y; d[2] = v[16 * H + i].z; d[3] = v[16 * H + i].w; }
    LDS_WAIT(); asm volatile("" ::: "memory");
#pragma unroll
    for (int j = 0; j < 4; ++j) { const int n = nn + 16 * j; const LAS float* s = scr + (16 * c) * 65 + n;
        v4u o;
        o.x = pg8::cvt4_fp8(s[0] * g[0], s[65] * g[1], s[130] * g[2], s[195] * g[3]); o.y = pg8::cvt4_fp8(s[260] * g[4], s[325] * g[5], s[390] * g[6], s[455] * g[7]);
        o.z = pg8::cvt4_fp8(s[520] * g[8], s[585] * g[9], s[650] * g[10], s[715] * g[11]); o.w = pg8::cvt4_fp8(s[780] * g[12], s[845] * g[13], s[910] * g[14], s[975] * g[15]);
        const int hid = I.n0 + n, drow = I.mode == 0 ? hid : 16 * (hid >> 3) + 8 * (I.mode - 1) + (hid & 7);
        *(GAS v4u*)(I.dst + (size_t)drow * I.ldk + I.k0 + 64 * H + 16 * c) = o; }
    LDS_WAIT(); asm volatile("" ::: "memory");
}
constexpr int P0_NONEXP = P0_I_WIN + P0_I_WOUT + P0_I_WR + P0_I_WPG + P0_I_WPP;
constexpr int P0_I_EXP = 768, P0_NITEMS = P0_I_WIN + P0_I_WOUT + P0_I_WR + P0_I_WPG + P0_I_WPP + 65 * P0_I_EXP;
__device__ __forceinline__ void p0_item(Frame& F, int it, LAS float* scr) {
    unsigned char* ws = F.ws; const int lane = F.lane;
    if (it < P0_I_WIN) { const int kb = it / (NPROJ / 64), nb = it % (NPROJ / 64); p0_transpose_item(F.in[I_WIN], NPROJ, (bf16*)(ws + WS_WIN), D, 64 * kb, 64 * nb, 64 * nb, F.in[I_NMIX] + 64 * kb, scr, lane); return; } it -= P0_I_WIN;
    if (it < P0_I_WOUT) { const int kb = it / (D / 64), nb = it % (D / 64), k0 = 64 * kb; const float* g = k0 < CW ? F.in[I_GCONV] + k0 : F.in[I_GSB] + (k0 - CW);
        p0_transpose_item_f8(F.in[I_WOUT], D, ws + WS_WOUT, D, k0, 64 * nb, 64 * nb, 0, g, scr, lane); return; } it -= P0_I_WOUT;
    if (it < P0_I_WR) return; it -= P0_I_WR;
    if (it < P0_I_WPG) { const int kb = it / (D / 64), nb = it % (D / 64); p0_transpose_item_f8(F.in[I_WPG], D, ws + WS_WPG, D, 64 * kb, 64 * nb, 64 * nb, 0, F.in[I_NPLE] + 64 * kb, scr, lane); return; } it -= P0_I_WPG;
    if (it < P0_I_WPP) { const int kb = it / (D / 64), nb = it % (D / 64); p0_transpose_item(F.in[I_WPP], D, (bf16*)(ws + WS_WPP), PLE, 64 * kb, 64 * nb, 64 * nb, nullptr, scr, lane); return; } it -= P0_I_WPP;
    const int e = it / P0_I_EXP, r = it % P0_I_EXP, sub = r / 256, q = r % 256;
    if (sub < 2) {
        const float* src = e < NE ? (sub == 0 ? F.in[I_WEG] : F.in[I_WEU]) + (size_t)e * D * ED : (sub == 0 ? F.in[I_WSG] : F.in[I_WSU]);
        const int kb = q / (ED / 64), nb = q % (ED / 64), n0 = 64 * nb;
        p0_transpose_item_f8(src, ED, ws + WS_WGU + (size_t)e * 1024 * D, D, 64 * kb, n0, 0, 1 + sub, F.in[I_NFFN] + 64 * kb, scr, lane);
    } else {
        const float* src = e < NE ? F.in[I_WED] + (size_t)e * ED * D : F.in[I_WSD];
        const int kb = q / (D / 64), nb = q % (D / 64);
        p0_transpose_item_f8(src, D, ws + WS_WDN + (size_t)e * D * ED, ED, 64 * kb, 64 * nb, 64 * nb, 0, nullptr, scr, lane);
    }
}
constexpr int EXP_ITEMS_PER = 384, EXP_ITEMS = 65 * EXP_ITEMS_PER;
__device__ __forceinline__ ExpItem exp_decode(Frame& F, int it) {
    unsigned char* ws = F.ws; ExpItem I;
    const int e = it / EXP_ITEMS_PER, r = it % EXP_ITEMS_PER, sub = r / 128, q = r % 128;
    if (sub < 2) { I.src = e < NE ? (sub == 0 ? F.in[I_WEG] : F.in[I_WEU]) + (size_t)e * D * ED : (sub == 0 ? F.in[I_WSG] : F.in[I_WSU]);
        const int kb = q / (ED / 64), nb = q % (ED / 64); I.N = ED; I.dst = ws + WS_WGU + (size_t)e * 1024 * D; I.ldk = D; I.k0 = 128 * kb; I.n0 = 64 * nb; I.mode = 1 + sub; I.g128 = F.in[I_NFFN] + 128 * kb; }
    else { I.src = e < NE ? F.in[I_WED] + (size_t)e * ED * D : F.in[I_WSD];
        const int kb = q / (D / 64), nb = q % (D / 64); I.N = D; I.dst = ws + WS_WDN + (size_t)e * D * ED; I.ldk = ED; I.k0 = 128 * kb; I.n0 = 64 * nb; I.mode = 0; I.g128 = nullptr; }
    return I;
}
__device__ __forceinline__ void p0_xpass(Frame& F) {
    const int lane = F.lane, r16 = lane & 15, g = lane >> 4, tid = F.tid;
    const float* x = F.in[I_X]; const float* wr = F.in[I_WR]; const float* gf = F.in[I_NFFN]; const float* wo = F.in[I_WOUT];
    bf16* XB = (bf16*)F.out; float* rmix = (float*)(F.ws + WS_RMIX); float* logx = (float*)(F.ws + WS_LOGX); bf16* wor = (bf16*)(F.ws + WS_WOR);
    LAS unsigned char* WL = F.lds;
    const int NGW = F.G * NWAVES;
    for (int u0 = F.bx * NWAVES; u0 < T / 16; u0 += NGW) {
        const int unit = u0 + F.wave; const bool act = unit < T / 16; const int t0 = unit * 16;
        const bool wact = act && (unit & 15) == 0; const int k0w = unit;
        f32x4 acc[4], acw[4];
#pragma unroll
        for (int nb = 0; nb < 4; ++nb) { acc[nb] = (f32x4){0.f, 0.f, 0.f, 0.f}; acw[nb] = (f32x4){0.f, 0.f, 0.f, 0.f}; }
        float ss = 0.f;
        for (int kc = 0; kc < 4; ++kc) {
            __syncthreads();
            { const int k = 512 * kc + tid; const float gk = gf[k]; const float* wp = wr + (size_t)k * NE;
#pragma unroll
              for (int q = 0; q < 16; ++q) { const f32x4 v = *(const GAS f32x4*)(wp + 4 * q);
                  *(LAS unsigned short*)(WL + (4 * q + 0) * 1040 + 2 * tid) = (unsigned short)f2bf(v.x * gk); *(LAS unsigned short*)(WL + (4 * q + 1) * 1040 + 2 * tid) = (unsigned short)f2bf(v.y * gk);
                  *(LAS unsigned short*)(WL + (4 * q + 2) * 1040 + 2 * tid) = (unsigned short)f2bf(v.z * gk); *(LAS unsigned short*)(WL + (4 * q + 3) * 1040 + 2 * tid) = (unsigned short)f2bf(v.w * gk); } }
            __syncthreads();
            if (act) {
                f32x4 xv[16][2];
                const float* xp = x + (size_t)(t0 + r16) * D + 512 * kc + 8 * g;
#pragma unroll
                for (int ks = 0; ks < 16; ++ks) { xv[ks][0] = *(const GAS f32x4*)(xp + 32 * ks); xv[ks][1] = *(const GAS f32x4*)(xp + 32 * ks + 4); }
#pragma unroll
                for (int ks = 0; ks < 16; ++ks) { const f32x4 a0 = xv[ks][0], a1 = xv[ks][1];
                    ss += (a0.x * a0.x + a0.y * a0.y) + (a0.z * a0.z + a0.w * a0.w) + (a1.x * a1.x + a1.y * a1.y) + (a1.z * a1.z + a1.w * a1.w);
                    v4u w; w.x = pg8::cvt_pk_bf16(a0.x, a0.y); w.y = pg8::cvt_pk_bf16(a0.z, a0.w); w.z = pg8::cvt_pk_bf16(a1.x, a1.y); w.w = pg8::cvt_pk_bf16(a1.z, a1.w);
                    *(GAS v4u*)(XB + (size_t)(t0 + r16) * D + 512 * kc + 32 * ks + 8 * g) = w;
                    const bf16x8 af = __builtin_bit_cast(bf16x8, w);
#pragma unroll
                    for (int nb = 0; nb < 4; ++nb) { const bf16x8 bf = *(const LAS bf16x8*)(WL + (16 * nb + r16) * 1040 + 64 * ks + 16 * g); acc[nb] = __builtin_amdgcn_mfma_f32_16x16x32_bf16(af, bf, acc[nb], 0, 0, 0); } }
            }
            if (wact) {
                const float* wp = wo + (size_t)(k0w + r16) * D + 512 * kc + 8 * g;
                f32x4 wv[16][2];
#pragma unroll
                for (int ks = 0; ks < 16; ++ks) { wv[ks][0] = *(const GAS f32x4*)(wp + 32 * ks); wv[ks][1] = *(const GAS f32x4*)(wp + 32 * ks + 4); }
#pragma unroll
                for (int ks = 0; ks < 16; ++ks) { const f32x4 a0 = wv[ks][0], a1 = wv[ks][1];
                    v4u w; w.x = pg8::cvt_pk_bf16(a0.x, a0.y); w.y = pg8::cvt_pk_bf16(a0.z, a0.w); w.z = pg8::cvt_pk_bf16(a1.x, a1.y); w.w = pg8::cvt_pk_bf16(a1.z, a1.w);
                    const bf16x8 af = __builtin_bit_cast(bf16x8, w);
#pragma unroll
                    for (int nb = 0; nb < 4; ++nb) { const bf16x8 bf = *(const LAS bf16x8*)(WL + (16 * nb + r16) * 1040 + 64 * ks + 16 * g); acw[nb] = __builtin_amdgcn_mfma_f32_16x16x32_bf16(af, bf, acw[nb], 0, 0, 0); } }
            }
        }
        if (act) {
            ss += __shfl_xor(ss, 16); ss += __shfl_xor(ss, 32);
            if (g == 0) rmix[t0 + r16] = __builtin_amdgcn_rsqf(ss * (1.f / D) + EPS);
#pragma unroll
            for (int nb = 0; nb < 4; ++nb)
#pragma unroll
                for (int j = 0; j < 4; ++j) logx[(size_t)(t0 + 4 * g + j) * NE + 16 * nb + r16] = acc[nb][j];
        }
        if (wact) {
#pragma unroll
            for (int j = 0; j < 4; ++j) { const int k = k0w + 4 * g + j; const float gk = k < CW ? F.in[I_GCONV][k] : F.in[I_GSB][k - CW];
#pragma unroll
                for (int nb = 0; nb < 4; ++nb) wor[(size_t)(16 * nb + r16) * D + k] = (bf16)f2bf(acw[nb][j] * gk); }
        }
    }
    __syncthreads();
}
__device__ __forceinline__ void p0_prologue(Frame& F) {
    LAS float* scr = (LAS float*)(F.lds + RING_OFF + F.wave * 16896);
    const int gw = F.bx * NWAVES + F.wave, NGW = F.G * NWAVES;
    p0_xpass(F);
    {
        const float* p = F.in[I_P]; bf16* PB = (bf16*)(F.ws + WS_PB);
        const int nchunk = T * PLE / 8, gt = F.bx * NTHR + F.tid, NGT = F.G * NTHR;
        for (int c0 = gt; c0 < nchunk; c0 += 8 * NGT) {
            f32x4 a[8], b[8];
#pragma unroll
            for (int i = 0; i < 8; ++i) { const int c = c0 + i * NGT, cc = c < nchunk ? c : gt; a[i] = *(const GAS f32x4*)(p + (size_t)cc * 8); b[i] = *(const GAS f32x4*)(p + (size_t)cc * 8 + 4); }
#pragma unroll
            for (int i = 0; i < 8; ++i) { const int c = c0 + i * NGT;
                if (c < nchunk) { v4u w; w.x = pk2(a[i].x, a[i].y); w.y = pk2(a[i].z, a[i].w); w.z = pk2(b[i].x, b[i].y); w.w = pk2(b[i].z, b[i].w); *(GAS v4u*)(PB + (size_t)c * 8) = w; } }
        }
    }
    for (int it = gw; it < P0_NONEXP; it += NGW) p0_item(F, it, scr);
}

__device__ __forceinline__ unsigned off_b(unsigned row, unsigned ch) { return 256u * row + 16u * (ch ^ (((row & 3) << 2) | ((row >> 2) & 3))); }
#define MFMA32(a, b, c) __builtin_amdgcn_mfma_f32_32x32x16_bf16((a), (b), (c), 0, 0, 0)

__device__ __forceinline__ void conv_item(Frame& F, int it) {
    const bf16* proj = (const bf16*)(F.ws + WS_PROJ); bf16* ymix = (bf16*)F.out + (size_t)T * D;
    const float* cw = F.in[I_CONVW]; const int lane = F.lane;
    float w0[16], w1[16], w2[16], u1[16], u2[16];
#pragma unroll
    for (int j = 0; j < 2; ++j)
#pragma unroll
        for (int i = 0; i < 8; ++i) { const int c = 512 * j + 8 * lane + i; w0[8 * j + i] = cw[c]; w1[8 * j + i] = cw[CW + c]; w2[8 * j + i] = cw[2 * CW + c]; u1[8 * j + i] = 0.f; u2[8 * j + i] = 0.f; }
    const int t0 = 16 * it; const bool seq_start = (t0 & (SEQ - 1)) == 0;
    for (int g = 0; g < 6; ++g) {
        v4u hw[3][2], cwv[3][2], bw[3][2];
#pragma unroll
        for (int q = 0; q < 3; ++q) { const long t = (long)t0 - 2 + 3 * g + q; const bf16* pr = proj + t * PCW + 8 * lane;
#pragma unroll
            for (int j = 0; j < 2; ++j) { hw[q][j] = *(const GAS v4u*)(pr + 512 * j); cwv[q][j] = *(const GAS v4u*)(pr + 2 * CW + 512 * j); bw[q][j] = *(const GAS v4u*)(pr + CW + 512 * j); } }
#pragma unroll
        for (int q = 0; q < 3; ++q) { const int tt = -2 + 3 * g + q; const long t = (long)t0 + tt;
            float u[16];
#pragma unroll
            for (int j = 0; j < 2; ++j)
#pragma unroll
                for (int k = 0; k < 4; ++k) { u[8 * j + 2 * k] = bflo(hw[q][j][k]) * bflo(cwv[q][j][k]); u[8 * j + 2 * k + 1] = bfhi(hw[q][j][k]) * bfhi(cwv[q][j][k]); }
            if (tt < 0 && seq_start) {
#pragma unroll
                for (int i = 0; i < 16; ++i) u[i] = 0.f;
            }
            if (tt >= 0) {
                float y[16], ss = 0.f;
#pragma unroll
                for (int j = 0; j < 2; ++j)
#pragma unroll
                    for (int k = 0; k < 4; ++k) { const int i = 8 * j + 2 * k;
                        y[i] = bflo(bw[q][j][k]) * (w0[i] * u2[i] + w1[i] * u1[i] + w2[i] * u[i]); y[i + 1] = bfhi(bw[q][j][k]) * (w0[i + 1] * u2[i + 1] + w1[i + 1] * u1[i + 1] + w2[i + 1] * u[i + 1]);
                        ss += y[i] * y[i] + y[i + 1] * y[i + 1]; }
                const float r = __builtin_amdgcn_rsqf(wave_sum(ss) * (1.f / CW) + EPS);
                bf16* yo = ymix + t * D + 8 * lane;
#pragma unroll
                for (int j = 0; j < 2; ++j) { v4u w; w.x = pg8::cvt_pk_bf16(y[8 * j] * r, y[8 * j + 1] * r); w.y = pg8::cvt_pk_bf16(y[8 * j + 2] * r, y[8 * j + 3] * r); w.z = pg8::cvt_pk_bf16(y[8 * j + 4] * r, y[8 * j + 5] * r); w.w = pg8::cvt_pk_bf16(y[8 * j + 6] * r, y[8 * j + 7] * r);
                    *(GAS v4u*)(yo + 512 * j) = w;
                    v2u w8; w8.x = pg8::cvt4_fp8(y[8 * j] * r, y[8 * j + 1] * r, y[8 * j + 2] * r, y[8 * j + 3] * r); w8.y = pg8::cvt4_fp8(y[8 * j + 4] * r, y[8 * j + 5] * r, y[8 * j + 6] * r, y[8 * j + 7] * r);
                    *(GAS v2u*)(F.ws + WS_YMIX8 + (size_t)t * D + 8 * lane + 512 * j) = w8; }
            }
#pragma unroll
            for (int i = 0; i < 16; ++i) { u2[i] = u1[i]; u1[i] = u[i]; }
        }
    }
}

__device__ __forceinline__ bf16x8 pack8(float a0, float a1, float a2, float a3, float a4, float a5, float a6, float a7) {
    v4u p; p.x = pg8::cvt_pk_bf16(a0, a1); p.y = pg8::cvt_pk_bf16(a2, a3); p.z = pg8::cvt_pk_bf16(a4, a5); p.w = pg8::cvt_pk_bf16(a6, a7); return __builtin_bit_cast(bf16x8, p);
}
__device__ __forceinline__ void tr_read4(unsigned a_t0, unsigned a_t1, s16x4& r00, s16x4& r01, s16x4& r10, s16x4& r11) {
    asm volatile("ds_read_b64_tr_b16 %0, %4\n\tds_read_b64_tr_b16 %1, %5\n\tds_read_b64_tr_b16 %2, %4 offset:4096\n\tds_read_b64_tr_b16 %3, %5 offset:4096\n\ts_waitcnt lgkmcnt(0)"
                 : "=&v"(r00), "=&v"(r01), "=&v"(r10), "=&v"(r11) : "v"(a_t0), "v"(a_t1) : "memory");
}
constexpr float ATT_C = 0.08838834764831845f * 1.4426950408889634f;
constexpr float ATT_EXIT = -152.f;

__device__ __forceinline__ float attn_head(Frame& F, int lw, int h, int b, int qblk, f32x16 (&oacc)[4]) {
    const int lane = F.lane, r = lane & 31, hh = lane >> 5;
    const bf16* qkv = (const bf16*)(F.ws + WS_QKV);
    const size_t hb = ((size_t)b * NH + h) * SEQ;
    const int t0 = qblk * 32;
    LAS unsigned char* kt = F.lds + lw * 16384; LAS unsigned char* vt = kt + 8192;
    bf16x8 qf[8];
    { const bf16* qp = qkv + (hb + t0 + r) * HD + 8 * hh;
#pragma unroll
      for (int kk = 0; kk < 8; ++kk) qf[kk] = *(const GAS bf16x8*)(qp + 16 * kk); }
#pragma unroll
    for (int c = 0; c < 4; ++c)
#pragma unroll
        for (int i = 0; i < 16; ++i) oacc[c][i] = 0.f;
    float L = 0.f;
    const unsigned pr = (unsigned)((r & 19) | ((r & 4) << 1) | ((r & 8) >> 1));
    const unsigned ktb = (unsigned)(size_t)kt, vtb = (unsigned)(size_t)vt;
    unsigned va[2][4];
    { const unsigned blk = (lane >> 4) & 1, q = (lane & 15) >> 2, p = lane & 3;
#pragma unroll
      for (int t = 0; t < 2; ++t)
#pragma unroll
          for (int c = 0; c < 4; ++c) va[t][c] = vtb + off_b(8 * hh + 4 * t + q, 4 * c + 2 * blk + (p >> 1)) + 8 * (p & 1); }
    unsigned loff[8];
#pragma unroll
    for (int i = 0; i < 8; ++i) { const unsigned row = 4 * i + (lane >> 4), ch = (lane & 15) ^ (((row & 3) << 2) | ((row >> 2) & 3)); loff[i] = (row * HD + ch * 8) * 2; }
    const char* kvb = (const char*)(qkv + ((size_t)NB * NH * SEQ + hb) * HD);
    constexpr size_t VOFF = (size_t)NB * NH * SEQ * HD * 2;
#define ATT_DMA(ldsb, gp) do { _Pragma("unroll") for (int _i = 0; _i < 8; ++_i) \
        __builtin_amdgcn_global_load_lds((const unsigned*)((gp) + loff[_i]), (LAS unsigned*)((ldsb) + _i * 1024), 16, 0, 0); } while (0)
    { const char* g0 = kvb + (size_t)(qblk * 32) * HD * 2; ATT_DMA(kt, g0); ATT_DMA(vt, g0 + VOFF); }
    for (int kti = qblk; kti >= 0; --kti) {
        const int s0 = kti * 32;
        const char* gn = kvb + (size_t)((kti > 0 ? kti - 1 : 0) * 32) * HD * 2;
        asm volatile("s_waitcnt vmcnt(8)" ::: "memory");
        f32x16 x;
#pragma unroll
        for (int i = 0; i < 16; ++i) x[i] = 0.f;
        bf16x8 kf[8];
#pragma unroll
        for (int kk = 0; kk < 8; ++kk) kf[kk] = *(const LAS bf16x8*)(kt + off_b(pr, 2 * kk + hh));
        LDS_WAIT();
        ATT_DMA(kt, gn);
#pragma unroll
        for (int kk = 0; kk < 8; ++kk) x = MFMA32(kf[kk], qf[kk], x);
        const bool diag = (kti == qblk);
        float zz[16], suf[16];
#pragma unroll
        for (int i = 0; i < 16; ++i) {
            zz[i] = x[i] * ATT_C;
            const float e = __builtin_amdgcn_exp2f(fminf(zz[i], 126.f));
            float l = -__builtin_amdgcn_logf(1.f + e);
            const int kap = 16 * (i >> 3) + 8 * hh + (i & 7);
            if (diag && !(kap < r)) l = 0.f;
            suf[i] = l;
        }
#pragma unroll
        for (int j = 6; j >= 0; --j) { suf[j] += suf[j + 1]; suf[8 + j] += suf[8 + j + 1]; }
        const float T0 = suf[0], T1 = suf[8];
        const float T0p = __shfl_xor(T0, 32), T1p = __shfl_xor(T1, 32);
        const float base0 = L + T1 + T1p + (hh == 0 ? T0p : 0.f), base1 = L + (hh == 0 ? T1p : 0.f);
        float a[16];
#pragma unroll
        for (int i = 0; i < 16; ++i) {
            float v = __builtin_amdgcn_exp2f(zz[i] + (i < 8 ? base0 : base1) + suf[i]);
            const int kap = 16 * (i >> 3) + 8 * hh + (i & 7);
            if (diag && !(kap < r)) v = 0.f;
            a[i] = v;
        }
        L += (T0 + T1) + (T0p + T1p);
        const bf16x8 pf0 = pack8(a[0], a[1], a[2], a[3], a[4], a[5], a[6], a[7]);
        const bf16x8 pf1 = pack8(a[8], a[9], a[10], a[11], a[12], a[13], a[14], a[15]);
        asm volatile("s_waitcnt vmcnt(8)" ::: "memory");
#pragma unroll
        for (int c = 0; c < 4; ++c) {
            s16x4 r00, r01, r10, r11; tr_read4(va[0][c], va[1][c], r00, r01, r10, r11);
            const bf16x8 vf0 = __builtin_shufflevector(r00, r01, 0, 1, 2, 3, 4, 5, 6, 7), vf1 = __builtin_shufflevector(r10, r11, 0, 1, 2, 3, 4, 5, 6, 7);
            oacc[c] = MFMA32(vf0, pf0, oacc[c]); oacc[c] = MFMA32(vf1, pf1, oacc[c]);
        }
        ATT_DMA(vt, gn + VOFF);
        if (__all(L < ATT_EXIT)) break;
    }
    VM_WAIT();
#undef ATT_DMA
    float ss = 0.f;
#pragma unroll
    for (int c = 0; c < 4; ++c)
#pragma unroll
        for (int i = 0; i < 16; ++i) ss += oacc[c][i] * oacc[c][i];
    ss += __shfl_xor(ss, 32);
    return ss;
}
constexpr int P2_BSCR_OFF = 65536, P2_XS_OFF = P2_BSCR_OFF + 4 * 16896;
static_assert(P2_XS_OFF + 2048 + 64 <= LDS_BYTES, "P2 LDS map");
__device__ __forceinline__ void p2_mixer(Frame& F) {
    const int lane = F.lane, w = F.wave, r = lane & 31, hh = lane >> 5;
    const int nunits = (NB * (SEQ / 32) - F.bx + F.G - 1) / F.G;
    if (F.tid < 8) ((volatile LAS unsigned*)(F.lds + P2_XS_OFF + 2048))[F.tid] = 0u;
    __syncthreads();
    if (w < 4) {
        bf16* ymix = (bf16*)F.out + (size_t)T * D;
        for (int j = 0; j < nunits; ++j) {
            const int u = F.bx + j * F.G, b = u % NB, qblk = u / NB;
            LAS float* XS = (LAS float*)(F.lds + P2_XS_OFF) + (j & 1) * 256;
            v2u st0[16];
            f32x16 oacc[4];
            const float ss0 = attn_head(F, w, w, b, qblk, oacc);
#pragma unroll
            for (int c = 0; c < 4; ++c)
#pragma unroll
                for (int g = 0; g < 4; ++g) { st0[c * 4 + g].x = pg8::cvt_pk_bf16(oacc[c][4 * g], oacc[c][4 * g + 1]); st0[c * 4 + g].y = pg8::cvt_pk_bf16(oacc[c][4 * g + 2], oacc[c][4 * g + 3]); }
            if (hh == 0) XS[w * 32 + r] = ss0;
            const float ss1 = attn_head(F, w, w + 4, b, qblk, oacc);
            if (hh == 0) XS[(w + 4) * 32 + r] = ss1;
            { volatile LAS unsigned* FL = (volatile LAS unsigned*)(F.lds + P2_XS_OFF + 2048) + (j & 1) * 4;
              LDS_WAIT(); if (lane == 0) FL[w] = (unsigned)(j + 1);
              for (unsigned sp = 0; sp < (1u << 22); ++sp) { const unsigned f0 = FL[0], f1 = FL[1], f2 = FL[2], f3 = FL[3]; if (f0 == (unsigned)(j + 1) && f1 == f0 && f2 == f0 && f3 == f0) break; __builtin_amdgcn_s_sleep(1); }
              asm volatile("" ::: "memory"); }
            float tot = 0.f;
#pragma unroll
            for (int k = 0; k < 8; ++k) tot += XS[k * 32 + r];
            const float rs = __builtin_amdgcn_rsqf(tot * (1.f / CW) + EPS);
            bf16* yo = ymix + ((size_t)b * SEQ + qblk * 32 + r) * D + CW + 4 * hh;
#pragma unroll
            for (int c = 0; c < 4; ++c)
#pragma unroll
                for (int g = 0; g < 4; ++g) {
                    v2u o0; o0.x = pg8::cvt_pk_bf16(bflo(st0[c * 4 + g].x) * rs, bfhi(st0[c * 4 + g].x) * rs); o0.y = pg8::cvt_pk_bf16(bflo(st0[c * 4 + g].y) * rs, bfhi(st0[c * 4 + g].y) * rs);
                    *(GAS v2u*)(yo + w * HD + 32 * c + 8 * g) = o0;
                    v2u o1; o1.x = pg8::cvt_pk_bf16(oacc[c][4 * g] * rs, oacc[c][4 * g + 1] * rs); o1.y = pg8::cvt_pk_bf16(oacc[c][4 * g + 2] * rs, oacc[c][4 * g + 3] * rs);
                    *(GAS v2u*)(yo + (w + 4) * HD + 32 * c + 8 * g) = o1; }
            {
                LAS unsigned char* img = F.lds + w * 16384;
#pragma unroll
                for (int c = 0; c < 4; ++c)
#pragma unroll
                    for (int g = 0; g < 4; ++g) {
                        *(LAS unsigned*)(img + r * 136 + 32 * c + 8 * g + 4 * hh) = pg8::cvt4_fp8(bflo(st0[c * 4 + g].x) * rs, bfhi(st0[c * 4 + g].x) * rs, bflo(st0[c * 4 + g].y) * rs, bfhi(st0[c * 4 + g].y) * rs);
                        *(LAS unsigned*)(img + 4352 + r * 136 + 32 * c + 8 * g + 4 * hh) = pg8::cvt4_fp8(oacc[c][4 * g] * rs, oacc[c][4 * g + 1] * rs, oacc[c][4 * g + 2] * rs, oacc[c][4 * g + 3] * rs); }
                LDS_WAIT();
                unsigned char* y8 = F.ws + WS_YMIX8 + ((size_t)b * SEQ + qblk * 32) * D + CW + 16 * (lane & 7);
#pragma unroll
                for (int hsel = 0; hsel < 2; ++hsel)
#pragma unroll
                    for (int i = 0; i < 4; ++i) { const int row = (lane >> 3) + 8 * i; const LAS unsigned char* p = img + hsel * 4352 + row * 136 + 16 * (lane & 7);
                        const v2u lo = *(const LAS v2u*)p, hi = *(const LAS v2u*)(p + 8); v4u o; o.x = lo.x; o.y = lo.y; o.z = hi.x; o.w = hi.y;
                        *(GAS v4u*)(y8 + (size_t)row * D + (w + 4 * hsel) * HD) = o; }
                LDS_WAIT();
            }
        }
    } else {
        LAS float* scr = (LAS float*)(F.lds + P2_BSCR_OFF + (w - 4) * 16896);
        const int gb = F.bx * 4 + (w - 4), NBW = F.G * 4;
        const int cnt = (EXP_ITEMS - gb + NBW - 1) / NBW;
        for (int j = 0; j < nunits; ++j) {
            const int k0 = (int)((long)cnt * j / nunits), k1 = (int)((long)cnt * (j + 1) / nunits);
            for (int k = k0; k < k1; ++k) {
                f32x4 v[32], gq[8];
                const ExpItem I = exp_decode(F, gb + k * NBW);
                exp_issue(I, lane, v, gq);
                exp_finish_half<0>(I, lane, v, gq, scr);
                exp_finish_half<1>(I, lane, v, gq, scr);
            }
        }
    }
    { unsigned* q = (unsigned*)(F.ws + WS_CTL) + CW_CONVQ;
      for (;;) { int it = 0; if (F.lane == 0) it = (int)__hip_atomic_fetch_add(q, 1u, __ATOMIC_RELAXED, __HIP_MEMORY_SCOPE_AGENT);
          it = __builtin_amdgcn_readfirstlane(it); if (it >= T / 16) break; conv_item(F, it); } }
}

constexpr int ROUTER_LG_OFF = 69632;
static_assert(64 * 1040 <= ROUTER_LG_OFF && ROUTER_LG_OFF + 8 * 6144 <= RT_OFF && 16 * 65 * 4 <= 6144, "router LDS map");
__device__ __forceinline__ void router_unit(Frame& F, int unit, LAS int* hist) {
    const int lane = F.lane, r16 = lane & 15, g = lane >> 4;
    const bf16* YM = (const bf16*)F.out + (size_t)T * D; const bf16* WOR = (const bf16*)(F.ws + WS_WOR);
    const int t0 = unit * 16;
    LAS float* LG = (LAS float*)(F.lds + ROUTER_LG_OFF + F.wave * 6144);
    LAS unsigned char* WL = F.lds;
    f32x4 acc[4];
#pragma unroll
    for (int nb = 0; nb < 4; ++nb) acc[nb] = (f32x4){0.f, 0.f, 0.f, 0.f};
    {
        const bf16* ap = YM + (size_t)(t0 + r16) * D + 8 * g;
        const int srow = F.tid >> 3, sseg = F.tid & 7;
        for (int kc = 0; kc < 4; ++kc) {
            v4u wst[8]; bf16x8 av[16];
#pragma unroll
            for (int i = 0; i < 8; ++i) wst[i] = *(const GAS v4u*)((const char*)WOR + (size_t)srow * (D * 2) + 1024 * kc + 128 * sseg + 16 * i);
#pragma unroll
            for (int ks = 0; ks < 16; ++ks) av[ks] = *(const GAS bf16x8*)(ap + 512 * kc + 32 * ks);
            __syncthreads();
#pragma unroll
            for (int i = 0; i < 8; ++i) *(LAS v4u*)(WL + srow * 1040 + 128 * sseg + 16 * i) = wst[i];
            __syncthreads();
#pragma unroll
            for (int ks = 0; ks < 16; ++ks)
#pragma unroll
                for (int nb = 0; nb < 4; ++nb) { const bf16x8 bf = *(const LAS bf16x8*)(WL + (16 * nb + r16) * 1040 + 64 * ks + 16 * g); acc[nb] = __builtin_amdgcn_mfma_f32_16x16x32_bf16(av[ks], bf, acc[nb], 0, 0, 0); }
        }
        const float* lx = (const float*)(F.ws + WS_LOGX) + (size_t)(t0 + 4 * g) * NE + r16;
#pragma unroll
        for (int nb = 0; nb < 4; ++nb)
#pragma unroll
            for (int j = 0; j < 4; ++j) acc[nb][j] += lx[(size_t)j * NE + 16 * nb];
    }
    float ss = 0.f;
    { const float* s1 = (const float*)(F.ws + WS_SSQ1) + (size_t)(8 * g) * T + t0 + r16;
#pragma unroll
      for (int p = 0; p < 8; ++p) ss += s1[(size_t)p * T]; }
    ss += __shfl_xor(ss, 16); ss += __shfl_xor(ss, 32);
#pragma unroll
    for (int nb = 0; nb < 4; ++nb)
#pragma unroll
        for (int j = 0; j < 4; ++j) LG[(4 * g + j) * 65 + 16 * nb + r16] = acc[nb][j];
    LDS_WAIT();
    if (lane < 16) {
        const int t = t0 + lane; const float rs = __builtin_amdgcn_rsqf(ss * (1.f / D) + EPS);
        ((float*)(F.ws + WS_RFFN))[t] = rs;
        const LAS float* lg = LG + lane * 65; const float* rb = F.in[I_RB];
        float sc[NE], bi[NE];
#pragma unroll
        for (int e = 0; e < NE; ++e) { const float s = fsigmoid(lg[e] * rs); sc[e] = s; bi[e] = s + rb[e]; }
        float gs[8];
#pragma unroll
        for (int gg = 0; gg < 8; ++gg) { float m1 = -__builtin_inff(), m2 = -__builtin_inff();
#pragma unroll
            for (int j = 0; j < 8; ++j) { const float v = bi[8 * gg + j]; const float lo = fminf(m1, v); m1 = fmaxf(m1, v); m2 = fmaxf(m2, lo); }
            gs[gg] = m1 + m2; }
        bool okg[8];
#pragma unroll
        for (int gg = 0; gg < 8; ++gg) { int cnt = 0;
#pragma unroll
            for (int g2 = 0; g2 < 8; ++g2) cnt += (gs[g2] > gs[gg] || (gs[g2] == gs[gg] && g2 < gg)) ? 1 : 0;
            okg[gg] = cnt < 4; }
#pragma unroll
        for (int e = 0; e < NE; ++e) bi[e] = okg[e >> 3] ? bi[e] : -__builtin_inff();
        int se[8]; float sv[8]; float wsum = 0.f;
#pragma unroll
        for (int k = 0; k < 8; ++k) { float best = -__builtin_inff(); int be = 0;
#pragma unroll
            for (int e = 0; e < NE; ++e) { const bool tk = bi[e] > best; best = tk ? bi[e] : best; be = tk ? e : be; }
            float svk = 0.f;
#pragma unroll
            for (int e = 0; e < NE; ++e) { const bool hit = (e == be); svk = hit ? sc[e] : svk; bi[e] = hit ? -__builtin_inff() : bi[e]; }
            se[k] = be; sv[k] = svk; wsum += svk; }
        const float inv = 2.5f / wsum;
        int* te = (int*)(F.ws + WS_TOPE) + (size_t)t * 8; float* tw = (float*)(F.ws + WS_TOPW) + (size_t)t * 8;
#pragma unroll
        for (int k = 0; k < 8; ++k) { te[k] = se[k]; tw[k] = sv[k] * inv; (void)__hip_atomic_fetch_add(hist + se[k], 1, __ATOMIC_RELAXED, __HIP_MEMORY_SCOPE_WORKGROUP); }
    }
}
__device__ __forceinline__ void p4_router(Frame& F) {
    LAS int* hist = (LAS int*)(F.lds + RT_OFF);
    for (int v = F.bx; v < 256; v += F.G) {
        if (F.tid < 64) hist[F.tid] = 0;
        __syncthreads();
        router_unit(F, v * 8 + F.wave, hist);
        __syncthreads();
        if (F.tid < 64) ((int*)(F.ws + WS_CNT))[v * 64 + F.tid] = hist[F.tid];
        __syncthreads();
    }
}

__device__ __forceinline__ void p4b_tables(Frame& F) {
    LAS int* L = (LAS int*)(F.lds + RING_OFF);
    LAS int* part_t = L;
    LAS int* part_b = L + 512;
    LAS int* totals = L + 1024;
    LAS int* below = L + 1088;
    LAS int* segst = L + 1152;
    LAS int* wcount = L + 1280;
    LAS int* pe = L + 2048;
    LAS int* rank = L + 3072;
    const int* CNT = (const int*)(F.ws + WS_CNT); const int* TOPE = (const int*)(F.ws + WS_TOPE); const float* TOPW = (const float*)(F.ws + WS_TOPW);
    const float* RFFN = (const float*)(F.ws + WS_RFFN);
    int* RTOK = (int*)(F.ws + WS_RTOK); float* RW = (float*)(F.ws + WS_RW); int* RDST = (int*)(F.ws + WS_RDST); float* RR = (float*)(F.ws + WS_RR); int* TILEE = (int*)(F.ws + WS_TILEE);
    const int tid = F.tid, lane = F.lane, wave = F.wave;
    for (int v = F.bx; v < 256; v += F.G) {
        { const int e = tid & 63, part = tid >> 6; int tot = 0, bel = 0;
          for (int vv = 32 * part; vv < 32 * part + 32; ++vv) { const int c = CNT[vv * 64 + e]; tot += c; bel += (vv < v) ? c : 0; }
          part_t[part * 64 + e] = tot; part_b[part * 64 + e] = bel; }
        for (int i = tid; i < 1024; i += NTHR) pe[i] = TOPE[(size_t)v * 1024 + i];
        __syncthreads();
        if (wave == 0) {
            int tot = 0, bel = 0;
#pragma unroll
            for (int p = 0; p < 8; ++p) { tot += part_t[p * 64 + lane]; bel += part_b[p * 64 + lane]; }
            totals[lane] = tot; below[lane] = bel;
            const int ru = (tot + 255) & ~255; int sc = ru;
#pragma unroll
            for (int o = 1; o < 64; o <<= 1) { const int n = __shfl_up(sc, o); if (lane >= o) sc += n; }
            segst[lane] = sc - ru; if (lane == 63) segst[64] = sc;
        }
        { int cnt = 0;
          for (int j = 0; j < 128; ++j) { const int p = 128 * wave + j; if (pe[p] == lane) { rank[p] = cnt; ++cnt; } }
          wcount[wave * 64 + lane] = cnt; }
        __syncthreads();
        const int SS = segst[64];
        for (int p = tid; p < 1024; p += NTHR) { const int e = pe[p], w = p >> 7; int off = 0;
            for (int w2 = 0; w2 < w; ++w2) off += wcount[w2 * 64 + e];
            const int row = segst[e] + below[e] + off + rank[p]; const int t = 128 * v + (p >> 3), k = p & 7;
            RTOK[row] = t; RW[row] = TOPW[(size_t)t * 8 + k]; RDST[row] = k * T + t; RR[row] = RFFN[t]; }
        if (tid < 128) { const int t = 128 * v + tid, row = SS + t; RTOK[row] = t; RW[row] = 1.f; RDST[row] = 8 * T + t; RR[row] = RFFN[t]; }
        if (v < NE) { const int e = v, tot = totals[e], ru = (tot + 255) & ~255, st = segst[e];
            if (tid < ru - tot) { const int row = st + tot + tid; RTOK[row] = 0; RW[row] = 0.f; RDST[row] = -1; RR[row] = 0.f; }
            if (tid < ru / 256) TILEE[st / 256 + tid] = e; }
        if (v == NE) { if (tid < T / 256) TILEE[SS / 256 + tid] = NE; if (tid == 0) TILEE[MAXTILES] = SS / 256 + T / 256; }
        __syncthreads();
    }
}

template <int MODE> __device__ __forceinline__ int group_setup(Frame& F, int nN) {
    const int* TILEE = (const int*)(F.ws + WS_TILEE);
    const int NT = __builtin_amdgcn_readfirstlane((int)__hip_atomic_load((unsigned*)TILEE + MAXTILES, RLX_AGENT));
    LAS int* te = (LAS int*)(F.lds + TE_OFF); LAS unsigned* rt = (LAS unsigned*)(F.lds + RT_OFF);
    for (int i = F.tid; i < NT && i < MAXTILES; i += NTHR) te[i] = TILEE[i];
    if (MODE == 1) {
        const int* RTOK = (const int*)(F.ws + WS_RTOK);
        for (int ui = F.tid >> 8; ui < RT_UNITS; ui += 2) { int pm, pn; if (!pg8::order_next(ui, F.G, F.bx, NT, nN, pm, pn)) break;
            rt[ui * 256 + (F.tid & 255)] = (unsigned)RTOK[pm * 256 + (F.tid & 255)] * (unsigned)D; }
    }
    __syncthreads();
    return NT;
}

__device__ __forceinline__ void acc_fp8x16(const v4u w, float (&o)[16]) {
#pragma unroll
    for (int q = 0; q < 4; ++q) { const f32x2 lo = __builtin_amdgcn_cvt_pk_f32_fp8((int)w[q], false), hi = __builtin_amdgcn_cvt_pk_f32_fp8((int)w[q], true);
        o[4 * q] += lo.x; o[4 * q + 1] += lo.y; o[4 * q + 2] += hi.x; o[4 * q + 3] += hi.y; }
}
__device__ __forceinline__ void comb_load(const unsigned char* S0, const unsigned char* S1, const unsigned char* S8, const unsigned char* H8, int t, int co, v4u& h8, v4u (&w)[9]) {
    h8 = *(const GAS v4u*)(H8 + (size_t)t * D + co);
#pragma unroll
    for (int k = 0; k < 4; ++k) { w[k] = *(const GAS v4u*)(S0 + ((size_t)k * T + t) * D + co); w[4 + k] = *(const GAS v4u*)(S1 + ((size_t)k * T + t) * D + co); }
    w[8] = *(const GAS v4u*)(S8 + (size_t)t * D + co);
}
__device__ __forceinline__ float comb_proc(unsigned char* hp8, const v4u h8, const v4u (&w)[9]) {
    float o[16];
#pragma unroll
    for (int i = 0; i < 16; ++i) o[i] = 0.f;
#pragma unroll
    for (int k = 0; k < 9; ++k) acc_fp8x16(w[k], o);
    float hf[16];
#pragma unroll
    for (int i = 0; i < 16; ++i) hf[i] = 0.f;
    acc_fp8x16(h8, hf);
    float ss = 0.f;
#pragma unroll
    for (int i = 0; i < 16; ++i) { hf[i] += o[i] * (1.f / SLOT_SCALE); ss += hf[i] * hf[i]; }
    v4u w8;
#pragma unroll
    for (int q = 0; q < 4; ++q) w8[q] = pg8::cvt4_fp8(hf[4 * q], hf[4 * q + 1], hf[4 * q + 2], hf[4 * q + 3]);
    *(GAS v4u*)hp8 = w8;
    return ss;
}
__device__ __forceinline__ void p7_combine(Frame& F, int n, int wg0, int nwg, int t_lo, int t_hi) {
    const int gw = t_lo + (F.bx - wg0) * NWAVES + F.wave, NGW = nwg * NWAVES, lane = F.lane; const int T = t_hi;
    const unsigned char* S0 = (const unsigned char*)F.out; const unsigned char* S1 = F.ws + WS_SLOT47; const unsigned char* S8 = F.ws + WS_SLOT8;
    unsigned char* H8 = F.ws + WS_H1F8; float* ssq2 = (float*)(F.ws + WS_SSQ2);
    const int coA = 16 * lane, coB = 1024 + 16 * lane;
    v4u hA, wA[9], hB, wB[9];
    if (gw < T) comb_load(S0, S1, S8, H8, gw, coA, hA, wA);
    for (int t = gw; t < T; t += NGW) {
        comb_load(S0, S1, S8, H8, t, coB, hB, wB);
        float ss = comb_proc(H8 + (size_t)t * D + coA, hA, wA);
        const int tn = t + NGW < T ? t + NGW : t;
        comb_load(S0, S1, S8, H8, tn, coA, hA, wA);
        ss += comb_proc(H8 + (size_t)t * D + coB, hB, wB);
        ss = wave_sum(ss);
        if (lane == 0) ssq2[t] = ss;
    }
}

__device__ __forceinline__ void p9_final(Frame& F, const bf16* H, const float* ssq, int nparts) {
    const int gw = F.bx * NWAVES + F.wave, NGW = F.G * NWAVES, lane = F.lane; const float* g = F.in[I_NFIN];
    for (int t = gw; t < T; t += NGW) {
        v4u w[4];
#pragma unroll
        for (int j = 0; j < 4; ++j) w[j] = *(const GAS v4u*)(H + (size_t)t * D + 512 * j + 8 * lane);
        float ss = 0.f;
        if (nparts > 0) { if (lane < nparts) ss = ssq[(size_t)lane * T + t]; }
        else {
#pragma unroll
            for (int j = 0; j < 4; ++j)
#pragma unroll
                for (int q = 0; q < 4; ++q) { const float lo = bflo(w[j][q]), hi = bfhi(w[j][q]); ss += lo * lo + hi * hi; }
        }
        const float r = __builtin_amdgcn_rsqf(wave_sum(ss) * (1.f / D) + EPS);
        float* o = F.out + (size_t)t * D;
#pragma unroll
        for (int j = 0; j < 4; ++j) { const int c = 512 * j + 8 * lane; const f32x4 g0 = *(const GAS f32x4*)(g + c), g1 = *(const GAS f32x4*)(g + c + 4);
            f32x4 a, b; a.x = bflo(w[j][0]) * r * g0.x; a.y = bfhi(w[j][0]) * r * g0.y; a.z = bflo(w[j][1]) * r * g0.z; a.w = bfhi(w[j][1]) * r * g0.w;
            b.x = bflo(w[j][2]) * r * g1.x; b.y = bfhi(w[j][2]) * r * g1.y; b.z = bflo(w[j][3]) * r * g1.z; b.w = bfhi(w[j][3]) * r * g1.w;
            *(GAS f32x4*)(o + c) = a; *(GAS f32x4*)(o + c + 4) = b; }
    }
}

__device__ __forceinline__ void p9_final8(Frame& F, const unsigned char* H8, const float* ssq) {
    const int gw = F.bx * NWAVES + F.wave, NGW = F.G * NWAVES, lane = F.lane; const float* g = F.in[I_NFIN];
    f32x4 gv[8];
#pragma unroll
    for (int q = 0; q < 8; ++q) gv[q] = *(const GAS f32x4*)(g + 256 * q + 4 * lane);
    for (int t0 = gw; t0 < T; t0 += 8 * NGW) {
        unsigned w[8][8]; float ss[8];
#pragma unroll
        for (int i = 0; i < 8; ++i) { const int t = t0 + i * NGW, tc = t < T ? t : T - 1;
#pragma unroll
            for (int q = 0; q < 8; ++q) w[i][q] = *(const GAS unsigned*)(H8 + (size_t)tc * D + 256 * q + 4 * lane);
            ss[i] = lane < 32 ? ssq[(size_t)lane * T + tc] : 0.f; }
#pragma unroll
        for (int i = 0; i < 8; ++i) { const int t = t0 + i * NGW;
            const float r = __builtin_amdgcn_rsqf(wave_sum(ss[i]) * (1.f / D) + EPS);
            if (t < T) { float* o = F.out + (size_t)t * D;
#pragma unroll
                for (int q = 0; q < 8; ++q) { const f32x2 a = __builtin_amdgcn_cvt_pk_f32_fp8((int)w[i][q], false), b2 = __builtin_amdgcn_cvt_pk_f32_fp8((int)w[i][q], true);
                    f32x4 v; v.x = a.x * r * gv[q].x; v.y = a.y * r * gv[q].y; v.z = b2.x * r * gv[q].z; v.w = b2.y * r * gv[q].w;
                    *(GAS f32x4*)(o + 256 * q + 4 * lane) = v; } }
        }
    }
}

struct Args { const float* in[21]; float* out; unsigned char* ws; int ph_lo, ph_hi, fin_mode, li; };
__global__ void __launch_bounds__(NTHR, 2) mk_fwd(Args args) {
    extern __shared__ __attribute__((aligned(16))) unsigned char lds[];
    Frame F;
    F.lds = (LAS unsigned char*)lds;
    F.tid = threadIdx.x; F.lane = F.tid & 63; F.wave = __builtin_amdgcn_readfirstlane(F.tid >> 6);
    F.G = gridDim.x; F.bx = blockIdx.x; F.ws = args.ws; F.out = args.out;
#pragma unroll
    for (int i = 0; i < 21; ++i) F.in[i] = args.in[i];
    volatile LAS unsigned* MISC = (volatile LAS unsigned*)(F.lds + MISC_OFF);
    if (F.tid < 32) MISC[F.tid] = 0u;
    __syncthreads();
    XcdBarrier bar = xcd_barrier_post((unsigned*)(F.ws + WS_CTL) + CW_BAR + args.li * XCD_BAR_WORDS, MISC + 8);
    unsigned char* ws = F.ws;
    const int lo = args.ph_lo, hi = args.ph_hi;
    LAS unsigned char* ring = F.lds + RING_OFF;
#define PHASE(k) if (lo <= (k) && (k) < hi)
#define PH(k) PHASE(k) { RELANE();
#define GRID_BAR() xcd_barrier(bar)
#define RELANE() do { int _t = threadIdx.x; asm volatile("" : "+v"(_t)); F.tid = _t; F.lane = _t & 63; F.wave = __builtin_amdgcn_readfirstlane(_t >> 6); } while (0)

    PHASE(0) { RELANE(); p0_prologue(F); GRID_BAR(); }
    PHASE(1) { RELANE();
        pg8::DenseSched S{T / 256, NPROJ / 256, F.G, F.bx, D * 2, (const char*)(ws + WS_WIN)};
        pg8::EpiProj E{(bf16*)(ws + WS_PROJ), (bf16*)(ws + WS_QKV), (const float*)(ws + WS_RMIX)};
        pg8::gemm_phase<false, 1>(F.tid, ring, (const char*)F.out, D * 2, S, E);
        GRID_BAR();
    }
    PHASE(2) { RELANE(); p2_mixer(F); GRID_BAR(); }
    PHASE(3) { RELANE();
        pg8::DenseSchedG S{T / 256, D / 256, F.G, F.bx, D, (const char*)(ws + WS_WOUT)};
        pg8::EpiResF32 E{(bf16*)(ws + WS_H1B), (const bf16*)F.out, D, ws + WS_H1F8, (float*)(ws + WS_SSQ1)};
        pg8::gemm_phase<true, 1>(F.tid, ring, (const char*)(ws + WS_YMIX8), D, S, E, 0x79797979, 0x7f7f7f7f);
        GRID_BAR();
    }
    PHASE(4) { RELANE(); p4_router(F); GRID_BAR(); }
    PHASE(5) { RELANE(); p4b_tables(F); GRID_BAR(); }
    PHASE(6) { RELANE();
        const int NT = group_setup<1>(F, 4);
        pg8::GroupSched<1> S{NT, 4, F.G, F.bx, D, 0, (const char*)(ws + WS_WGU), (size_t)1024 * D, (const LAS int*)(F.lds + TE_OFF), (const LAS unsigned*)(F.lds + RT_OFF)};
        pg8::EpiGateUp E{ws + WS_HPERM, (const float*)(ws + WS_RR)};
        pg8::gemm_phase<true, 0>(F.tid, ring, (const char*)(ws + WS_H1F8), D, S, E, 0x79797979, 0x7f7f7f7f);
        GRID_BAR();
    }
    {
        for (int n = 0; n < NSLICE; ++n) {
            PHASE(7 + 2 * n) { RELANE();
            const int NT = group_setup<2>(F, SLW / 256);
            pg8::GroupSched<2> S{NT, SLW / 256, F.G, F.bx, ED, (SLW / 256) * n, (const char*)(ws + WS_WDN), (size_t)D * ED, (const LAS int*)(F.lds + TE_OFF), (const LAS unsigned*)(F.lds + RT_OFF)};
            pg8::EpiDown E{(unsigned char*)F.out, ws + WS_SLOT47, ws + WS_SLOT8, (const float*)(ws + WS_RW), (const int*)(ws + WS_RDST)};
            pg8::gemm_phase<true, 0>(F.tid, ring, (const char*)(ws + WS_HPERM), ED, S, E, 0x79797979, 0x7f7f7f7f);
            GRID_BAR();
            }
            PHASE(8 + 2 * n) { RELANE();
            const int npl = F.G >= 2 * P8_NPLE ? P8_NPLE : 0;
            if (F.bx < npl) {
                pg8::DenseSched S{T / 256, D / 256, npl, F.bx, PLE * 2, (const char*)(ws + WS_WPP)};
                pg8::EpiF8x16 E{ws + WS_PP, D};
                pg8::gemm_phase<false, 1>(F.tid, ring, (const char*)(ws + WS_PB), PLE * 2, S, E);
                RELANE();
                p7_combine(F, n, 0, npl, 0, P8_TSPLIT);
            } else p7_combine(F, n, npl, F.G - npl, npl ? P8_TSPLIT : 0, ::T);
            GRID_BAR();
            }
        }
    }
    PHASE(15) { RELANE();
        if (F.G < 2 * P8_NPLE) {
        pg8::DenseSched S{T / 256, D / 256, F.G, F.bx, PLE * 2, (const char*)(ws + WS_WPP)};
        pg8::EpiF8x16 E{ws + WS_PP, D};
        pg8::gemm_phase<false, 1>(F.tid, ring, (const char*)(ws + WS_PB), PLE * 2, S, E);
        GRID_BAR();
        }
    }
    PHASE(16) { RELANE();
        pg8::DenseSchedG S{T / 256, D / 256, F.G, F.bx, D, (const char*)(ws + WS_WPG)};
        pg8::EpiPle E{ws + WS_H3, ws + WS_H1F8, ws + WS_PP, (const float*)(ws + WS_SSQ2), (float*)(ws + WS_SSQ3)};
        pg8::gemm_phase<true, 1>(F.tid, ring, (const char*)(ws + WS_H1F8), D, S, E, 0x79797979, 0x7f7f7f7f);
        GRID_BAR();
    }
    PHASE(17) { RELANE();
    if (args.fin_mode == 0) p9_final8(F, ws + WS_H3, (const float*)(ws + WS_SSQ3));
    else p9_final(F, (const bf16*)(ws + WS_H1B), nullptr, 0);
    }
}

extern "C" void kernel_launch(void* const* d_in, const int* in_sizes, int n_in, void* d_out, int out_size, void* d_ws, size_t ws_size, hipStream_t stream) {
    static int grid = 0;
    if (grid == 0) {
        int dev = 0, cus = 0;
        if (n_in != 21 || ws_size < WS_END) { fprintf(stderr, "kernel_launch: n_in %d ws %zu (need %zu)\n", n_in, ws_size, (size_t)WS_END); grid = -1; return; }
        if (hipGetDevice(&dev) != hipSuccess || hipDeviceGetAttribute(&cus, hipDeviceAttributeMultiprocessorCount, dev) != hipSuccess) { grid = -1; return; }
        if (hipFuncSetAttribute((const void*)mk_fwd, hipFuncAttributeMaxDynamicSharedMemorySize, LDS_BYTES) != hipSuccess) { fprintf(stderr, "hipFuncSetAttribute failed\n"); grid = -1; return; }
        int per_cu = 0;
        (void)hipOccupancyMaxActiveBlocksPerMultiprocessor(&per_cu, (const void*)mk_fwd, NTHR, LDS_BYTES);
        (void)hipGetLastError();
        grid = cus > 256 ? 256 : cus;
    }
    if (grid < 0) return;
    (void)hipMemsetAsync((char*)d_ws + WS_CTL, 0, CTL_ZERO_BYTES, stream);
    Args a{};
    for (int i = 0; i < 21; ++i) a.in[i] = (const float*)d_in[i];
    a.out = (float*)d_out; a.ws = (unsigned char*)d_ws; a.fin_mode = FIN_MODE;
#if PROBE_K >= 0
    a.ph_lo = 0; a.ph_hi = PROBE_K + 1; a.li = 0;
    hipLaunchKernelGGL(mk_fwd, dim3(grid), dim3(NTHR), LDS_BYTES, stream, a);
    a.ph_lo = PROBE_K; a.ph_hi = PH_HI; a.li = 1;
    hipLaunchKernelGGL(mk_fwd, dim3(grid), dim3(NTHR), LDS_BYTES, stream, a);
#else
    a.ph_lo = 0; a.ph_hi = PH_HI; a.li = 0;
    hipLaunchKernelGGL(mk_fwd, dim3(grid), dim3(NTHR), LDS_BYTES, stream, a);
#endif
}
```

```cpp
#include <hip/hip_runtime.h>
#include <cstdio>
#ifndef PROBE_K
#define PROBE_K -1
#endif
#ifndef PH_HI
#define PH_HI 100
#endif
#ifndef FIN_MODE
#define FIN_MODE 0
#endif

#define GAS __attribute__((address_space(1)))
#define LAS __attribute__((address_space(3)))
typedef unsigned short bf16;
typedef unsigned v4u __attribute__((ext_vector_type(4)));
typedef unsigned v2u __attribute__((ext_vector_type(2)));
typedef float f32x4 __attribute__((ext_vector_type(4)));
typedef float f32x2 __attribute__((ext_vector_type(2)));
typedef float f32x16 __attribute__((ext_vector_type(16)));
typedef short bf16x8 __attribute__((ext_vector_type(8)));
typedef short s16x4 __attribute__((ext_vector_type(4)));
typedef GAS unsigned gu32;
#define RLX_AGENT __ATOMIC_RELAXED, __HIP_MEMORY_SCOPE_AGENT
#define LDS_WAIT() asm volatile("s_waitcnt lgkmcnt(0)" ::: "memory")
#define VM_WAIT() asm volatile("s_waitcnt vmcnt(0)" ::: "memory")

constexpr int NB = 8, SEQ = 4096, T = NB * SEQ, D = 2048, NPROJ = 6144, CW = 1024, HD = 128, NH = 8;
constexpr int PCW = 3 * CW;
constexpr int PLE = 256, NE = 64, ED = 512, TOPK = 8, NSLOT = 9;
constexpr float EPS = 1e-6f;
constexpr int NWAVES = 8, NTHR = 512;
constexpr int MAXTILES = 1216;
constexpr int MAXROWS = MAXTILES * 256;
constexpr int P8_TSPLIT = 8192;
constexpr int P8_NPLE = 128;
constexpr int NSLICE = 1, SLW = D / NSLICE;
constexpr float SLOT_SCALE = 16.f;

constexpr size_t MiB = 1u << 20;
constexpr size_t WS_CTL = 0, CTL_ZERO_BYTES = 1 * MiB;
constexpr size_t WS_RMIX = 1 * MiB;
constexpr size_t WS_RFFN = WS_RMIX + 128 * 1024;
constexpr size_t WS_SSQ2 = WS_RFFN + 128 * 1024;
constexpr size_t WS_SSQ3 = WS_SSQ2 + 512 * 1024;
constexpr size_t WS_TOPE = WS_SSQ3 + 4 * MiB;
constexpr size_t WS_TOPW = WS_TOPE + 1 * MiB;
constexpr size_t WS_CNT  = WS_TOPW + 1 * MiB;
constexpr size_t WS_RTOK = WS_CNT + 64 * 1024;
constexpr size_t WS_RW   = WS_RTOK + 1280 * 1024;
constexpr size_t WS_RDST = WS_RW + 1280 * 1024;
constexpr size_t WS_RR   = WS_RDST + 1280 * 1024;
constexpr size_t WS_TILEE = WS_RR + 1280 * 1024;
constexpr size_t WS_WR   = 16 * MiB;
constexpr size_t WS_WOR  = WS_WR + 512 * 1024;
constexpr size_t WS_WIN  = 17 * MiB;
constexpr size_t WS_WOUT = WS_WIN + 24 * MiB;
constexpr size_t WS_WGU  = WS_WOUT + 8 * MiB;
constexpr size_t WS_WDN  = WS_WGU + 130 * MiB;
constexpr size_t WS_WPG  = WS_WDN + 65 * MiB;
constexpr size_t WS_WPP  = WS_WPG + 8 * MiB;
constexpr size_t WS_PB   = WS_WPP + 1 * MiB;
constexpr size_t WS_H1B  = WS_PB + 16 * MiB;
constexpr size_t WS_H1F8 = WS_H1B + 128 * MiB;
constexpr size_t WS_OVL  = WS_H1F8 + 64 * MiB;
constexpr size_t WS_PROJ = WS_OVL;
constexpr size_t WS_QKV  = WS_OVL + 192 * MiB;
constexpr size_t WS_HPERM = WS_OVL;
constexpr size_t WS_SLOT8 = WS_OVL + 304 * MiB;
constexpr size_t WS_PP   = WS_OVL;
constexpr size_t WS_H3   = WS_OVL + 128 * MiB;
constexpr size_t WS_SLOT47 = WS_OVL + 384 * MiB;
constexpr size_t WS_YMIX8 = WS_SLOT47;
constexpr size_t WS_LOGX = WS_SLOT47 + 64 * MiB;
constexpr size_t WS_SSQ1 = WS_SSQ3;
constexpr size_t WS_END  = WS_SLOT47 + 256 * MiB;
constexpr int CW_BAR = 4096, CW_CONVQ = 1024;

constexpr int RING_OFF = 0, RING_BYTES = 131072;
constexpr int RT_OFF = 131072, RT_UNITS = 20, RT_BYTES = RT_UNITS * 1024;
constexpr int TE_OFF = RT_OFF + RT_BYTES, TE_BYTES = 4864 + 128;
constexpr int EPT_OFF = TE_OFF + TE_BYTES, EPT_BYTES = 4096;
constexpr int MISC_OFF = EPT_OFF + EPT_BYTES;
constexpr int LDS_BYTES = MISC_OFF + 128;
static_assert(LDS_BYTES <= 163840, "LDS");

__device__ __forceinline__ unsigned f2bf(float f) { unsigned u = __builtin_bit_cast(unsigned, f); return (u + 0x7fffu + ((u >> 16) & 1u)) >> 16; }
__device__ __forceinline__ unsigned pk2(float lo, float hi) { return f2bf(lo) | (f2bf(hi) << 16); }
__device__ __forceinline__ float bflo(unsigned w) { return __builtin_bit_cast(float, w << 16); }
__device__ __forceinline__ float bfhi(unsigned w) { return __builtin_bit_cast(float, w & 0xffff0000u); }
__device__ __forceinline__ float wave_sum(float v) {
#pragma unroll
    for (int o = 1; o < 64; o <<= 1) v += __shfl_xor(v, o);
    return v;
}
__device__ __forceinline__ float fsigmoid(float v) { return __builtin_amdgcn_rcpf(1.f + __builtin_amdgcn_exp2f(-1.4426950409f * v)); }

#define XB_TMO      128
#define XB_XCNT(j)  (256  + 64 * (j))
#define XB_XSUB(j)  (1280 + 64 * (j))
#define XB_XGEN(j)  (2304 + 64 * (j))
#define XB_TOP      3328
#define XB_TOPGEN   3392
#define XCD_BAR_WORDS 3456
#define XB_SPIN_CAP (1u << 18)
__device__ __forceinline__ unsigned xb_ld(unsigned* p)              { return __hip_atomic_load(p, __ATOMIC_RELAXED, __HIP_MEMORY_SCOPE_AGENT); }
__device__ __forceinline__ unsigned xb_add(unsigned* p, unsigned v) { return __hip_atomic_fetch_add(p, v, __ATOMIC_RELAXED, __HIP_MEMORY_SCOPE_AGENT); }
__device__ __forceinline__ unsigned xb_xcc_id() { return (unsigned)__builtin_amdgcn_s_getreg((3 << 11) | 20) & 0xFu; }
#define XB_SPIN(cond, bar) do { unsigned _sp = 0; while (cond) { __builtin_amdgcn_s_sleep(1); \
    if ((++_sp & 255u) == 0u) { if (xb_ld(&(bar)[XB_TMO])) break; if (_sp > XB_SPIN_CAP) { atomicAdd(&(bar)[XB_TMO], 1u); break; } } } } while (0)
struct XcdBarrier { unsigned* bar; unsigned x; volatile LAS unsigned* st; };
__device__ __forceinline__ XcdBarrier xcd_barrier_post(unsigned* bar, volatile LAS unsigned* st) {
    XcdBarrier b; b.bar = bar; b.x = xb_xcc_id(); b.st = st;
    if (threadIdx.x == 0) (void)xb_add(&bar[XB_XCNT(b.x)], 1u);
    return b;
}
__device__ __forceinline__ void xcd_barrier_complete(unsigned* bar, unsigned x, unsigned& nloc, unsigned& nx) {
    const unsigned G = gridDim.x * gridDim.y * gridDim.z;
    unsigned sum, cnt, mine, sp = 0u;
    for (;;) {
        sum = 0u; cnt = 0u; mine = 0u;
#pragma unroll
        for (unsigned j = 0; j < 16; ++j) { const unsigned c = xb_ld(&bar[XB_XCNT(j)]); sum += c; cnt += (c > 0u) ? 1u : 0u; mine = (j == x) ? c : mine; }
        if (sum == G) break;
        __builtin_amdgcn_s_sleep(1);
        if ((++sp & 255u) == 0u) { if (xb_ld(&bar[XB_TMO])) break; if (sp > XB_SPIN_CAP) { atomicAdd(&bar[XB_TMO], 1u); break; } }
    }
    nloc = mine > 0u ? mine : 1u; nx = cnt > 0u ? cnt : 1u;
}
__device__ __forceinline__ void xcd_barrier(const XcdBarrier& b) {
    asm volatile("s_waitcnt vmcnt(0)" ::: "memory");
    __syncthreads();
    if (threadIdx.x == 0) {
        unsigned* bar = b.bar;
        __builtin_amdgcn_s_waitcnt(0);
        unsigned nloc = b.st[0], nx = b.st[1];
        if (nloc == 0u) { xcd_barrier_complete(bar, b.x, nloc, nx); b.st[0] = nloc; b.st[1] = nx; }
        const unsigned old = xb_add(&bar[XB_XSUB(b.x)], 1u);
        const unsigned gen = old / nloc;
        if (old + 1u == (gen + 1u) * nloc) {
            __builtin_amdgcn_fence(__ATOMIC_RELEASE, "agent");
            asm volatile("s_waitcnt vmcnt(0)" ::: "memory");
            const unsigned og = xb_add(&bar[XB_TOP], 1u);
            const unsigned tg = og / nx;
            if (og + 1u == (tg + 1u) * nx) xb_add(&bar[XB_TOPGEN], 1u);
            else XB_SPIN(xb_ld(&bar[XB_TOPGEN]) == tg, bar);
            __builtin_amdgcn_fence(__ATOMIC_ACQUIRE, "agent");
            xb_add(&bar[XB_XGEN(b.x)], 1u);
            asm volatile("s_waitcnt vmcnt(0)" ::: "memory");
        } else {
            XB_SPIN(xb_ld(&bar[XB_XGEN(b.x)]) == gen, bar);
            __builtin_amdgcn_fence(__ATOMIC_ACQUIRE, "agent");
            asm volatile("s_waitcnt vmcnt(0)" ::: "memory");
        }
    }
    __syncthreads();
}

namespace pg8 {
constexpr int BM = 256, BK = 64, HALF = 128, HTB = HALF * BK * 2, STAGE_BYTES = 8 * HTB, NXCD = 8, WGM = 8;
__device__ __forceinline__ int lds_byte(int r, int c) { const int st = (r >> 4) * 2 + (c >> 5), rr = r & 15, cc = c & 31, ob = rr * 64 + cc * 2; return st * 1024 + (ob ^ (((ob >> 9) & 1) << 5)); }
__device__ __forceinline__ void stage_rc(int b, int& R, int& C) { const int st = b / 1024, sb = b % 1024, swz = sb ^ (((sb >> 9) & 1) << 5); R = (st >> 1) * 16 + swz / 64; C = (st & 1) * 32 + (swz % 64) / 2; }
__device__ __forceinline__ int brow(int R) { return 64 * (R >> 5) + 16 * ((R & 15) >> 2) + 4 * ((R >> 4) & 1) + (R & 3); }
__device__ __forceinline__ int brow1(int R) { return 64 * (R >> 5) + 8 * ((R & 15) >> 2) + 4 * ((R >> 4) & 1) + (R & 3); }

struct Unit { int pm, pn, e; };

__device__ __forceinline__ bool order_next(int i, int G, int c, int nM, int nN, int& pm, int& pn) {
    const int nwg = nM * nN; const long L = (long)i * G + c; if (L >= nwg) return false;
    int wgid = (int)L; { const int q = nwg / NXCD, r = nwg % NXCD, xcd = wgid % NXCD, off = wgid / NXCD; wgid = (xcd < r ? xcd * (q + 1) : r * (q + 1) + (xcd - r) * q) + off; }
    const int nig = WGM * nN, gid = wgid / nig, fm = gid * WGM, gsz = (nM - fm) < WGM ? (nM - fm) : WGM;
    pm = fm + ((wgid % nig) % gsz); pn = (wgid % nig) / gsz; return true;
}

struct DenseSched {
    static constexpr bool GATHER = false;
    int nM, nN, G, c, KB; const char* Bt;
    __device__ __forceinline__ bool next(int i, Unit& u) const { u.e = 0; return order_next(i, G, c, nM, nN, u.pm, u.pn); }
    __device__ __forceinline__ const char* bbase(const Unit& u) const { return Bt + (size_t)u.pn * BM * KB; }
    __device__ __forceinline__ const char* abase(const char* A, const Unit& u) const { return A + (size_t)u.pm * BM * KB; }
    __device__ __forceinline__ void aoffs(int ui, const Unit& u, int tid, unsigned (&ao)[2][2]) const {}
};
struct DenseSchedG {
    static constexpr bool GATHER = true;
    int nM, nN, G, c, KB; const char* Bt;
    __device__ __forceinline__ bool next(int i, Unit& u) const { u.e = 0; return order_next(i, G, c, nM, nN, u.pm, u.pn); }
    __device__ __forceinline__ const char* bbase(const Unit& u) const { return Bt + (size_t)u.pn * BM * KB; }
    __device__ __forceinline__ const char* abase(const char* A, const Unit& u) const { return A; }
    __device__ __forceinline__ void aoffs(int ui, const Unit& u, int tid, unsigned (&ao)[2][2]) const {
        asm volatile("" : "+v"(tid));
#pragma unroll
        for (int i = 0; i < 2; ++i) { int R, C; stage_rc(tid * 16 + i * 8192, R, C);
#pragma unroll
            for (int h = 0; h < 2; ++h) ao[h][i] = (unsigned)(u.pm * BM + h * HALF + R) * (unsigned)KB + (unsigned)C * 2u; }
    }
};
template <int MODE> struct GroupSched {
    static constexpr bool GATHER = true;
    int nM, nN, G, c, KB, pn0; const char* Bt; size_t estride; const LAS int* te; const LAS unsigned* rt;
    __device__ __forceinline__ bool next(int i, Unit& u) const { if (!order_next(i, G, c, nM, nN, u.pm, u.pn)) return false; u.e = __builtin_amdgcn_readfirstlane(te[u.pm]); return true; }
    __device__ __forceinline__ const char* bbase(const Unit& u) const { return Bt + (size_t)u.e * estride + (size_t)(pn0 + u.pn) * BM * KB; }
    __device__ __forceinline__ void aoffs(int ui, const Unit& u, int tid, unsigned (&ao)[2][2]) const {
        asm volatile("" : "+v"(tid));
#pragma unroll
        for (int i = 0; i < 2; ++i) { int R, C; stage_rc(tid * 16 + i * 8192, R, C);
#pragma unroll
            for (int h = 0; h < 2; ++h) { if (MODE == 1) ao[h][i] = rt[ui * 256 + h * HALF + R] + (unsigned)C * 2u; else ao[h][i] = (unsigned)(u.pm * BM + h * HALF + R) * (unsigned)KB + (unsigned)C * 2u; } }
    }
    __device__ __forceinline__ const char* abase(const char* A, const Unit& u) const { return A; }
};

__device__ __forceinline__ unsigned cvt_pk_bf16(float lo, float hi) { unsigned r; asm volatile("v_cvt_pk_bf16_f32 %0, %1, %2" : "=v"(r) : "v"(lo), "v"(hi)); return r; }

typedef int v8i __attribute__((ext_vector_type(8)));
typedef int v4i __attribute__((ext_vector_type(4)));
union Frag { v8i v; struct { v4i lo, hi; }; };
template <bool F8, int LAY, class Epi, class Sched>
__device__ __forceinline__ void gemm_phase(const int tid, LAS unsigned char* lds, const char* Abase, const int KB, const Sched& S, const Epi& E, const int sw = 0x7f7f7f7f, const int sa = 0x7f7f7f7f) {
    LAS unsigned char* const ept = lds + (EPT_OFF - RING_OFF);
    const int wid = __builtin_amdgcn_readfirstlane(tid >> 6), lane = tid & 63, wr = wid >> 2, wc = wid & 3, fr = lane & 15, fq = lane >> 4;
    const int nt = KB / 128;
    constexpr bool GA = Sched::GATHER;
    unsigned voffB[2], voffA[2];
#pragma unroll
    for (int i = 0; i < 2; ++i) { int R, C; stage_rc(tid * 16 + i * 8192, R, C); const int Rb = LAY ? brow1(R) : brow(R); voffB[i] = (unsigned)Rb * (unsigned)KB + (unsigned)C * 2u; voffA[i] = (unsigned)R * (unsigned)KB + (unsigned)C * 2u; }
    const size_t kstep = (size_t)(BK * 2);
    const size_t hstep = (size_t)HALF * KB;
    const size_t hstepB = (size_t)(LAY ? 32 : 8) * KB;
    const unsigned ldsw = (unsigned)wid * 1024u;
    const int aoff = lds_byte(wr * 64 + fr, fq * 8), boff = lds_byte(wc * 32 + fr, fq * 8);
#define PG8_SA(b, h) (((b) * 2 + (h)) * HTB)
#define PG8_SB(b, h) ((4 + (b) * 2 + (h)) * HTB)
#define PG8_STAGE(bufoff, gbase, voff) do { _Pragma("unroll") for (int _i = 0; _i < 2; ++_i) \
        __builtin_amdgcn_global_load_lds((const unsigned*)((const char*)(gbase) + (voff)[_i]), (LAS unsigned*)(lds + (bufoff) + ldsw + _i * 8192), 16, 0, 0); } while (0)
#define PG8_STAGEA(bufoff, gbase, half) do { if constexpr (GA) { PG8_STAGE(bufoff, gbase, ca[half]); } else { PG8_STAGE(bufoff, (gbase) + (half) * hstep, voffA); } } while (0)
#define PG8_LD1(dst, off) do { const v4i _lo = *(const LAS v4i*)(lds + (off)), _hi = *(const LAS v4i*)(lds + (off) + 1024); dst.lo = _lo; dst.hi = _hi; } while (0)
#define PG8_LDA(dst, b, h) do { _Pragma("unroll") for (int m = 0; m < 4; ++m) PG8_LD1(dst[m], PG8_SA(b, h) + aoff + m * 2048); } while (0)
#define PG8_LDB(dst, b, h) do { _Pragma("unroll") for (int n = 0; n < 2; ++n) PG8_LD1(dst[n], PG8_SB(b, h) + boff + n * 2048); } while (0)
#define PG8_MMA(ai, bj, At, Bt) do { __builtin_amdgcn_s_setprio(1); _Pragma("unroll") for (int m = 0; m < 4; ++m) _Pragma("unroll") for (int n = 0; n < 2; ++n) { \
        if constexpr (F8) { acc[ai][bj][m][n] = __builtin_amdgcn_mfma_scale_f32_16x16x128_f8f6f4(Bt[n].v, At[m].v, acc[ai][bj][m][n], 0, 0, 0, sw, 0, sa); } \
        else { acc[ai][bj][m][n] = __builtin_amdgcn_mfma_f32_16x16x32_bf16(__builtin_bit_cast(bf16x8, Bt[n].lo), __builtin_bit_cast(bf16x8, At[m].lo), acc[ai][bj][m][n], 0, 0, 0); \
               acc[ai][bj][m][n] = __builtin_amdgcn_mfma_f32_16x16x32_bf16(__builtin_bit_cast(bf16x8, Bt[n].hi), __builtin_bit_cast(bf16x8, At[m].hi), acc[ai][bj][m][n], 0, 0, 0); } } \
        __builtin_amdgcn_s_setprio(0); } while (0)
#define PG8_WAIT_V(n) asm volatile("s_waitcnt vmcnt(" #n ")" ::: "memory")
#define PG8_WAIT_L(n) asm volatile("s_waitcnt lgkmcnt(" #n ")" ::: "memory")
#define PG8_BAR __builtin_amdgcn_s_barrier()
#define PG8_SCHED __builtin_amdgcn_sched_barrier(0)
    Unit cur, nxt; int ui = 0;
    if (!S.next(0, cur)) return;
    f32x4 acc[2][2][4][2];
#pragma unroll
    for (int a = 0; a < 2; ++a)
#pragma unroll
        for (int b = 0; b < 2; ++b)
#pragma unroll
            for (int m = 0; m < 4; ++m)
#pragma unroll
                for (int n = 0; n < 2; ++n) acc[a][b][m][n] = (f32x4){0.f, 0.f, 0.f, 0.f};
    Frag At[4], B0[2], B1[2];
    unsigned ca[2][2], na[2][2];
    if constexpr (GA) S.aoffs(0, cur, tid, ca);
    const char* cB = S.bbase(cur); const char* cA = S.abase(Abase, cur);
    PG8_STAGE(PG8_SB(0, 0), cB, voffB); PG8_STAGEA(PG8_SA(0, 0), cA, 0); PG8_STAGE(PG8_SB(0, 1), cB + hstepB, voffB); PG8_STAGEA(PG8_SA(0, 1), cA, 1);
    if (wr == 1) PG8_BAR;
    PG8_WAIT_V(4); PG8_BAR;
    PG8_STAGE(PG8_SB(1, 0), cB + kstep, voffB); PG8_STAGEA(PG8_SA(1, 0), cA + kstep, 0); PG8_STAGE(PG8_SB(1, 1), cB + hstepB + kstep, voffB);
    PG8_WAIT_V(6); PG8_BAR;
    for (;;) {
        const bool has_next = S.next(ui + 1, nxt);
        const char* nB = has_next ? S.bbase(nxt) : cB; const char* nA = has_next ? S.abase(Abase, nxt) : cA;
        if constexpr (GA) {
            if (has_next) S.aoffs(ui + 1, nxt, tid, na);
            else {
#pragma unroll
                for (int h = 0; h < 2; ++h)
#pragma unroll
                    for (int i = 0; i < 2; ++i) na[h][i] = ca[h][i];
            }
        }
#pragma nounroll
        for (int t = 0; t < nt; t += 2) {
            const bool last = (t == nt - 2);
            const char* a1 = cA + (size_t)(t + 1) * kstep;
            const char* a2 = last ? nA : cA + (size_t)(t + 2) * kstep; const char* b2 = last ? nB : cB + (size_t)(t + 2) * kstep;
            const char* a3 = a2 + kstep; const char* b3 = b2 + kstep;
            if (t == 0 && wid == 0) { int tz = tid; asm volatile("" : "+v"(tz)); E.prefetch(cur, ept + (ui & 1) * 2048, tz & 63); }
            PG8_LDB(B0, 0, 0); PG8_SCHED; PG8_LDA(At, 0, 0); PG8_STAGEA(PG8_SA(1, 1), a1, 1);
            PG8_WAIT_L(8); PG8_BAR; PG8_WAIT_L(0); PG8_MMA(0, 0, At, B0); PG8_BAR; PG8_SCHED;
            if constexpr (GA) { if (last) {
#pragma unroll
                for (int h = 0; h < 2; ++h)
#pragma unroll
                    for (int i = 0; i < 2; ++i) ca[h][i] = na[h][i];
            } }
            PG8_LDB(B1, 0, 1); PG8_STAGE(PG8_SB(0, 0), b2, voffB);
            PG8_BAR; PG8_WAIT_L(0); PG8_MMA(0, 1, At, B1); PG8_BAR;
            PG8_LDA(At, 0, 1); PG8_STAGEA(PG8_SA(0, 0), a2, 0);
            PG8_BAR; PG8_WAIT_L(0); PG8_MMA(1, 0, At, B0); PG8_BAR; PG8_SCHED;
            PG8_STAGE(PG8_SB(0, 1), b2 + hstepB, voffB);
            PG8_WAIT_V(6); PG8_BAR; PG8_MMA(1, 1, At, B1); PG8_BAR;
            PG8_LDB(B0, 1, 0); PG8_SCHED; PG8_LDA(At, 1, 0); PG8_STAGEA(PG8_SA(0, 1), a2, 1);
            PG8_WAIT_L(8); PG8_BAR; PG8_WAIT_L(0); PG8_MMA(0, 0, At, B0); PG8_BAR; PG8_SCHED;
            PG8_LDB(B1, 1, 1); PG8_STAGE(PG8_SB(1, 0), b3, voffB);
            PG8_BAR; PG8_WAIT_L(0); PG8_MMA(0, 1, At, B1); PG8_BAR;
            PG8_LDA(At, 1, 1); PG8_STAGEA(PG8_SA(1, 0), a3, 0);
            PG8_BAR; PG8_WAIT_L(0); PG8_MMA(1, 0, At, B0); PG8_BAR; PG8_SCHED;
            PG8_STAGE(PG8_SB(1, 1), b3 + hstepB, voffB);
            PG8_WAIT_V(6); PG8_BAR; PG8_MMA(1, 1, At, B1); PG8_BAR;
        }
        { int tz = tid; asm volatile("" : "+v"(tz)); const int l2 = tz & 63; E(acc, cur, wr, wc, l2 & 15, l2 >> 4, ept + (ui & 1) * 2048); }
        if (!has_next) break;
#pragma unroll
        for (int a = 0; a < 2; ++a)
#pragma unroll
            for (int b = 0; b < 2; ++b)
#pragma unroll
                for (int m = 0; m < 4; ++m)
#pragma unroll
                    for (int n = 0; n < 2; ++n) acc[a][b][m][n] = (f32x4){0.f, 0.f, 0.f, 0.f};
        cur = nxt; cB = nB; cA = nA; ++ui;
    }
    PG8_WAIT_V(0);
    if (wr == 0) PG8_BAR;
    PG8_BAR;
#undef PG8_SA
#undef PG8_SB
#undef PG8_STAGE
#undef PG8_STAGEA
#undef PG8_LD1
#undef PG8_LDA
#undef PG8_LDB
#undef PG8_MMA
#undef PG8_WAIT_V
#undef PG8_WAIT_L
#undef PG8_BAR
#undef PG8_SCHED
}

__device__ __forceinline__ unsigned cvt4_fp8(float a, float b, float c, float d) { int w = 0; w = __builtin_amdgcn_cvt_pk_fp8_f32(a, b, w, false); w = __builtin_amdgcn_cvt_pk_fp8_f32(c, d, w, true); return (unsigned)w; }
__device__ __forceinline__ v4u pack8_bf16(const f32x4 a, const f32x4 b) { v4u w; w.x = cvt_pk_bf16(a[0], a[1]); w.y = cvt_pk_bf16(a[2], a[3]); w.z = cvt_pk_bf16(b[0], b[1]); w.w = cvt_pk_bf16(b[2], b[3]); return w; }
__device__ __forceinline__ void unpack8(const v4u w, f32x4& a, f32x4& b) { a = (f32x4){bflo(w[0]), bfhi(w[0]), bflo(w[1]), bfhi(w[1])}; b = (f32x4){bflo(w[2]), bfhi(w[2]), bflo(w[3]), bfhi(w[3])}; }
struct EpiBf16Scale {
    bf16* O; int ldc; const float* rs;
    __device__ __forceinline__ void prefetch(const Unit& u, LAS unsigned char* tab, int lane) const {
        if (rs) __builtin_amdgcn_global_load_lds((const unsigned*)(rs + u.pm * BM + 4 * lane), (LAS unsigned*)tab, 16, 0, 0);
    }
    __device__ __forceinline__ void operator()(const f32x4 (&acc)[2][2][4][2], const Unit& u, int wr, int wc, int fr, int fq, const LAS unsigned char* tab) const {
        const int row0 = u.pm * BM + wr * 64 + fr, col0 = u.pn * BM + wc * 64 + 8 * fq;
        float sc[8];
#pragma unroll
        for (int q = 0; q < 8; ++q) sc[q] = rs ? ((const LAS float*)tab)[wr * 64 + fr + (q >> 2) * HALF + (q & 3) * 16] : 1.f;
#pragma unroll
        for (int ai = 0; ai < 2; ++ai)
#pragma unroll
            for (int m = 0; m < 4; ++m) { const int row = row0 + ai * HALF + m * 16; const float s = sc[ai * 4 + m]; bf16* rowp = O + (size_t)row * ldc + col0;
#pragma unroll
                for (int bj = 0; bj < 2; ++bj) *(v4u*)(rowp + 32 * bj) = pack8_bf16(acc[ai][bj][m][0] * s, acc[ai][bj][m][1] * s); }
    }
};
struct EpiF8x16 {
    unsigned char* O8; int ldc;
    __device__ __forceinline__ void prefetch(const Unit&, LAS unsigned char*, int) const {}
    __device__ __forceinline__ void operator()(const f32x4 (&acc)[2][2][4][2], const Unit& u, int wr, int wc, int fr, int fq, const LAS unsigned char*) const {
        const int row0 = u.pm * BM + wr * 64 + fr, col0 = u.pn * BM + wc * 64 + 8 * fq;
#pragma unroll
        for (int ai = 0; ai < 2; ++ai)
#pragma unroll
            for (int m = 0; m < 4; ++m) { unsigned char* rowp = O8 + (size_t)(row0 + ai * HALF + m * 16) * ldc + col0;
#pragma unroll
                for (int bj = 0; bj < 2; ++bj) { const f32x4 v0 = acc[ai][bj][m][0] * 16.f, v1 = acc[ai][bj][m][1] * 16.f;
                    v2u w; w.x = cvt4_fp8(v0[0], v0[1], v0[2], v0[3]); w.y = cvt4_fp8(v1[0], v1[1], v1[2], v1[3]);
                    *(v2u*)(rowp + 32 * bj) = w; } }
    }
};
struct EpiProj {
    bf16* O; bf16* QKV; const float* rs;
    __device__ __forceinline__ void prefetch(const Unit& u, LAS unsigned char* tab, int lane) const {
        __builtin_amdgcn_global_load_lds((const unsigned*)(rs + u.pm * BM + 4 * lane), (LAS unsigned*)tab, 16, 0, 0);
    }
    __device__ __forceinline__ void operator()(const f32x4 (&acc)[2][2][4][2], const Unit& u, int wr, int wc, int fr, int fq, const LAS unsigned char* tab) const {
        const int row0 = u.pm * BM + wr * 64 + fr;
        float sc[8];
#pragma unroll
        for (int q = 0; q < 8; ++q) sc[q] = ((const LAS float*)tab)[wr * 64 + fr + (q >> 2) * HALF + (q & 3) * 16];
        const bool conv = u.pn < PCW / BM;
        const int cp = (conv ? u.pn : (u.pn - PCW / BM) & 3) * BM + wc * 64 + 8 * fq;
        const int part = (u.pn - PCW / BM) >> 2, h = cp >> 7, d = cp & 127;
#pragma unroll
        for (int ai = 0; ai < 2; ++ai)
#pragma unroll
            for (int m = 0; m < 4; ++m) { const int row = row0 + ai * HALF + m * 16; const float s = sc[ai * 4 + m];
                bf16* rowp = conv ? O + (size_t)row * PCW + cp : QKV + ((((size_t)part * NB + (row >> 12)) * NH + h) * SEQ + (row & (SEQ - 1))) * HD + d;
#pragma unroll
                for (int bj = 0; bj < 2; ++bj) *(v4u*)(rowp + 32 * bj) = pack8_bf16(acc[ai][bj][m][0] * s, acc[ai][bj][m][1] * s); }
    }
};
struct EpiResF32 {
    bf16* O; const bf16* X; int ldc; unsigned char* O8; float* ssq1;
    __device__ __forceinline__ void prefetch(const Unit&, LAS unsigned char*, int) const {}
    __device__ __forceinline__ void operator()(const f32x4 (&acc)[2][2][4][2], const Unit& u, int wr, int wc, int fr, int fq, const LAS unsigned char*) const {
        const int row0 = u.pm * BM + wr * 64 + fr, col0 = u.pn * BM + wc * 64 + 8 * fq;
#pragma unroll
        for (int ai = 0; ai < 2; ++ai) {
            v4u xw[4][2];
#pragma unroll
            for (int m = 0; m < 4; ++m)
#pragma unroll
                for (int bj = 0; bj < 2; ++bj) xw[m][bj] = *(const v4u*)(X + (size_t)(row0 + ai * HALF + m * 16) * ldc + col0 + 32 * bj);
#pragma unroll
            for (int m = 0; m < 4; ++m) { const int row = row0 + ai * HALF + m * 16; const size_t ro = (size_t)row * ldc + col0; float ss = 0.f;
#pragma unroll
                for (int bj = 0; bj < 2; ++bj) { f32x4 x0, x1; unpack8(xw[m][bj], x0, x1);
                    const f32x4 v0 = acc[ai][bj][m][0] + x0, v1 = acc[ai][bj][m][1] + x1;
#pragma unroll
                    for (int j = 0; j < 4; ++j) ss += v0[j] * v0[j] + v1[j] * v1[j];
                    v2u w8; w8.x = cvt4_fp8(v0[0], v0[1], v0[2], v0[3]); w8.y = cvt4_fp8(v1[0], v1[1], v1[2], v1[3]);
                    *(v2u*)(O8 + ro + 32 * bj) = w8; }
                ss += __shfl_xor(ss, 16); ss += __shfl_xor(ss, 32);
                if (fq == 0) ssq1[(size_t)(u.pn * 4 + wc) * T + row] = ss; }
        }
    }
};
struct EpiGateUp {
    unsigned char* Hp; const float* rr;
    __device__ __forceinline__ void prefetch(const Unit& u, LAS unsigned char* tab, int lane) const {
        __builtin_amdgcn_global_load_lds((const unsigned*)(rr + u.pm * BM + 4 * lane), (LAS unsigned*)tab, 16, 0, 0);
    }
    __device__ __forceinline__ void operator()(const f32x4 (&acc)[2][2][4][2], const Unit& u, int wr, int wc, int fr, int fq, const LAS unsigned char* tab) const {
        const int row0 = u.pm * BM + wr * 64 + fr, col0 = u.pn * HALF + wc * 32 + 8 * fq;
        float sc[8];
#pragma unroll
        for (int q = 0; q < 8; ++q) sc[q] = ((const LAS float*)tab)[wr * 64 + fr + (q >> 2) * HALF + (q & 3) * 16];
#pragma unroll
        for (int ai = 0; ai < 2; ++ai)
#pragma unroll
            for (int m = 0; m < 4; ++m) { const int row = row0 + ai * HALF + m * 16; const float s = sc[ai * 4 + m];
                const float sn = s * -1.4426950409f, is2 = __builtin_amdgcn_rcpf(s * s);
                float h[8];
#pragma unroll
                for (int n = 0; n < 2; ++n)
#pragma unroll
                    for (int j = 0; j < 4; ++j) { const float ag = acc[ai][0][m][n][j], au = acc[ai][1][m][n][j];
                        h[n * 4 + j] = (ag * au) * __builtin_amdgcn_rcpf(__builtin_fmaf(__builtin_amdgcn_exp2f(ag * sn), is2, is2)); }
                v2u w; w.x = cvt4_fp8(h[0], h[1], h[2], h[3]); w.y = cvt4_fp8(h[4], h[5], h[6], h[7]);
                *(v2u*)(Hp + (size_t)row * ED + col0) = w; }
    }
};
struct EpiDown {
    unsigned char* S0; unsigned char* S1; unsigned char* S8; const float* rw; const int* rdst;
    __device__ __forceinline__ void prefetch(const Unit& u, LAS unsigned char* tab, int lane) const {
        __builtin_amdgcn_global_load_lds((const unsigned*)(rw + u.pm * BM + 4 * lane), (LAS unsigned*)tab, 16, 0, 0);
        __builtin_amdgcn_global_load_lds((const unsigned*)(rdst + u.pm * BM + 4 * lane), (LAS unsigned*)(tab + 1024), 16, 0, 0);
    }
    __device__ __forceinline__ void operator()(const f32x4 (&acc)[2][2][4][2], const Unit& u, int wr, int wc, int fr, int fq, const LAS unsigned char* tab) const {
        const int row0 = u.pm * BM + wr * 64 + fr, col0 = u.pn * BM + wc * 64 + 16 * fq;
        float sc[8]; int ds[8];
#pragma unroll
        for (int q = 0; q < 8; ++q) { const int lr = wr * 64 + fr + (q >> 2) * HALF + (q & 3) * 16; sc[q] = ((const LAS float*)tab)[lr]; ds[q] = ((const LAS int*)(tab + 1024))[lr]; }
#pragma unroll
        for (int ai = 0; ai < 2; ++ai)
#pragma unroll
            for (int m = 0; m < 4; ++m) { const float s = sc[ai * 4 + m] * SLOT_SCALE; const int dst = ds[ai * 4 + m];
                if (dst >= 0) { unsigned char* rowp = (dst < 4 * T ? S0 + (size_t)dst * D : dst < 8 * T ? S1 + (size_t)(dst - 4 * T) * D : S8 + (size_t)(dst - 8 * T) * D) + col0;
                    v4u w;
#pragma unroll
                    for (int bj = 0; bj < 2; ++bj) { const f32x4 v0 = acc[ai][bj][m][0] * s, v1 = acc[ai][bj][m][1] * s;
                        w[2 * bj] = cvt4_fp8(v0[0], v0[1], v0[2], v0[3]); w[2 * bj + 1] = cvt4_fp8(v1[0], v1[1], v1[2], v1[3]); }
                    *(v4u*)rowp = w; } }
    }
};
struct EpiPle {
    unsigned char* H3; const unsigned char* H2; const unsigned char* PP; const float* ssq2; float* ssq3;
    __device__ __forceinline__ void prefetch(const Unit&, LAS unsigned char*, int) const {}
    __device__ __forceinline__ void operator()(const f32x4 (&acc)[2][2][4][2], const Unit& u, int wr, int wc, int fr, int fq, const LAS unsigned char*) const {
        const int row0 = u.pm * BM + wr * 64 + fr, col0 = u.pn * BM + wc * 64 + 8 * fq;
        float sq[8];
#pragma unroll
        for (int q = 0; q < 8; ++q) sq[q] = ssq2[row0 + (q >> 2) * HALF + (q & 3) * 16];
#pragma unroll
        for (int ai = 0; ai < 2; ++ai)
#pragma unroll
            for (int mp = 0; mp < 2; ++mp) {
                v2u hw[2][2]; v2u pw[2][2];
#pragma unroll
                for (int mm = 0; mm < 2; ++mm)
#pragma unroll
                    for (int bj = 0; bj < 2; ++bj) { const size_t o = (size_t)(row0 + ai * HALF + (2 * mp + mm) * 16) * D + col0 + 32 * bj; hw[mm][bj] = *(const v2u*)(H2 + o); pw[mm][bj] = *(const v2u*)(PP + o); }
#pragma unroll
                for (int mm = 0; mm < 2; ++mm) { const int m = 2 * mp + mm, row = row0 + ai * HALF + m * 16;
                    const float rn = __builtin_amdgcn_rsqf(sq[ai * 4 + m] * (1.f / D) + EPS) * -1.4426950409f;
                    const size_t ro = (size_t)row * D + col0; float ss = 0.f;
#pragma unroll
                    for (int bj = 0; bj < 2; ++bj) { f32x4 h0, h1, p0, p1;
                        { const f32x2 a = __builtin_amdgcn_cvt_pk_f32_fp8((int)hw[mm][bj].x, false), b = __builtin_amdgcn_cvt_pk_f32_fp8((int)hw[mm][bj].x, true),
                                      c = __builtin_amdgcn_cvt_pk_f32_fp8((int)hw[mm][bj].y, false), d = __builtin_amdgcn_cvt_pk_f32_fp8((int)hw[mm][bj].y, true);
                          h0 = (f32x4){a.x, a.y, b.x, b.y}; h1 = (f32x4){c.x, c.y, d.x, d.y}; }
                        { const f32x2 a = __builtin_amdgcn_cvt_pk_f32_fp8((int)pw[mm][bj].x, false), b = __builtin_amdgcn_cvt_pk_f32_fp8((int)pw[mm][bj].x, true),
                                      c = __builtin_amdgcn_cvt_pk_f32_fp8((int)pw[mm][bj].y, false), d = __builtin_amdgcn_cvt_pk_f32_fp8((int)pw[mm][bj].y, true);
                          p0 = (f32x4){a.x, a.y, b.x, b.y}; p1 = (f32x4){c.x, c.y, d.x, d.y}; }
                        f32x4 o0, o1;
#pragma unroll
                        for (int j = 0; j < 4; ++j) {
                            o0[j] = h0[j] + p0[j] * __builtin_amdgcn_rcpf(__builtin_fmaf(__builtin_amdgcn_exp2f(acc[ai][bj][m][0][j] * rn), 16.f, 16.f));
                            o1[j] = h1[j] + p1[j] * __builtin_amdgcn_rcpf(__builtin_fmaf(__builtin_amdgcn_exp2f(acc[ai][bj][m][1][j] * rn), 16.f, 16.f));
                            ss += o0[j] * o0[j] + o1[j] * o1[j]; }
                        v2u w8; w8.x = cvt4_fp8(o0[0], o0[1], o0[2], o0[3]); w8.y = cvt4_fp8(o1[0], o1[1], o1[2], o1[3]);
                        *(v2u*)(H3 + ro + 32 * bj) = w8; }
                    ss += __shfl_xor(ss, 16); ss += __shfl_xor(ss, 32);
                    if (fq == 0) ssq3[(size_t)(u.pn * 4 + wc) * T + row] = ss; }
            }
    }
};
}

struct Frame {
    LAS unsigned char* lds;
    int tid, lane, wave, G, bx;
    unsigned char* ws;
    const float* in[21];
    float* out;
};
enum { I_X = 0, I_P, I_NMIX, I_WIN, I_CONVW, I_GCONV, I_GSB, I_WOUT, I_NFFN, I_WR, I_RB, I_WEG, I_WEU, I_WED, I_WSG, I_WSU, I_WSD, I_NPLE, I_WPG, I_WPP, I_NFIN };

__device__ __forceinline__ void p0_transpose_item(const float* W, int N, bf16* WT, int ldk, int k0, int n0, int row_off, const float* g64, LAS float* scr, int lane) {
    const int n4 = lane & 15, kr = lane >> 4;
    f32x4 v[16];
    const float* src = W + (size_t)(k0 + kr) * N + n0 + 4 * n4;
#pragma unroll
    for (int i = 0; i < 16; ++i) v[i] = *(const GAS f32x4*)(src + (size_t)(4 * i) * N);
    const int c = lane >> 3, nn = lane & 7;
    f32x4 ga = (f32x4){1.f, 1.f, 1.f, 1.f}, gb = ga;
    if (g64) { ga = *(const GAS f32x4*)(g64 + 8 * c); gb = *(const GAS f32x4*)(g64 + 8 * c + 4); }
#pragma unroll
    for (int i = 0; i < 16; ++i) { LAS float* d = scr + (4 * i + kr) * 65 + 4 * n4; d[0] = v[i].x; d[1] = v[i].y; d[2] = v[i].z; d[3] = v[i].w; }
    LDS_WAIT(); asm volatile("" ::: "memory");
#pragma unroll
    for (int j = 0; j < 8; ++j) { const int n = nn + 8 * j; const LAS float* s = scr + (8 * c) * 65 + n;
        v4u o; o.x = pg8::cvt_pk_bf16(s[0] * ga.x, s[65] * ga.y); o.y = pg8::cvt_pk_bf16(s[130] * ga.z, s[195] * ga.w); o.z = pg8::cvt_pk_bf16(s[260] * gb.x, s[325] * gb.y); o.w = pg8::cvt_pk_bf16(s[390] * gb.z, s[455] * gb.w);
        *(GAS v4u*)(WT + (size_t)(row_off + n) * ldk + k0 + 8 * c) = o; }
    LDS_WAIT(); asm volatile("" ::: "memory");
}
__device__ __forceinline__ void p0_transpose_item_f8(const float* W, int N, unsigned char* WT, int ldk, int k0, int n0, int row_off, int mode, const float* g64, LAS float* scr, int lane) {
    const int n4 = lane & 15, kr = lane >> 4;
    f32x4 v[16];
    const float* src = W + (size_t)(k0 + kr) * N + n0 + 4 * n4;
#pragma unroll
    for (int i = 0; i < 16; ++i) v[i] = *(const GAS f32x4*)(src + (size_t)(4 * i) * N);
    const int c = lane >> 4, nn = lane & 15;
    float g[16];
#pragma unroll
    for (int q = 0; q < 4; ++q) { f32x4 t = (f32x4){1.f, 1.f, 1.f, 1.f}; if (g64) t = *(const GAS f32x4*)(g64 + 16 * c + 4 * q); g[4 * q] = 64.f * t.x; g[4 * q + 1] = 64.f * t.y; g[4 * q + 2] = 64.f * t.z; g[4 * q + 3] = 64.f * t.w; }
#pragma unroll
    for (int i = 0; i < 16; ++i) { LAS float* d = scr + (4 * i + kr) * 65 + 4 * n4; d[0] = v[i].x; d[1] = v[i].y; d[2] = v[i].z; d[3] = v[i].w; }
    LDS_WAIT(); asm volatile("" ::: "memory");
#pragma unroll
    for (int j = 0; j < 4; ++j) { const int n = nn + 16 * j; const LAS float* s = scr + (16 * c) * 65 + n;
        v4u o;
        o.x = pg8::cvt4_fp8(s[0] * g[0], s[65] * g[1], s[130] * g[2], s[195] * g[3]); o.y = pg8::cvt4_fp8(s[260] * g[4], s[325] * g[5], s[390] * g[6], s[455] * g[7]);
        o.z = pg8::cvt4_fp8(s[520] * g[8], s[585] * g[9], s[650] * g[10], s[715] * g[11]); o.w = pg8::cvt4_fp8(s[780] * g[12], s[845] * g[13], s[910] * g[14], s[975] * g[15]);
        const int hid = n0 + n, drow = mode == 0 ? row_off + n : 16 * (hid >> 3) + 8 * (mode - 1) + (hid & 7);
        *(GAS v4u*)(WT + (size_t)drow * ldk + k0 + 16 * c) = o; }
    LDS_WAIT(); asm volatile("" ::: "memory");
}
constexpr int P0_I_WIN = (D / 64) * (NPROJ / 64), P0_I_WOUT = (D / 64) * (D / 64), P0_I_WR = (D / 64) * (NE / 64), P0_I_WPG = (D / 64) * (D / 64), P0_I_WPP = (PLE / 64) * (D / 64);
struct ExpItem { const float* src; const float* g128; unsigned char* dst; int N, ldk, k0, n0, mode; };
__device__ __forceinline__ void exp_issue(const ExpItem& I, int lane, f32x4 (&v)[32], f32x4 (&gq)[8]) {
    const int n4 = lane & 15, kr = lane >> 4;
#pragma unroll
    for (int q = 0; q < 8; ++q) { gq[q] = (f32x4){1.f, 1.f, 1.f, 1.f}; if (I.g128) gq[q] = *(const GAS f32x4*)(I.g128 + 64 * (q >> 2) + 16 * (lane >> 4) + 4 * (q & 3)); }
    const float* src = I.src + (size_t)(I.k0 + kr) * I.N + I.n0 + 4 * n4;
#pragma unroll
    for (int i = 0; i < 32; ++i) v[i] = *(const GAS f32x4*)(src + (size_t)(4 * i) * I.N);
}
template <int H> __device__ __forceinline__ void exp_finish_half(const ExpItem& I, int lane, const f32x4 (&v)[32], const f32x4 (&gq)[8], LAS float* scr) {
    const int n4 = lane & 15, kr = lane >> 4, c = lane >> 4, nn = lane & 15;
    float g[16];
#pragma unroll
    for (int q = 0; q < 4; ++q) { g[4 * q] = 64.f * gq[4 * H + q].x; g[4 * q + 1] = 64.f * gq[4 * H + q].y; g[4 * q + 2] = 64.f * gq[4 * H + q].z; g[4 * q + 3] = 64.f * gq[4 * H + q].w; }
#pragma unroll
    for (int i = 0; i < 16; ++i) { LAS float* d = scr + (4 * i + kr) * 65 + 4 * n4; d[0] = v[16 * H + i].x; d[1] = v[16 * H + i].y; d[2] = v[16 * H + i].z; d[3] = v[16 * H + i].w; }
    LDS_WAIT(); asm volatile("" ::: "memory");
#pragma unroll
    for (int j = 0; j < 4; ++j) { const int n = nn + 16 * j; const LAS float* s = scr + (16 * c) * 65 + n;
        v4u o;
        o.x = pg8::cvt4_fp8(s[0] * g[0], s[65] * g[1], s[130] * g[2], s[195] * g[3]); o.y = pg8::cvt4_fp8(s[260] * g[4], s[325] * g[5], s[390] * g[6], s[455] * g[7]);
        o.z = pg8::cvt4_fp8(s[520] * g[8], s[585] * g[9], s[650] * g[10], s[715] * g[11]); o.w = pg8::cvt4_fp8(s[780] * g[12], s[845] * g[13], s[910] * g[14], s[975] * g[15]);
        const int hid = I.n0 + n, drow = I.mode == 0 ? hid : 16 * (hid >> 3) + 8 * (I.mode - 1) + (hid & 7);
        *(GAS v4u*)(I.dst + (size_t)drow * I.ldk + I.k0 + 64 * H + 16 * c) = o; }
    LDS_WAIT(); asm volatile("" ::: "memory");
}
constexpr int P0_NONEXP = P0_I_WIN + P0_I_WOUT + P0_I_WR + P0_I_WPG + P0_I_WPP;
constexpr int P0_I_EXP = 768, P0_NITEMS = P0_I_WIN + P0_I_WOUT + P0_I_WR + P0_I_WPG + P0_I_WPP + 65 * P0_I_EXP;
__device__ __forceinline__ void p0_item(Frame& F, int it, LAS float* scr) {
    unsigned char* ws = F.ws; const int lane = F.lane;
    if (it < P0_I_WIN) { const int kb = it / (NPROJ / 64), nb = it % (NPROJ / 64); p0_transpose_item(F.in[I_WIN], NPROJ, (bf16*)(ws + WS_WIN), D, 64 * kb, 64 * nb, 64 * nb, F.in[I_NMIX] + 64 * kb, scr, lane); return; } it -= P0_I_WIN;
    if (it < P0_I_WOUT) { const int kb = it / (D / 64), nb = it % (D / 64), k0 = 64 * kb; const float* g = k0 < CW ? F.in[I_GCONV] + k0 : F.in[I_GSB] + (k0 - CW);
        p0_transpose_item_f8(F.in[I_WOUT], D, ws + WS_WOUT, D, k0, 64 * nb, 64 * nb, 0, g, scr, lane); return; } it -= P0_I_WOUT;
    if (it < P0_I_WR) return; it -= P0_I_WR;
    if (it < P0_I_WPG) { const int kb = it / (D / 64), nb = it % (D / 64); p0_transpose_item_f8(F.in[I_WPG], D, ws + WS_WPG, D, 64 * kb, 64 * nb, 64 * nb, 0, F.in[I_NPLE] + 64 * kb, scr, lane); return; } it -= P0_I_WPG;
    if (it < P0_I_WPP) { const int kb = it / (D / 64), nb = it % (D / 64); p0_transpose_item(F.in[I_WPP], D, (bf16*)(ws + WS_WPP), PLE, 64 * kb, 64 * nb, 64 * nb, nullptr, scr, lane); return; } it -= P0_I_WPP;
    const int e = it / P0_I_EXP, r = it % P0_I_EXP, sub = r / 256, q = r % 256;
    if (sub < 2) {
        const float* src = e < NE ? (sub == 0 ? F.in[I_WEG] : F.in[I_WEU]) + (size_t)e * D * ED : (sub == 0 ? F.in[I_WSG] : F.in[I_WSU]);
        const int kb = q / (ED / 64), nb = q % (ED / 64), n0 = 64 * nb;
        p0_transpose_item_f8(src, ED, ws + WS_WGU + (size_t)e * 1024 * D, D, 64 * kb, n0, 0, 1 + sub, F.in[I_NFFN] + 64 * kb, scr, lane);
    } else {
        const float* src = e < NE ? F.in[I_WED] + (size_t)e * ED * D : F.in[I_WSD];
        const int kb = q / (D / 64), nb = q % (D / 64);
        p0_transpose_item_f8(src, D, ws + WS_WDN + (size_t)e * D * ED, ED, 64 * kb, 64 * nb, 64 * nb, 0, nullptr, scr, lane);
    }
}
constexpr int EXP_ITEMS_PER = 384, EXP_ITEMS = 65 * EXP_ITEMS_PER;
__device__ __forceinline__ ExpItem exp_decode(Frame& F, int it) {
    unsigned char* ws = F.ws; ExpItem I;
    const int e = it / EXP_ITEMS_PER, r = it % EXP_ITEMS_PER, sub = r / 128, q = r % 128;
    if (sub < 2) { I.src = e < NE ? (sub == 0 ? F.in[I_WEG] : F.in[I_WEU]) + (size_t)e * D * ED : (sub == 0 ? F.in[I_WSG] : F.in[I_WSU]);
        const int kb = q / (ED / 64), nb = q % (ED / 64); I.N = ED; I.dst = ws + WS_WGU + (size_t)e * 1024 * D; I.ldk = D; I.k0 = 128 * kb; I.n0 = 64 * nb; I.mode = 1 + sub; I.g128 = F.in[I_NFFN] + 128 * kb; }
    else { I.src = e < NE ? F.in[I_WED] + (size_t)e * ED * D : F.in[I_WSD];
        const int kb = q / (D / 64), nb = q % (D / 64); I.N = D; I.dst = ws + WS_WDN + (size_t)e * D * ED; I.ldk = ED; I.k0 = 128 * kb; I.n0 = 64 * nb; I.mode = 0; I.g128 = nullptr; }
    return I;
}
__device__ __forceinline__ void p0_xpass(Frame& F) {
    const int lane = F.lane, r16 = lane & 15, g = lane >> 4, tid = F.tid;
    const float* x = F.in[I_X]; const float* wr = F.in[I_WR]; const float* gf = F.in[I_NFFN]; const float* wo = F.in[I_WOUT];
    bf16* XB = (bf16*)F.out; float* rmix = (float*)(F.ws + WS_RMIX); float* logx = (float*)(F.ws + WS_LOGX); bf16* wor = (bf16*)(F.ws + WS_WOR);
    LAS unsigned char* WL = F.lds;
    const int NGW = F.G * NWAVES;
    for (int u0 = F.bx * NWAVES; u0 < T / 16; u0 += NGW) {
        const int unit = u0 + F.wave; const bool act = unit < T / 16; const int t0 = unit * 16;
        const bool wact = act && (unit & 15) == 0; const int k0w = unit;
        f32x4 acc[4], acw[4];
#pragma unroll
        for (int nb = 0; nb < 4; ++nb) { acc[nb] = (f32x4){0.f, 0.f, 0.f, 0.f}; acw[nb] = (f32x4){0.f, 0.f, 0.f, 0.f}; }
        float ss = 0.f;
        for (int kc = 0; kc < 4; ++kc) {
            __syncthreads();
            { const int k = 512 * kc + tid; const float gk = gf[k]; const float* wp = wr + (size_t)k * NE;
#pragma unroll
              for (int q = 0; q < 16; ++q) { const f32x4 v = *(const GAS f32x4*)(wp + 4 * q);
                  *(LAS unsigned short*)(WL + (4 * q + 0) * 1040 + 2 * tid) = (unsigned short)f2bf(v.x * gk); *(LAS unsigned short*)(WL + (4 * q + 1) * 1040 + 2 * tid) = (unsigned short)f2bf(v.y * gk);
                  *(LAS unsigned short*)(WL + (4 * q + 2) * 1040 + 2 * tid) = (unsigned short)f2bf(v.z * gk); *(LAS unsigned short*)(WL + (4 * q + 3) * 1040 + 2 * tid) = (unsigned short)f2bf(v.w * gk); } }
            __syncthreads();
            if (act) {
                f32x4 xv[16][2];
                const float* xp = x + (size_t)(t0 + r16) * D + 512 * kc + 8 * g;
#pragma unroll
                for (int ks = 0; ks < 16; ++ks) { xv[ks][0] = *(const GAS f32x4*)(xp + 32 * ks); xv[ks][1] = *(const GAS f32x4*)(xp + 32 * ks + 4); }
#pragma unroll
                for (int ks = 0; ks < 16; ++ks) { const f32x4 a0 = xv[ks][0], a1 = xv[ks][1];
                    ss += (a0.x * a0.x + a0.y * a0.y) + (a0.z * a0.z + a0.w * a0.w) + (a1.x * a1.x + a1.y * a1.y) + (a1.z * a1.z + a1.w * a1.w);
                    v4u w; w.x = pg8::cvt_pk_bf16(a0.x, a0.y); w.y = pg8::cvt_pk_bf16(a0.z, a0.w); w.z = pg8::cvt_pk_bf16(a1.x, a1.y); w.w = pg8::cvt_pk_bf16(a1.z, a1.w);
                    *(GAS v4u*)(XB + (size_t)(t0 + r16) * D + 512 * kc + 32 * ks + 8 * g) = w;
                    const bf16x8 af = __builtin_bit_cast(bf16x8, w);
#pragma unroll
                    for (int nb = 0; nb < 4; ++nb) { const bf16x8 bf = *(const LAS bf16x8*)(WL + (16 * nb + r16) * 1040 + 64 * ks + 16 * g); acc[nb] = __builtin_amdgcn_mfma_f32_16x16x32_bf16(af, bf, acc[nb], 0, 0, 0); } }
            }
            if (wact) {
                const float* wp = wo + (size_t)(k0w + r16) * D + 512 * kc + 8 * g;
                f32x4 wv[16][2];
#pragma unroll
                for (int ks = 0; ks < 16; ++ks) { wv[ks][0] = *(const GAS f32x4*)(wp + 32 * ks); wv[ks][1] = *(const GAS f32x4*)(wp + 32 * ks + 4); }
#pragma unroll
                for (int ks = 0; ks < 16; ++ks) { const f32x4 a0 = wv[ks][0], a1 = wv[ks][1];
                    v4u w; w.x = pg8::cvt_pk_bf16(a0.x, a0.y); w.y = pg8::cvt_pk_bf16(a0.z, a0.w); w.z = pg8::cvt_pk_bf16(a1.x, a1.y); w.w = pg8::cvt_pk_bf16(a1.z, a1.w);
                    const bf16x8 af = __builtin_bit_cast(bf16x8, w);
#pragma unroll
                    for (int nb = 0; nb < 4; ++nb) { const bf16x8 bf = *(const LAS bf16x8*)(WL + (16 * nb + r16) * 1040 + 64 * ks + 16 * g); acw[nb] = __builtin_amdgcn_mfma_f32_16x16x32_bf16(af, bf, acw[nb], 0, 0, 0); } }
            }
        }
        if (act) {
            ss += __shfl_xor(ss, 16); ss += __shfl_xor(ss, 32);
            if (g == 0) rmix[t0 + r16] = __builtin_amdgcn_rsqf(ss * (1.f / D) + EPS);
#pragma unroll
            for (int nb = 0; nb < 4; ++nb)
#pragma unroll
                for (int j = 0; j < 4; ++j) logx[(size_t)(t0 + 4 * g + j) * NE + 16 * nb + r16] = acc[nb][j];
        }
        if (wact) {
#pragma unroll
            for (int j = 0; j < 4; ++j) { const int k = k0w + 4 * g + j; const float gk = k < CW ? F.in[I_GCONV][k] : F.in[I_GSB][k - CW];
#pragma unroll
                for (int nb = 0; nb < 4; ++nb) wor[(size_t)(16 * nb + r16) * D + k] = (bf16)f2bf(acw[nb][j] * gk); }
        }
    }
    __syncthreads();
}
__device__ __forceinline__ void p0_prologue(Frame& F) {
    LAS float* scr = (LAS float*)(F.lds + RING_OFF + F.wave * 16896);
    const int gw = F.bx * NWAVES + F.wave, NGW = F.G * NWAVES;
    p0_xpass(F);
    {
        const float* p = F.in[I_P]; bf16* PB = (bf16*)(F.ws + WS_PB);
        const int nchunk = T * PLE / 8, gt = F.bx * NTHR + F.tid, NGT = F.G * NTHR;
        for (int c0 = gt; c0 < nchunk; c0 += 8 * NGT) {
            f32x4 a[8], b[8];
#pragma unroll
            for (int i = 0; i < 8; ++i) { const int c = c0 + i * NGT, cc = c < nchunk ? c : gt; a[i] = *(const GAS f32x4*)(p + (size_t)cc * 8); b[i] = *(const GAS f32x4*)(p + (size_t)cc * 8 + 4); }
#pragma unroll
            for (int i = 0; i < 8; ++i) { const int c = c0 + i * NGT;
                if (c < nchunk) { v4u w; w.x = pk2(a[i].x, a[i].y); w.y = pk2(a[i].z, a[i].w); w.z = pk2(b[i].x, b[i].y); w.w = pk2(b[i].z, b[i].w); *(GAS v4u*)(PB + (size_t)c * 8) = w; } }
        }
    }
    for (int it = gw; it < P0_NONEXP; it += NGW) p0_item(F, it, scr);
}

__device__ __forceinline__ unsigned off_b(unsigned row, unsigned ch) { return 256u * row + 16u * (ch ^ (((row & 3) << 2) | ((row >> 2) & 3))); }
#define MFMA32(a, b, c) __builtin_amdgcn_mfma_f32_32x32x16_bf16((a), (b), (c), 0, 0, 0)

__device__ __forceinline__ void conv_item(Frame& F, int it) {
    const bf16* proj = (const bf16*)(F.ws + WS_PROJ); bf16* ymix = (bf16*)F.out + (size_t)T * D;
    const float* cw = F.in[I_CONVW]; const int lane = F.lane;
    float w0[16], w1[16], w2[16], u1[16], u2[16];
#pragma unroll
    for (int j = 0; j < 2; ++j)
#pragma unroll
        for (int i = 0; i < 8; ++i) { const int c = 512 * j + 8 * lane + i; w0[8 * j + i] = cw[c]; w1[8 * j + i] = cw[CW + c]; w2[8 * j + i] = cw[2 * CW + c]; u1[8 * j + i] = 0.f; u2[8 * j + i] = 0.f; }
    const int t0 = 16 * it; const bool seq_start = (t0 & (SEQ - 1)) == 0;
    for (int g = 0; g < 6; ++g) {
        v4u hw[3][2], cwv[3][2], bw[3][2];
#pragma unroll
        for (int q = 0; q < 3; ++q) { const long t = (long)t0 - 2 + 3 * g + q; const bf16* pr = proj + t * PCW + 8 * lane;
#pragma unroll
            for (int j = 0; j < 2; ++j) { hw[q][j] = *(const GAS v4u*)(pr + 512 * j); cwv[q][j] = *(const GAS v4u*)(pr + 2 * CW + 512 * j); bw[q][j] = *(const GAS v4u*)(pr + CW + 512 * j); } }
#pragma unroll
        for (int q = 0; q < 3; ++q) { const int tt = -2 + 3 * g + q; const long t = (long)t0 + tt;
            float u[16];
#pragma unroll
            for (int j = 0; j < 2; ++j)
#pragma unroll
                for (int k = 0; k < 4; ++k) { u[8 * j + 2 * k] = bflo(hw[q][j][k]) * bflo(cwv[q][j][k]); u[8 * j + 2 * k + 1] = bfhi(hw[q][j][k]) * bfhi(cwv[q][j][k]); }
            if (tt < 0 && seq_start) {
#pragma unroll
                for (int i = 0; i < 16; ++i) u[i] = 0.f;
            }
            if (tt >= 0) {
                float y[16], ss = 0.f;
#pragma unroll
                for (int j = 0; j < 2; ++j)
#pragma unroll
                    for (int k = 0; k < 4; ++k) { const int i = 8 * j + 2 * k;
                        y[i] = bflo(bw[q][j][k]) * (w0[i] * u2[i] + w1[i] * u1[i] + w2[i] * u[i]); y[i + 1] = bfhi(bw[q][j][k]) * (w0[i + 1] * u2[i + 1] + w1[i + 1] * u1[i + 1] + w2[i + 1] * u[i + 1]);
                        ss += y[i] * y[i] + y[i + 1] * y[i + 1]; }
                const float r = __builtin_amdgcn_rsqf(wave_sum(ss) * (1.f / CW) + EPS);
                bf16* yo = ymix + t * D + 8 * lane;
#pragma unroll
                for (int j = 0; j < 2; ++j) { v4u w; w.x = pg8::cvt_pk_bf16(y[8 * j] * r, y[8 * j + 1] * r); w.y = pg8::cvt_pk_bf16(y[8 * j + 2] * r, y[8 * j + 3] * r); w.z = pg8::cvt_pk_bf16(y[8 * j + 4] * r, y[8 * j + 5] * r); w.w = pg8::cvt_pk_bf16(y[8 * j + 6] * r, y[8 * j + 7] * r);
                    *(GAS v4u*)(yo + 512 * j) = w;
                    v2u w8; w8.x = pg8::cvt4_fp8(y[8 * j] * r, y[8 * j + 1] * r, y[8 * j + 2] * r, y[8 * j + 3] * r); w8.y = pg8::cvt4_fp8(y[8 * j + 4] * r, y[8 * j + 5] * r, y[8 * j + 6] * r, y[8 * j + 7] * r);
                    *(GAS v2u*)(F.ws + WS_YMIX8 + (size_t)t * D + 8 * lane + 512 * j) = w8; }
            }
#pragma unroll
            for (int i = 0; i < 16; ++i) { u2[i] = u1[i]; u1[i] = u[i]; }
        }
    }
}

__device__ __forceinline__ bf16x8 pack8(float a0, float a1, float a2, float a3, float a4, float a5, float a6, float a7) {
    v4u p; p.x = pg8::cvt_pk_bf16(a0, a1); p.y = pg8::cvt_pk_bf16(a2, a3); p.z = pg8::cvt_pk_bf16(a4, a5); p.w = pg8::cvt_pk_bf16(a6, a7); return __builtin_bit_cast(bf16x8, p);
}
__device__ __forceinline__ void tr_read4(unsigned a_t0, unsigned a_t1, s16x4& r00, s16x4& r01, s16x4& r10, s16x4& r11) {
    asm volatile("ds_read_b64_tr_b16 %0, %4\n\tds_read_b64_tr_b16 %1, %5\n\tds_read_b64_tr_b16 %2, %4 offset:4096\n\tds_read_b64_tr_b16 %3, %5 offset:4096\n\ts_waitcnt lgkmcnt(0)"
                 : "=&v"(r00), "=&v"(r01), "=&v"(r10), "=&v"(r11) : "v"(a_t0), "v"(a_t1) : "memory");
}
constexpr float ATT_C = 0.08838834764831845f * 1.4426950408889634f;
constexpr float ATT_EXIT = -152.f;

__device__ __forceinline__ float attn_head(Frame& F, int lw, int h, int b, int qblk, f32x16 (&oacc)[4]) {
    const int lane = F.lane, r = lane & 31, hh = lane >> 5;
    const bf16* qkv = (const bf16*)(F.ws + WS_QKV);
    const size_t hb = ((size_t)b * NH + h) * SEQ;
    const int t0 = qblk * 32;
    LAS unsigned char* kt = F.lds + lw * 16384; LAS unsigned char* vt = kt + 8192;
    bf16x8 qf[8];
    { const bf16* qp = qkv + (hb + t0 + r) * HD + 8 * hh;
#pragma unroll
      for (int kk = 0; kk < 8; ++kk) qf[kk] = *(const GAS bf16x8*)(qp + 16 * kk); }
#pragma unroll
    for (int c = 0; c < 4; ++c)
#pragma unroll
        for (int i = 0; i < 16; ++i) oacc[c][i] = 0.f;
    float L = 0.f;
    const unsigned pr = (unsigned)((r & 19) | ((r & 4) << 1) | ((r & 8) >> 1));
    const unsigned ktb = (unsigned)(size_t)kt, vtb = (unsigned)(size_t)vt;
    unsigned va[2][4];
    { const unsigned blk = (lane >> 4) & 1, q = (lane & 15) >> 2, p = lane & 3;
#pragma unroll
      for (int t = 0; t < 2; ++t)
#pragma unroll
          for (int c = 0; c < 4; ++c) va[t][c] = vtb + off_b(8 * hh + 4 * t + q, 4 * c + 2 * blk + (p >> 1)) + 8 * (p & 1); }
    unsigned loff[8];
#pragma unroll
    for (int i = 0; i < 8; ++i) { const unsigned row = 4 * i + (lane >> 4), ch = (lane & 15) ^ (((row & 3) << 2) | ((row >> 2) & 3)); loff[i] = (row * HD + ch * 8) * 2; }
    const char* kvb = (const char*)(qkv + ((size_t)NB * NH * SEQ + hb) * HD);
    constexpr size_t VOFF = (size_t)NB * NH * SEQ * HD * 2;
#define ATT_DMA(ldsb, gp) do { _Pragma("unroll") for (int _i = 0; _i < 8; ++_i) \
        __builtin_amdgcn_global_load_lds((const unsigned*)((gp) + loff[_i]), (LAS unsigned*)((ldsb) + _i * 1024), 16, 0, 0); } while (0)
    { const char* g0 = kvb + (size_t)(qblk * 32) * HD * 2; ATT_DMA(kt, g0); ATT_DMA(vt, g0 + VOFF); }
    for (int kti = qblk; kti >= 0; --kti) {
        const int s0 = kti * 32;
        const char* gn = kvb + (size_t)((kti > 0 ? kti - 1 : 0) * 32) * HD * 2;
        asm volatile("s_waitcnt vmcnt(8)" ::: "memory");
        f32x16 x;
#pragma unroll
        for (int i = 0; i < 16; ++i) x[i] = 0.f;
        bf16x8 kf[8];
#pragma unroll
        for (int kk = 0; kk < 8; ++kk) kf[kk] = *(const LAS bf16x8*)(kt + off_b(pr, 2 * kk + hh));
        LDS_WAIT();
        ATT_DMA(kt, gn);
#pragma unroll
        for (int kk = 0; kk < 8; ++kk) x = MFMA32(kf[kk], qf[kk], x);
        const bool diag = (kti == qblk);
        float zz[16], suf[16];
#pragma unroll
        for (int i = 0; i < 16; ++i) {
            zz[i] = x[i] * ATT_C;
            const float e = __builtin_amdgcn_exp2f(fminf(zz[i], 126.f));
            float l = -__builtin_amdgcn_logf(1.f + e);
            const int kap = 16 * (i >> 3) + 8 * hh + (i & 7);
            if (diag && !(kap < r)) l = 0.f;
            suf[i] = l;
        }
#pragma unroll
        for (int j = 6; j >= 0; --j) { suf[j] += suf[j + 1]; suf[8 + j] += suf[8 + j + 1]; }
        const float T0 = suf[0], T1 = suf[8];
        const float T0p = __shfl_xor(T0, 32), T1p = __shfl_xor(T1, 32);
        const float base0 = L + T1 + T1p + (hh == 0 ? T0p : 0.f), base1 = L + (hh == 0 ? T1p : 0.f);
        float a[16];
#pragma unroll
        for (int i = 0; i < 16; ++i) {
            float v = __builtin_amdgcn_exp2f(zz[i] + (i < 8 ? base0 : base1) + suf[i]);
            const int kap = 16 * (i >> 3) + 8 * hh + (i & 7);
            if (diag && !(kap < r)) v = 0.f;
            a[i] = v;
        }
        L += (T0 + T1) + (T0p + T1p);
        const bf16x8 pf0 = pack8(a[0], a[1], a[2], a[3], a[4], a[5], a[6], a[7]);
        const bf16x8 pf1 = pack8(a[8], a[9], a[10], a[11], a[12], a[13], a[14], a[15]);
        asm volatile("s_waitcnt vmcnt(8)" ::: "memory");
#pragma unroll
        for (int c = 0; c < 4; ++c) {
            s16x4 r00, r01, r10, r11; tr_read4(va[0][c], va[1][c], r00, r01, r10, r11);
            const bf16x8 vf0 = __builtin_shufflevector(r00, r01, 0, 1, 2, 3, 4, 5, 6, 7), vf1 = __builtin_shufflevector(r10, r11, 0, 1, 2, 3, 4, 5, 6, 7);
            oacc[c] = MFMA32(vf0, pf0, oacc[c]); oacc[c] = MFMA32(vf1, pf1, oacc[c]);
        }
        ATT_DMA(vt, gn + VOFF);
        if (__all(L < ATT_EXIT)) break;
    }
    VM_WAIT();
#undef ATT_DMA
    float ss = 0.f;
#pragma unroll
    for (int c = 0; c < 4; ++c)
#pragma unroll
        for (int i = 0; i < 16; ++i) ss += oacc[c][i] * oacc[c][i];
    ss += __shfl_xor(ss, 32);
    return ss;
}
constexpr int P2_BSCR_OFF = 65536, P2_XS_OFF = P2_BSCR_OFF + 4 * 16896;
static_assert(P2_XS_OFF + 2048 + 64 <= LDS_BYTES, "P2 LDS map");
__device__ __forceinline__ void p2_mixer(Frame& F) {
    const int lane = F.lane, w = F.wave, r = lane & 31, hh = lane >> 5;
    const int nunits = (NB * (SEQ / 32) - F.bx + F.G - 1) / F.G;
    if (F.tid < 8) ((volatile LAS unsigned*)(F.lds + P2_XS_OFF + 2048))[F.tid] = 0u;
    __syncthreads();
    if (w < 4) {
        bf16* ymix = (bf16*)F.out + (size_t)T * D;
        for (int j = 0; j < nunits; ++j) {
            const int u = F.bx + j * F.G, b = u % NB, qblk = u / NB;
            LAS float* XS = (LAS float*)(F.lds + P2_XS_OFF) + (j & 1) * 256;
            v2u st0[16];
            f32x16 oacc[4];
            const float ss0 = attn_head(F, w, w, b, qblk, oacc);
#pragma unroll
            for (int c = 0; c < 4; ++c)
#pragma unroll
                for (int g = 0; g < 4; ++g) { st0[c * 4 + g].x = pg8::cvt_pk_bf16(oacc[c][4 * g], oacc[c][4 * g + 1]); st0[c * 4 + g].y = pg8::cvt_pk_bf16(oacc[c][4 * g + 2], oacc[c][4 * g + 3]); }
            if (hh == 0) XS[w * 32 + r] = ss0;
            const float ss1 = attn_head(F, w, w + 4, b, qblk, oacc);
            if (hh == 0) XS[(w + 4) * 32 + r] = ss1;
            { volatile LAS unsigned* FL = (volatile LAS unsigned*)(F.lds + P2_XS_OFF + 2048) + (j & 1) * 4;
              LDS_WAIT(); if (lane == 0) FL[w] = (unsigned)(j + 1);
              for (unsigned sp = 0; sp < (1u << 22); ++sp) { const unsigned f0 = FL[0], f1 = FL[1], f2 = FL[2], f3 = FL[3]; if (f0 == (unsigned)(j + 1) && f1 == f0 && f2 == f0 && f3 == f0) break; __builtin_amdgcn_s_sleep(1); }
              asm volatile("" ::: "memory"); }
            float tot = 0.f;
#pragma unroll
            for (int k = 0; k < 8; ++k) tot += XS[k * 32 + r];
            const float rs = __builtin_amdgcn_rsqf(tot * (1.f / CW) + EPS);
            {
                LAS unsigned char* img = F.lds + w * 16384;
                int ln = lane; asm volatile("" : "+v"(ln));
                const int r = ln & 31, hh = ln >> 5;
                bf16* yrow = ymix + ((size_t)b * SEQ + qblk * 32) * D + CW + 8 * (ln & 15);
                unsigned char* y8 = F.ws + WS_YMIX8 + ((size_t)b * SEQ + qblk * 32) * D + CW + 16 * (ln & 7);
#pragma unroll
                for (int hsel = 0; hsel < 2; ++hsel) {
#pragma unroll
                    for (int c = 0; c < 4; ++c)
#pragma unroll
                        for (int g = 0; g < 4; ++g) { float v0, v1, v2, v3;
                            if (hsel == 0) { v0 = bflo(st0[c * 4 + g].x) * rs; v1 = bfhi(st0[c * 4 + g].x) * rs; v2 = bflo(st0[c * 4 + g].y) * rs; v3 = bfhi(st0[c * 4 + g].y) * rs; }
                            else { v0 = oacc[c][4 * g] * rs; v1 = oacc[c][4 * g + 1] * rs; v2 = oacc[c][4 * g + 2] * rs; v3 = oacc[c][4 * g + 3] * rs; }
                            const int col = 32 * c + 8 * g + 4 * hh;
                            v2u o; o.x = pg8::cvt_pk_bf16(v0, v1); o.y = pg8::cvt_pk_bf16(v2, v3);
                            *(LAS v2u*)(img + r * 264 + 2 * col) = o;
                            *(LAS unsigned*)(img + 8448 + r * 136 + col) = pg8::cvt4_fp8(v0, v1, v2, v3); }
                    LDS_WAIT();
#pragma unroll
                    for (int i = 0; i < 8; ++i) { const int row = (ln >> 4) + 4 * i; const LAS unsigned char* p = img + row * 264 + 16 * (ln & 15);
                        const v2u lo = *(const LAS v2u*)p, hi = *(const LAS v2u*)(p + 8); v4u o; o.x = lo.x; o.y = lo.y; o.z = hi.x; o.w = hi.y;
                        *(GAS v4u*)(yrow + (size_t)row * D + (w + 4 * hsel) * HD) = o; }
#pragma unroll
                    for (int i = 0; i < 4; ++i) { const int row = (ln >> 3) + 8 * i; const LAS unsigned char* p = img + 8448 + row * 136 + 16 * (ln & 7);
                        const v2u lo = *(const LAS v2u*)p, hi = *(const LAS v2u*)(p + 8); v4u o; o.x = lo.x; o.y = lo.y; o.z = hi.x; o.w = hi.y;
                        *(GAS v4u*)(y8 + (size_t)row * D + (w + 4 * hsel) * HD) = o; }
                    LDS_WAIT();
                }
            }
        }
    } else {
        LAS float* scr = (LAS float*)(F.lds + P2_BSCR_OFF + (w - 4) * 16896);
        const int gb = F.bx * 4 + (w - 4), NBW = F.G * 4;
        const int cnt = (EXP_ITEMS - gb + NBW - 1) / NBW;
        for (int j = 0; j < nunits; ++j) {
            const int k0 = (int)((long)cnt * j / nunits), k1 = (int)((long)cnt * (j + 1) / nunits);
            for (int k = k0; k < k1; ++k) {
                f32x4 v[32], gq[8];
                const ExpItem I = exp_decode(F, gb + k * NBW);
                exp_issue(I, lane, v, gq);
                exp_finish_half<0>(I, lane, v, gq, scr);
                exp_finish_half<1>(I, lane, v, gq, scr);
            }
        }
    }
    { unsigned* q = (unsigned*)(F.ws + WS_CTL) + CW_CONVQ;
      for (;;) { int it = 0; if (F.lane == 0) it = (int)__hip_atomic_fetch_add(q, 1u, __ATOMIC_RELAXED, __HIP_MEMORY_SCOPE_AGENT);
          it = __builtin_amdgcn_readfirstlane(it); if (it >= T / 16) break; conv_item(F, it); } }
}

constexpr int ROUTER_LG_OFF = 69632;
static_assert(64 * 1040 <= ROUTER_LG_OFF && ROUTER_LG_OFF + 8 * 6144 <= RT_OFF && 16 * 65 * 4 <= 6144, "router LDS map");
__device__ __forceinline__ void router_unit(Frame& F, int unit, LAS int* hist) {
    const int lane = F.lane, r16 = lane & 15, g = lane >> 4;
    const bf16* YM = (const bf16*)F.out + (size_t)T * D; const bf16* WOR = (const bf16*)(F.ws + WS_WOR);
    const int t0 = unit * 16;
    LAS float* LG = (LAS float*)(F.lds + ROUTER_LG_OFF + F.wave * 6144);
    LAS unsigned char* WL = F.lds;
    f32x4 acc[4];
#pragma unroll
    for (int nb = 0; nb < 4; ++nb) acc[nb] = (f32x4){0.f, 0.f, 0.f, 0.f};
    {
        const bf16* ap = YM + (size_t)(t0 + r16) * D + 8 * g;
        const int srow = F.tid >> 3, sseg = F.tid & 7;
        for (int kc = 0; kc < 4; ++kc) {
            v4u wst[8]; bf16x8 av[16];
#pragma unroll
            for (int i = 0; i < 8; ++i) wst[i] = *(const GAS v4u*)((const char*)WOR + (size_t)srow * (D * 2) + 1024 * kc + 128 * sseg + 16 * i);
#pragma unroll
            for (int ks = 0; ks < 16; ++ks) av[ks] = *(const GAS bf16x8*)(ap + 512 * kc + 32 * ks);
            __syncthreads();
#pragma unroll
            for (int i = 0; i < 8; ++i) *(LAS v4u*)(WL + srow * 1040 + 128 * sseg + 16 * i) = wst[i];
            __syncthreads();
#pragma unroll
            for (int ks = 0; ks < 16; ++ks)
#pragma unroll
                for (int nb = 0; nb < 4; ++nb) { const bf16x8 bf = *(const LAS bf16x8*)(WL + (16 * nb + r16) * 1040 + 64 * ks + 16 * g); acc[nb] = __builtin_amdgcn_mfma_f32_16x16x32_bf16(av[ks], bf, acc[nb], 0, 0, 0); }
        }
        const float* lx = (const float*)(F.ws + WS_LOGX) + (size_t)(t0 + 4 * g) * NE + r16;
#pragma unroll
        for (int nb = 0; nb < 4; ++nb)
#pragma unroll
            for (int j = 0; j < 4; ++j) acc[nb][j] += lx[(size_t)j * NE + 16 * nb];
    }
    float ss = 0.f;
    { const float* s1 = (const float*)(F.ws + WS_SSQ1) + (size_t)(8 * g) * T + t0 + r16;
#pragma unroll
      for (int p = 0; p < 8; ++p) ss += s1[(size_t)p * T]; }
    ss += __shfl_xor(ss, 16); ss += __shfl_xor(ss, 32);
#pragma unroll
    for (int nb = 0; nb < 4; ++nb)
#pragma unroll
        for (int j = 0; j < 4; ++j) LG[(4 * g + j) * 65 + 16 * nb + r16] = acc[nb][j];
    LDS_WAIT();
    if (lane < 16) {
        const int t = t0 + lane; const float rs = __builtin_amdgcn_rsqf(ss * (1.f / D) + EPS);
        ((float*)(F.ws + WS_RFFN))[t] = rs;
        const LAS float* lg = LG + lane * 65; const float* rb = F.in[I_RB];
        float sc[NE], bi[NE];
#pragma unroll
        for (int e = 0; e < NE; ++e) { const float s = fsigmoid(lg[e] * rs); sc[e] = s; bi[e] = s + rb[e]; }
        float gs[8];
#pragma unroll
        for (int gg = 0; gg < 8; ++gg) { float m1 = -__builtin_inff(), m2 = -__builtin_inff();
#pragma unroll
            for (int j = 0; j < 8; ++j) { const float v = bi[8 * gg + j]; const float lo = fminf(m1, v); m1 = fmaxf(m1, v); m2 = fmaxf(m2, lo); }
            gs[gg] = m1 + m2; }
        bool okg[8];
#pragma unroll
        for (int gg = 0; gg < 8; ++gg) { int cnt = 0;
#pragma unroll
            for (int g2 = 0; g2 < 8; ++g2) cnt += (gs[g2] > gs[gg] || (gs[g2] == gs[gg] && g2 < gg)) ? 1 : 0;
            okg[gg] = cnt < 4; }
#pragma unroll
        for (int e = 0; e < NE; ++e) bi[e] = okg[e >> 3] ? bi[e] : -__builtin_inff();
        int se[8]; float sv[8]; float wsum = 0.f;
#pragma unroll
        for (int k = 0; k < 8; ++k) { float best = -__builtin_inff(); int be = 0;
#pragma unroll
            for (int e = 0; e < NE; ++e) { const bool tk = bi[e] > best; best = tk ? bi[e] : best; be = tk ? e : be; }
            float svk = 0.f;
#pragma unroll
            for (int e = 0; e < NE; ++e) { const bool hit = (e == be); svk = hit ? sc[e] : svk; bi[e] = hit ? -__builtin_inff() : bi[e]; }
            se[k] = be; sv[k] = svk; wsum += svk; }
        const float inv = 2.5f / wsum;
        int* te = (int*)(F.ws + WS_TOPE) + (size_t)t * 8; float* tw = (float*)(F.ws + WS_TOPW) + (size_t)t * 8;
#pragma unroll
        for (int k = 0; k < 8; ++k) { te[k] = se[k]; tw[k] = sv[k] * inv; (void)__hip_atomic_fetch_add(hist + se[k], 1, __ATOMIC_RELAXED, __HIP_MEMORY_SCOPE_WORKGROUP); }
    }
}
__device__ __forceinline__ void p4_router(Frame& F) {
    LAS int* hist = (LAS int*)(F.lds + RT_OFF);
    for (int v = F.bx; v < 256; v += F.G) {
        if (F.tid < 64) hist[F.tid] = 0;
        __syncthreads();
        router_unit(F, v * 8 + F.wave, hist);
        __syncthreads();
        if (F.tid < 64) ((int*)(F.ws + WS_CNT))[v * 64 + F.tid] = hist[F.tid];
        __syncthreads();
    }
}

__device__ __forceinline__ void p4b_tables(Frame& F) {
    LAS int* L = (LAS int*)(F.lds + RING_OFF);
    LAS int* part_t = L;
    LAS int* part_b = L + 512;
    LAS int* totals = L + 1024;
    LAS int* below = L + 1088;
    LAS int* segst = L + 1152;
    LAS int* wcount = L + 1280;
    LAS int* pe = L + 2048;
    LAS int* rank = L + 3072;
    const int* CNT = (const int*)(F.ws + WS_CNT); const int* TOPE = (const int*)(F.ws + WS_TOPE); const float* TOPW = (const float*)(F.ws + WS_TOPW);
    const float* RFFN = (const float*)(F.ws + WS_RFFN);
    int* RTOK = (int*)(F.ws + WS_RTOK); float* RW = (float*)(F.ws + WS_RW); int* RDST = (int*)(F.ws + WS_RDST); float* RR = (float*)(F.ws + WS_RR); int* TILEE = (int*)(F.ws + WS_TILEE);
    const int tid = F.tid, lane = F.lane, wave = F.wave;
    for (int v = F.bx; v < 256; v += F.G) {
        { const int e = tid & 63, part = tid >> 6; int tot = 0, bel = 0;
          for (int vv = 32 * part; vv < 32 * part + 32; ++vv) { const int c = CNT[vv * 64 + e]; tot += c; bel += (vv < v) ? c : 0; }
          part_t[part * 64 + e] = tot; part_b[part * 64 + e] = bel; }
        for (int i = tid; i < 1024; i += NTHR) pe[i] = TOPE[(size_t)v * 1024 + i];
        __syncthreads();
        if (wave == 0) {
            int tot = 0, bel = 0;
#pragma unroll
            for (int p = 0; p < 8; ++p) { tot += part_t[p * 64 + lane]; bel += part_b[p * 64 + lane]; }
            totals[lane] = tot; below[lane] = bel;
            const int ru = (tot + 255) & ~255; int sc = ru;
#pragma unroll
            for (int o = 1; o < 64; o <<= 1) { const int n = __shfl_up(sc, o); if (lane >= o) sc += n; }
            segst[lane] = sc - ru; if (lane == 63) segst[64] = sc;
        }
        { int cnt = 0;
          for (int j = 0; j < 128; ++j) { const int p = 128 * wave + j; if (pe[p] == lane) { rank[p] = cnt; ++cnt; } }
          wcount[wave * 64 + lane] = cnt; }
        __syncthreads();
        const int SS = segst[64];
        for (int p = tid; p < 1024; p += NTHR) { const int e = pe[p], w = p >> 7; int off = 0;
            for (int w2 = 0; w2 < w; ++w2) off += wcount[w2 * 64 + e];
            const int row = segst[e] + below[e] + off + rank[p]; const int t = 128 * v + (p >> 3), k = p & 7;
            RTOK[row] = t; RW[row] = TOPW[(size_t)t * 8 + k]; RDST[row] = k * T + t; RR[row] = RFFN[t]; }
        if (tid < 128) { const int t = 128 * v + tid, row = SS + t; RTOK[row] = t; RW[row] = 1.f; RDST[row] = 8 * T + t; RR[row] = RFFN[t]; }
        if (v < NE) { const int e = v, tot = totals[e], ru = (tot + 255) & ~255, st = segst[e];
            if (tid < ru - tot) { const int row = st + tot + tid; RTOK[row] = 0; RW[row] = 0.f; RDST[row] = -1; RR[row] = 0.f; }
            if (tid < ru / 256) TILEE[st / 256 + tid] = e; }
        if (v == NE) { if (tid < T / 256) TILEE[SS / 256 + tid] = NE; if (tid == 0) TILEE[MAXTILES] = SS / 256 + T / 256; }
        __syncthreads();
    }
}

template <int MODE> __device__ __forceinline__ int group_setup(Frame& F, int nN) {
    const int* TILEE = (const int*)(F.ws + WS_TILEE);
    const int NT = __builtin_amdgcn_readfirstlane((int)__hip_atomic_load((unsigned*)TILEE + MAXTILES, RLX_AGENT));
    LAS int* te = (LAS int*)(F.lds + TE_OFF); LAS unsigned* rt = (LAS unsigned*)(F.lds + RT_OFF);
    for (int i = F.tid; i < NT && i < MAXTILES; i += NTHR) te[i] = TILEE[i];
    if (MODE == 1) {
        const int* RTOK = (const int*)(F.ws + WS_RTOK);
        for (int ui = F.tid >> 8; ui < RT_UNITS; ui += 2) { int pm, pn; if (!pg8::order_next(ui, F.G, F.bx, NT, nN, pm, pn)) break;
            rt[ui * 256 + (F.tid & 255)] = (unsigned)RTOK[pm * 256 + (F.tid & 255)] * (unsigned)D; }
    }
    __syncthreads();
    return NT;
}

__device__ __forceinline__ void acc_fp8x16(const v4u w, float (&o)[16]) {
#pragma unroll
    for (int q = 0; q < 4; ++q) { const f32x2 lo = __builtin_amdgcn_cvt_pk_f32_fp8((int)w[q], false), hi = __builtin_amdgcn_cvt_pk_f32_fp8((int)w[q], true);
        o[4 * q] += lo.x; o[4 * q + 1] += lo.y; o[4 * q + 2] += hi.x; o[4 * q + 3] += hi.y; }
}
__device__ __forceinline__ void comb_load(const unsigned char* S0, const unsigned char* S1, const unsigned char* S8, const unsigned char* H8, int t, int co, v4u& h8, v4u (&w)[9]) {
    h8 = *(const GAS v4u*)(H8 + (size_t)t * D + co);
#pragma unroll
    for (int k = 0; k < 4; ++k) { w[k] = *(const GAS v4u*)(S0 + ((size_t)k * T + t) * D + co); w[4 + k] = *(const GAS v4u*)(S1 + ((size_t)k * T + t) * D + co); }
    w[8] = *(const GAS v4u*)(S8 + (size_t)t * D + co);
}
__device__ __forceinline__ float comb_proc(unsigned char* hp8, const v4u h8, const v4u (&w)[9]) {
    float o[16];
#pragma unroll
    for (int i = 0; i < 16; ++i) o[i] = 0.f;
#pragma unroll
    for (int k = 0; k < 9; ++k) acc_fp8x16(w[k], o);
    float hf[16];
#pragma unroll
    for (int i = 0; i < 16; ++i) hf[i] = 0.f;
    acc_fp8x16(h8, hf);
    float ss = 0.f;
#pragma unroll
    for (int i = 0; i < 16; ++i) { hf[i] += o[i] * (1.f / SLOT_SCALE); ss += hf[i] * hf[i]; }
    v4u w8;
#pragma unroll
    for (int q = 0; q < 4; ++q) w8[q] = pg8::cvt4_fp8(hf[4 * q], hf[4 * q + 1], hf[4 * q + 2], hf[4 * q + 3]);
    *(GAS v4u*)hp8 = w8;
    return ss;
}
__device__ __forceinline__ void p7_combine(Frame& F, int n, int wg0, int nwg, int t_lo, int t_hi) {
    const int gw = t_lo + (F.bx - wg0) * NWAVES + F.wave, NGW = nwg * NWAVES, lane = F.lane; const int T = t_hi;
    const unsigned char* S0 = (const unsigned char*)F.out; const unsigned char* S1 = F.ws + WS_SLOT47; const unsigned char* S8 = F.ws + WS_SLOT8;
    unsigned char* H8 = F.ws + WS_H1F8; float* ssq2 = (float*)(F.ws + WS_SSQ2);
    const int coA = 16 * lane, coB = 1024 + 16 * lane;
    v4u hA, wA[9], hB, wB[9];
    if (gw < T) comb_load(S0, S1, S8, H8, gw, coA, hA, wA);
    for (int t = gw; t < T; t += NGW) {
        comb_load(S0, S1, S8, H8, t, coB, hB, wB);
        float ss = comb_proc(H8 + (size_t)t * D + coA, hA, wA);
        const int tn = t + NGW < T ? t + NGW : t;
        comb_load(S0, S1, S8, H8, tn, coA, hA, wA);
        ss += comb_proc(H8 + (size_t)t * D + coB, hB, wB);
        ss = wave_sum(ss);
        if (lane == 0) ssq2[t] = ss;
    }
}

__device__ __forceinline__ void p9_final(Frame& F, const bf16* H, const float* ssq, int nparts) {
    const int gw = F.bx * NWAVES + F.wave, NGW = F.G * NWAVES, lane = F.lane; const float* g = F.in[I_NFIN];
    for (int t = gw; t < T; t += NGW) {
        v4u w[4];
#pragma unroll
        for (int j = 0; j < 4; ++j) w[j] = *(const GAS v4u*)(H + (size_t)t * D + 512 * j + 8 * lane);
        float ss = 0.f;
        if (nparts > 0) { if (lane < nparts) ss = ssq[(size_t)lane * T + t]; }
        else {
#pragma unroll
            for (int j = 0; j < 4; ++j)
#pragma unroll
                for (int q = 0; q < 4; ++q) { const float lo = bflo(w[j][q]), hi = bfhi(w[j][q]); ss += lo * lo + hi * hi; }
        }
        const float r = __builtin_amdgcn_rsqf(wave_sum(ss) * (1.f / D) + EPS);
        float* o = F.out + (size_t)t * D;
#pragma unroll
        for (int j = 0; j < 4; ++j) { const int c = 512 * j + 8 * lane; const f32x4 g0 = *(const GAS f32x4*)(g + c), g1 = *(const GAS f32x4*)(g + c + 4);
            f32x4 a, b; a.x = bflo(w[j][0]) * r * g0.x; a.y = bfhi(w[j][0]) * r * g0.y; a.z = bflo(w[j][1]) * r * g0.z; a.w = bfhi(w[j][1]) * r * g0.w;
            b.x = bflo(w[j][2]) * r * g1.x; b.y = bfhi(w[j][2]) * r * g1.y; b.z = bflo(w[j][3]) * r * g1.z; b.w = bfhi(w[j][3]) * r * g1.w;
            *(GAS f32x4*)(o + c) = a; *(GAS f32x4*)(o + c + 4) = b; }
    }
}

__device__ __forceinline__ void p9_final8(Frame& F, const unsigned char* H8, const float* ssq) {
    const int gw = F.bx * NWAVES + F.wave, NGW = F.G * NWAVES, lane = F.lane; const float* g = F.in[I_NFIN];
    f32x4 gv[8];
#pragma unroll
    for (int q = 0; q < 8; ++q) gv[q] = *(const GAS f32x4*)(g + 256 * q + 4 * lane);
    for (int t0 = gw; t0 < T; t0 += 8 * NGW) {
        unsigned w[8][8]; float ss[8];
#pragma unroll
        for (int i = 0; i < 8; ++i) { const int t = t0 + i * NGW, tc = t < T ? t : T - 1;
#pragma unroll
            for (int q = 0; q < 8; ++q) w[i][q] = *(const GAS unsigned*)(H8 + (size_t)tc * D + 256 * q + 4 * lane);
            ss[i] = lane < 32 ? ssq[(size_t)lane * T + tc] : 0.f; }
#pragma unroll
        for (int i = 0; i < 8; ++i) { const int t = t0 + i * NGW;
            const float r = __builtin_amdgcn_rsqf(wave_sum(ss[i]) * (1.f / D) + EPS);
            if (t < T) { float* o = F.out + (size_t)t * D;
#pragma unroll
                for (int q = 0; q < 8; ++q) { const f32x2 a = __builtin_amdgcn_cvt_pk_f32_fp8((int)w[i][q], false), b2 = __builtin_amdgcn_cvt_pk_f32_fp8((int)w[i][q], true);
                    f32x4 v; v.x = a.x * r * gv[q].x; v.y = a.y * r * gv[q].y; v.z = b2.x * r * gv[q].z; v.w = b2.y * r * gv[q].w;
                    *(GAS f32x4*)(o + 256 * q + 4 * lane) = v; } }
        }
    }
}

struct Args { const float* in[21]; float* out; unsigned char* ws; int ph_lo, ph_hi, fin_mode, li; };
__global__ void __launch_bounds__(NTHR, 2) mk_fwd(Args args) {
    extern __shared__ __attribute__((aligned(16))) unsigned char lds[];
    Frame F;
    F.lds = (LAS unsigned char*)lds;
    F.tid = threadIdx.x; F.lane = F.tid & 63; F.wave = __builtin_amdgcn_readfirstlane(F.tid >> 6);
    F.G = gridDim.x; F.bx = blockIdx.x; F.ws = args.ws; F.out = args.out;
#pragma unroll
    for (int i = 0; i < 21; ++i) F.in[i] = args.in[i];
    volatile LAS unsigned* MISC = (volatile LAS unsigned*)(F.lds + MISC_OFF);
    if (F.tid < 32) MISC[F.tid] = 0u;
    __syncthreads();
    XcdBarrier bar = xcd_barrier_post((unsigned*)(F.ws + WS_CTL) + CW_BAR + args.li * XCD_BAR_WORDS, MISC + 8);
    unsigned char* ws = F.ws;
    const int lo = args.ph_lo, hi = args.ph_hi;
    LAS unsigned char* ring = F.lds + RING_OFF;
#define PHASE(k) if (lo <= (k) && (k) < hi)
#define PH(k) PHASE(k) { RELANE();
#define GRID_BAR() xcd_barrier(bar)
#define RELANE() do { int _t = threadIdx.x; asm volatile("" : "+v"(_t)); F.tid = _t; F.lane = _t & 63; F.wave = __builtin_amdgcn_readfirstlane(_t >> 6); } while (0)

    PHASE(0) { RELANE(); p0_prologue(F); GRID_BAR(); }
    PHASE(1) { RELANE();
        pg8::DenseSched S{T / 256, NPROJ / 256, F.G, F.bx, D * 2, (const char*)(ws + WS_WIN)};
        pg8::EpiProj E{(bf16*)(ws + WS_PROJ), (bf16*)(ws + WS_QKV), (const float*)(ws + WS_RMIX)};
        pg8::gemm_phase<false, 1>(F.tid, ring, (const char*)F.out, D * 2, S, E);
        GRID_BAR();
    }
    PHASE(2) { RELANE(); p2_mixer(F); GRID_BAR(); }
    PHASE(3) { RELANE();
        pg8::DenseSchedG S{T / 256, D / 256, F.G, F.bx, D, (const char*)(ws + WS_WOUT)};
        pg8::EpiResF32 E{(bf16*)(ws + WS_H1B), (const bf16*)F.out, D, ws + WS_H1F8, (float*)(ws + WS_SSQ1)};
        pg8::gemm_phase<true, 1>(F.tid, ring, (const char*)(ws + WS_YMIX8), D, S, E, 0x79797979, 0x7f7f7f7f);
        GRID_BAR();
    }
    PHASE(4) { RELANE(); p4_router(F); GRID_BAR(); }
    PHASE(5) { RELANE(); p4b_tables(F); GRID_BAR(); }
    PHASE(6) { RELANE();
        const int NT = group_setup<1>(F, 4);
        pg8::GroupSched<1> S{NT, 4, F.G, F.bx, D, 0, (const char*)(ws + WS_WGU), (size_t)1024 * D, (const LAS int*)(F.lds + TE_OFF), (const LAS unsigned*)(F.lds + RT_OFF)};
        pg8::EpiGateUp E{ws + WS_HPERM, (const float*)(ws + WS_RR)};
        pg8::gemm_phase<true, 0>(F.tid, ring, (const char*)(ws + WS_H1F8), D, S, E, 0x79797979, 0x7f7f7f7f);
        GRID_BAR();
    }
    {
        for (int n = 0; n < NSLICE; ++n) {
            PHASE(7 + 2 * n) { RELANE();
            const int NT = group_setup<2>(F, SLW / 256);
            pg8::GroupSched<2> S{NT, SLW / 256, F.G, F.bx, ED, (SLW / 256) * n, (const char*)(ws + WS_WDN), (size_t)D * ED, (const LAS int*)(F.lds + TE_OFF), (const LAS unsigned*)(F.lds + RT_OFF)};
            pg8::EpiDown E{(unsigned char*)F.out, ws + WS_SLOT47, ws + WS_SLOT8, (const float*)(ws + WS_RW), (const int*)(ws + WS_RDST)};
            pg8::gemm_phase<true, 0>(F.tid, ring, (const char*)(ws + WS_HPERM), ED, S, E, 0x79797979, 0x7f7f7f7f);
            GRID_BAR();
            }
            PHASE(8 + 2 * n) { RELANE();
            const int npl = F.G >= 2 * P8_NPLE ? P8_NPLE : 0;
            if (F.bx < npl) {
                pg8::DenseSched S{T / 256, D / 256, npl, F.bx, PLE * 2, (const char*)(ws + WS_WPP)};
                pg8::EpiF8x16 E{ws + WS_PP, D};
                pg8::gemm_phase<false, 1>(F.tid, ring, (const char*)(ws + WS_PB), PLE * 2, S, E);
                RELANE();
                p7_combine(F, n, 0, npl, 0, P8_TSPLIT);
            } else p7_combine(F, n, npl, F.G - npl, npl ? P8_TSPLIT : 0, ::T);
            GRID_BAR();
            }
        }
    }
    PHASE(15) { RELANE();
        if (F.G < 2 * P8_NPLE) {
        pg8::DenseSched S{T / 256, D / 256, F.G, F.bx, PLE * 2, (const char*)(ws + WS_WPP)};
        pg8::EpiF8x16 E{ws + WS_PP, D};
        pg8::gemm_phase<false, 1>(F.tid, ring, (const char*)(ws + WS_PB), PLE * 2, S, E);
        GRID_BAR();
        }
    }
    PHASE(16) { RELANE();
        pg8::DenseSchedG S{T / 256, D / 256, F.G, F.bx, D, (const char*)(ws + WS_WPG)};
        pg8::EpiPle E{ws + WS_H3, ws + WS_H1F8, ws + WS_PP, (const float*)(ws + WS_SSQ2), (float*)(ws + WS_SSQ3)};
        pg8::gemm_phase<true, 1>(F.tid, ring, (const char*)(ws + WS_H1F8), D, S, E, 0x79797979, 0x7f7f7f7f);
        GRID_BAR();
    }
    PHASE(17) { RELANE();
    if (args.fin_mode == 0) p9_final8(F, ws + WS_H3, (const float*)(ws + WS_SSQ3));
    else p9_final(F, (const bf16*)(ws + WS_H1B), nullptr, 0);
    }
}

extern "C" void kernel_launch(void* const* d_in, const int* in_sizes, int n_in, void* d_out, int out_size, void* d_ws, size_t ws_size, hipStream_t stream) {
    static int grid = 0;
    if (grid == 0) {
        int dev = 0, cus = 0;
        if (n_in != 21 || ws_size < WS_END) { fprintf(stderr, "kernel_launch: n_in %d ws %zu (need %zu)\n", n_in, ws_size, (size_t)WS_END); grid = -1; return; }
        if (hipGetDevice(&dev) != hipSuccess || hipDeviceGetAttribute(&cus, hipDeviceAttributeMultiprocessorCount, dev) != hipSuccess) { grid = -1; return; }
        if (hipFuncSetAttribute((const void*)mk_fwd, hipFuncAttributeMaxDynamicSharedMemorySize, LDS_BYTES) != hipSuccess) { fprintf(stderr, "hipFuncSetAttribute failed\n"); grid = -1; return; }
        int per_cu = 0;
        (void)hipOccupancyMaxActiveBlocksPerMultiprocessor(&per_cu, (const void*)mk_fwd, NTHR, LDS_BYTES);
        (void)hipGetLastError();
        grid = cus > 256 ? 256 : cus;
    }
    if (grid < 0) return;
    (void)hipMemsetAsync((char*)d_ws + WS_CTL, 0, CTL_ZERO_BYTES, stream);
    Args a{};
    for (int i = 0; i < 21; ++i) a.in[i] = (const float*)d_in[i];
    a.out = (float*)d_out; a.ws = (unsigned char*)d_ws; a.fin_mode = FIN_MODE;
#if PROBE_K >= 0
    a.ph_lo = 0; a.ph_hi = PROBE_K + 1; a.li = 0;
    hipLaunchKernelGGL(mk_fwd, dim3(grid), dim3(NTHR), LDS_BYTES, stream, a);
    a.ph_lo = PROBE_K; a.ph_hi = PH_HI; a.li = 1;
    hipLaunchKernelGGL(mk_fwd, dim3(grid), dim3(NTHR), LDS_BYTES, stream, a);
#else
    a.ph_lo = 0; a.ph_hi = PH_HI; a.li = 0;
    hipLaunchKernelGGL(mk_fwd, dim3(grid), dim3(NTHR), LDS_BYTES, stream, a);
#endif
}
```
